# Optimizing an MI355X kernel written in HIP

```python
import jax, jax.numpy as jnp
from jax import lax
import numpy as np

D_MODEL = 1024
BATCH = 16
SEQ = 2048
DEPTH = 2

N_MIXERS = 2
PLE_DIM = 256
NORM_EPS = 1e-6
A_HEADS = 8
A_QK_DIM = 128
A_V_DIM = 128
A_Q_RANK = 384
A_KV_RANK = 256
IDX_HEADS = 8
IDX_DIM = 64
TOPK_MAX = 256
Q_BLOCK = 128
A_WIDTH = A_HEADS * A_V_DIM
A_SPLITS = [A_Q_RANK, A_Q_RANK + A_KV_RANK, A_Q_RANK + A_KV_RANK + IDX_DIM, A_Q_RANK + A_KV_RANK + IDX_DIM + IDX_HEADS]
A_IN = A_SPLITS[-1] + A_WIDTH
R_HEADS = 4
R_QK_DIM = D_MODEL // R_HEADS
R_V_DIM = 2 * D_MODEL // R_HEADS
R_WIDTH = R_HEADS * R_V_DIM
R_CHUNK = 128
R_SPLITS = [D_MODEL, 2 * D_MODEL, 2 * D_MODEL + R_WIDTH]
R_IN = R_SPLITS[-1] + R_WIDTH
N_A_LAYERS = (DEPTH + 1) // 2
N_B_LAYERS = DEPTH // 2

kernel_name = "dsa_retention_interleaved_hybrid"


def rmsnorm(x, g):
    xf = x.astype(jnp.float32)
    y = xf * lax.rsqrt(jnp.mean(xf * xf, axis=-1, keepdims=True) + NORM_EPS)
    return (y * g.astype(jnp.float32)).astype(x.dtype)


def layernorm(x, g, b):
    xf = x.astype(jnp.float32)
    mu = jnp.mean(xf, axis=-1, keepdims=True)
    var = jnp.mean(jnp.square(xf - mu), axis=-1, keepdims=True)
    y = (xf - mu) * lax.rsqrt(var + NORM_EPS)
    return (y * g.astype(jnp.float32) + b.astype(jnp.float32)).astype(x.dtype)


def dsa_mixer(h, w_in, g_q, g_kv, w_q_up, w_idx_q, g_ik, b_ik, w_uk, w_uv, w_out):
    B, L, _ = h.shape
    z = h @ w_in
    c_q, c_kv, k_idx, w_idx, gate = jnp.split(z, A_SPLITS, axis=-1)
    c_q = rmsnorm(c_q, g_q)
    c_kv = rmsnorm(c_kv, g_kv)
    q = (c_q @ w_q_up).reshape(B, L, A_HEADS, A_QK_DIM)
    q_abs = jnp.einsum('blhd,hcd->blhc', q, w_uk) * (A_QK_DIM ** -0.5)
    q_idx = (c_q @ w_idx_q).reshape(B, L, IDX_HEADS, IDX_DIM)
    k_idx = layernorm(k_idx, g_ik, b_ik)
    w_idx = w_idx * (IDX_HEADS ** -0.5 * IDX_DIM ** -0.5)
    topk = min(TOPK_MAX, L // 4)
    nblk = L // Q_BLOCK
    key_pos = jnp.arange(L)

    def to_blocks(a):
        return a.reshape(B, nblk, Q_BLOCK, *a.shape[2:]).swapaxes(0, 1)

    def block(args):
        blk, qa, qi, wi = args
        t = blk * Q_BLOCK + jnp.arange(Q_BLOCK)
        sc = jnp.einsum('bqhd,bsd->bqhs', qi, k_idx)
        idx_score = jnp.einsum('bqhs,bqh->bqs', jax.nn.relu(sc), wi).astype(jnp.float32)
        causal = key_pos[None, :] <= t[:, None]
        idx_score = jnp.where(causal[None], idx_score, -jnp.inf)
        _, sel = lax.top_k(idx_score, topk)
        valid = sel <= t[None, :, None]
        kv_sel = jax.vmap(lambda c, i: c[i])(c_kv, sel)
        s = jnp.einsum('bqhc,bqkc->bqhk', qa, kv_sel).astype(jnp.float32)
        s = jnp.where(valid[:, :, None, :], s, -jnp.inf)
        pr = jax.nn.softmax(s, axis=-1).astype(kv_sel.dtype)
        return jnp.einsum('bqhk,bqkc->bqhc', pr, kv_sel)

    o = lax.map(block, (jnp.arange(nblk), to_blocks(q_abs), to_blocks(q_idx), to_blocks(w_idx)))
    o = o.swapaxes(0, 1).reshape(B, L, A_HEADS, A_KV_RANK)
    o = jnp.einsum('blhc,hcv->blhv', o, w_uv).reshape(B, L, A_WIDTH)
    return (o * jax.nn.silu(gate)) @ w_out


def rotate_every_two(x):
    x1 = x[..., ::2]
    x2 = x[..., 1::2]
    return jnp.stack((-x2, x1), axis=-1).reshape(x.shape)


def retention_mixer(h, w_in, w_out):
    B, L, _ = h.shape
    z = h @ w_in
    q, k, v, gate = jnp.split(z, R_SPLITS, axis=-1)
    q = q.reshape(B, L, R_HEADS, R_QK_DIM).astype(jnp.float32)
    k = k.reshape(B, L, R_HEADS, R_QK_DIM).astype(jnp.float32) * (R_QK_DIM ** -0.5)
    v = v.reshape(B, L, R_HEADS, R_V_DIM).astype(jnp.float32)
    pos = jnp.arange(L, dtype=jnp.float32)
    angle = 1.0 / (10000.0 ** jnp.linspace(0.0, 1.0, R_QK_DIM // 2, dtype=jnp.float32))
    angle = jnp.repeat(angle, 2)
    theta = pos[:, None] * angle[None, :]
    sin = jnp.sin(theta)[None, :, None, :]
    cos = jnp.cos(theta)[None, :, None, :]
    q = q * cos + rotate_every_two(q) * sin
    k = k * cos + rotate_every_two(k) * sin
    log_gamma = jnp.log(1.0 - 2.0 ** (-5.0 - jnp.arange(R_HEADS, dtype=jnp.float32)))
    ci = jnp.arange(R_CHUNK, dtype=jnp.float32)
    diff = ci[:, None] - ci[None, :]
    dmask = jnp.where(diff[None] >= 0, jnp.exp(diff[None] * log_gamma[:, None, None]), 0.0)
    xi = jnp.exp((ci[None, :] + 1.0) * log_gamma[:, None]).T
    zeta = jnp.exp((R_CHUNK - 1.0 - ci[None, :]) * log_gamma[:, None])
    chunk_decay = jnp.exp(R_CHUNK * log_gamma)
    n = L // R_CHUNK

    def to_chunks(a):
        return a.reshape(B, n, R_CHUNK, *a.shape[2:]).swapaxes(0, 1)

    def step(state, inp):
        qc, kc, vc = inp
        s = jnp.einsum('bihd,bjhd->bhij', qc, kc) * dmask[None]
        inner = jnp.einsum('bhij,bjhv->bihv', s, vc)
        cross = jnp.einsum('bihd,bhdv->bihv', qc, state) * xi[None, :, :, None]
        state = state * chunk_decay[None, :, None, None] + jnp.einsum('bjhd,bjhv,hj->bhdv', kc, vc, zeta)
        return state, inner + cross

    state0 = jnp.zeros((B, R_HEADS, R_QK_DIM, R_V_DIM), jnp.float32)
    _, o = lax.scan(step, state0, (to_chunks(q), to_chunks(k), to_chunks(v)))
    o = o.swapaxes(0, 1).reshape(B, L, R_HEADS, R_V_DIM)
    mu = jnp.mean(o, axis=-1, keepdims=True)
    var = jnp.mean(jnp.square(o - mu), axis=-1, keepdims=True)
    o = ((o - mu) * lax.rsqrt(var + NORM_EPS)).reshape(B, L, R_WIDTH).astype(h.dtype)
    return (o * jax.nn.silu(gate)) @ w_out


def setup_inputs(seed: int = 0) -> dict:
    key = jax.random.key(seed)
    ks = jax.random.split(key, 24)
    f32 = jnp.float32

    def nrm(k, shape, fan_in):
        return jax.random.normal(k, shape, f32) * (fan_in ** -0.5)

    def gain(k, shape):
        return 1.0 + 0.02 * jax.random.normal(k, shape, f32)

    return {
        "x": jax.random.normal(ks[0], (BATCH, SEQ, D_MODEL), f32),
        "p": jax.random.normal(ks[1], (DEPTH, BATCH, SEQ, PLE_DIM), f32),
        "g_pre": gain(ks[2], (DEPTH, D_MODEL)),
        "a_w_in": nrm(ks[3], (N_A_LAYERS, D_MODEL, A_IN), D_MODEL),
        "a_g_q": gain(ks[4], (N_A_LAYERS, A_Q_RANK)),
        "a_g_kv": gain(ks[5], (N_A_LAYERS, A_KV_RANK)),
        "a_w_q_up": nrm(ks[6], (N_A_LAYERS, A_Q_RANK, A_HEADS * A_QK_DIM), A_Q_RANK),
        "a_w_idx_q": nrm(ks[7], (N_A_LAYERS, A_Q_RANK, IDX_HEADS * IDX_DIM), A_Q_RANK),
        "a_g_ik": gain(ks[8], (N_A_LAYERS, IDX_DIM)),
        "a_b_ik": 0.02 * jax.random.normal(ks[9], (N_A_LAYERS, IDX_DIM), f32),
        "a_w_uk": nrm(ks[10], (N_A_LAYERS, A_HEADS, A_KV_RANK, A_QK_DIM), A_KV_RANK),
        "a_w_uv": nrm(ks[11], (N_A_LAYERS, A_HEADS, A_KV_RANK, A_V_DIM), A_KV_RANK),
        "a_w_out": nrm(ks[12], (N_A_LAYERS, A_WIDTH, D_MODEL), A_WIDTH),
        "r_w_in": nrm(ks[13], (N_B_LAYERS, D_MODEL, R_IN), D_MODEL),
        "r_w_out": nrm(ks[14], (N_B_LAYERS, R_WIDTH, D_MODEL), R_WIDTH),
        "w_ple_gate": nrm(ks[15], (DEPTH, D_MODEL, D_MODEL), D_MODEL),
        "g_ple": gain(ks[16], (DEPTH, D_MODEL)),
        "w_ple": nrm(ks[17], (DEPTH, PLE_DIM, D_MODEL), PLE_DIM),
        "g_final": gain(ks[18], (D_MODEL,)),
    }


def reference(x, p, g_pre, a_w_in, a_g_q, a_g_kv, a_w_q_up, a_w_idx_q, a_g_ik, a_b_ik,
              a_w_uk, a_w_uv, a_w_out, r_w_in, r_w_out, w_ple_gate, g_ple, w_ple, g_final):
    h = x
    for i in range(DEPTH):
        hn = rmsnorm(h, g_pre[i])
        j = i // N_MIXERS
        if i % N_MIXERS == 0:
            y = dsa_mixer(hn, a_w_in[j], a_g_q[j], a_g_kv[j], a_w_q_up[j], a_w_idx_q[j],
                          a_g_ik[j], a_b_ik[j], a_w_uk[j], a_w_uv[j], a_w_out[j])
        else:
            y = retention_mixer(hn, r_w_in[j], r_w_out[j])
        h = h + y
        ple_gate = jax.nn.sigmoid(rmsnorm(h, g_ple[i]) @ w_ple_gate[i])
        h = h + (p[i] @ w_ple[i]) * ple_gate
    return rmsnorm(h, g_final)
```

```cpp
#include <hip/hip_runtime.h>
#include <hip/hip_cooperative_groups.h>
#include <cstdio>
#include <cstdint>
namespace cg = cooperative_groups;
#ifndef MK_DUP_MASK
#define MK_DUP_MASK 0
#endif
#ifndef MK_P3_REPA
#define MK_P3_REPA 0
#endif
#ifndef MK_P3_REPB
#define MK_P3_REPB 0
#endif
#ifndef MK_EPI_REP
#define MK_EPI_REP 0
#endif
#ifndef MK_DUP_N
#define MK_DUP_N 3
#endif

typedef _Float16 h16;
typedef _Float16 h16x2 __attribute__((ext_vector_type(2)));
typedef _Float16 h16x4 __attribute__((ext_vector_type(4)));
typedef _Float16 h16x8 __attribute__((ext_vector_type(8)));
typedef float f32x2 __attribute__((ext_vector_type(2)));
typedef float f32x4 __attribute__((ext_vector_type(4)));
typedef unsigned u32x4 __attribute__((ext_vector_type(4)));

constexpr int NB = 16, L = 2048, T = NB * L, D = 1024;
constexpr float EPS = 1e-6f;
constexpr int NPH = 12;
constexpr int NTHREADS = 512, NWAVES = 8;
constexpr int LDS_BYTES = 147456;

constexpr size_t MiB = (size_t)1 << 20;
constexpr size_t WS_WAIN = 0 * MiB;
constexpr size_t WS_WQ = 4 * MiB;
constexpr size_t WS_WKV = 6 * MiB;
constexpr size_t WS_WAOUT = 7 * MiB;
constexpr size_t WS_WPG = 9 * MiB;
constexpr size_t WS_WPLE = 13 * MiB;
constexpr size_t WS_WRIN = 14 * MiB;
constexpr size_t WS_WROUT = 26 * MiB;
constexpr size_t WS_SINCOS = 30 * MiB;
constexpr size_t WS_SQKV = 32 * MiB;
constexpr size_t WS_SQQ = 33 * MiB;
constexpr size_t WS_SQH = 34 * MiB;
constexpr size_t WS_KIDXN = 42 * MiB;
constexpr size_t WS_WIDX = 46 * MiB;
constexpr size_t WS_BAR = 47 * MiB;
constexpr size_t WS_PH1 = 48 * MiB;
constexpr size_t WS_R1 = 64 * MiB;
constexpr size_t WS_R2 = 128 * MiB;
constexpr size_t WS_R3 = 192 * MiB;
constexpr size_t WS_R4 = 256 * MiB;
constexpr size_t WS_R5 = 320 * MiB;
constexpr size_t WS_PH0 = 384 * MiB;
constexpr size_t WS_CQX = 400 * MiB;
constexpr size_t WS_CKV = 432 * MiB;
constexpr size_t WS_QIDX = 448 * MiB;
constexpr size_t WS_MASK = 480 * MiB;
constexpr size_t WS_AO = 400 * MiB;
constexpr size_t WS_RG = 384 * MiB;
constexpr size_t WS_END = 512 * MiB;

struct Params { const float* in[19]; float* out; unsigned char* ws; int ph_lo, ph_hi; };

__constant__ float kAngle[128] = {
    1.000000000e+00f, 9.300450087e-01f, 8.649836779e-01f, 8.044736385e-01f, 7.481966019e-01f, 6.958565116e-01f, 6.471778154e-01f, 6.019044518e-01f,
    5.597981811e-01f, 5.206375122e-01f, 4.842162728e-01f, 4.503428936e-01f, 4.188391268e-01f, 3.895392120e-01f, 3.622889817e-01f, 3.369450271e-01f,
    3.133740425e-01f, 2.914519310e-01f, 2.710633874e-01f, 2.521011233e-01f, 2.344653904e-01f, 2.180633694e-01f, 2.028087080e-01f, 1.886212230e-01f,
    1.754262149e-01f, 1.631542742e-01f, 1.517407894e-01f, 1.411257535e-01f, 1.312533021e-01f, 1.220714748e-01f, 1.135319397e-01f, 1.055898219e-01f,
    9.820328653e-02f, 9.133346379e-02f, 8.494423330e-02f, 7.900195569e-02f, 7.347535342e-02f, 6.833537668e-02f, 6.355497986e-02f, 5.910899118e-02f,
    5.497401953e-02f, 5.112830922e-02f, 4.755162448e-02f, 4.422515258e-02f, 4.113136977e-02f, 3.825402260e-02f, 3.557796404e-02f, 3.308910504e-02f,
    3.077435680e-02f, 2.862153389e-02f, 2.661931701e-02f, 2.475716174e-02f, 2.302526683e-02f, 2.141453326e-02f, 1.991648041e-02f, 1.852322184e-02f,
    1.722742990e-02f, 1.602228358e-02f, 1.490144618e-02f, 1.385901403e-02f, 1.288950257e-02f, 1.198781747e-02f, 1.114920899e-02f, 1.036926545e-02f,
    9.643883444e-03f, 8.969245479e-03f, 8.341802284e-03f, 7.758250926e-03f, 7.215522230e-03f, 6.710760761e-03f, 6.241309457e-03f, 5.804697983e-03f,
    5.398627371e-03f, 5.020966288e-03f, 4.669724498e-03f, 4.343053792e-03f, 4.039235413e-03f, 3.756670747e-03f, 3.493872471e-03f, 3.249458736e-03f,
    3.022142686e-03f, 2.810728736e-03f, 2.614103956e-03f, 2.431234345e-03f, 2.261157380e-03f, 2.102978062e-03f, 1.955864020e-03f, 1.819041790e-03f,
    1.691789716e-03f, 1.573440502e-03f, 1.463370281e-03f, 1.361000235e-03f, 1.265791478e-03f, 1.177242957e-03f, 1.094888896e-03f, 1.018295996e-03f,
    9.470609948e-04f, 8.808093844e-04f, 8.191923262e-04f, 7.618857198e-04f, 7.085879333e-04f, 6.590186385e-04f, 6.129170069e-04f, 5.700403708e-04f,
    5.301629426e-04f, 4.930753494e-04f, 4.585822753e-04f, 4.265021416e-04f, 3.966661752e-04f, 3.689173318e-04f, 3.431097430e-04f, 3.191074939e-04f,
    2.967843320e-04f, 2.760227653e-04f, 2.567135962e-04f, 2.387551940e-04f, 2.220530587e-04f, 2.065193403e-04f, 1.920722716e-04f, 1.786358480e-04f,
    1.661392889e-04f, 1.545170089e-04f, 1.437077590e-04f, 1.336546848e-04f, 1.243048755e-04f, 1.156091312e-04f, 1.075216787e-04f, 9.999999747e-05f,
};

__device__ __forceinline__ float wave_sum(float v) {
#pragma unroll
    for (int o = 1; o < 64; o <<= 1) v += __shfl_xor(v, o);
    return v;
}
__device__ __forceinline__ float wave_max(float v) {
#pragma unroll
    for (int o = 1; o < 64; o <<= 1) v = fmaxf(v, __shfl_xor(v, o));
    return v;
}
#define DPP_RED6S(v, F) do { v = F<0x111, 0xf>(v); v = F<0x112, 0xf>(v); v = F<0x114, 0xf>(v); v = F<0x118, 0xf>(v); v = F<0x142, 0xa>(v); v = F<0x143, 0xc>(v); } while (0)
template <int CTRL, int RMASK> __device__ __forceinline__ float fadd_dpp_(float a) { return a + __builtin_bit_cast(float, __builtin_amdgcn_update_dpp(0, __builtin_bit_cast(int, a), CTRL, RMASK, 0xf, false)); }
__device__ __forceinline__ float wave_sum_dpp(float v) { DPP_RED6S(v, fadd_dpp_); return __builtin_bit_cast(float, __builtin_amdgcn_readlane(__builtin_bit_cast(int, v), 63)); }
__device__ __forceinline__ float dot4(f32x4 a) { return (a[0] * a[0] + a[1] * a[1]) + (a[2] * a[2] + a[3] * a[3]); }
__device__ __forceinline__ float fq_sum(float s) {
    { auto rr = __builtin_amdgcn_permlane16_swap(__float_as_uint(s), __float_as_uint(s), false, false); s = __uint_as_float(rr[0]) + __uint_as_float(rr[1]); }
    { auto rr = __builtin_amdgcn_permlane32_swap(__float_as_uint(s), __float_as_uint(s), false, false); s = __uint_as_float(rr[0]) + __uint_as_float(rr[1]); }
    return s;
}
__device__ __forceinline__ h16x8 pack8(f32x4 a, f32x4 b) {
    h16x8 r; r[0] = (h16)a[0]; r[1] = (h16)a[1]; r[2] = (h16)a[2]; r[3] = (h16)a[3]; r[4] = (h16)b[0]; r[5] = (h16)b[1]; r[6] = (h16)b[2]; r[7] = (h16)b[3]; return r;
}
__device__ __forceinline__ h16x4 pack4(f32x4 a) { h16x4 r; r[0] = (h16)a[0]; r[1] = (h16)a[1]; r[2] = (h16)a[2]; r[3] = (h16)a[3]; return r; }
__device__ __forceinline__ float sigmoidf_(float x) { return __builtin_amdgcn_rcpf(1.0f + __builtin_amdgcn_exp2f(-1.4426950408889634f * x)); }
__device__ __forceinline__ float siluf_(float x) { return x * __builtin_amdgcn_rcpf(1.0f + __builtin_amdgcn_exp2f(-1.4426950408889634f * x)); }
#define LDS_FENCE() do { asm volatile("s_waitcnt lgkmcnt(0)" ::: "memory"); } while (0)
__device__ __forceinline__ int my_tid(int wv) { unsigned m = ~0u; asm volatile("" : "+s"(m)); int t = wv * 64 + (int)__builtin_amdgcn_mbcnt_hi(m, __builtin_amdgcn_mbcnt_lo(m, 0u)); asm volatile("" : "+v"(t)); return t; }
template <class Tp> __device__ __forceinline__ Tp* opaque_ptr(Tp* p) { size_t z = 0; asm volatile("" : "+s"(z)); return p + z; }

#define PG8_LAS __attribute__((address_space(3)))
__device__ __forceinline__ constexpr int pg8_stage_bytes() { return 131072; }
struct Unit { int pm, pn; };
struct Gemm { const h16* A; const h16* Bt; int lda, ldb, M, N, K; };
__device__ __forceinline__ int perm32(int rho) { const int n = rho >> 4, i = rho & 15; return 8 * (i >> 2) + 4 * n + (i & 3); }

template <class Epi>
__device__ __forceinline__ void gemm_simple(const Gemm g, const Epi& E, int blk, int nblk, int wv) {
    const int tid = my_tid(wv), wid = __builtin_amdgcn_readfirstlane(tid >> 6), lane = tid & 63, wr = wid >> 2, wc = wid & 3, fr = lane & 15, fq = lane >> 4;
    const int nN = g.N / 256, nU = (g.M / 256) * nN;
    for (int u = blk; u < nU; u += nblk) {
        Unit un; un.pm = u / nN; un.pn = u % nN;
        f32x4 acc[2][2][4][2];
#pragma unroll
        for (int a = 0; a < 2; ++a)
#pragma unroll
            for (int b = 0; b < 2; ++b)
#pragma unroll
                for (int m = 0; m < 4; ++m)
#pragma unroll
                    for (int n = 0; n < 2; ++n) acc[a][b][m][n] = (f32x4){0.f, 0.f, 0.f, 0.f};
        const h16* Ap = g.A + (size_t)(un.pm * 256 + wr * 64 + fr) * g.lda + fq * 8;
        const h16* Bp[2];
#pragma unroll
        for (int n = 0; n < 2; ++n) Bp[n] = g.Bt + (size_t)(un.pn * 256 + wc * 32 + (Epi::PERM ? perm32(16 * n + fr) : 16 * n + fr)) * g.ldb + fq * 8;
        for (int k0 = 0; k0 < g.K; k0 += 32) {
            h16x8 At[2][4], Bt[2][2];
#pragma unroll
            for (int ai = 0; ai < 2; ++ai)
#pragma unroll
                for (int m = 0; m < 4; ++m) At[ai][m] = *(const h16x8*)(Ap + (size_t)(ai * 128 + m * 16) * g.lda + k0);
#pragma unroll
            for (int bj = 0; bj < 2; ++bj)
#pragma unroll
                for (int n = 0; n < 2; ++n) Bt[bj][n] = *(const h16x8*)(Bp[n] + (size_t)(bj * 128) * g.ldb + k0);
#pragma unroll
            for (int ai = 0; ai < 2; ++ai)
#pragma unroll
                for (int bj = 0; bj < 2; ++bj)
#pragma unroll
                    for (int m = 0; m < 4; ++m)
#pragma unroll
                        for (int n = 0; n < 2; ++n) acc[ai][bj][m][n] = __builtin_amdgcn_mfma_f32_16x16x32_f16(Bt[bj][n], At[ai][m], acc[ai][bj][m][n], 0, 0, 0);
        }
        E(acc, un, wr, wc, fr, fq, nullptr);
    }
}

template <class E_> struct epi_fused { template <class X> static constexpr bool g(decltype(X::FUSED_FINAL)*) { return X::FUSED_FINAL; } template <class X> static constexpr bool g(...) { return false; } static constexpr bool v = g<E_>(nullptr); };
namespace pg8 {
constexpr int BM = 256, BK = 64, HALF = 128, HTB = HALF * BK * 2  , STAGE_BYTES = 8 * HTB, NXCD = 8, WGM = 8;
__host__ __device__ __forceinline__ int lds_byte(int r, int c) { const int st = (r >> 4) * 2 + (c >> 5), rr = r & 15, cc = c & 31, ob = rr * 64 + cc * 2; return st * 1024 + (ob ^ (((ob >> 9) & 1) << 5)); }
__host__ __device__ __forceinline__ void stage_rc(int b, int& R, int& C) { const int st = b / 1024, sb = b % 1024, swz = sb ^ (((sb >> 9) & 1) << 5); R = (st >> 1) * 16 + swz / 64; C = (st & 1) * 32 + (swz % 64) / 2; }
struct StaticOrder {
    int nM, nN, nwg, G, c;
    __host__ __device__ void init(int M, int N, int G_, int c_) { nM = M / BM; nN = N / BM; nwg = nM * nN; G = G_; c = c_; }
    __host__ __device__ bool next(int i, Unit& u) const {
        const long Lq = (long)i * G + c; if (Lq >= nwg) return false;
        int wgid = (int)Lq; { const int q = nwg / NXCD, r = nwg % NXCD, xcd = wgid % NXCD, off = wgid / NXCD; wgid = (xcd < r ? xcd * (q + 1) : r * (q + 1) + (xcd - r) * q) + off; }
        const int nig = WGM * nN, gid = wgid / nig, fm = gid * WGM, gsz = (nM - fm) < WGM ? (nM - fm) : WGM;
        u.pm = fm + ((wgid % nig) % gsz); u.pn = (wgid % nig) / gsz; return true;
    }
};
template <class Epi, bool ALIGN_EPI = true>
__device__ __forceinline__ void gemm_phase(PG8_LAS unsigned char* lds, const Gemm g, const StaticOrder& S, const Epi& E, int wv) {
    const int tid = my_tid(wv), wid = __builtin_amdgcn_readfirstlane(tid >> 6), lane = tid & 63, wr = wid >> 2, wc = wid & 3, fr = lane & 15, fq = lane >> 4;
    const int K = g.K, nt = K / BK;
    unsigned voffA[2], voffB[2];
#pragma unroll
    for (int i = 0; i < 2; ++i) { int R, C; stage_rc(tid * 16 + i * 8192, R, C); const int Rb = Epi::PERM ? ((R & ~31) + perm32(R & 31)) : R;
        voffA[i] = (unsigned)(R * g.lda + C) * 2u; voffB[i] = (unsigned)(Rb * g.ldb + C) * 2u; }
    const size_t kstep = (size_t)(BK * 2);
    const size_t hstepA = (size_t)HALF * g.lda * 2, hstepB = (size_t)HALF * g.ldb * 2;
    const size_t tstepA = 2 * hstepA, tstepB = 2 * hstepB;
    const unsigned ldsw = (unsigned)wid * 1024u;
    const int aoff = lds_byte(wr * 64 + fr, fq * 8), boff = lds_byte(wc * 32 + fr, fq * 8);
#define PG8_SA(b, h) (((b) * 2 + (h)) * HTB)
#define PG8_SB(b, h) ((4 + (b) * 2 + (h)) * HTB)
#define PG8_STAGE(bufoff, gbase, voff) do { _Pragma("unroll") for (int _i = 0; _i < 2; ++_i) \
        __builtin_amdgcn_global_load_lds((const unsigned*)((const char*)(gbase) + (voff)[_i]), (PG8_LAS unsigned*)(lds + (bufoff) + ldsw + _i * 8192), 16, 0, 0); } while (0)
#define PG8_LDA(dst, b, h) do { _Pragma("unroll") for (int m = 0; m < 4; ++m) _Pragma("unroll") for (int k = 0; k < 2; ++k) dst[m][k] = *(const PG8_LAS h16x8*)(lds + PG8_SA(b, h) + aoff + m * 2048 + k * 1024); } while (0)
#define PG8_LDB(dst, b, h) do { _Pragma("unroll") for (int n = 0; n < 2; ++n) _Pragma("unroll") for (int k = 0; k < 2; ++k) dst[n][k] = *(const PG8_LAS h16x8*)(lds + PG8_SB(b, h) + boff + n * 2048 + k * 1024); } while (0)
#define PG8_MMA(ai, bj, At, Bt) do { __builtin_amdgcn_s_setprio(1); _Pragma("unroll") for (int m = 0; m < 4; ++m) _Pragma("unroll") for (int n = 0; n < 2; ++n) _Pragma("unroll") for (int k = 0; k < 2; ++k) \
        acc[ai][bj][m][n] = __builtin_amdgcn_mfma_f32_16x16x32_f16(Bt[n][k], At[m][k], acc[ai][bj][m][n], 0, 0, 0); __builtin_amdgcn_s_setprio(0); } while (0)
#define PG8_WAIT_V(n) asm volatile("s_waitcnt vmcnt(" #n ")" ::: "memory")
#define PG8_WAIT_L(n) asm volatile("s_waitcnt lgkmcnt(" #n ")" ::: "memory")
#define PG8_BAR __builtin_amdgcn_s_barrier()
#define PG8_SCHED __builtin_amdgcn_sched_barrier(0)
    Unit cur, nxt; int ui = 0;
    if (!S.next(0, cur)) return;
    PG8_LAS float* rtab = (PG8_LAS float*)(lds + STAGE_BYTES);
#define PG8_FILL(U, PAR) do { const int tf_ = my_tid(wv); if (E.sqp != nullptr && tf_ < 256) { const size_t r_ = (size_t)(U).pm * 256 + tf_; float s_ = 0.f; \
        for (int j_ = 0; j_ < E.sqn; j_ += 4) { const f32x4 q_ = *(const f32x4*)(E.sqp + r_ * E.sqn + j_); s_ += (q_[0] + q_[1]) + (q_[2] + q_[3]); } \
        rtab[(PAR) * 256 + tf_] = rsqrtf(s_ * E.sqi + EPS); } } while (0)
    PG8_FILL(cur, 0);
    f32x4 acc[2][2][4][2];
#pragma unroll
    for (int a = 0; a < 2; ++a)
#pragma unroll
        for (int b = 0; b < 2; ++b)
#pragma unroll
            for (int m = 0; m < 4; ++m)
#pragma unroll
                for (int n = 0; n < 2; ++n) acc[a][b][m][n] = (f32x4){0.f, 0.f, 0.f, 0.f};
    h16x8 At[4][2], B0[2][2], B1[2][2];
    const char* cA = (const char*)g.A + (size_t)cur.pm * tstepA; const char* cB = (const char*)g.Bt + (size_t)cur.pn * tstepB;
    PG8_STAGE(PG8_SB(0, 0), cB, voffB); PG8_STAGE(PG8_SB(0, 1), cB + hstepB, voffB); PG8_STAGE(PG8_SA(0, 0), cA, voffA); PG8_STAGE(PG8_SA(0, 1), cA + hstepA, voffA);
    if (wr == 1) PG8_BAR;
    PG8_WAIT_V(2); PG8_BAR;
    PG8_STAGE(PG8_SB(1, 0), cB + kstep, voffB); PG8_STAGE(PG8_SA(1, 0), cA + kstep, voffA); PG8_STAGE(PG8_SB(1, 1), cB + hstepB + kstep, voffB);
    PG8_WAIT_V(6); PG8_BAR;
    for (;;) {
        const bool has_next = S.next(ui + 1, nxt);
        const char* nA = has_next ? (const char*)g.A + (size_t)nxt.pm * tstepA : cA; const char* nB = has_next ? (const char*)g.Bt + (size_t)nxt.pn * tstepB : cB;
        for (int t = 0; t < nt; t += 2) {
            const bool last = (t == nt - 2);
            const char* a1 = cA + (size_t)(t + 1) * kstep;
            const char* a2 = last ? nA : cA + (size_t)(t + 2) * kstep; const char* b2 = last ? nB : cB + (size_t)(t + 2) * kstep;
            const char* a3 = a2 + kstep; const char* b3 = b2 + kstep;
            PG8_LDB(B0, 0, 0); PG8_LDB(B1, 0, 1); PG8_SCHED; PG8_LDA(At, 0, 0); PG8_STAGE(PG8_SA(1, 1), a1 + hstepA, voffA);
            PG8_WAIT_V(8); PG8_WAIT_L(0); PG8_BAR; PG8_MMA(0, 0, At, B0); PG8_MMA(0, 1, At, B1); PG8_BAR; PG8_SCHED;
            PG8_LDA(At, 0, 1); PG8_STAGE(PG8_SB(0, 0), b2, voffB); PG8_STAGE(PG8_SB(0, 1), b2 + hstepB, voffB); PG8_STAGE(PG8_SA(0, 0), a2, voffA);
            PG8_WAIT_V(8); PG8_WAIT_L(0); PG8_BAR; PG8_MMA(1, 0, At, B0); PG8_MMA(1, 1, At, B1); PG8_BAR; PG8_SCHED;
            PG8_LDB(B0, 1, 0); PG8_LDB(B1, 1, 1); PG8_SCHED; PG8_LDA(At, 1, 0); PG8_STAGE(PG8_SA(0, 1), a2 + hstepA, voffA);
            PG8_WAIT_V(8); PG8_WAIT_L(0); PG8_BAR; PG8_MMA(0, 0, At, B0); PG8_MMA(0, 1, At, B1); PG8_BAR; PG8_SCHED;
            PG8_LDA(At, 1, 1); PG8_STAGE(PG8_SB(1, 0), b3, voffB); PG8_STAGE(PG8_SB(1, 1), b3 + hstepB, voffB); PG8_STAGE(PG8_SA(1, 0), a3, voffA);
            PG8_WAIT_V(8); PG8_WAIT_L(0); PG8_BAR; PG8_MMA(1, 0, At, B0); PG8_MMA(1, 1, At, B1); PG8_BAR; PG8_SCHED;
        }
        if constexpr (ALIGN_EPI) { if (wr == 0) PG8_BAR; }
        { const int te_ = my_tid(wv), le_ = te_ & 63;
          if constexpr (epi_fused<Epi>::v) E.final(acc, cur, wr, wc, le_ & 15, le_ >> 4, rtab + (ui & 1) * 256, lds, te_); else E(acc, cur, wr, wc, le_ & 15, le_ >> 4, rtab + (ui & 1) * 256); }
        if (has_next) PG8_FILL(nxt, (ui + 1) & 1);
        if (!has_next) break;
#pragma unroll
        for (int a = 0; a < 2; ++a)
#pragma unroll
            for (int b = 0; b < 2; ++b)
#pragma unroll
                for (int m = 0; m < 4; ++m)
#pragma unroll
                    for (int n = 0; n < 2; ++n) acc[a][b][m][n] = (f32x4){0.f, 0.f, 0.f, 0.f};
        cur = nxt; cA = nA; cB = nB; ++ui;
        if constexpr (ALIGN_EPI) { if (wr == 1) PG8_BAR; }
    }
    PG8_WAIT_V(0);
    if constexpr (!ALIGN_EPI) { if (wr == 0) PG8_BAR; }
    PG8_BAR;
#undef PG8_FILL
#undef PG8_SA
#undef PG8_SB
#undef PG8_STAGE
#undef PG8_LDA
#undef PG8_LDB
#undef PG8_MMA
#undef PG8_WAIT_V
#undef PG8_WAIT_L
#undef PG8_BAR
#undef PG8_SCHED
}
}
template <class Epi>
__device__ __forceinline__ void gemm_run(unsigned char* lds, const Gemm g, const Epi& E, int blk, int nblk, int wv) {
    pg8::StaticOrder S; S.init(g.M, g.N, nblk, blk);
    pg8::gemm_phase<Epi, true>((PG8_LAS unsigned char*)lds, g, S, E, wv);
}

struct EpiInA {
    static constexpr bool PERM = true;
    h16* ckv; h16* cqx; h16* sg; float* sqkv; float* sqq; const float* sqp; int sqn; float sqi;
    __device__ __forceinline__ void operator()(const f32x4 (&acc)[2][2][4][2], const Unit& u, int wr, int wc, int fr, int fq, const PG8_LAS float* rtab) const {
        asm volatile("" : "+v"(fr), "+v"(fq));
#pragma unroll
        for (int ai = 0; ai < 2; ++ai)
#pragma unroll
            for (int m = 0; m < 4; ++m) {
                const size_t r = (size_t)u.pm * 256 + ai * 128 + wr * 64 + m * 16 + fr;
                float ss = 0.f;
#pragma unroll
                for (int bj = 0; bj < 2; ++bj) {
                    const int c0 = bj * 128 + wc * 32 + 8 * fq;
                    f32x4 v0 = acc[ai][bj][m][0], v1 = acc[ai][bj][m][1];
                    if (u.pn == 0) { *(h16x8*)(ckv + r * 256 + c0) = pack8(v0, v1); ss += dot4(v0) + dot4(v1); }
                    else if (u.pn <= 2) { const int cq = (u.pn - 1) * 256 + c0; *(h16x8*)(cqx + r * 512 + cq) = pack8(v0, v1); if (cq < 384) ss += dot4(v0) + dot4(v1); }
                    else {
#pragma unroll
                        for (int e = 0; e < 4; ++e) { v0[e] = siluf_(v0[e]); v1[e] = siluf_(v1[e]); }
                        *(h16x8*)(sg + r * 1024 + (u.pn - 3) * 256 + c0) = pack8(v0, v1);
                    }
                }
                if (u.pn <= 2) {
                    ss = fq_sum(ss);
                    if (fq == 0) { if (u.pn == 0) sqkv[r * 4 + wc] = ss; else sqq[r * 8 + (u.pn - 1) * 4 + wc] = ss; }
                }
            }
    }
};
__device__ __forceinline__ unsigned cvtpk_bf16(float lo, float hi) { unsigned r; asm volatile("v_cvt_pk_bf16_f32 %0, %1, %2" : "=v"(r) : "v"(lo), "v"(hi)); return r; }
struct EpiScale {
    static constexpr bool PERM = true;
    const float* sqp; int sqn; float sqi; h16* d0; h16* d1; int split, ld0, ld1, bf0, bf1;
    __device__ __forceinline__ void operator()(const f32x4 (&acc)[2][2][4][2], const Unit& u, int wr, int wc, int fr, int fq, const PG8_LAS float* rtab) const {
        asm volatile("" : "+v"(fr), "+v"(fq));
#pragma unroll
        for (int ai = 0; ai < 2; ++ai)
#pragma unroll
            for (int m = 0; m < 4; ++m) {
                const size_t r = (size_t)u.pm * 256 + ai * 128 + wr * 64 + m * 16 + fr;
                float rs = 1.f;
                if (sqp) rs = rtab[ai * 128 + wr * 64 + m * 16 + fr];
#pragma unroll
                for (int bj = 0; bj < 2; ++bj) {
                    const int c0 = bj * 128 + wc * 32 + 8 * fq;
                    const f32x4 v0 = acc[ai][bj][m][0] * rs, v1 = acc[ai][bj][m][1] * rs;
                    const bool first = u.pn < split;
                    h16* dst = first ? d0 + r * ld0 + u.pn * 256 + c0 : d1 + r * ld1 + (u.pn - split) * 256 + c0;
                    if (first ? bf0 : bf1) { u32x4 w; w[0] = cvtpk_bf16(v0[0], v0[1]); w[1] = cvtpk_bf16(v0[2], v0[3]); w[2] = cvtpk_bf16(v1[0], v1[1]); w[3] = cvtpk_bf16(v1[2], v1[3]); *(u32x4*)dst = w; }
                    else *(h16x8*)dst = pack8(v0, v1);
                }
            }
    }
};
struct EpiRes {
    static constexpr bool PERM = true;
    const float* basef; const h16* baseh; h16* HH; float* sq; const float* sqp; int sqn; float sqi;
    __device__ __forceinline__ void operator()(const f32x4 (&acc)[2][2][4][2], const Unit& u, int wr, int wc, int fr, int fq, const PG8_LAS float* rtab) const {
        asm volatile("" : "+v"(fr), "+v"(fq));
#pragma unroll
        for (int ai = 0; ai < 2; ++ai)
#pragma unroll
            for (int m = 0; m < 4; ++m) {
                const size_t r = (size_t)u.pm * 256 + ai * 128 + wr * 64 + m * 16 + fr;
                float ss = 0.f;
#pragma unroll
                for (int bj = 0; bj < 2; ++bj) {
                    const size_t o = r * 1024 + u.pn * 256 + bj * 128 + wc * 32 + 8 * fq;
                    f32x4 h0, h1;
                    if (basef) { h0 = *(const f32x4*)(basef + o); h1 = *(const f32x4*)(basef + o + 4); }
                    else { const h16x8 b = *(const h16x8*)(baseh + o); h0 = (f32x4){(float)b[0], (float)b[1], (float)b[2], (float)b[3]}; h1 = (f32x4){(float)b[4], (float)b[5], (float)b[6], (float)b[7]}; }
                    h0 = h0 + acc[ai][bj][m][0]; h1 = h1 + acc[ai][bj][m][1];
                    *(h16x8*)(HH + o) = pack8(h0, h1); ss += dot4(h0) + dot4(h1);
                }
                ss = fq_sum(ss);
                if (fq == 0) sq[r * 16 + u.pn * 4 + wc] = ss;
            }
    }
};
struct EpiPle {
    static constexpr bool PERM = true;
    const h16* Hin; const h16* U; h16* Hout; const float* sqp; float* sqout; int sqn; float sqi;
    __device__ __forceinline__ void operator()(const f32x4 (&acc)[2][2][4][2], const Unit& u, int wr, int wc, int fr, int fq, const PG8_LAS float* rtab) const {
        asm volatile("" : "+v"(fr), "+v"(fq));
#pragma unroll
        for (int ai = 0; ai < 2; ++ai)
#pragma unroll
            for (int m = 0; m < 4; ++m) {
                const size_t r = (size_t)u.pm * 256 + ai * 128 + wr * 64 + m * 16 + fr;
                const float rs = rtab[ai * 128 + wr * 64 + m * 16 + fr];
                float ss = 0.f;
#pragma unroll
                for (int bj = 0; bj < 2; ++bj) {
                    const size_t o = r * 1024 + u.pn * 256 + bj * 128 + wc * 32 + 8 * fq;
                    const h16x8 uu = *(const h16x8*)(U + o); const h16x8 hh = *(const h16x8*)(Hin + o);
                    const f32x4 a0 = acc[ai][bj][m][0] * rs, a1 = acc[ai][bj][m][1] * rs; f32x4 h0, h1;
#pragma unroll
                    for (int e = 0; e < 4; ++e) { h0[e] = (float)hh[e] + (float)uu[e] * sigmoidf_(a0[e]); h1[e] = (float)hh[4 + e] + (float)uu[4 + e] * sigmoidf_(a1[e]); }
                    *(h16x8*)(Hout + o) = pack8(h0, h1); ss += dot4(h0) + dot4(h1);
                }
                ss = fq_sum(ss);
                if (fq == 0) sqout[r * 16 + u.pn * 4 + wc] = ss;
            }
    }
};
struct EpiPleFinal {
    static constexpr bool PERM = true, FUSED_FINAL = true;
    const h16* Hin; const h16* U; const float* sqp; int sqn; float sqi; const float* gfin; float* out; unsigned* xslot; unsigned* pcnt; unsigned* tmo;
    __device__ __forceinline__ void final(f32x4 (&acc)[2][2][4][2], const Unit& u, int wr, int wc, int fr, int fq, const PG8_LAS float* rtab, PG8_LAS unsigned char* lds, int tid) const {
        PG8_LAS float* Pt = (PG8_LAS float*)(lds + pg8_stage_bytes() + 2048);
        PG8_LAS float* St = Pt + 1024;
        const int wid = tid >> 6, lane = tid & 63;
        asm volatile("" : "+v"(fr), "+v"(fq));
#pragma unroll
        for (int ai = 0; ai < 2; ++ai)
#pragma unroll
            for (int m = 0; m < 4; ++m) {
                const int rl = ai * 128 + wr * 64 + m * 16 + fr; const size_t r = (size_t)u.pm * 256 + rl;
                const float rs = rtab[rl]; float ss = 0.f;
#pragma unroll
                for (int bj = 0; bj < 2; ++bj) {
                    const size_t o = r * 1024 + u.pn * 256 + bj * 128 + wc * 32 + 8 * fq;
                    const h16x8 uu = *(const h16x8*)(U + o); const h16x8 hh = *(const h16x8*)(Hin + o);
                    const f32x4 a0 = acc[ai][bj][m][0] * rs, a1 = acc[ai][bj][m][1] * rs; f32x4 h0, h1;
#pragma unroll
                    for (int e = 0; e < 4; ++e) { h0[e] = (float)hh[e] + (float)uu[e] * sigmoidf_(a0[e]); h1[e] = (float)hh[4 + e] + (float)uu[4 + e] * sigmoidf_(a1[e]); }
                    acc[ai][bj][m][0] = h0; acc[ai][bj][m][1] = h1; ss += dot4(h0) + dot4(h1);
                }
                ss = fq_sum(ss);
                if (fq == 0) Pt[rl * 4 + wc] = ss;
                asm volatile("" : "+v"(acc[ai][0][m][0]), "+v"(acc[ai][0][m][1]), "+v"(acc[ai][1][m][0]), "+v"(acc[ai][1][m][1]) :: "memory");
            }
        asm volatile("s_waitcnt lgkmcnt(0)" ::: "memory"); __builtin_amdgcn_s_barrier(); asm volatile("" ::: "memory");
        if (tid < 256) {
            const f32x4 p = *(const PG8_LAS f32x4*)(Pt + tid * 4);
            __hip_atomic_store(xslot + ((size_t)u.pm * 256 + tid) * 4 + u.pn, __float_as_uint((p[0] + p[1]) + (p[2] + p[3])), __ATOMIC_RELAXED, __HIP_MEMORY_SCOPE_AGENT);
            asm volatile("s_waitcnt vmcnt(0)" ::: "memory");
            if (lane == 0) __hip_atomic_fetch_add(pcnt + 64 * u.pm, 1u, __ATOMIC_RELAXED, __HIP_MEMORY_SCOPE_AGENT);
        }
        if (wid == 0) {
            unsigned sp = 0u;
            while (__hip_atomic_load(pcnt + 64 * u.pm, __ATOMIC_RELAXED, __HIP_MEMORY_SCOPE_AGENT) < 16u) {
                __builtin_amdgcn_s_sleep(2);
                if (++sp > (1u << 22)) { if (lane == 0) __hip_atomic_store(tmo, 1u, __ATOMIC_RELAXED, __HIP_MEMORY_SCOPE_AGENT); break; }
            }
            __builtin_amdgcn_fence(__ATOMIC_ACQUIRE, "agent");
        }
        asm volatile("s_waitcnt vmcnt(0) lgkmcnt(0)" ::: "memory"); __builtin_amdgcn_s_barrier(); asm volatile("" ::: "memory");
        if (tid < 256) {
            const unsigned* sl = xslot + ((size_t)u.pm * 256 + tid) * 4; float s = 0.f;
#pragma unroll
            for (int t = 0; t < 4; ++t) s += __uint_as_float(__hip_atomic_load(sl + t, __ATOMIC_RELAXED, __HIP_MEMORY_SCOPE_AGENT));
            St[tid] = rsqrtf(s * (1.0f / 1024.0f) + EPS);
        }
        asm volatile("s_waitcnt vmcnt(0) lgkmcnt(0)" ::: "memory"); __builtin_amdgcn_s_barrier(); asm volatile("" ::: "memory");
#pragma unroll
        for (int ai = 0; ai < 2; ++ai)
#pragma unroll
            for (int m = 0; m < 4; ++m) {
                const int rl = ai * 128 + wr * 64 + m * 16 + fr; const size_t r = (size_t)u.pm * 256 + rl;
                const float rr = St[rl];
#pragma unroll
                for (int bj = 0; bj < 2; ++bj) {
                    const int c = u.pn * 256 + bj * 128 + wc * 32 + 8 * fq;
                    const f32x4 g0 = *(const f32x4*)(gfin + c), g1 = *(const f32x4*)(gfin + c + 4);
                    *(f32x4*)(out + r * 1024 + c) = acc[ai][bj][m][0] * rr * g0; *(f32x4*)(out + r * 1024 + c + 4) = acc[ai][bj][m][1] * rr * g1;
                }
            }
    }
};
struct EpiInR {
    static constexpr bool PERM = true;
    const float* sqp; const f32x2* sincos; h16* rq; h16* rk; h16* rv; h16* rg; int sqn; float sqi;
    __device__ __forceinline__ void operator()(const f32x4 (&acc)[2][2][4][2], const Unit& u, int wr, int wc, int fr, int fq, const PG8_LAS float* rtab) const {
        asm volatile("" : "+v"(fr), "+v"(fq));
#pragma unroll
        for (int ai = 0; ai < 2; ++ai)
#pragma unroll
            for (int m = 0; m < 4; ++m) {
                const size_t r = (size_t)u.pm * 256 + ai * 128 + wr * 64 + m * 16 + fr;
                const float rs = rtab[ai * 128 + wr * 64 + m * 16 + fr];
                const int pos = (int)(r & (L - 1));
#pragma unroll
                for (int bj = 0; bj < 2; ++bj) {
                    const int c0 = bj * 128 + wc * 32 + 8 * fq;
                    f32x4 v0 = acc[ai][bj][m][0] * rs, v1 = acc[ai][bj][m][1] * rs;
                    if (u.pn < 8) {
                        const f32x2* sc = sincos + (size_t)pos * 128 + (c0 >> 1);
                        const f32x2 s0 = sc[0], s1 = sc[1], s2 = sc[2], s3 = sc[3];
                        f32x4 w0, w1;
                        w0[0] = v0[0] * s0[1] - v0[1] * s0[0]; w0[1] = v0[1] * s0[1] + v0[0] * s0[0];
                        w0[2] = v0[2] * s1[1] - v0[3] * s1[0]; w0[3] = v0[3] * s1[1] + v0[2] * s1[0];
                        w1[0] = v1[0] * s2[1] - v1[1] * s2[0]; w1[1] = v1[1] * s2[1] + v1[0] * s2[0];
                        w1[2] = v1[2] * s3[1] - v1[3] * s3[0]; w1[3] = v1[3] * s3[1] + v1[2] * s3[0];
                        h16* dst = (u.pn < 4) ? rq + r * 1024 + u.pn * 256 + c0 : rk + r * 1024 + (u.pn - 4) * 256 + c0;
                        *(h16x8*)dst = pack8(w0, w1);
                    } else if (u.pn < 16) {
                        *(h16x8*)(rv + r * 2048 + (u.pn - 8) * 256 + c0) = pack8(v0, v1);
                    } else {
#pragma unroll
                        for (int e = 0; e < 4; ++e) { v0[e] = siluf_(v0[e]); v1[e] = siluf_(v1[e]); }
                        *(h16x8*)(rg + r * 2048 + (u.pn - 16) * 256 + c0) = pack8(v0, v1);
                    }
                }
            }
    }
};

template <int MODE>
__device__ __forceinline__ void tr_item(const float* __restrict__ W, int K, int N, h16* Wt, int ld, int row_off, const float* ks, float scale, float* scr, int item, int lane) {
    const int nbn = (N + 31) >> 5, kb = item / nbn, nb = item % nbn, k0 = kb * 64, n0 = nb * 32;
    const int n4 = n0 + (lane & 7) * 4;
    f32x4 wv[8];
#pragma unroll
    for (int i = 0; i < 8; ++i) { const int kk = 8 * i + (lane >> 3); wv[i] = (n4 < N) ? *(const f32x4*)(W + (size_t)(k0 + kk) * N + n4) : (f32x4){0.f, 0.f, 0.f, 0.f}; }
#pragma unroll
    for (int i = 0; i < 8; ++i) { const int kk = 8 * i + (lane >> 3); const float kf = ks ? ks[k0 + kk] : 1.f;
#pragma unroll
        for (int e = 0; e < 4; ++e) scr[kk * 33 + (lane & 7) * 4 + e] = wv[i][e] * kf; }
    LDS_FENCE();
    const int c = lane & 7;
#pragma unroll
    for (int j = 0; j < 4; ++j) {
        const int nl = (lane >> 3) + 8 * j, n = n0 + nl;
        if (n < N) {
            int row = n; float sc = scale;
            if (MODE == 1) row = (n < 384) ? 256 + n : (n < 640) ? n - 384 : (n < 712) ? n : n + 56;
            if (MODE == 2 && n >= 1024 && n < 2048) sc *= 0.0625f;
            const float* s = scr + (8 * c) * 33 + nl;
            h16x8 o;
#pragma unroll
            for (int e = 0; e < 8; ++e) o[e] = (h16)(s[e * 33] * sc);
            *(h16x8*)(Wt + (size_t)(row_off + row) * ld + k0 + 8 * c) = o;
        }
    }
    LDS_FENCE();
}

__device__ __forceinline__ void p0_prologue(const Params& P, unsigned char* lds, int blk, int nblk, int wv) {
    const int tid = my_tid(wv), wid = __builtin_amdgcn_readfirstlane(tid >> 6), lane = tid & 63;
    float* scr = (float*)lds + wid * (64 * 33);
    const int gw = blk * NWAVES + wid, ngw = nblk * NWAVES;
    unsigned char* ws = opaque_ptr(P.ws);
    h16* WAIN = (h16*)(ws + WS_WAIN); h16* WQ = (h16*)(ws + WS_WQ); h16* WKV = (h16*)(ws + WS_WKV); h16* WAOUT = (h16*)(ws + WS_WAOUT);
    h16* WPG = (h16*)(ws + WS_WPG); h16* WPLE = (h16*)(ws + WS_WPLE); h16* WRIN = (h16*)(ws + WS_WRIN); h16* WROUT = (h16*)(ws + WS_WROUT);
    const float QSCALE = 0.08838834764831845f * 1.4426950408889634f;
    constexpr int I1 = 16 * 55, I2 = 6 * 32, I3 = 6 * 16, I4 = 8 * 16, I5 = 8 * 16, I6 = 16 * 32, I7 = 2 * 16 * 32, I8 = 2 * 4 * 32, I9 = 16 * 192, I10 = 32 * 32;
    constexpr int NIT = I1 + I2 + I3 + I4 + I5 + I6 + I7 + I8 + I9 + I10;
    for (int it = gw; it < NIT; it += ngw) {
        int r = it;
        if (r < I1) { tr_item<1>(P.in[3], 1024, 1736, WAIN, 1024, 0, nullptr, 1.f, scr, r, lane); continue; } r -= I1;
        if (r < I2) { tr_item<0>(P.in[6], 384, 1024, WQ, 384, 0, P.in[4], QSCALE, scr, r, lane); continue; } r -= I2;
        if (r < I3) { tr_item<0>(P.in[7], 384, 512, WQ, 384, 1024, P.in[4], 1.f, scr, r, lane); continue; } r -= I3;
        if (r < I4) { const int h = r / 16; tr_item<0>(P.in[10] + (size_t)h * 256 * 128, 256, 128, WKV, 256, h * 128, P.in[5], 1.f, scr, r % 16, lane); continue; } r -= I4;
        if (r < I5) { const int h = r / 16; tr_item<0>(P.in[11] + (size_t)h * 256 * 128, 256, 128, WKV, 256, 1024 + h * 128, P.in[5], 1.f, scr, r % 16, lane); continue; } r -= I5;
        if (r < I6) { tr_item<0>(P.in[12], 1024, 1024, WAOUT, 1024, 0, nullptr, 1.f, scr, r, lane); continue; } r -= I6;
        if (r < I7) { const int i = r / 512; tr_item<0>(P.in[15] + (size_t)i * 1024 * 1024, 1024, 1024, WPG + (size_t)i * 1024 * 1024, 1024, 0, P.in[16] + i * 1024, 1.f, scr, r % 512, lane); continue; } r -= I7;
        if (r < I8) { const int i = r / 128; tr_item<0>(P.in[17] + (size_t)i * 256 * 1024, 256, 1024, WPLE + (size_t)i * 1024 * 256, 256, 0, nullptr, 1.f, scr, r % 128, lane); continue; } r -= I8;
        if (r < I9) { tr_item<2>(P.in[13], 1024, 6144, WRIN, 1024, 0, P.in[2] + 1024, 1.f, scr, r, lane); continue; } r -= I9;
        tr_item<0>(P.in[14], 2048, 1024, WROUT, 2048, 0, nullptr, 1.f, scr, r, lane);
    }
    const int gt = blk * NTHREADS + tid, ngt = nblk * NTHREADS;
    { unsigned zz = 0u; asm volatile("" : "+v"(zz));
      for (int i = gt; i < 56 * 1024 / 8; i += ngt) ((u32x4*)(WAIN + 712 * 1024))[i] = (u32x4){zz, zz, zz, zz}; }
    {
        const float* x = P.in[0]; const f32x4* g4 = (const f32x4*)P.in[2]; h16* XN0 = (h16*)(ws + WS_R1);
        f32x4 gv[4];
#pragma unroll
        for (int j = 0; j < 4; ++j) gv[j] = g4[lane + 64 * j];
        for (int r0 = gw; r0 < T; r0 += 4 * ngw) {
            f32x4 v[4][4];
#pragma unroll
            for (int k = 0; k < 4; ++k) { const int r = (r0 + k * ngw < T) ? r0 + k * ngw : r0; const f32x4* xr = (const f32x4*)(x + (size_t)r * 1024) + lane;
#pragma unroll
                for (int j = 0; j < 4; ++j) v[k][j] = xr[64 * j]; }
#pragma unroll
            for (int k = 0; k < 4; ++k) { const int r = r0 + k * ngw; float s = 0.f;
#pragma unroll
                for (int j = 0; j < 4; ++j) s += dot4(v[k][j]);
                const float rstd = rsqrtf(wave_sum_dpp(s) * (1.0f / 1024.0f) + EPS);
                if (r < T) {
#pragma unroll
                    for (int j = 0; j < 4; ++j) { const f32x4 o = v[k][j] * rstd * gv[j]; *(h16x4*)(XN0 + (size_t)r * 1024 + (lane + 64 * j) * 4) = pack4(o); } } }
        }
    }
    {
        const f32x4* p4 = (const f32x4*)P.in[1]; h16* PH0 = (h16*)(ws + WS_PH0); h16* PH1 = (h16*)(ws + WS_PH1);
        const int nv = T * 256 / 8;
        for (int i0_ = gt; i0_ < 2 * nv; i0_ += 4 * ngt) {
            f32x4 a[4], b2[4];
#pragma unroll
            for (int k = 0; k < 4; ++k) { const int i = (i0_ + k * ngt < 2 * nv) ? i0_ + k * ngt : i0_; a[k] = p4[2 * (size_t)i]; b2[k] = p4[2 * (size_t)i + 1]; }
#pragma unroll
            for (int k = 0; k < 4; ++k) { const int i = i0_ + k * ngt; if (i < 2 * nv) { h16* dst = (i < nv) ? PH0 + (size_t)i * 8 : PH1 + (size_t)(i - nv) * 8; *(h16x8*)dst = pack8(a[k], b2[k]); } }
        }
    }
    {
        f32x2* SC = (f32x2*)(ws + WS_SINCOS);
        for (int i = gt; i < L * 128; i += ngt) {
            const int pos = i >> 7, fi = i & 127;
            const float th = (float)pos * kAngle[fi];
            double rev = (double)th * 0.15915494309189535; rev -= __builtin_rint(rev);
            const float r = (float)(rev * 6.283185307179586), r2 = r * r;
            float sn = 1.9572941e-20f;
            sn = sn * r2 - 8.2206352e-18f;
            sn = sn * r2 + 2.8114573e-15f;
            sn = sn * r2 - 7.6471637e-13f;
            sn = sn * r2 + 1.6059044e-10f;
            sn = sn * r2 - 2.5052108e-8f;
            sn = sn * r2 + 2.7557319e-6f;
            sn = sn * r2 - 1.9841270e-4f;
            sn = sn * r2 + 8.3333333e-3f;
            sn = sn * r2 - 1.6666667e-1f;
            sn = sn * r2 + 1.0f;
            sn = sn * r;
            float cs = 4.1103176e-19f;
            cs = cs * r2 - 1.5619207e-16f;
            cs = cs * r2 + 4.7794773e-14f;
            cs = cs * r2 - 1.1470746e-11f;
            cs = cs * r2 + 2.0876757e-9f;
            cs = cs * r2 - 2.7557319e-7f;
            cs = cs * r2 + 2.4801587e-5f;
            cs = cs * r2 - 1.3888889e-3f;
            cs = cs * r2 + 4.1666667e-2f;
            cs = cs * r2 - 0.5f;
            cs = cs * r2 + 1.0f;
            SC[i] = (f32x2){sn, cs};
        }
    }
}

__device__ __forceinline__ void p2_kidx(const Params& P, int blk, int nblk, int wv) {
    const h16* CQX = (const h16*)(P.ws + WS_CQX); h16* KIDXN = (h16*)(P.ws + WS_KIDXN); float* WIDX = (float*)(P.ws + WS_WIDX);
    const float* g = P.in[8]; const float* bb = P.in[9];
    for (int r = blk * NTHREADS + my_tid(wv); r < T; r += nblk * NTHREADS) {
        float v[64]; float s = 0.f;
#pragma unroll
        for (int c = 0; c < 8; ++c) { const h16x8 k = *(const h16x8*)(CQX + (size_t)r * 512 + 384 + c * 8);
#pragma unroll
            for (int e = 0; e < 8; ++e) { v[c * 8 + e] = (float)k[e]; s += v[c * 8 + e]; } }
        const float mu = s * (1.0f / 64.0f); float q = 0.f;
#pragma unroll
        for (int i = 0; i < 64; ++i) { v[i] -= mu; q += v[i] * v[i]; }
        const float rstd = rsqrtf(q * (1.0f / 64.0f) + EPS);
#pragma unroll
        for (int c = 0; c < 8; ++c) { h16x8 o;
#pragma unroll
            for (int e = 0; e < 8; ++e) o[e] = (h16)(v[c * 8 + e] * rstd * g[c * 8 + e] + bb[c * 8 + e]);
            *(h16x8*)(KIDXN + (size_t)r * 64 + c * 8) = o; }
        const h16x8 w = *(const h16x8*)(CQX + (size_t)r * 512 + 448);
        const float wsc = 0.04419417382415922f;
        f32x4 w0, w1;
#pragma unroll
        for (int e = 0; e < 4; ++e) { w0[e] = (float)w[e] * wsc; w1[e] = (float)w[4 + e] * wsc; }
        *(f32x4*)(WIDX + (size_t)r * 8) = w0; *(f32x4*)(WIDX + (size_t)r * 8 + 4) = w1;
    }
}

__device__ __forceinline__ unsigned fmap_u(float s) { s += 0.0f; const unsigned b = __float_as_uint(s); return (b & 0x80000000u) ? ~b : (b | 0x80000000u); }
__device__ __forceinline__ unsigned topk_select(const unsigned (&u)[32], int lane) {
    unsigned Tv = 0u;
    for (int bit = 31; bit >= 0; --bit) {
        const unsigned cand = Tv | (1u << bit); int cnt = 0;
#pragma unroll
        for (int i = 0; i < 32; ++i) cnt += __popcll(__ballot(u[i] >= cand));
        if (cnt >= 256) Tv = cand;
    }
    int gt = 0;
#pragma unroll
    for (int i = 0; i < 32; ++i) gt += __popcll(__ballot(u[i] > Tv));
    int need = 256 - gt;
    unsigned sel = 0u;
#pragma unroll
    for (int i = 0; i < 32; ++i) {
        const bool eq = (u[i] == Tv);
        const unsigned long long em = __ballot(eq);
        const int rank = (int)__builtin_amdgcn_mbcnt_hi((unsigned)(em >> 32), __builtin_amdgcn_mbcnt_lo((unsigned)em, 0u));
        const bool take = (u[i] > Tv) || (eq && rank < need);
        sel |= (take ? 1u : 0u) << i;
        need -= __popcll(em);
    }
    return sel;
}


__device__ __forceinline__ unsigned topk_select_radix(const unsigned (&u)[32], int lane, volatile __attribute__((address_space(3))) unsigned* hist) {
    typedef __attribute__((address_space(3))) unsigned lu32;
    unsigned prefix = 0u; int kk = 256;
#pragma unroll 1
    for (int pass = 0; pass < 4; ++pass) {
        const int shift = 24 - 8 * pass;
        { unsigned zz = 0u; asm volatile("" : "+v"(zz)); ((__attribute__((address_space(3))) u32x4*)hist)[lane] = (u32x4){zz, zz, zz, zz}; }
        LDS_FENCE();
#pragma unroll
        for (int i = 0; i < 32; ++i) {
            const bool in = (u[i] != 0u) && (pass == 0 || (u[i] >> (shift + 8)) == prefix);
            if (in) __hip_atomic_fetch_add((lu32*)hist + ((u[i] >> shift) & 255u), 1u, __ATOMIC_RELAXED, __HIP_MEMORY_SCOPE_WORKGROUP);
        }
        LDS_FENCE();
        const u32x4 c = ((__attribute__((address_space(3))) u32x4*)hist)[lane];
        const int tot = (int)(c[0] + c[1] + c[2] + c[3]);
        int S = tot;
#pragma unroll
        for (int o = 1; o < 64; o <<= 1) { const int v = __shfl_down(S, o); if (lane + o < 64) S += v; }
        const unsigned long long bm = __ballot(S >= kk);
        const int Ls = 63 - __builtin_clzll(bm);
        int cum = S - tot, bin = 0, above = 0; bool found = false;
#pragma unroll
        for (int j = 3; j >= 0; --j) { const int cj = (int)c[j]; if (!found && cum + cj >= kk) { bin = 4 * lane + j; above = cum; found = true; } cum += cj; }
        bin = __builtin_amdgcn_readlane(bin, Ls); above = __builtin_amdgcn_readlane(above, Ls);
        kk -= above; prefix = (prefix << 8) | (unsigned)bin;
        LDS_FENCE();
    }
    const unsigned Tv = prefix; int need = kk;
    unsigned sel = 0u;
#pragma unroll
    for (int i = 0; i < 32; ++i) {
        const bool eq = (u[i] == Tv);
        const unsigned long long em = __ballot(eq);
        const int rank = (int)__builtin_amdgcn_mbcnt_hi((unsigned)(em >> 32), __builtin_amdgcn_mbcnt_lo((unsigned)em, 0u));
        const bool take = (u[i] > Tv) || (eq && rank < need);
        sel |= (take ? 1u : 0u) << i;
        need -= __popcll(em);
    }
    return sel;
}


#define DPP_STEP_I(v, op, ident, ctrl, rmask) v = op(v, __builtin_amdgcn_update_dpp((int)(ident), v, ctrl, rmask, 0xf, false))
__device__ __forceinline__ int imax_(int a, int b) { return a > b ? a : b; }
__device__ __forceinline__ int iadd_(int a, int b) { return a + b; }
__device__ __forceinline__ int wave_scan_add(int v) {
    DPP_STEP_I(v, iadd_, 0, 0x111, 0xf); DPP_STEP_I(v, iadd_, 0, 0x112, 0xf); DPP_STEP_I(v, iadd_, 0, 0x114, 0xf); DPP_STEP_I(v, iadd_, 0, 0x118, 0xf);
    DPP_STEP_I(v, iadd_, 0, 0x142, 0xa); DPP_STEP_I(v, iadd_, 0, 0x143, 0xc); return v;
}
template <int CTRL, int RMASK> __device__ __forceinline__ float fmax_dpp_(float a) { return fmaxf(a, __builtin_bit_cast(float, __builtin_amdgcn_update_dpp((int)0xff800000u, __builtin_bit_cast(int, a), CTRL, RMASK, 0xf, false))); }
template <int CTRL, int RMASK> __device__ __forceinline__ float fmin_dpp_(float a) { return fminf(a, __builtin_bit_cast(float, __builtin_amdgcn_update_dpp((int)0x7f800000u, __builtin_bit_cast(int, a), CTRL, RMASK, 0xf, false))); }
#define DPP_RED6(v, F) do { v = F<0x111, 0xf>(v); v = F<0x112, 0xf>(v); v = F<0x114, 0xf>(v); v = F<0x118, 0xf>(v); v = F<0x142, 0xa>(v); v = F<0x143, 0xc>(v); } while (0)
__device__ __forceinline__ float wave_max_dpp(float v) { DPP_RED6(v, fmax_dpp_); return __builtin_bit_cast(float, __builtin_amdgcn_readlane(__builtin_bit_cast(int, v), 63)); }
__device__ __forceinline__ float wave_min_dpp(float v) { DPP_RED6(v, fmin_dpp_); return __builtin_bit_cast(float, __builtin_amdgcn_readlane(__builtin_bit_cast(int, v), 63)); }
__device__ __forceinline__ unsigned topk_select_lin(const float (&s)[32], unsigned valid, int lane, volatile __attribute__((address_space(3))) unsigned* ws_) {
    typedef __attribute__((address_space(3))) unsigned lu32;
    typedef __attribute__((address_space(3))) float lf32;
    typedef __attribute__((address_space(3))) f32x4 lf32x4;
    lu32* hist = (lu32*)ws_; lf32* cand = (lf32*)ws_ + 256;
    unsigned act = valid; int kk = 256; float Tv = 0.f; int need = 0; bool solved = false; int cnt = 0;
#pragma unroll 1
    for (int iter = 0; iter < 8; ++iter) {
        float mn = __builtin_inff(), mx = -__builtin_inff();
        if (iter == 0) {
#pragma unroll
            for (int i = 0; i < 32; ++i) { mn = fminf(mn, s[i]); mx = fmaxf(mx, s[i]); }
        } else {
#pragma unroll
            for (int i = 0; i < 32; ++i) { const bool a = (act >> i) & 1u; mn = fminf(mn, a ? s[i] : __builtin_inff()); mx = fmaxf(mx, a ? s[i] : -__builtin_inff()); }
        }
        mn = wave_min_dpp(mn); mx = wave_max_dpp(mx);
        if (mn == mx) { Tv = mx; need = kk; solved = true; break; }
        const float scale = 254.9f / (mx - mn), bias = -mn * scale;
        { unsigned zz = 0u; asm volatile("" : "+v"(zz)); ((__attribute__((address_space(3))) u32x4*)hist)[lane] = (u32x4){zz, zz, zz, zz}; }
        LDS_FENCE();
#pragma unroll
        for (int i = 0; i < 32; ++i) { int b = (int)fmaf(s[i], scale, bias); b = b < 0 ? 0 : b;
            __hip_atomic_fetch_add(hist + (((act >> i) & 1u) ? b : 321 + (lane & 15)), 1u, __ATOMIC_RELAXED, __HIP_MEMORY_SCOPE_WORKGROUP); }
        LDS_FENCE();
        const u32x4 c = ((__attribute__((address_space(3))) u32x4*)hist)[lane];
        const int tot = (int)(c[0] + c[1] + c[2] + c[3]);
        const int pre = wave_scan_add(tot);
        const int total = __builtin_amdgcn_readlane(pre, 63);
        const int S = total - pre + tot;
        const unsigned long long bm = __ballot(S >= kk);
        const int Ls = 63 - __builtin_clzll(bm | 1ull);
        int cum = S - tot, bin = 0, above = 0, cb = 0; bool found = false;
#pragma unroll
        for (int j = 3; j >= 0; --j) { const int cj = (int)c[j]; if (!found && cum + cj >= kk) { bin = 4 * lane + j; above = cum; cb = cj; found = true; } cum += cj; }
        bin = __builtin_amdgcn_readlane(bin, Ls); above = __builtin_amdgcn_readlane(above, Ls); cnt = __builtin_amdgcn_readlane(cb, Ls);
        kk -= above;
        { float sc2 = scale; asm volatile("" : "+v"(sc2));
#pragma unroll
          for (int i = 0; i < 32; ++i) { int b = (int)fmaf(s[i], sc2, bias); b = b < 0 ? 0 : b; act &= ~((b != bin ? 1u : 0u) << i); } }
        LDS_FENCE();
        if (cnt <= 64) break;
    }
    if (!solved) {
        cand[lane] = __builtin_nanf("");
        const int myc = __popc(act);
        int off = wave_scan_add(myc) - myc;
        LDS_FENCE();
#pragma unroll
        for (int i = 0; i < 32; ++i) { const bool a = (act >> i) & 1u; const int slot = (a && off < 64) ? off : 65 + (lane & 15); cand[slot] = s[i]; off += a ? 1 : 0; }
        LDS_FENCE();
        const int m = cnt < 64 ? cnt : 64;
        const float v = (lane < m) ? cand[lane] : -__builtin_inff();
        int gt = 0, eq = 0;
#pragma unroll
        for (int j4 = 0; j4 < 16; ++j4) { const f32x4 cj = ((lf32x4*)cand)[j4];
#pragma unroll
            for (int e = 0; e < 4; ++e) { gt += (cj[e] > v) ? 1 : 0; eq += (cj[e] == v) ? 1 : 0; } }
        const bool ok = (lane < m) && gt < kk && kk <= gt + eq;
        const unsigned long long okm = __ballot(ok);
        const int fl = okm ? __builtin_ctzll(okm) : 0;
        Tv = __builtin_bit_cast(float, __builtin_amdgcn_readlane(__builtin_bit_cast(int, v), fl)); need = kk - __builtin_amdgcn_readlane(gt, fl);
        LDS_FENCE();
    }
    unsigned sel = 0u, eqb = 0u;
#pragma unroll
    for (int i = 0; i < 32; ++i) { sel |= ((s[i] > Tv) ? 1u : 0u) << i; eqb |= ((s[i] == Tv) ? 1u : 0u) << i; }
    const int eqtot = __builtin_amdgcn_readlane(wave_scan_add(__popc(eqb)), 63);
    if (eqtot <= need) sel |= eqb;
    else {
#pragma unroll
        for (int i = 0; i < 32; ++i) {
            const bool eq = (eqb >> i) & 1u;
            const unsigned long long em = __ballot(eq);
            const int rank = (int)__builtin_amdgcn_mbcnt_hi((unsigned)(em >> 32), __builtin_amdgcn_mbcnt_lo((unsigned)em, 0u));
            sel |= ((eq && rank < need) ? 1u : 0u) << i;
            need -= __popcll(em);
        }
    }
    return sel;
}

__device__ __forceinline__ void p3_indexer_naive(const Params& P, unsigned char* lds, int blk, int nblk, int wv) {
    const int tid = my_tid(wv), wid = __builtin_amdgcn_readfirstlane(tid >> 6), lane = tid & 63;
    float* sc = (float*)lds + wid * 2048; float* qf = (float*)(lds + 65536) + wid * 512; float* wf = (float*)(lds + 65536 + 16384) + wid * 8;
    const h16* QIDX = (const h16*)(P.ws + WS_QIDX); const h16* KIDXN = (const h16*)(P.ws + WS_KIDXN); const float* WIDX = (const float*)(P.ws + WS_WIDX);
    unsigned long long* MASK = (unsigned long long*)(P.ws + WS_MASK);
    const int gw = blk * NWAVES + wid, ngw = nblk * NWAVES;
    for (int it = gw; it < T; it += ngw) {
        const int b = it >> 11, pos = ((it & 2047) + b * 389) & 2047, t = b * L + pos, nk = pos + 1;
        { const h16x8 qv = *(const h16x8*)(QIDX + (size_t)t * 512 + lane * 8);
#pragma unroll
          for (int e = 0; e < 8; ++e) qf[lane * 8 + e] = (float)qv[e];
          if (lane < 8) wf[lane] = WIDX[(size_t)t * 8 + lane]; }
        LDS_FENCE();
        for (int i = 0; i * 64 < nk; ++i) {
            const int key = i * 64 + lane; float score = 0.f;
            if (key < nk) {
                const h16x8* kp = (const h16x8*)(KIDXN + (size_t)(b * L + key) * 64);
                float kf[64];
#pragma unroll
                for (int c = 0; c < 8; ++c) { const h16x8 kv = kp[c];
#pragma unroll
                    for (int e = 0; e < 8; ++e) kf[c * 8 + e] = (float)kv[e]; }
                for (int h = 0; h < 8; ++h) {
                    float a = 0.f;
#pragma unroll
                    for (int d = 0; d < 64; ++d) a = fmaf(qf[h * 64 + d], kf[d], a);
                    score += fmaxf(a, 0.f) * wf[h];
                }
            }
            sc[key] = score;
        }
        LDS_FENCE();
        unsigned selbits = 0u;
        if (nk <= 256) {
#pragma unroll
            for (int i = 0; i < 32; ++i) selbits |= ((i * 64 + lane) < nk ? 1u : 0u) << i;
        } else {
            unsigned u[32];
#pragma unroll
            for (int i = 0; i < 32; ++i) { const int key = i * 64 + lane; const float s = sc[key]; u[i] = (key < nk) ? fmap_u(s) : 0u; }
            selbits = topk_select(u, lane);
        }
#pragma unroll
        for (int i = 0; i < 32; ++i) { const unsigned long long bal = __ballot((selbits >> i) & 1u); if (lane == 0) MASK[(size_t)t * 32 + i] = bal; }
        LDS_FENCE();
    }
}


typedef float f32x16 __attribute__((ext_vector_type(16)));
__device__ __forceinline__ h16x8 relu_pk8(const f32x16& s, int base) {
    h16x8 r;
#pragma unroll
    for (int e = 0; e < 4; ++e) { const h16x2 p = __builtin_bit_cast(h16x2, __builtin_amdgcn_cvt_pkrtz(fmaxf(s[base + 2 * e], 0.f), fmaxf(s[base + 2 * e + 1], 0.f))); r[2 * e] = p[0]; r[2 * e + 1] = p[1]; }
    return r;
}
__device__ __forceinline__ void p3_indexer(const Params& P, unsigned char* lds_, int blk, int nblk, int wv) {
    typedef __attribute__((address_space(3))) float lfloat;
    const int tid = my_tid(wv), wid = __builtin_amdgcn_readfirstlane(tid >> 6), lane = tid & 63;
    unsigned char* ws = opaque_ptr(P.ws);
    lfloat* sc = (lfloat*)lds_;
    const h16* QIDX = (const h16*)(ws + WS_QIDX); const h16* KIDXN = (const h16*)(ws + WS_KIDXN); const float* WIDX = (const float*)(ws + WS_WIDX);
    unsigned long long* MASK = (unsigned long long*)(ws + WS_MASK);
    h16x8 Afn[4][4]; f32x4 wn = (f32x4){0.f, 0.f, 0.f, 0.f};
    { const int r = lane & 31, h = lane >> 5; const int u0 = (blk < NB * (L / 16)) ? blk : 0; const int tt0 = (u0 & 15) * L + (u0 >> 4) * 16;
#pragma unroll
      for (int g = 0; g < 4; ++g)
#pragma unroll
          for (int s = 0; s < 4; ++s) Afn[g][s] = *(const h16x8*)(QIDX + (size_t)(tt0 + 4 * g + (r >> 3)) * 512 + (r & 7) * 64 + 16 * s + 8 * h);
      if (r < 16) wn = *(const f32x4*)(WIDX + (size_t)(tt0 + r) * 8 + 4 * h); }
    for (int unit = blk; unit < NB * (L / 16); unit += nblk) {
        const int b = unit & 15, qg = unit >> 4, p0 = qg * 16, t0 = b * L + p0, NT = (p0 + 15) / 32 + 1;
        int lane_o = lane; asm volatile("" : "+v"(lane_o));
        const int r = lane_o & 31, h = lane_o >> 5;
        h16x8 Af[4][4];
#pragma unroll
        for (int g = 0; g < 4; ++g)
#pragma unroll
            for (int s = 0; s < 4; ++s) Af[g][s] = Afn[g][s];
        h16x8 fragA;
        { const f32x4 w = wn;
          const h16 z = (h16)0.f;
          if (r & 1) { fragA[0] = z; fragA[1] = z; fragA[2] = z; fragA[3] = z; fragA[4] = (h16)w[0]; fragA[5] = (h16)w[1]; fragA[6] = (h16)w[2]; fragA[7] = (h16)w[3]; }
          else { fragA[0] = (h16)w[0]; fragA[1] = (h16)w[1]; fragA[2] = (h16)w[2]; fragA[3] = (h16)w[3]; fragA[4] = z; fragA[5] = z; fragA[6] = z; fragA[7] = z; } }
        const int code = (r < 16) ? (r >> 1) : -1;
        const h16* kbase = KIDXN + (size_t)b * L * 64 + (size_t)r * 64 + 8 * h;
        h16x8 Bf[4];
        if (wid < NT) {
#pragma unroll
            for (int s = 0; s < 4; ++s) Bf[s] = *(const h16x8*)(kbase + (size_t)wid * 32 * 64 + 16 * s);
        }
        for (int rep_ = 0; rep_ <= MK_P3_REPA; ++rep_) {
        if (rep_ > 0 && wid < NT) {
#pragma unroll
            for (int s = 0; s < 4; ++s) Bf[s] = *(const h16x8*)(kbase + (size_t)wid * 32 * 64 + 16 * s);
        }
        for (int kt = wid; kt < NT; kt += NWAVES) {
            h16x8 Bn[4];
            const int ktn = (kt + NWAVES < NT) ? kt + NWAVES : kt;
#pragma unroll
            for (int s = 0; s < 4; ++s) Bn[s] = *(const h16x8*)(kbase + (size_t)ktn * 32 * 64 + 16 * s);
            f32x16 C = {};
#pragma unroll
            for (int g = 0; g < 4; ++g) {
                f32x16 S = {};
#pragma unroll
                for (int s = 0; s < 4; ++s) S = __builtin_amdgcn_mfma_f32_32x32x16_f16(Af[g][s], Bf[s], S, 0, 0, 0);
                const h16x8 X0 = relu_pk8(S, 0), X1 = relu_pk8(S, 8);
                const h16x8 zero8 = (h16x8){0, 0, 0, 0, 0, 0, 0, 0};
                const h16x8 W0 = (code == 2 * g) ? fragA : zero8, W1 = (code == 2 * g + 1) ? fragA : zero8;
                C = __builtin_amdgcn_mfma_f32_32x32x16_f16(W0, X0, C, 0, 0, 0);
                C = __builtin_amdgcn_mfma_f32_32x32x16_f16(W1, X1, C, 0, 0, 0);
            }
            const int key = kt * 32 + r;
#pragma unroll
            for (int e = 0; e < 4; ++e) { sc[(e + 4 * h) * 2048 + key] = C[e]; sc[(8 + e + 4 * h) * 2048 + key] = C[4 + e]; }
#pragma unroll
            for (int s = 0; s < 4; ++s) Bf[s] = Bn[s];
        }
        }
        __syncthreads();
        { const int un = (unit + nblk < NB * (L / 16)) ? unit + nblk : unit; const int ttn = (un & 15) * L + (un >> 4) * 16;
#pragma unroll
          for (int g = 0; g < 4; ++g)
#pragma unroll
              for (int s = 0; s < 4; ++s) Afn[g][s] = *(const h16x8*)(QIDX + (size_t)(ttn + 4 * g + (r >> 3)) * 512 + (r & 7) * 64 + 16 * s + 8 * h);
          if (r < 16) wn = *(const f32x4*)(WIDX + (size_t)(ttn + r) * 8 + 4 * h); }
#pragma unroll 1
        for (int qq_ = 0; qq_ < 2 * (1 + MK_P3_REPB); ++qq_) {
            const int qq = qq_ & 1;
            const int qi = 2 * wid + qq, pos = p0 + qi, nk = pos + 1, t = t0 + qi;
            unsigned selbits = 0u;
            if (nk <= 256) {
#pragma unroll
                for (int i = 0; i < 32; ++i) selbits |= ((i * 64 + lane) < nk ? 1u : 0u) << i;
            } else {
                float sv[32];
                const int full = nk >> 6;
                const unsigned valid = (full >= 32 ? 0xffffffffu : ((1u << full) - 1u)) | ((full < 32 && lane < (nk & 63)) ? (1u << full) : 0u);
#pragma unroll
                for (int i = 0; i < 32; ++i) { const float x = sc[qi * 2048 + i * 64 + lane]; sv[i] = ((valid >> i) & 1u) ? x : __builtin_nanf(""); }
                selbits = topk_select_lin(sv, valid, lane, (volatile __attribute__((address_space(3))) unsigned*)(sc + 16 * 2048 + wid * 448));
            }
            {
                __attribute__((address_space(3))) unsigned long long* stg = (__attribute__((address_space(3))) unsigned long long*)(sc + 16 * 2048 + wid * 448 + (qq ? 0 : 338));
                LDS_FENCE();
#pragma unroll
                for (int i = 0; i < 32; ++i) { const unsigned long long bal = __ballot((selbits >> i) & 1u); if (lane == 0) stg[i] = bal; }
            }
            (void)t;
        }
        __syncthreads();
        { const int q = tid & 15, tl = tid >> 4;
          MASK[((size_t)b * 32 + tl) * L + p0 + q] = ((__attribute__((address_space(3))) unsigned long long*)(sc + 16 * 2048 + (q >> 1) * 448 + ((q & 1) ? 0 : 338)))[tl]; }
    }
}

__device__ __forceinline__ void p4_attn_naive(const Params& P, unsigned char* lds, int blk, int nblk, int wv) {
    const int tid = my_tid(wv), wid = __builtin_amdgcn_readfirstlane(tid >> 6), lane = tid & 63;
    int* keys = (int*)lds; float* qf = (float*)(lds + 1024); float* pf = (float*)(lds + 1024 + 4096) + wid * 256; int* nselp = (int*)(lds + 1024 + 4096 + 8192);
    h16* QA = (h16*)(P.ws + WS_R1); const h16* Kb = (const h16*)(P.ws + WS_R2); const h16* Vb = (const h16*)(P.ws + WS_R3); const h16* SG = (const h16*)(P.ws + WS_R4);
    const unsigned long long* MASK = (const unsigned long long*)(P.ws + WS_MASK);
    for (int t = blk; t < T; t += nblk) {
        const int b = t >> 11;
        __syncthreads();
        if (tid < 128) { const h16x8 qv = *(const h16x8*)(QA + (size_t)t * 1024 + tid * 8);
#pragma unroll
            for (int e = 0; e < 8; ++e) qf[tid * 8 + e] = (float)qv[e]; }
        if (wid == 0) {
            unsigned long long m = (lane < 32) ? MASK[(size_t)t * 32 + lane] : 0ull;
            const int cnt = __popcll(m); int inc = cnt;
#pragma unroll
            for (int o = 1; o < 64; o <<= 1) { const int v = __shfl_up(inc, o); if (lane >= o) inc += v; }
            int off = inc - cnt;
            while (m) { const int k = __builtin_ctzll(m); keys[off++] = lane * 64 + k; m &= m - 1; }
            if (lane == 63) nselp[0] = inc;
        }
        __syncthreads();
        const int nsel = nselp[0], h = wid;
        float s[4];
#pragma unroll
        for (int c = 0; c < 4; ++c) {
            const int idx = lane + 64 * c; s[c] = -INFINITY;
            if (idx < nsel) {
                const h16x8* kp = (const h16x8*)(Kb + (size_t)(b * L + keys[idx]) * 1024 + h * 128); float a = 0.f;
#pragma unroll
                for (int cc = 0; cc < 16; ++cc) { const h16x8 kv = kp[cc];
#pragma unroll
                    for (int e = 0; e < 8; ++e) a = fmaf(qf[h * 128 + cc * 8 + e], (float)kv[e], a); }
                s[c] = a;
            }
        }
        const float mx = wave_max(fmaxf(fmaxf(s[0], s[1]), fmaxf(s[2], s[3])));
        float ls = 0.f;
#pragma unroll
        for (int c = 0; c < 4; ++c) { const int idx = lane + 64 * c; const float p = (idx < nsel) ? exp2f(s[c] - mx) : 0.f; pf[idx] = p; ls += p; }
        ls = wave_sum(ls);
        LDS_FENCE();
        float o0 = 0.f, o1 = 0.f;
        for (int k = 0; k < nsel; ++k) {
            const h16x2 v = *(const h16x2*)(Vb + (size_t)(b * L + keys[k]) * 1024 + h * 128 + 2 * lane); const float pk = pf[k];
            o0 = fmaf(pk, (float)v[0], o0); o1 = fmaf(pk, (float)v[1], o1);
        }
        const float inv = 1.0f / ls;
        const h16x2 g = *(const h16x2*)(SG + (size_t)t * 1024 + h * 128 + 2 * lane);
        h16x2 o; o[0] = (h16)(o0 * inv * (float)g[0]); o[1] = (h16)(o1 * inv * (float)g[1]);
        *(h16x2*)(QA + (size_t)t * 1024 + h * 128 + 2 * lane) = o;
    }
}


namespace att {
typedef unsigned short bf16;
typedef short bf16x8 __attribute__((ext_vector_type(8)));
typedef short s16x4 __attribute__((ext_vector_type(4)));
typedef float f32x16 __attribute__((ext_vector_type(16)));
typedef __attribute__((address_space(3))) char lchar;
typedef __attribute__((address_space(3))) float lfloat;
typedef __attribute__((address_space(3))) bf16x8 lbf16x8;
constexpr int D = 128, PITCH = 1024, NW = 8, QBLK = 32, KVBLK = 64, QB = NW * QBLK;
constexpr int SHM_V = KVBLK * D * 2, SHM_K = KVBLK * D * 2;
constexpr int LDS_ATT = 2 * SHM_V + 2 * SHM_K + NW * 64 * 4;
constexpr float THR = 8.f;
#define KSWZ(row, colB) ((row) * 256 + ((colB) ^ (((row) & 7) << 4)))
#define SBAR() __builtin_amdgcn_sched_barrier(0)
__device__ __forceinline__ int v_st(int k, int c) { const int kk = (k & ~0xC) | ((k & 4) << 1) | ((k & 8) >> 1); return ((kk >> 3) * 4 + (c >> 5)) * 512 + ((kk & 7) * 32 + (c & 31)) * 2; }
__device__ __forceinline__ int v_rd_base(int lane) { return ((lane & 3) << 3) | (((lane >> 2) & 3) << 6) | (((lane >> 4) & 1) << 5) | (((lane >> 5) & 1) << 8); }
constexpr int v_rd_off(int d0, int ks, int half) { return d0 * 512 + ks * 4096 + half * 2048; }
__device__ __forceinline__ int crow(int r, int hi) { return (r & 3) + 8 * (r >> 2) + 4 * hi; }
__device__ __forceinline__ bf16x8 load8(const bf16* p) { return *reinterpret_cast<const bf16x8*>(p); }
__device__ __forceinline__ void mask_init(f32x16& p0, f32x16& p1, unsigned long long mk, int hi) {
    const unsigned lo = (unsigned)mk >> (4 * hi), hh = (unsigned)(mk >> 32) >> (4 * hi);
#pragma unroll
    for (int r = 0; r < 16; ++r) {
        const int c = (r & 3) + 8 * (r >> 2);
        const int t0 = __builtin_amdgcn_sbfe(lo, c, 1), t1 = __builtin_amdgcn_sbfe(hh, c, 1);
        p0[r] = __uint_as_float(~(unsigned)t0 & 0xff800000u); p1[r] = __uint_as_float(~(unsigned)t1 & 0xff800000u);
    }
}
__device__ __forceinline__ void partialSM(f32x16& p0, f32x16& p1, float& m_reg, float& mn, float& alpha) {
    float pmax = p0[0]; for (int r = 1; r < 16; ++r) pmax = fmaxf(pmax, p0[r]); for (int r = 0; r < 16; ++r) pmax = fmaxf(pmax, p1[r]);
    { auto rr = __builtin_amdgcn_permlane32_swap(__float_as_uint(pmax), __float_as_uint(pmax), false, false);
      pmax = fmaxf(__uint_as_float(rr[0]), __uint_as_float(rr[1])); }
    if (__builtin_expect(__all((pmax - m_reg) <= THR), 1)) { mn = m_reg; alpha = 1.f; }
    else { mn = fmaxf(m_reg, pmax); alpha = __builtin_amdgcn_exp2f(m_reg - mn); m_reg = mn; }
    for (int r = 0; r < 16; ++r) p0[r] = p0[r] - mn; for (int r = 0; r < 16; ++r) p1[r] = p1[r] - mn;
    for (int r = 0; r < 16; ++r) p0[r] = __builtin_amdgcn_exp2f(p0[r]);
}
__device__ __forceinline__ void finishSM(f32x16& p0, f32x16& p1, float alpha, float& l_reg, bf16x8& pa0, bf16x8& pa1, bf16x8& pa2, bf16x8& pa3) {
    for (int r = 0; r < 16; ++r) p1[r] = __builtin_amdgcn_exp2f(p1[r]);
    float ps = 0; for (int r = 0; r < 16; ++r) ps += p0[r]; for (int r = 0; r < 16; ++r) ps += p1[r];
    { auto rr = __builtin_amdgcn_permlane32_swap(__float_as_uint(ps), __float_as_uint(ps), false, false);
      ps = __uint_as_float(rr[0]) + __uint_as_float(rr[1]); }
    l_reg = l_reg * alpha + ps;
#define PK4(P, B_, OUT) do { unsigned a0 = cvtpk_bf16(P[B_+0], P[B_+1]), a1 = cvtpk_bf16(P[B_+2], P[B_+3]);                          \
        unsigned b0 = cvtpk_bf16(P[B_+4], P[B_+5]), b1 = cvtpk_bf16(P[B_+6], P[B_+7]);                                             \
        auto r0 = __builtin_amdgcn_permlane32_swap(a0, b0, false, false); auto r1 = __builtin_amdgcn_permlane32_swap(a1, b1, false, false); \
        u32x4 w = {r0[0], r1[0], r0[1], r1[1]}; OUT = *reinterpret_cast<bf16x8*>(&w); } while (0)
    PK4(p0, 0, pa0); PK4(p0, 8, pa1); PK4(p1, 0, pa2); PK4(p1, 8, pa3);
#undef PK4
}
template <int KB>
__device__ __forceinline__ void qkt(f32x16& p0, f32x16& p1, const lchar* K_lds, int r32, int hi, const bf16x8* qr) {
    const lchar* kb[4];
#pragma unroll
    for (int dd = 0; dd < 4; ++dd) kb[dd] = K_lds + KB * SHM_K + KSWZ(r32, (dd * 16 + hi * 8) * 2);
#pragma unroll
    for (int d0 = 0; d0 < 8; ++d0) { const lchar* a = kb[d0 & 3] + (d0 >> 2) * 128;
        bf16x8 b0 = *(const lbf16x8*)(a);
        bf16x8 b1 = *(const lbf16x8*)(a + 32 * 256);
        p0 = __builtin_amdgcn_mfma_f32_32x32x16_bf16(b0, qr[d0], p0, 0, 0, 0);
        p1 = __builtin_amdgcn_mfma_f32_32x32x16_bf16(b1, qr[d0], p1, 0, 0, 0); }
}
template <int VB>
__device__ __forceinline__ void pv_tile(f32x16* o, int vb0, bf16x8 pa0, bf16x8 pa1, bf16x8 pa2, bf16x8 pa3) {
#define TRRD(dst, off) asm volatile("ds_read_b64_tr_b16 %0, %1 offset:%2" : "=&v"(dst) : "v"(vb0), "i"(off) : "memory")
#define PV_D0(d0) do { s16x4 l0, l1, l2, l3, h0, h1, h2, h3; constexpr int b_ = VB * SHM_V + v_rd_off(d0, 0, 0); \
        TRRD(l0, b_); TRRD(h0, b_ + 2048); TRRD(l1, b_ + 4096); TRRD(h1, b_ + 6144); TRRD(l2, b_ + 8192); TRRD(h2, b_ + 10240); TRRD(l3, b_ + 12288); TRRD(h3, b_ + 14336); \
        asm volatile("s_waitcnt lgkmcnt(0)" ::: "memory"); SBAR();   \
        o[d0] = __builtin_amdgcn_mfma_f32_32x32x16_bf16(pa0, (bf16x8){l0[0], l0[1], l0[2], l0[3], h0[0], h0[1], h0[2], h0[3]}, o[d0], 0, 0, 0);   \
        o[d0] = __builtin_amdgcn_mfma_f32_32x32x16_bf16(pa1, (bf16x8){l1[0], l1[1], l1[2], l1[3], h1[0], h1[1], h1[2], h1[3]}, o[d0], 0, 0, 0);   \
        o[d0] = __builtin_amdgcn_mfma_f32_32x32x16_bf16(pa2, (bf16x8){l2[0], l2[1], l2[2], l2[3], h2[0], h2[1], h2[2], h2[3]}, o[d0], 0, 0, 0);   \
        o[d0] = __builtin_amdgcn_mfma_f32_32x32x16_bf16(pa3, (bf16x8){l3[0], l3[1], l3[2], l3[3], h3[0], h3[1], h3[2], h3[3]}, o[d0], 0, 0, 0); } while (0)
    PV_D0(0); PV_D0(1); PV_D0(2); PV_D0(3);
#undef PV_D0
#undef TRRD
}
struct BlockRef { const bf16* Q; const bf16* K; const bf16* V; h16* O; const unsigned long long* M; const h16* G; int P0; };
struct Seam { bf16x8 qr[8]; bf16x8 st_v0, st_v1, st_k0, st_k1; };
#define VMW() asm volatile("s_waitcnt vmcnt(0)" ::: "memory")
#define VMWN(n) asm volatile("s_waitcnt vmcnt(%0)" :: "i"(n) : "memory")
#define SLOAD_H(Kp, Vp, k0) do { const unsigned o0_ = ro0 + (unsigned)(k0) * PITCH, o1_ = o0_ + 32u * PITCH;     \
                         S.st_v0 = load8((Vp) + o0_); S.st_v1 = load8((Vp) + o1_); S.st_k0 = load8((Kp) + o0_); S.st_k1 = load8((Kp) + o1_); } while (0)
#define SWRITE_HK(bf) do { *(lbf16x8*)(K_lds + (bf) * SHM_K + kws) = S.st_k0; *(lbf16x8*)(K_lds + (bf) * SHM_K + kws + 32 * 256) = S.st_k1; } while (0)
#define SWRITE_HV(bf) do { *(lbf16x8*)(V_lds + (bf) * SHM_V + vst0) = S.st_v0; *(lbf16x8*)(V_lds + (bf) * SHM_V + vst1) = S.st_v1; } while (0)
#define SWRITE_H(bf) do { SWRITE_HV(bf); SWRITE_HK(bf); } while (0)
__device__ __forceinline__ void prime(const BlockRef& cur, lchar* lds, Seam& S, int wv) {
    const int tid = my_tid(wv);
    const int wid = __builtin_amdgcn_readfirstlane(tid >> 6), lane = tid & 63, r32 = lane & 31, hi = lane >> 5;
    const int sr = tid >> 4, sc = (tid & 15) * 8, kws = KSWZ(sr, sc * 2); lchar* K_lds = lds + 2 * SHM_V;
    const unsigned ro0 = (unsigned)(sr * PITCH + sc), qo = (unsigned)((wid * QBLK + r32) * PITCH + hi * 8);
    for (int d0 = 0; d0 < 8; ++d0) S.qr[d0] = load8(cur.Q + (qo + (unsigned)(d0 * 16)));
    SLOAD_H(cur.K, cur.V, 0); VMW(); SWRITE_HK(0);
    __syncthreads();
}
__device__ __forceinline__ void block(const BlockRef& cur, const BlockRef& nxt, lchar* lds, Seam& S, int wv) {
    const int tid = my_tid(wv);
    const int wid = __builtin_amdgcn_readfirstlane(tid >> 6), lane = tid & 63, r32 = lane & 31, hi = lane >> 5;
    const int NT = (cur.P0 + QB - 1) / KVBLK + 1;
    lchar* V_lds = lds; lchar* K_lds = lds + 2 * SHM_V;
    lfloat* ws = (lfloat*)(lds + 2 * SHM_V + 2 * SHM_K) + wid * 64; lfloat* li_l = ws, * al_l = ws + 32;
    float m_reg = -1e30f, l_reg = 0; f32x16 o[4] = {};
    const int sr = tid >> 4, sc = (tid & 15) * 8, vst0 = v_st(sr, sc), vst1 = v_st(32 + sr, sc), kws = KSWZ(sr, sc * 2);
    const int vb0 = (int)(unsigned)(uintptr_t)V_lds + v_rd_base(lane);
    const unsigned ro0 = (unsigned)(sr * PITCH + sc), qo = (unsigned)((wid * QBLK + r32) * PITCH + hi * 8);
    const bf16* Kh = cur.K; const bf16* Vh = cur.V;
    const unsigned mro = (unsigned)(wid * QBLK + r32) * 8u;
#define LDMASK(tile) (*(const unsigned long long*)((const char*)cur.M + (mro + (unsigned)(tile) * (unsigned)(L * 8))))
    unsigned long long mk;
#define RESC(a) do { if (__any((a) < 1.f)) { if (hi == 0) al_l[r32] = (a); asm volatile("s_waitcnt lgkmcnt(0)" ::: "memory");              \
                     for (int d_ = 0; d_ < 4; ++d_) for (int r = 0; r < 16; ++r) o[d_][r] *= al_l[crow(r, hi)]; } } while (0)
#define KBASE(t) ((t) * KVBLK)
    constexpr int NQL = 8;
#define SEAM_K0() do { VMWN(NQL); SWRITE_HK(0); SBAR(); } while (0)
    f32x16 pA0, pA1, pB0, pB1; float mnA, mnB, alA, alB; bf16x8 pa0, pa1, pa2, pa3;
    SWRITE_HV(0); SBAR();
    mk = LDMASK(0);
    if (NT > 1) { SLOAD_H(Kh, Vh, KBASE(1)); }
    mask_init(pA0, pA1, mk, hi); if (NT > 1) mk = LDMASK(1);
    SBAR(); qkt<0>(pA0, pA1, K_lds, r32, hi, S.qr);
    partialSM(pA0, pA1, m_reg, mnA, alA);
    if (NT > 1) { VMW(); SWRITE_H(1); }
    __syncthreads();
#define HALF_STEP(PX0, PX1, mnX, alX, PY0, PY1, alY, t, KB, VB, SB) do {                                                      \
        mask_init(PX0, PX1, mk, hi);                                       \
        SBAR(); qkt<KB>(PX0, PX1, K_lds, r32, hi, S.qr);                                                                      \
        if ((t) + 1 < NT) mk = LDMASK((t) + 1);                                                              \
        finishSM(PY0, PY1, alY, l_reg, pa0, pa1, pa2, pa3); SBAR();                                                           \
        if ((t) + 1 < NT) { SLOAD_H(Kh, Vh, KBASE((t) + 1)); SBAR(); }                                                        \
        pv_tile<VB>(o, vb0, pa0, pa1, pa2, pa3); partialSM(PX0, PX1, m_reg, mnX, alX);                                        \
        __syncthreads();                                                                                                      \
        if ((t) + 1 < NT) { VMW(); SWRITE_H(SB); }                                                                            \
        RESC(alX); __syncthreads(); } while (0)
    for (int t = 1; t + 1 < NT; t += 2) {
        HALF_STEP(pB0, pB1, mnB, alB, pA0, pA1, alA, t, 1, 0, 0);
        HALF_STEP(pA0, pA1, mnA, alA, pB0, pB1, alB, t + 1, 0, 1, 1);
    }
    const bool even = (NT & 1) == 0;
    if (even) { mask_init(pB0, pB1, mk, hi); SBAR(); qkt<1>(pB0, pB1, K_lds, r32, hi, S.qr); SBAR(); }
    SLOAD_H(nxt.K, nxt.V, 0); SBAR();
#pragma unroll
    for (int d0 = 0; d0 < 8; ++d0) S.qr[d0] = load8(nxt.Q + (qo + (unsigned)(d0 * 16)));
    SBAR();
    finishSM(pA0, pA1, alA, l_reg, pa0, pa1, pa2, pa3); SBAR();
    pv_tile<0>(o, vb0, pa0, pa1, pa2, pa3);
    if (even) { partialSM(pB0, pB1, m_reg, mnB, alB); __syncthreads(); RESC(alB);
        finishSM(pB0, pB1, alB, l_reg, pa0, pa1, pa2, pa3); SBAR(); pv_tile<1>(o, vb0, pa0, pa1, pa2, pa3); }
    SBAR(); SEAM_K0();
    if (hi == 0) li_l[r32] = l_reg; asm volatile("s_waitcnt lgkmcnt(0)" ::: "memory");
    float rli[16];
#pragma unroll
    for (int r = 0; r < 16; ++r) rli[r] = __builtin_amdgcn_rcpf(li_l[crow(r, hi)]);
    __syncthreads();
    {
        typedef __attribute__((address_space(3))) h16 lh16; typedef __attribute__((address_space(3))) h16x8 lh16x8_;
        lchar* ob = V_lds + wid * 4096;
#pragma unroll
        for (int half = 0; half < 2; ++half) {
#pragma unroll
            for (int r = 0; r < 16; ++r) { const int orow = crow(r, hi);
#pragma unroll
                for (int dd = 0; dd < 2; ++dd) *(lh16*)(ob + orow * 128 + (dd * 32 + r32) * 2) = (h16)(o[half * 2 + dd][r] * rli[r]); }
            asm volatile("s_waitcnt lgkmcnt(0)" ::: "memory");
#pragma unroll
            for (int i = 0; i < 4; ++i) { const int c = lane + 64 * i, row = c >> 3, c8 = c & 7;
                const h16x8 ov = *(const lh16x8_*)(ob + row * 128 + c8 * 16);
                const unsigned oo = (unsigned)((wid * QBLK + row) * PITCH + half * 64 + c8 * 8);
                const h16x8 gv = *(const h16x8*)(cur.G + oo);
                *(h16x8*)(cur.O + oo) = ov * gv; }
            asm volatile("s_waitcnt lgkmcnt(0)" ::: "memory");
        }
    }
    __syncthreads();
#undef LDMASK
#undef RESC
#undef KBASE
#undef SEAM_K0
#undef HALF_STEP
}
#undef VMW
#undef VMWN
#undef SLOAD_H
#undef SWRITE_HK
#undef SWRITE_HV
#undef SWRITE_H
#undef KSWZ
#undef SBAR
}

__device__ __forceinline__ att::BlockRef att_ref(const Params& P, unsigned char* ws, int item, int pass) {
    const int xcd = item & 7, kq = item >> 3, bh = (kq >> 2) * 8 + xcd, x = kq & 3, qb = pass ? 7 - x : x, b = bh >> 3, h = bh & 7;
    const size_t row0 = (size_t)b * L + (size_t)qb * 256;
    att::BlockRef r;
    r.Q = (const att::bf16*)(ws + WS_R1) + row0 * 1024 + h * 128; r.O = (h16*)(ws + WS_AO) + row0 * 1024 + h * 128;
    r.K = (const att::bf16*)(ws + WS_R2) + (size_t)b * L * 1024 + h * 128; r.V = (const att::bf16*)(ws + WS_R3) + (size_t)b * L * 1024 + h * 128;
    r.M = (const unsigned long long*)(ws + WS_MASK) + (size_t)b * 32 * L + (size_t)qb * 256;
    r.G = (const h16*)(ws + WS_R4) + row0 * 1024 + h * 128; r.P0 = qb * 256;
    return r;
}
__device__ __forceinline__ void p4_attn(const Params& P, unsigned char* lds, int blk, int nblk, int wv) {
    unsigned char* ws = opaque_ptr(P.ws);
    const int total = NB * 8 * 4;
    int it = blk; if (it >= total) return;
    int pass = 0;
    att::BlockRef cur = att_ref(P, ws, it, 0);
    att::Seam S;
    att::prime(cur, (att::lchar*)lds, S, wv);
    for (;;) {
        const bool more_pass = pass == 0, more_item = it + nblk < total, last = !more_pass && !more_item;
        int itn = it, passn = pass + 1;
        if (!more_pass) { passn = 0; itn = more_item ? it + nblk : it; }
        const att::BlockRef nxt = last ? cur : att_ref(P, ws, itn, passn);
        att::block(cur, nxt, (att::lchar*)lds, S, wv);
        if (last) break;
        cur = nxt; it = itn; pass = passn;
    }
}

__device__ __forceinline__ void p8_ret_naive(const Params& P, unsigned char* lds, int blk, int nblk, int wv) {
    const int tid = my_tid(wv);
    float* qk = (float*)lds;
    const h16* RQ = (const h16*)(P.ws + WS_R1); const h16* RK = (const h16*)(P.ws + WS_R2); h16* RV = (h16*)(P.ws + WS_R4);
    const int j = tid >> 2, iq = tid & 3;
    for (int it = blk; it < 256; it += nblk) {
        const int b = it >> 4, h = (it >> 2) & 3, sl = it & 3;
        const float gamma = 1.0f - exp2f(-5.0f - (float)h);
        float S[64];
#pragma unroll
        for (int i = 0; i < 64; ++i) S[i] = 0.f;
        const int col = tid & 255;
        const h16* src = (tid < 256 ? RQ : RK) + (size_t)b * L * 1024 + h * 256 + col;
        float* dst = qk + (tid >> 8) * 272 + (col >> 6) * 68 + (col & 63);
        h16* vp = RV + (size_t)b * L * 2048 + h * 512 + sl * 128 + j;
        for (int t0 = 0; t0 < L; t0 += 16) {
            __syncthreads();
            h16 vv[16];
#pragma unroll
            for (int tt = 0; tt < 16; ++tt) { dst[tt * 544] = (float)src[(size_t)(t0 + tt) * 1024]; vv[tt] = vp[(size_t)(t0 + tt) * 2048]; }
            __syncthreads();
#pragma unroll
            for (int tt = 0; tt < 16; ++tt) {
                const f32x4* qp = (const f32x4*)(qk + tt * 544 + iq * 68); const f32x4* kp = (const f32x4*)(qk + tt * 544 + 272 + iq * 68);
                const float v = (float)vv[tt]; float o = 0.f;
#pragma unroll
                for (int i4 = 0; i4 < 16; ++i4) { const f32x4 q4 = qp[i4], k4 = kp[i4];
#pragma unroll
                    for (int e = 0; e < 4; ++e) { S[i4 * 4 + e] = fmaf(gamma, S[i4 * 4 + e], k4[e] * v); o = fmaf(q4[e], S[i4 * 4 + e], o); } }
                o += __shfl_xor(o, 1); o += __shfl_xor(o, 2);
                if (iq == 0) vp[(size_t)(t0 + tt) * 2048] = (h16)o;
            }
        }
    }
}


namespace ret {
typedef __attribute__((address_space(3))) unsigned char lch;
typedef __attribute__((address_space(3))) h16x8 lh16x8;
typedef __attribute__((address_space(3))) h16x4 lh16x4;
typedef __attribute__((address_space(3))) u32x4 lu32x4;
typedef short v4i16 __attribute__((ext_vector_type(4)));
typedef __attribute__((address_space(3))) v4i16 lv4i16;
constexpr int SKB = 544, SVB = 288, SSB = 544;
constexpr int OFF_K = 0, OFF_V = 64 * SKB, OFF_S = OFF_V + 64 * SVB, LDS_RET = OFF_S + 128 * SSB;
__device__ __forceinline__ h16x4 trrd(const lch* p) { return __builtin_bit_cast(h16x4, __builtin_amdgcn_ds_read_tr16_b64_v4i16((lv4i16*)p)); }
__device__ __forceinline__ h16x8 cat8(h16x4 a, h16x4 b) { return __builtin_shufflevector(a, b, 0, 1, 2, 3, 4, 5, 6, 7); }
}
__device__ __forceinline__ void p8_retention(const Params& P, unsigned char* lds_, int blk, int nblk, int wv) {
    using namespace ret;
    const int tid = my_tid(wv), wid = __builtin_amdgcn_readfirstlane(tid >> 6), lane = tid & 63, c16 = lane & 15, g = lane >> 4, q4 = c16 >> 2, p4 = c16 & 3;
    const int it = wid & 3, dh = wid >> 2;
    unsigned char* ws = opaque_ptr(P.ws);
    lch* Kc = (lch*)lds_ + OFF_K; lch* Vc = (lch*)lds_ + OFF_V; lch* St = (lch*)lds_ + OFF_S;
    const h16* RQ = (const h16*)(ws + WS_R1); const h16* RK = (const h16*)(ws + WS_R2); h16* RV = (h16*)(ws + WS_R4);
    for (int item = blk; item < 256; item += nblk) {
        const int b = item >> 4, h = (item >> 2) & 3, sl = item & 3;
        const float lgam = log2f(1.0f - exp2f(-5.0f - (float)h));
        const float gamma64 = exp2f(64.0f * lgam);
        f32x4 state[16];
#pragma unroll
        for (int d = 0; d < 16; ++d) state[d] = (f32x4){0.f, 0.f, 0.f, 0.f};
        __syncthreads();
        { unsigned zz = 0u; asm volatile("" : "+v"(zz));
          for (int i = tid; i < 128 * SSB / 16; i += NTHREADS) ((lu32x4*)St)[i] = (u32x4){zz, zz, zz, zz}; }
        const h16* kg = RK + (size_t)b * L * 1024 + h * 256; const h16* vg = RV + (size_t)b * L * 2048 + h * 512 + sl * 128;
        h16x8 kreg[4], vreg[2];
        const unsigned qoff = (unsigned)((16 * it + c16) * 1024 + 8 * g), ooff = (unsigned)((16 * it + c16) * 2048 + 64 * dh + 4 * g);
        unsigned ko[4], vo[2];
#pragma unroll
        for (int i = 0; i < 4; ++i) { const int c = tid + NTHREADS * i; ko[i] = (unsigned)((c >> 5) * 1024 + (c & 31) * 8); }
#pragma unroll
        for (int i = 0; i < 2; ++i) { const int c = tid + NTHREADS * i; vo[i] = (unsigned)((c >> 4) * 2048 + (c & 15) * 8); }
#pragma unroll
        for (int i = 0; i < 4; ++i) kreg[i] = *(const h16x8*)(kg + ko[i]);
#pragma unroll
        for (int i = 0; i < 2; ++i) vreg[i] = *(const h16x8*)(vg + vo[i]);
#pragma unroll
        for (int i = 0; i < 4; ++i) { const int c = tid + NTHREADS * i; *(lh16x8*)(Kc + (c >> 5) * SKB + (c & 31) * 16) = kreg[i]; }
#pragma unroll
        for (int i = 0; i < 2; ++i) { const int c = tid + NTHREADS * i; *(lh16x8*)(Vc + (c >> 4) * SVB + (c & 15) * 16) = vreg[i]; }
        h16x8 Qn[8];
#pragma unroll
        for (int s = 0; s < 8; ++s) Qn[s] = *(const h16x8*)((RQ + (size_t)b * L * 1024 + h * 256) + (qoff + (unsigned)(32 * s)));
        __syncthreads();
        for (int n = 0; n < L / 64; ++n) {
            const size_t row0 = (size_t)b * L + (size_t)n * 64;
            const int nn = (n + 1 < L / 64) ? n + 1 : n;
            float lg = lgam; asm volatile("" : "+v"(lg));
            const float xi = __builtin_amdgcn_exp2f((float)(16 * it + c16 + 1) * lg);
            h16x8 Qf[8];
#pragma unroll
            for (int s = 0; s < 8; ++s) Qf[s] = Qn[s];
#pragma unroll
            for (int s = 0; s < 8; ++s) Qn[s] = *(const h16x8*)((RQ + ((size_t)b * L + (size_t)nn * 64) * 1024 + h * 256) + (qoff + (unsigned)(32 * s)));
            h16x8 Pf[2];
#pragma unroll
            for (int ks = 0; ks < 2; ++ks)
#pragma unroll
                for (int e = 0; e < 8; ++e) Pf[ks][e] = (h16)0.f;
#pragma unroll
            for (int jt = 0; jt < 4; ++jt) {
                if (jt <= it) {
                    f32x4 S = (f32x4){0.f, 0.f, 0.f, 0.f};
#pragma unroll
                    for (int s = 0; s < 8; ++s) { const h16x8 A = *(const lh16x8*)(Kc + (16 * jt + c16) * SKB + (32 * s + 8 * g) * 2); S = __builtin_amdgcn_mfma_f32_16x16x32_f16(A, Qf[s], S, 0, 0, 0); }
#pragma unroll
                    for (int e = 0; e < 4; ++e) { const int d = (16 * it + c16) - (16 * jt + 4 * g + e); const float f = (d >= 0) ? __builtin_amdgcn_exp2f((float)d * lg) : 0.f; Pf[jt >> 1][(jt & 1) * 4 + e] = (h16)(S[e] * f); }
                }
            }
            f32x4 acc[4];
#pragma unroll
            for (int dt = 0; dt < 4; ++dt) {
                acc[dt] = (f32x4){0.f, 0.f, 0.f, 0.f};
#pragma unroll
                for (int s = 0; s < 8; ++s) { const h16x8 A = *(const lh16x8*)(St + (16 * (4 * dh + dt) + c16) * SSB + (32 * s + 8 * g) * 2); acc[dt] = __builtin_amdgcn_mfma_f32_16x16x32_f16(A, Qf[s], acc[dt], 0, 0, 0); }
                acc[dt] = acc[dt] * xi;
            }
#pragma unroll
            for (int ks = 0; ks < 2; ++ks) {
                if (2 * ks <= it) {
#pragma unroll
                    for (int dt = 0; dt < 4; ++dt) {
                        const lch* vp = Vc + (32 * ks + 4 * g + q4) * SVB + (16 * (4 * dh + dt) + 4 * p4) * 2;
                        const h16x8 A = cat8(trrd(vp), trrd(vp + 16 * SVB));
                        acc[dt] = __builtin_amdgcn_mfma_f32_16x16x32_f16(A, Pf[ks], acc[dt], 0, 0, 0);
                    }
                }
            }
#pragma unroll
            for (int dt = 0; dt < 4; ++dt) *(h16x4*)((vg + (size_t)n * 64 * 2048) + (ooff + (unsigned)(16 * dt))) = pack4(acc[dt]);
#pragma unroll
            for (int i = 0; i < 4; ++i) kreg[i] = *(const h16x8*)((kg + (size_t)nn * 64 * 1024) + ko[i]);
#pragma unroll
            for (int i = 0; i < 2; ++i) vreg[i] = *(const h16x8*)((vg + (size_t)nn * 64 * 2048) + vo[i]);
            h16x8 Bv[2];
#pragma unroll
            for (int ks = 0; ks < 2; ++ks) { const lch* vp = Vc + (32 * ks + 8 * g + q4) * SVB + (16 * wid + 4 * p4) * 2; h16x8 zf;
#pragma unroll
                for (int e = 0; e < 8; ++e) zf[e] = (h16)__builtin_amdgcn_exp2f((float)(63 - (32 * ks + 8 * g + e)) * lg);
                Bv[ks] = cat8(trrd(vp), trrd(vp + 4 * SVB)) * zf; }
#pragma unroll
            for (int dkt = 0; dkt < 16; ++dkt) {
                state[dkt] = state[dkt] * gamma64;
#pragma unroll
                for (int ks = 0; ks < 2; ++ks) { const lch* kp = Kc + (32 * ks + 8 * g + q4) * SKB + (16 * dkt + 4 * p4) * 2;
                    const h16x8 A = cat8(trrd(kp), trrd(kp + 4 * SKB)); state[dkt] = __builtin_amdgcn_mfma_f32_16x16x32_f16(A, Bv[ks], state[dkt], 0, 0, 0); }
            }
            __syncthreads();
#pragma unroll
            for (int dkt = 0; dkt < 16; ++dkt) *(lh16x4*)(St + (16 * wid + c16) * SSB + (16 * dkt + 4 * g) * 2) = pack4(state[dkt]);
#pragma unroll
            for (int i = 0; i < 4; ++i) { const int c = tid + NTHREADS * i; *(lh16x8*)(Kc + (c >> 5) * SKB + (c & 31) * 16) = kreg[i]; }
#pragma unroll
            for (int i = 0; i < 2; ++i) { const int c = tid + NTHREADS * i; *(lh16x8*)(Vc + (c >> 4) * SVB + (c & 15) * 16) = vreg[i]; }
            __syncthreads();
        }
    }
}

__device__ __forceinline__ void p9_gnorm(const Params& P, int blk, int nblk, int wv) {
    const int tid = my_tid(wv), wid = tid >> 6, lane = tid & 63;
    unsigned char* ws = opaque_ptr(P.ws);
    h16* RO = (h16*)(ws + WS_R4); const h16* RG = (const h16*)(ws + WS_RG);
    const int gw = blk * NWAVES + wid, ngw = nblk * NWAVES;
    for (int t0 = gw; t0 < T; t0 += 2 * ngw) {
        h16x8 xv[2][4], gv[2][4];
#pragma unroll
        for (int k = 0; k < 2; ++k) { const int t = (t0 + k * ngw < T) ? t0 + k * ngw : t0;
#pragma unroll
            for (int h = 0; h < 4; ++h) { const size_t o = (size_t)t * 2048 + h * 512 + lane * 8; xv[k][h] = *(const h16x8*)(RO + o); gv[k][h] = *(const h16x8*)(RG + o); } }
#pragma unroll
        for (int k = 0; k < 2; ++k) { const int t = t0 + k * ngw;
#pragma unroll
            for (int h = 0; h < 4; ++h) {
                float v[8]; float s = 0.f;
#pragma unroll
                for (int e = 0; e < 8; ++e) { v[e] = (float)xv[k][h][e]; s += v[e]; }
                const float mu = wave_sum_dpp(s) * (1.0f / 512.0f); float q = 0.f;
#pragma unroll
                for (int e = 0; e < 8; ++e) { v[e] -= mu; q += v[e] * v[e]; }
                const float rstd = rsqrtf(wave_sum_dpp(q) * (1.0f / 512.0f) + EPS);
                h16x8 y;
#pragma unroll
                for (int e = 0; e < 8; ++e) y[e] = (h16)(v[e] * rstd * (float)gv[k][h][e]);
                if (t < T) *(h16x8*)(RO + (size_t)t * 2048 + h * 512 + lane * 8) = y;
            } }
    }
}

__device__ __forceinline__ void p12_final(const Params& P, int blk, int nblk, int wv) {
    const int tid = my_tid(wv), wid = tid >> 6, lane = tid & 63;
    unsigned char* ws = opaque_ptr(P.ws);
    const float* sq = (const float*)(ws + WS_SQH) + (size_t)3 * T * 16; const f32x4* g4 = (const f32x4*)P.in[18]; const h16* H4 = (const h16*)(ws + WS_R1);
    const int gw = blk * NWAVES + wid, ngw = nblk * NWAVES;
    for (int r0 = gw; r0 < T; r0 += 4 * ngw) {
        h16x8 hv[4][2]; f32x4 qv[4][4];
#pragma unroll
        for (int k = 0; k < 4; ++k) { const int r = r0 + k * ngw; if (r < T) {
#pragma unroll
            for (int j = 0; j < 2; ++j) hv[k][j] = *(const h16x8*)(H4 + (size_t)r * 1024 + (lane + 64 * j) * 8);
#pragma unroll
            for (int j = 0; j < 4; ++j) qv[k][j] = ((const f32x4*)(sq + (size_t)r * 16))[j]; } }
#pragma unroll
        for (int k = 0; k < 4; ++k) { const int r = r0 + k * ngw; if (r < T) {
            float s = 0.f;
#pragma unroll
            for (int j = 0; j < 4; ++j) s += (qv[k][j][0] + qv[k][j][1]) + (qv[k][j][2] + qv[k][j][3]);
            const float rstd = rsqrtf(s * (1.0f / 1024.0f) + EPS);
            f32x4* orow = (f32x4*)(P.out + (size_t)r * 1024);
#pragma unroll
            for (int j = 0; j < 2; ++j) { const int c4 = (lane + 64 * j) * 2; const f32x4 ga = g4[c4], gb = g4[c4 + 1]; f32x4 a, b2;
#pragma unroll
                for (int e = 0; e < 4; ++e) { a[e] = (float)hv[k][j][e] * rstd * ga[e]; b2[e] = (float)hv[k][j][4 + e] * rstd * gb[e]; }
                orow[c4] = a; orow[c4 + 1] = b2; } } }
    }
}

#define XB_TMO      128
#define XB_XCNT(j)  (256  + 64 * (j))
#define XB_XSUB(j)  (1280 + 64 * (j))
#define XB_XGEN(j)  (2304 + 64 * (j))
#define XB_TOP      3328
#define XB_TOPGEN   3392
#define XCD_BAR_WORDS 3456
#define XB_SPIN_CAP (1u << 18)
__device__ __forceinline__ unsigned xb_ld(unsigned* p)              { return __hip_atomic_load(p, __ATOMIC_RELAXED, __HIP_MEMORY_SCOPE_AGENT); }
__device__ __forceinline__ unsigned xb_add(unsigned* p, unsigned v) { return __hip_atomic_fetch_add(p, v, __ATOMIC_RELAXED, __HIP_MEMORY_SCOPE_AGENT); }
__device__ __forceinline__ unsigned xb_xcc_id() { return (unsigned)__builtin_amdgcn_s_getreg((3 << 11) | 20) & 0xFu; }
#define XB_SPIN(cond, bar) do { unsigned _sp = 0; while (cond) { __builtin_amdgcn_s_sleep(1); \
    if ((++_sp & 255u) == 0u) { if (xb_ld(&(bar)[XB_TMO])) break; if (_sp > XB_SPIN_CAP) { atomicAdd(&(bar)[XB_TMO], 1u); break; } } } } while (0)
typedef volatile __attribute__((address_space(3))) unsigned lvu32;
__device__ __forceinline__ void xcd_barrier_complete(unsigned* bar, unsigned x, unsigned G, unsigned& nloc, unsigned& nx) {
    unsigned sum, cnt, mine, sp = 0u;
    for (;;) {
        sum = 0u; cnt = 0u; mine = 0u;
#pragma unroll
        for (unsigned j = 0; j < 16; ++j) { const unsigned c = xb_ld(&bar[XB_XCNT(j)]); sum += c; cnt += (c > 0u) ? 1u : 0u; mine = (j == x) ? c : mine; }
        if (sum == G) break;
        __builtin_amdgcn_s_sleep(1);
        if ((++sp & 255u) == 0u) { if (xb_ld(&bar[XB_TMO])) break; if (sp > XB_SPIN_CAP) { atomicAdd(&bar[XB_TMO], 1u); break; } }
    }
    nloc = mine > 0u ? mine : 1u; nx = cnt > 0u ? cnt : 1u;
}
__device__ __forceinline__ void xcd_barrier(unsigned* bar_, unsigned x_, lvu32* st, unsigned G, int wv) {
    unsigned x = x_; asm volatile("" : "+s"(x));
    unsigned* bar = opaque_ptr(bar_);
    asm volatile("s_waitcnt vmcnt(0)" ::: "memory");
    __syncthreads();
    if (my_tid(wv) == 0) {
        __builtin_amdgcn_s_waitcnt(0);
        unsigned nloc = st[0], nx = st[1];
        if (nloc == 0u) { xcd_barrier_complete(bar, x, G, nloc, nx); st[0] = nloc; st[1] = nx; }
        const unsigned old = xb_add(&bar[XB_XSUB(x)], 1u);
        const unsigned gen = old / nloc;
        if (old + 1u == (gen + 1u) * nloc) {
            __builtin_amdgcn_fence(__ATOMIC_RELEASE, "agent");
            asm volatile("s_waitcnt vmcnt(0)" ::: "memory");
            const unsigned og = xb_add(&bar[XB_TOP], 1u);
            const unsigned tg = og / nx;
            if (og + 1u == (tg + 1u) * nx) xb_add(&bar[XB_TOPGEN], 1u);
            else XB_SPIN(xb_ld(&bar[XB_TOPGEN]) == tg, bar);
            __builtin_amdgcn_fence(__ATOMIC_ACQUIRE, "agent");
            xb_add(&bar[XB_XGEN(x)], 1u);
            asm volatile("s_waitcnt vmcnt(0)" ::: "memory");
        } else {
            XB_SPIN(xb_ld(&bar[XB_XGEN(x)]) == gen, bar);
            __builtin_amdgcn_fence(__ATOMIC_ACQUIRE, "agent");
            asm volatile("s_waitcnt vmcnt(0)" ::: "memory");
        }
    }
    __syncthreads();
}

__device__ __forceinline__ void run_gemm_job(const Params& P, unsigned char* lds, int ph, int j, int blk, int nblk, int wv) {
    unsigned char* ws = opaque_ptr(P.ws);
    float* SQKV = (float*)(ws + WS_SQKV); float* SQQ = (float*)(ws + WS_SQQ); float* SQH = (float*)(ws + WS_SQH);
    int kind = 0; Gemm g; g.M = T; g.A = nullptr; g.Bt = nullptr; g.lda = g.ldb = g.N = g.K = 0;
    h16 *h0 = nullptr, *h1 = nullptr; const h16* ch0 = nullptr; const h16* ch1 = nullptr; const float* cf0 = nullptr; float* f0 = nullptr; float* f1 = nullptr; int i0 = 0, i1 = 0, i2 = 0, i3 = 0, i4 = 0; float x0 = 0.f;
    if (ph == 1) { kind = 0; g.A = (const h16*)(ws + WS_R1); g.Bt = (const h16*)(ws + WS_WAIN); g.lda = 1024; g.ldb = 1024; g.N = 1792; g.K = 1024; }
    else if (ph == 2) {
        kind = 1;
        if (j == 0) { g.A = (const h16*)(ws + WS_CQX); g.Bt = (const h16*)(ws + WS_WQ); g.lda = 512; g.ldb = 384; g.N = 1536; g.K = 384;
                      cf0 = SQQ; i0 = 8; x0 = 1.0f / 384.0f; h0 = (h16*)(ws + WS_R1); h1 = (h16*)(ws + WS_QIDX); i1 = 1024; i2 = 512; i3 = 1; i4 = 0; }
        else if (j == 1) { g.A = (const h16*)(ws + WS_CKV); g.Bt = (const h16*)(ws + WS_WKV); g.lda = 256; g.ldb = 256; g.N = 2048; g.K = 256;
                      cf0 = SQKV; i0 = 4; x0 = 1.0f / 256.0f; h0 = (h16*)(ws + WS_R2); h1 = (h16*)(ws + WS_R3); i1 = 1024; i2 = 1024; i3 = 1; i4 = 1; }
        else { g.A = (const h16*)(ws + WS_PH0); g.Bt = (const h16*)(ws + WS_WPLE); g.lda = 256; g.ldb = 256; g.N = 1024; g.K = 256;
                      cf0 = nullptr; i0 = 0; x0 = 0.f; h0 = (h16*)(ws + WS_R5); h1 = nullptr; i1 = 1024; i2 = 1024; }
    }
    else if (ph == 5) { kind = 2; g.A = (const h16*)(ws + WS_AO); g.Bt = (const h16*)(ws + WS_WAOUT); g.lda = 1024; g.ldb = 1024; g.N = 1024; g.K = 1024;
                      cf0 = P.in[0]; ch0 = nullptr; h0 = (h16*)(ws + WS_R2); f1 = SQH; }
    else if (ph == 6) { kind = 3; g.A = (const h16*)(ws + WS_R2); g.Bt = (const h16*)(ws + WS_WPG); g.lda = 1024; g.ldb = 1024; g.N = 1024; g.K = 1024;
                      ch1 = (const h16*)(ws + WS_R2); ch0 = (const h16*)(ws + WS_R5); h0 = (h16*)(ws + WS_R3); cf0 = SQH; f1 = SQH + (size_t)T * 16; }
    else if (ph == 7) { kind = 4; g.A = (const h16*)(ws + WS_R3); g.Bt = (const h16*)(ws + WS_WRIN); g.lda = 1024; g.ldb = 1024; g.N = 6144; g.K = 1024; }
    else if (ph == 10) {
        if (j == 0) { kind = 2; g.A = (const h16*)(ws + WS_R4); g.Bt = (const h16*)(ws + WS_WROUT); g.lda = 2048; g.ldb = 2048; g.N = 1024; g.K = 2048;
                      cf0 = nullptr; ch0 = (const h16*)(ws + WS_R3); h0 = (h16*)(ws + WS_R2); f1 = SQH + (size_t)2 * T * 16; }
        else { kind = 1; g.A = (const h16*)(ws + WS_PH1); g.Bt = (const h16*)(ws + WS_WPLE) + (size_t)1024 * 256; g.lda = 256; g.ldb = 256; g.N = 1024; g.K = 256;
                      cf0 = nullptr; i0 = 0; x0 = 0.f; h0 = (h16*)(ws + WS_R1); h1 = nullptr; i1 = 1024; i2 = 1024; }
    }
    else { kind = 5; g.A = (const h16*)(ws + WS_R2); g.Bt = (const h16*)(ws + WS_WPG) + (size_t)1024 * 1024; g.lda = 1024; g.ldb = 1024; g.N = 1024; g.K = 1024;
                      ch1 = (const h16*)(ws + WS_R2); ch0 = (const h16*)(ws + WS_R1); h0 = (h16*)(ws + WS_R1); cf0 = SQH + (size_t)2 * T * 16; f1 = SQH + (size_t)3 * T * 16; }
    switch (kind) {
        case 0: { EpiInA E{(h16*)(ws + WS_CKV), (h16*)(ws + WS_CQX), (h16*)(ws + WS_R4), SQKV, SQQ, nullptr, 0, 0.f}; gemm_run(lds, g, E, blk, nblk, wv); break; }
        case 1: { EpiScale E{cf0, i0, x0, h0, h1, 4, i1, i2, i3, i4}; gemm_run(lds, g, E, blk, nblk, wv); break; }
        case 2: { EpiRes E{cf0, ch0, h0, f1, nullptr, 0, 0.f}; gemm_run(lds, g, E, blk, nblk, wv); break; }
        case 3: { EpiPle E{ch1, ch0, h0, cf0, f1, 16, 1.0f / 1024.0f}; gemm_run(lds, g, E, blk, nblk, wv); break; }
        case 5: { EpiPleFinal E{ch1, ch0, cf0, 16, 1.0f / 1024.0f, P.in[18], P.out, (unsigned*)(SQH + (size_t)3 * T * 16), (unsigned*)(ws + WS_BAR + 16384), (unsigned*)(ws + WS_BAR) + XB_TMO}; gemm_run(lds, g, E, blk, nblk, wv); break; }
        default: { EpiInR E{SQH + (size_t)T * 16, (const f32x2*)(ws + WS_SINCOS), (h16*)(ws + WS_R1), (h16*)(ws + WS_R2), (h16*)(ws + WS_R4), (h16*)(ws + WS_RG), 16, 1.0f / 1024.0f}; gemm_run(lds, g, E, blk, nblk, wv); break; }
    }
}

__global__ void __launch_bounds__(NTHREADS, 2) mk_fwd(Params P_) {
    extern __shared__ __attribute__((aligned(16))) unsigned char lds[];
    cg::grid_group grid = cg::this_grid();
    const int wv = __builtin_amdgcn_readfirstlane((int)(threadIdx.x >> 6));
    lvu32* bst = (lvu32*)(lds + LDS_BYTES - 16);
    unsigned* bar = (unsigned*)(P_.ws + WS_BAR);
    const unsigned xcc = xb_xcc_id();
    if (threadIdx.x == 0) { bst[0] = 0u; bst[1] = 0u; if (P_.ph_hi - P_.ph_lo > 1) (void)xb_add(&bar[XB_XCNT(xcc)], 1u); }
    __syncthreads();
    int dup_cnt = 0; (void)dup_cnt;
    const int blk_k = blockIdx.x, nblk_k = gridDim.x; const int ph_lo = P_.ph_lo, ph_hi = P_.ph_hi;
    for (int ph = ph_lo; ph < ph_hi; ++ph) {
        int blk = blk_k, nblk = nblk_k; asm volatile("" : "+s"(blk), "+s"(nblk));
        const Params& P = P_;
        if (ph == 0) p0_prologue(P, lds, blk, nblk, wv);
        else if (ph == 3) p3_indexer(P, lds, blk, nblk, wv);
        else if (ph == 4) p4_attn(P, lds, blk, nblk, wv);
        else if (ph == 8) p8_retention(P, lds, blk, nblk, wv);
        else if (ph == 9) p9_gnorm(P, blk, nblk, wv);
        else {
            if (ph == 2) p2_kidx(P, blk, nblk, wv);
            const int nj = (ph == 2) ? 3 : (ph == 10) ? 2 : 1;
            for (int j = 0; j < nj; ++j) run_gemm_job(P, lds, ph, j, blk, nblk, wv);
        }
        if (ph + 1 < ph_hi) { if (ph_hi < 0) grid.sync(); else xcd_barrier(bar, xcc, bst, (unsigned)nblk, wv); }
#if MK_DUP_MASK
        if (((MK_DUP_MASK >> ph) & 1) && dup_cnt < MK_DUP_N) { ++dup_cnt; --ph; } else dup_cnt = 0;
#endif
    }
}

#ifndef MK_FUSED
#define MK_FUSED 1
#endif
extern "C" void kernel_launch(void* const* d_in, const int* in_sizes, int n_in, void* d_out, int out_size, void* d_ws, size_t ws_size, hipStream_t stream) {
    static int grid = 0;
    if (grid == 0) {
        if (n_in != 19 || out_size != T * D || ws_size < WS_END) { fprintf(stderr, "kernel_launch: unexpected shapes (n_in %d, out %d, ws %zu)\n", n_in, out_size, ws_size); grid = -1; return; }
        int dev = 0, cus = 0, per_cu = 0;
        hipGetDevice(&dev);
        hipDeviceGetAttribute(&cus, hipDeviceAttributeMultiprocessorCount, dev);
        if (hipFuncSetAttribute((const void*)mk_fwd, hipFuncAttributeMaxDynamicSharedMemorySize, LDS_BYTES) != hipSuccess) { fprintf(stderr, "kernel_launch: hipFuncSetAttribute failed\n"); grid = -1; return; }
        hipOccupancyMaxActiveBlocksPerMultiprocessor(&per_cu, (const void*)mk_fwd, NTHREADS, LDS_BYTES);
        if (per_cu < 1) { fprintf(stderr, "kernel_launch: occupancy query says %d blocks per CU\n", per_cu); grid = -1; return; }
        grid = cus * 1;
    }
    if (grid < 0) return;
    (void)hipMemsetAsync((char*)d_ws + WS_BAR, 0, 16384 + 32768, stream);
    Params P{};
    for (int i = 0; i < 19; ++i) P.in[i] = (const float*)d_in[i];
    P.out = (float*)d_out; P.ws = (unsigned char*)d_ws;
#if MK_FUSED
    P.ph_lo = 0; P.ph_hi = NPH;
    void* args[] = {&P};
    hipError_t e = hipLaunchCooperativeKernel((const void*)mk_fwd, dim3(grid), dim3(NTHREADS), args, LDS_BYTES, stream);
    if (e != hipSuccess) fprintf(stderr, "cooperative launch failed: %s (grid %d)\n", hipGetErrorString(e), grid);
#else
    for (int ph = 0; ph < NPH; ++ph) {
        P.ph_lo = ph; P.ph_hi = ph + 1;
        hipLaunchKernelGGL(mk_fwd, dim3(grid), dim3(NTHREADS), LDS_BYTES, stream, P);
    }
#endif
}
```

```cpp
#include <hip/hip_runtime.h>
#include <hip/hip_cooperative_groups.h>
#include <cstdio>
#include <cstdint>
namespace cg = cooperative_groups;
#ifndef MK_DUP_MASK
#define MK_DUP_MASK 0
#endif
#ifndef MK_P3_REPA
#define MK_P3_REPA 0
#endif
#ifndef MK_P3_REPB
#define MK_P3_REPB 0
#endif
#ifndef MK_EPI_REP
#define MK_EPI_REP 0
#endif
#ifndef MK_DUP_N
#define MK_DUP_N 3
#endif

typedef _Float16 h16;
typedef _Float16 h16x2 __attribute__((ext_vector_type(2)));
typedef _Float16 h16x4 __attribute__((ext_vector_type(4)));
typedef _Float16 h16x8 __attribute__((ext_vector_type(8)));
typedef float f32x2 __attribute__((ext_vector_type(2)));
typedef float f32x4 __attribute__((ext_vector_type(4)));
typedef unsigned u32x4 __attribute__((ext_vector_type(4)));

constexpr int NB = 16, L = 2048, T = NB * L, D = 1024;
constexpr float EPS = 1e-6f;
constexpr int NPH = 12;
constexpr int NTHREADS = 512, NWAVES = 8;
constexpr int LDS_BYTES = 147456;

constexpr size_t MiB = (size_t)1 << 20;
constexpr size_t WS_WAIN = 0 * MiB;
constexpr size_t WS_WQ = 4 * MiB;
constexpr size_t WS_WKV = 6 * MiB;
constexpr size_t WS_WAOUT = 7 * MiB;
constexpr size_t WS_WPG = 9 * MiB;
constexpr size_t WS_WPLE = 13 * MiB;
constexpr size_t WS_WRIN = 14 * MiB;
constexpr size_t WS_WROUT = 26 * MiB;
constexpr size_t WS_SINCOS = 30 * MiB;
constexpr size_t WS_SQKV = 32 * MiB;
constexpr size_t WS_SQQ = 33 * MiB;
constexpr size_t WS_SQH = 34 * MiB;
constexpr size_t WS_KIDXN = 42 * MiB;
constexpr size_t WS_WIDX = 46 * MiB;
constexpr size_t WS_BAR = 47 * MiB;
constexpr size_t WS_PH1 = 48 * MiB;
constexpr size_t WS_R1 = 64 * MiB;
constexpr size_t WS_R2 = 128 * MiB;
constexpr size_t WS_R3 = 192 * MiB;
constexpr size_t WS_R4 = 256 * MiB;
constexpr size_t WS_R5 = 320 * MiB;
constexpr size_t WS_PH0 = 384 * MiB;
constexpr size_t WS_CQX = 400 * MiB;
constexpr size_t WS_CKV = 432 * MiB;
constexpr size_t WS_QIDX = 448 * MiB;
constexpr size_t WS_MASK = 480 * MiB;
constexpr size_t WS_AO = 400 * MiB;
constexpr size_t WS_RG = 384 * MiB;
constexpr size_t WS_END = 512 * MiB;

struct Params { const float* in[19]; float* out; unsigned char* ws; int ph_lo, ph_hi; };

__constant__ float kAngle[128] = {
    1.000000000e+00f, 9.300450087e-01f, 8.649836779e-01f, 8.044736385e-01f, 7.481966019e-01f, 6.958565116e-01f, 6.471778154e-01f, 6.019044518e-01f,
    5.597981811e-01f, 5.206375122e-01f, 4.842162728e-01f, 4.503428936e-01f, 4.188391268e-01f, 3.895392120e-01f, 3.622889817e-01f, 3.369450271e-01f,
    3.133740425e-01f, 2.914519310e-01f, 2.710633874e-01f, 2.521011233e-01f, 2.344653904e-01f, 2.180633694e-01f, 2.028087080e-01f, 1.886212230e-01f,
    1.754262149e-01f, 1.631542742e-01f, 1.517407894e-01f, 1.411257535e-01f, 1.312533021e-01f, 1.220714748e-01f, 1.135319397e-01f, 1.055898219e-01f,
    9.820328653e-02f, 9.133346379e-02f, 8.494423330e-02f, 7.900195569e-02f, 7.347535342e-02f, 6.833537668e-02f, 6.355497986e-02f, 5.910899118e-02f,
    5.497401953e-02f, 5.112830922e-02f, 4.755162448e-02f, 4.422515258e-02f, 4.113136977e-02f, 3.825402260e-02f, 3.557796404e-02f, 3.308910504e-02f,
    3.077435680e-02f, 2.862153389e-02f, 2.661931701e-02f, 2.475716174e-02f, 2.302526683e-02f, 2.141453326e-02f, 1.991648041e-02f, 1.852322184e-02f,
    1.722742990e-02f, 1.602228358e-02f, 1.490144618e-02f, 1.385901403e-02f, 1.288950257e-02f, 1.198781747e-02f, 1.114920899e-02f, 1.036926545e-02f,
    9.643883444e-03f, 8.969245479e-03f, 8.341802284e-03f, 7.758250926e-03f, 7.215522230e-03f, 6.710760761e-03f, 6.241309457e-03f, 5.804697983e-03f,
    5.398627371e-03f, 5.020966288e-03f, 4.669724498e-03f, 4.343053792e-03f, 4.039235413e-03f, 3.756670747e-03f, 3.493872471e-03f, 3.249458736e-03f,
    3.022142686e-03f, 2.810728736e-03f, 2.614103956e-03f, 2.431234345e-03f, 2.261157380e-03f, 2.102978062e-03f, 1.955864020e-03f, 1.819041790e-03f,
    1.691789716e-03f, 1.573440502e-03f, 1.463370281e-03f, 1.361000235e-03f, 1.265791478e-03f, 1.177242957e-03f, 1.094888896e-03f, 1.018295996e-03f,
    9.470609948e-04f, 8.808093844e-04f, 8.191923262e-04f, 7.618857198e-04f, 7.085879333e-04f, 6.590186385e-04f, 6.129170069e-04f, 5.700403708e-04f,
    5.301629426e-04f, 4.930753494e-04f, 4.585822753e-04f, 4.265021416e-04f, 3.966661752e-04f, 3.689173318e-04f, 3.431097430e-04f, 3.191074939e-04f,
    2.967843320e-04f, 2.760227653e-04f, 2.567135962e-04f, 2.387551940e-04f, 2.220530587e-04f, 2.065193403e-04f, 1.920722716e-04f, 1.786358480e-04f,
    1.661392889e-04f, 1.545170089e-04f, 1.437077590e-04f, 1.336546848e-04f, 1.243048755e-04f, 1.156091312e-04f, 1.075216787e-04f, 9.999999747e-05f,
};

__device__ __forceinline__ float wave_sum(float v) {
#pragma unroll
    for (int o = 1; o < 64; o <<= 1) v += __shfl_xor(v, o);
    return v;
}
__device__ __forceinline__ float wave_max(float v) {
#pragma unroll
    for (int o = 1; o < 64; o <<= 1) v = fmaxf(v, __shfl_xor(v, o));
    return v;
}
#define DPP_RED6S(v, F) do { v = F<0x111, 0xf>(v); v = F<0x112, 0xf>(v); v = F<0x114, 0xf>(v); v = F<0x118, 0xf>(v); v = F<0x142, 0xa>(v); v = F<0x143, 0xc>(v); } while (0)
template <int CTRL, int RMASK> __device__ __forceinline__ float fadd_dpp_(float a) { return a + __builtin_bit_cast(float, __builtin_amdgcn_update_dpp(0, __builtin_bit_cast(int, a), CTRL, RMASK, 0xf, false)); }
__device__ __forceinline__ float wave_sum_dpp(float v) { DPP_RED6S(v, fadd_dpp_); return __builtin_bit_cast(float, __builtin_amdgcn_readlane(__builtin_bit_cast(int, v), 63)); }
__device__ __forceinline__ float dot4(f32x4 a) { return (a[0] * a[0] + a[1] * a[1]) + (a[2] * a[2] + a[3] * a[3]); }
__device__ __forceinline__ float fq_sum(float s) {
    { auto rr = __builtin_amdgcn_permlane16_swap(__float_as_uint(s), __float_as_uint(s), false, false); s = __uint_as_float(rr[0]) + __uint_as_float(rr[1]); }
    { auto rr = __builtin_amdgcn_permlane32_swap(__float_as_uint(s), __float_as_uint(s), false, false); s = __uint_as_float(rr[0]) + __uint_as_float(rr[1]); }
    return s;
}
__device__ __forceinline__ h16x8 pack8(f32x4 a, f32x4 b) {
    h16x8 r; r[0] = (h16)a[0]; r[1] = (h16)a[1]; r[2] = (h16)a[2]; r[3] = (h16)a[3]; r[4] = (h16)b[0]; r[5] = (h16)b[1]; r[6] = (h16)b[2]; r[7] = (h16)b[3]; return r;
}
__device__ __forceinline__ h16x4 pack4(f32x4 a) { h16x4 r; r[0] = (h16)a[0]; r[1] = (h16)a[1]; r[2] = (h16)a[2]; r[3] = (h16)a[3]; return r; }
__device__ __forceinline__ float sigmoidf_(float x) { return __builtin_amdgcn_rcpf(1.0f + __builtin_amdgcn_exp2f(-1.4426950408889634f * x)); }
__device__ __forceinline__ float siluf_(float x) { return x * __builtin_amdgcn_rcpf(1.0f + __builtin_amdgcn_exp2f(-1.4426950408889634f * x)); }
#define LDS_FENCE() do { asm volatile("s_waitcnt lgkmcnt(0)" ::: "memory"); } while (0)
__device__ __forceinline__ int my_tid(int wv) { unsigned m = ~0u; asm volatile("" : "+s"(m)); int t = wv * 64 + (int)__builtin_amdgcn_mbcnt_hi(m, __builtin_amdgcn_mbcnt_lo(m, 0u)); asm volatile("" : "+v"(t)); return t; }
template <class Tp> __device__ __forceinline__ Tp* opaque_ptr(Tp* p) { size_t z = 0; asm volatile("" : "+s"(z)); return p + z; }

#define PG8_LAS __attribute__((address_space(3)))
__device__ __forceinline__ constexpr int pg8_stage_bytes() { return 131072; }
struct Unit { int pm, pn; };
struct Gemm { const h16* A; const h16* Bt; int lda, ldb, M, N, K; };
__device__ __forceinline__ int perm32(int rho) { const int n = rho >> 4, i = rho & 15; return 8 * (i >> 2) + 4 * n + (i & 3); }

template <class Epi>
__device__ __forceinline__ void gemm_simple(const Gemm g, const Epi& E, int blk, int nblk, int wv) {
    const int tid = my_tid(wv), wid = __builtin_amdgcn_readfirstlane(tid >> 6), lane = tid & 63, wr = wid >> 2, wc = wid & 3, fr = lane & 15, fq = lane >> 4;
    const int nN = g.N / 256, nU = (g.M / 256) * nN;
    for (int u = blk; u < nU; u += nblk) {
        Unit un; un.pm = u / nN; un.pn = u % nN;
        f32x4 acc[2][2][4][2];
#pragma unroll
        for (int a = 0; a < 2; ++a)
#pragma unroll
            for (int b = 0; b < 2; ++b)
#pragma unroll
                for (int m = 0; m < 4; ++m)
#pragma unroll
                    for (int n = 0; n < 2; ++n) acc[a][b][m][n] = (f32x4){0.f, 0.f, 0.f, 0.f};
        const h16* Ap = g.A + (size_t)(un.pm * 256 + wr * 64 + fr) * g.lda + fq * 8;
        const h16* Bp[2];
#pragma unroll
        for (int n = 0; n < 2; ++n) Bp[n] = g.Bt + (size_t)(un.pn * 256 + wc * 32 + (Epi::PERM ? perm32(16 * n + fr) : 16 * n + fr)) * g.ldb + fq * 8;
        for (int k0 = 0; k0 < g.K; k0 += 32) {
            h16x8 At[2][4], Bt[2][2];
#pragma unroll
            for (int ai = 0; ai < 2; ++ai)
#pragma unroll
                for (int m = 0; m < 4; ++m) At[ai][m] = *(const h16x8*)(Ap + (size_t)(ai * 128 + m * 16) * g.lda + k0);
#pragma unroll
            for (int bj = 0; bj < 2; ++bj)
#pragma unroll
                for (int n = 0; n < 2; ++n) Bt[bj][n] = *(const h16x8*)(Bp[n] + (size_t)(bj * 128) * g.ldb + k0);
#pragma unroll
            for (int ai = 0; ai < 2; ++ai)
#pragma unroll
                for (int bj = 0; bj < 2; ++bj)
#pragma unroll
                    for (int m = 0; m < 4; ++m)
#pragma unroll
                        for (int n = 0; n < 2; ++n) acc[ai][bj][m][n] = __builtin_amdgcn_mfma_f32_16x16x32_f16(Bt[bj][n], At[ai][m], acc[ai][bj][m][n], 0, 0, 0);
        }
        E(acc, un, wr, wc, fr, fq, nullptr);
    }
}

template <class E_> struct epi_fused { template <class X> static constexpr bool g(decltype(X::FUSED_FINAL)*) { return X::FUSED_FINAL; } template <class X> static constexpr bool g(...) { return false; } static constexpr bool v = g<E_>(nullptr); };
namespace pg8 {
constexpr int BM = 256, BK = 64, HALF = 128, HTB = HALF * BK * 2  , STAGE_BYTES = 8 * HTB, NXCD = 8, WGM = 8;
__host__ __device__ __forceinline__ int lds_byte(int r, int c) { const int st = (r >> 4) * 2 + (c >> 5), rr = r & 15, cc = c & 31, ob = rr * 64 + cc * 2; return st * 1024 + (ob ^ (((ob >> 9) & 1) << 5)); }
__host__ __device__ __forceinline__ void stage_rc(int b, int& R, int& C) { const int st = b / 1024, sb = b % 1024, swz = sb ^ (((sb >> 9) & 1) << 5); R = (st >> 1) * 16 + swz / 64; C = (st & 1) * 32 + (swz % 64) / 2; }
struct StaticOrder {
    int nM, nN, nwg, G, c;
    __host__ __device__ void init(int M, int N, int G_, int c_) { nM = M / BM; nN = N / BM; nwg = nM * nN; G = G_; c = c_; }
    __host__ __device__ bool next(int i, Unit& u) const {
        const long Lq = (long)i * G + c; if (Lq >= nwg) return false;
        int wgid = (int)Lq; { const int q = nwg / NXCD, r = nwg % NXCD, xcd = wgid % NXCD, off = wgid / NXCD; wgid = (xcd < r ? xcd * (q + 1) : r * (q + 1) + (xcd - r) * q) + off; }
        const int nig = WGM * nN, gid = wgid / nig, fm = gid * WGM, gsz = (nM - fm) < WGM ? (nM - fm) : WGM;
        u.pm = fm + ((wgid % nig) % gsz); u.pn = (wgid % nig) / gsz; return true;
    }
};
template <class Epi, bool ALIGN_EPI = true>
__device__ __forceinline__ void gemm_phase(PG8_LAS unsigned char* lds, const Gemm g, const StaticOrder& S, const Epi& E, int wv) {
    const int tid = my_tid(wv), wid = __builtin_amdgcn_readfirstlane(tid >> 6), lane = tid & 63, wr = wid >> 2, wc = wid & 3, fr = lane & 15, fq = lane >> 4;
    const int K = g.K, nt = K / BK;
    unsigned voffA[2], voffB[2];
#pragma unroll
    for (int i = 0; i < 2; ++i) { int R, C; stage_rc(tid * 16 + i * 8192, R, C); const int Rb = Epi::PERM ? ((R & ~31) + perm32(R & 31)) : R;
        voffA[i] = (unsigned)(R * g.lda + C) * 2u; voffB[i] = (unsigned)(Rb * g.ldb + C) * 2u; }
    const size_t kstep = (size_t)(BK * 2);
    const size_t hstepA = (size_t)HALF * g.lda * 2, hstepB = (size_t)HALF * g.ldb * 2;
    const size_t tstepA = 2 * hstepA, tstepB = 2 * hstepB;
    const unsigned ldsw = (unsigned)wid * 1024u;
    const int aoff = lds_byte(wr * 64 + fr, fq * 8), boff = lds_byte(wc * 32 + fr, fq * 8);
#define PG8_SA(b, h) (((b) * 2 + (h)) * HTB)
#define PG8_SB(b, h) ((4 + (b) * 2 + (h)) * HTB)
#define PG8_STAGE(bufoff, gbase, voff) do { _Pragma("unroll") for (int _i = 0; _i < 2; ++_i) \
        __builtin_amdgcn_global_load_lds((const unsigned*)((const char*)(gbase) + (voff)[_i]), (PG8_LAS unsigned*)(lds + (bufoff) + ldsw + _i * 8192), 16, 0, 0); } while (0)
#define PG8_LDA(dst, b, h) do { _Pragma("unroll") for (int m = 0; m < 4; ++m) _Pragma("unroll") for (int k = 0; k < 2; ++k) dst[m][k] = *(const PG8_LAS h16x8*)(lds + PG8_SA(b, h) + aoff + m * 2048 + k * 1024); } while (0)
#define PG8_LDB(dst, b, h) do { _Pragma("unroll") for (int n = 0; n < 2; ++n) _Pragma("unroll") for (int k = 0; k < 2; ++k) dst[n][k] = *(const PG8_LAS h16x8*)(lds + PG8_SB(b, h) + boff + n * 2048 + k * 1024); } while (0)
#define PG8_MMA(ai, bj, At, Bt) do { __builtin_amdgcn_s_setprio(1); _Pragma("unroll") for (int m = 0; m < 4; ++m) _Pragma("unroll") for (int n = 0; n < 2; ++n) _Pragma("unroll") for (int k = 0; k < 2; ++k) \
        acc[ai][bj][m][n] = __builtin_amdgcn_mfma_f32_16x16x32_f16(Bt[n][k], At[m][k], acc[ai][bj][m][n], 0, 0, 0); __builtin_amdgcn_s_setprio(0); } while (0)
#define PG8_WAIT_V(n) asm volatile("s_waitcnt vmcnt(" #n ")" ::: "memory")
#define PG8_WAIT_L(n) asm volatile("s_waitcnt lgkmcnt(" #n ")" ::: "memory")
#define PG8_BAR __builtin_amdgcn_s_barrier()
#define PG8_SCHED __builtin_amdgcn_sched_barrier(0)
    Unit cur, nxt; int ui = 0;
    if (!S.next(0, cur)) return;
    PG8_LAS float* rtab = (PG8_LAS float*)(lds + STAGE_BYTES);
#define PG8_FILL(U, PAR) do { const int tf_ = my_tid(wv); if (E.sqp != nullptr && tf_ < 256) { const size_t r_ = (size_t)(U).pm * 256 + tf_; float s_ = 0.f; \
        for (int j_ = 0; j_ < E.sqn; j_ += 4) { const f32x4 q_ = *(const f32x4*)(E.sqp + r_ * E.sqn + j_); s_ += (q_[0] + q_[1]) + (q_[2] + q_[3]); } \
        rtab[(PAR) * 256 + tf_] = rsqrtf(s_ * E.sqi + EPS); } } while (0)
    PG8_FILL(cur, 0);
    f32x4 acc[2][2][4][2];
#pragma unroll
    for (int a = 0; a < 2; ++a)
#pragma unroll
        for (int b = 0; b < 2; ++b)
#pragma unroll
            for (int m = 0; m < 4; ++m)
#pragma unroll
                for (int n = 0; n < 2; ++n) acc[a][b][m][n] = (f32x4){0.f, 0.f, 0.f, 0.f};
    h16x8 At[4][2], B0[2][2], B1[2][2];
    const char* cA = (const char*)g.A + (size_t)cur.pm * tstepA; const char* cB = (const char*)g.Bt + (size_t)cur.pn * tstepB;
    PG8_STAGE(PG8_SB(0, 0), cB, voffB); PG8_STAGE(PG8_SB(0, 1), cB + hstepB, voffB); PG8_STAGE(PG8_SA(0, 0), cA, voffA); PG8_STAGE(PG8_SA(0, 1), cA + hstepA, voffA);
    if (wr == 1) PG8_BAR;
    PG8_WAIT_V(2); PG8_BAR;
    PG8_STAGE(PG8_SB(1, 0), cB + kstep, voffB); PG8_STAGE(PG8_SA(1, 0), cA + kstep, voffA); PG8_STAGE(PG8_SB(1, 1), cB + hstepB + kstep, voffB);
    PG8_WAIT_V(6); PG8_BAR;
    for (;;) {
        const bool has_next = S.next(ui + 1, nxt);
        const char* nA = has_next ? (const char*)g.A + (size_t)nxt.pm * tstepA : cA; const char* nB = has_next ? (const char*)g.Bt + (size_t)nxt.pn * tstepB : cB;
        for (int t = 0; t < nt; t += 2) {
            const bool last = (t == nt - 2);
            const char* a1 = cA + (size_t)(t + 1) * kstep;
            const char* a2 = last ? nA : cA + (size_t)(t + 2) * kstep; const char* b2 = last ? nB : cB + (size_t)(t + 2) * kstep;
            const char* a3 = a2 + kstep; const char* b3 = b2 + kstep;
            PG8_LDB(B0, 0, 0); PG8_LDB(B1, 0, 1); PG8_SCHED; PG8_LDA(At, 0, 0); PG8_STAGE(PG8_SA(1, 1), a1 + hstepA, voffA);
            PG8_WAIT_V(8); PG8_WAIT_L(0); PG8_BAR; PG8_MMA(0, 0, At, B0); PG8_MMA(0, 1, At, B1); PG8_BAR; PG8_SCHED;
            PG8_LDA(At, 0, 1); PG8_STAGE(PG8_SB(0, 0), b2, voffB); PG8_STAGE(PG8_SB(0, 1), b2 + hstepB, voffB); PG8_STAGE(PG8_SA(0, 0), a2, voffA);
            PG8_WAIT_V(8); PG8_WAIT_L(0); PG8_BAR; PG8_MMA(1, 0, At, B0); PG8_MMA(1, 1, At, B1); PG8_BAR; PG8_SCHED;
            PG8_LDB(B0, 1, 0); PG8_LDB(B1, 1, 1); PG8_SCHED; PG8_LDA(At, 1, 0); PG8_STAGE(PG8_SA(0, 1), a2 + hstepA, voffA);
            PG8_WAIT_V(8); PG8_WAIT_L(0); PG8_BAR; PG8_MMA(0, 0, At, B0); PG8_MMA(0, 1, At, B1); PG8_BAR; PG8_SCHED;
            PG8_LDA(At, 1, 1); PG8_STAGE(PG8_SB(1, 0), b3, voffB); PG8_STAGE(PG8_SB(1, 1), b3 + hstepB, voffB); PG8_STAGE(PG8_SA(1, 0), a3, voffA);
            PG8_WAIT_V(8); PG8_WAIT_L(0); PG8_BAR; PG8_MMA(1, 0, At, B0); PG8_MMA(1, 1, At, B1); PG8_BAR; PG8_SCHED;
        }
        if constexpr (ALIGN_EPI) { if (wr == 0) PG8_BAR; }
        { const int te_ = my_tid(wv), le_ = te_ & 63;
          if constexpr (epi_fused<Epi>::v) E.final(acc, cur, wr, wc, le_ & 15, le_ >> 4, rtab + (ui & 1) * 256, lds, te_); else E(acc, cur, wr, wc, le_ & 15, le_ >> 4, rtab + (ui & 1) * 256); }
        if (has_next) PG8_FILL(nxt, (ui + 1) & 1);
        if (!has_next) break;
#pragma unroll
        for (int a = 0; a < 2; ++a)
#pragma unroll
            for (int b = 0; b < 2; ++b)
#pragma unroll
                for (int m = 0; m < 4; ++m)
#pragma unroll
                    for (int n = 0; n < 2; ++n) acc[a][b][m][n] = (f32x4){0.f, 0.f, 0.f, 0.f};
        cur = nxt; cA = nA; cB = nB; ++ui;
        if constexpr (ALIGN_EPI) { if (wr == 1) PG8_BAR; }
    }
    PG8_WAIT_V(0);
    if constexpr (!ALIGN_EPI) { if (wr == 0) PG8_BAR; }
    PG8_BAR;
#undef PG8_FILL
#undef PG8_SA
#undef PG8_SB
#undef PG8_STAGE
#undef PG8_LDA
#undef PG8_LDB
#undef PG8_MMA
#undef PG8_WAIT_V
#undef PG8_WAIT_L
#undef PG8_BAR
#undef PG8_SCHED
}
}
template <class Epi>
__device__ __forceinline__ void gemm_run(unsigned char* lds, const Gemm g, const Epi& E, int blk, int nblk, int wv) {
    pg8::StaticOrder S; S.init(g.M, g.N, nblk, blk);
    pg8::gemm_phase<Epi, true>((PG8_LAS unsigned char*)lds, g, S, E, wv);
}

struct EpiInA {
    static constexpr bool PERM = true;
    h16* ckv; h16* cqx; h16* sg; float* sqkv; float* sqq; const float* sqp; int sqn; float sqi;
    __device__ __forceinline__ void operator()(const f32x4 (&acc)[2][2][4][2], const Unit& u, int wr, int wc, int fr, int fq, const PG8_LAS float* rtab) const {
        asm volatile("" : "+v"(fr), "+v"(fq));
#pragma unroll
        for (int ai = 0; ai < 2; ++ai)
#pragma unroll
            for (int m = 0; m < 4; ++m) {
                const size_t r = (size_t)u.pm * 256 + ai * 128 + wr * 64 + m * 16 + fr;
                float ss = 0.f;
#pragma unroll
                for (int bj = 0; bj < 2; ++bj) {
                    const int c0 = bj * 128 + wc * 32 + 8 * fq;
                    f32x4 v0 = acc[ai][bj][m][0], v1 = acc[ai][bj][m][1];
                    if (u.pn == 0) { *(h16x8*)(ckv + r * 256 + c0) = pack8(v0, v1); ss += dot4(v0) + dot4(v1); }
                    else if (u.pn <= 2) { const int cq = (u.pn - 1) * 256 + c0; *(h16x8*)(cqx + r * 512 + cq) = pack8(v0, v1); if (cq < 384) ss += dot4(v0) + dot4(v1); }
                    else {
#pragma unroll
                        for (int e = 0; e < 4; ++e) { v0[e] = siluf_(v0[e]); v1[e] = siluf_(v1[e]); }
                        *(h16x8*)(sg + r * 1024 + (u.pn - 3) * 256 + c0) = pack8(v0, v1);
                    }
                }
                if (u.pn <= 2) {
                    ss = fq_sum(ss);
                    if (fq == 0) { if (u.pn == 0) sqkv[r * 4 + wc] = ss; else sqq[r * 8 + (u.pn - 1) * 4 + wc] = ss; }
                }
            }
    }
};
__device__ __forceinline__ unsigned cvtpk_bf16(float lo, float hi) { unsigned r; asm volatile("v_cvt_pk_bf16_f32 %0, %1, %2" : "=v"(r) : "v"(lo), "v"(hi)); return r; }
struct EpiScale {
    static constexpr bool PERM = true;
    const float* sqp; int sqn; float sqi; h16* d0; h16* d1; int split, ld0, ld1, bf0, bf1;
    __device__ __forceinline__ void operator()(const f32x4 (&acc)[2][2][4][2], const Unit& u, int wr, int wc, int fr, int fq, const PG8_LAS float* rtab) const {
        asm volatile("" : "+v"(fr), "+v"(fq));
#pragma unroll
        for (int ai = 0; ai < 2; ++ai)
#pragma unroll
            for (int m = 0; m < 4; ++m) {
                const size_t r = (size_t)u.pm * 256 + ai * 128 + wr * 64 + m * 16 + fr;
                float rs = 1.f;
                if (sqp) rs = rtab[ai * 128 + wr * 64 + m * 16 + fr];
#pragma unroll
                for (int bj = 0; bj < 2; ++bj) {
                    const int c0 = bj * 128 + wc * 32 + 8 * fq;
                    const f32x4 v0 = acc[ai][bj][m][0] * rs, v1 = acc[ai][bj][m][1] * rs;
                    const bool first = u.pn < split;
                    h16* dst = first ? d0 + r * ld0 + u.pn * 256 + c0 : d1 + r * ld1 + (u.pn - split) * 256 + c0;
                    if (first ? bf0 : bf1) { u32x4 w; w[0] = cvtpk_bf16(v0[0], v0[1]); w[1] = cvtpk_bf16(v0[2], v0[3]); w[2] = cvtpk_bf16(v1[0], v1[1]); w[3] = cvtpk_bf16(v1[2], v1[3]); *(u32x4*)dst = w; }
                    else *(h16x8*)dst = pack8(v0, v1);
                }
            }
    }
};
struct EpiRes {
    static constexpr bool PERM = true;
    const float* basef; const h16* baseh; h16* HH; float* sq; const float* sqp; int sqn; float sqi;
    __device__ __forceinline__ void operator()(const f32x4 (&acc)[2][2][4][2], const Unit& u, int wr, int wc, int fr, int fq, const PG8_LAS float* rtab) const {
        asm volatile("" : "+v"(fr), "+v"(fq));
#pragma unroll
        for (int ai = 0; ai < 2; ++ai)
#pragma unroll
            for (int m = 0; m < 4; ++m) {
                const size_t r = (size_t)u.pm * 256 + ai * 128 + wr * 64 + m * 16 + fr;
                float ss = 0.f;
#pragma unroll
                for (int bj = 0; bj < 2; ++bj) {
                    const size_t o = r * 1024 + u.pn * 256 + bj * 128 + wc * 32 + 8 * fq;
                    f32x4 h0, h1;
                    if (basef) { h0 = *(const f32x4*)(basef + o); h1 = *(const f32x4*)(basef + o + 4); }
                    else { const h16x8 b = *(const h16x8*)(baseh + o); h0 = (f32x4){(float)b[0], (float)b[1], (float)b[2], (float)b[3]}; h1 = (f32x4){(float)b[4], (float)b[5], (float)b[6], (float)b[7]}; }
                    h0 = h0 + acc[ai][bj][m][0]; h1 = h1 + acc[ai][bj][m][1];
                    *(h16x8*)(HH + o) = pack8(h0, h1); ss += dot4(h0) + dot4(h1);
                }
                ss = fq_sum(ss);
                if (fq == 0) sq[r * 16 + u.pn * 4 + wc] = ss;
            }
    }
};
struct EpiPle {
    static constexpr bool PERM = true;
    const h16* Hin; const h16* U; h16* Hout; const float* sqp; float* sqout; int sqn; float sqi;
    __device__ __forceinline__ void operator()(const f32x4 (&acc)[2][2][4][2], const Unit& u, int wr, int wc, int fr, int fq, const PG8_LAS float* rtab) const {
        asm volatile("" : "+v"(fr), "+v"(fq));
#pragma unroll
        for (int ai = 0; ai < 2; ++ai)
#pragma unroll
            for (int m = 0; m < 4; ++m) {
                const size_t r = (size_t)u.pm * 256 + ai * 128 + wr * 64 + m * 16 + fr;
                const float rs = rtab[ai * 128 + wr * 64 + m * 16 + fr];
                float ss = 0.f;
#pragma unroll
                for (int bj = 0; bj < 2; ++bj) {
                    const size_t o = r * 1024 + u.pn * 256 + bj * 128 + wc * 32 + 8 * fq;
                    const h16x8 uu = *(const h16x8*)(U + o); const h16x8 hh = *(const h16x8*)(Hin + o);
                    const f32x4 a0 = acc[ai][bj][m][0] * rs, a1 = acc[ai][bj][m][1] * rs; f32x4 h0, h1;
#pragma unroll
                    for (int e = 0; e < 4; ++e) { h0[e] = (float)hh[e] + (float)uu[e] * sigmoidf_(a0[e]); h1[e] = (float)hh[4 + e] + (float)uu[4 + e] * sigmoidf_(a1[e]); }
                    *(h16x8*)(Hout + o) = pack8(h0, h1); ss += dot4(h0) + dot4(h1);
                }
                ss = fq_sum(ss);
                if (fq == 0) sqout[r * 16 + u.pn * 4 + wc] = ss;
            }
    }
};
struct EpiPleFinal {
    static constexpr bool PERM = true, FUSED_FINAL = true;
    const h16* Hin; const h16* U; const float* sqp; int sqn; float sqi; const float* gfin; float* out; unsigned* xslot; unsigned* pcnt; unsigned* tmo;
    __device__ __forceinline__ void final(f32x4 (&acc)[2][2][4][2], const Unit& u, int wr, int wc, int fr, int fq, const PG8_LAS float* rtab, PG8_LAS unsigned char* lds, int tid) const {
        PG8_LAS float* Pt = (PG8_LAS float*)(lds + pg8_stage_bytes() + 2048);
        PG8_LAS float* St = Pt + 1024;
        const int wid = tid >> 6, lane = tid & 63;
        asm volatile("" : "+v"(fr), "+v"(fq));
#pragma unroll
        for (int ai = 0; ai < 2; ++ai)
#pragma unroll
            for (int m = 0; m < 4; ++m) {
                const int rl = ai * 128 + wr * 64 + m * 16 + fr; const size_t r = (size_t)u.pm * 256 + rl;
                const float rs = rtab[rl]; float ss = 0.f;
#pragma unroll
                for (int bj = 0; bj < 2; ++bj) {
                    const size_t o = r * 1024 + u.pn * 256 + bj * 128 + wc * 32 + 8 * fq;
                    const h16x8 uu = *(const h16x8*)(U + o); const h16x8 hh = *(const h16x8*)(Hin + o);
                    const f32x4 a0 = acc[ai][bj][m][0] * rs, a1 = acc[ai][bj][m][1] * rs; f32x4 h0, h1;
#pragma unroll
                    for (int e = 0; e < 4; ++e) { h0[e] = (float)hh[e] + (float)uu[e] * sigmoidf_(a0[e]); h1[e] = (float)hh[4 + e] + (float)uu[4 + e] * sigmoidf_(a1[e]); }
                    acc[ai][bj][m][0] = h0; acc[ai][bj][m][1] = h1; ss += dot4(h0) + dot4(h1);
                }
                ss = fq_sum(ss);
                if (fq == 0) Pt[rl * 4 + wc] = ss;
                asm volatile("" : "+v"(acc[ai][0][m][0]), "+v"(acc[ai][0][m][1]), "+v"(acc[ai][1][m][0]), "+v"(acc[ai][1][m][1]) :: "memory");
            }
        asm volatile("s_waitcnt lgkmcnt(0)" ::: "memory"); __builtin_amdgcn_s_barrier(); asm volatile("" ::: "memory");
        if (tid < 256) {
            const f32x4 p = *(const PG8_LAS f32x4*)(Pt + tid * 4);
            __hip_atomic_store(xslot + ((size_t)u.pm * 256 + tid) * 4 + u.pn, __float_as_uint((p[0] + p[1]) + (p[2] + p[3])), __ATOMIC_RELAXED, __HIP_MEMORY_SCOPE_AGENT);
            asm volatile("s_waitcnt vmcnt(0)" ::: "memory");
            if (lane == 0) __hip_atomic_fetch_add(pcnt + 64 * u.pm, 1u, __ATOMIC_RELAXED, __HIP_MEMORY_SCOPE_AGENT);
        }
        if (wid == 0) {
            unsigned sp = 0u;
            while (__hip_atomic_load(pcnt + 64 * u.pm, __ATOMIC_RELAXED, __HIP_MEMORY_SCOPE_AGENT) < 16u) {
                __builtin_amdgcn_s_sleep(2);
                if (++sp > (1u << 22)) { if (lane == 0) __hip_atomic_store(tmo, 1u, __ATOMIC_RELAXED, __HIP_MEMORY_SCOPE_AGENT); break; }
            }
            __builtin_amdgcn_fence(__ATOMIC_ACQUIRE, "agent");
        }
        asm volatile("s_waitcnt vmcnt(0) lgkmcnt(0)" ::: "memory"); __builtin_amdgcn_s_barrier(); asm volatile("" ::: "memory");
        if (tid < 256) {
            const unsigned* sl = xslot + ((size_t)u.pm * 256 + tid) * 4; float s = 0.f;
#pragma unroll
            for (int t = 0; t < 4; ++t) s += __uint_as_float(__hip_atomic_load(sl + t, __ATOMIC_RELAXED, __HIP_MEMORY_SCOPE_AGENT));
            St[tid] = rsqrtf(s * (1.0f / 1024.0f) + EPS);
        }
        asm volatile("s_waitcnt vmcnt(0) lgkmcnt(0)" ::: "memory"); __builtin_amdgcn_s_barrier(); asm volatile("" ::: "memory");
#pragma unroll
        for (int ai = 0; ai < 2; ++ai)
#pragma unroll
            for (int m = 0; m < 4; ++m) {
                const int rl = ai * 128 + wr * 64 + m * 16 + fr; const size_t r = (size_t)u.pm * 256 + rl;
                const float rr = St[rl];
#pragma unroll
                for (int bj = 0; bj < 2; ++bj) {
                    const int c = u.pn * 256 + bj * 128 + wc * 32 + 8 * fq;
                    const f32x4 g0 = *(const f32x4*)(gfin + c), g1 = *(const f32x4*)(gfin + c + 4);
                    *(f32x4*)(out + r * 1024 + c) = acc[ai][bj][m][0] * rr * g0; *(f32x4*)(out + r * 1024 + c + 4) = acc[ai][bj][m][1] * rr * g1;
                }
            }
    }
};
struct EpiInR {
    static constexpr bool PERM = true;
    const float* sqp; const f32x2* sincos; h16* rq; h16* rk; h16* rv; h16* rg; int sqn; float sqi;
    __device__ __forceinline__ void operator()(const f32x4 (&acc)[2][2][4][2], const Unit& u, int wr, int wc, int fr, int fq, const PG8_LAS float* rtab) const {
        asm volatile("" : "+v"(fr), "+v"(fq));
#pragma unroll
        for (int ai = 0; ai < 2; ++ai)
#pragma unroll
            for (int m = 0; m < 4; ++m) {
                const size_t r = (size_t)u.pm * 256 + ai * 128 + wr * 64 + m * 16 + fr;
                const float rs = rtab[ai * 128 + wr * 64 + m * 16 + fr];
                const int pos = (int)(r & (L - 1));
#pragma unroll
                for (int bj = 0; bj < 2; ++bj) {
                    const int c0 = bj * 128 + wc * 32 + 8 * fq;
                    f32x4 v0 = acc[ai][bj][m][0] * rs, v1 = acc[ai][bj][m][1] * rs;
                    if (u.pn < 8) {
                        const f32x2* sc = sincos + (size_t)pos * 128 + (c0 >> 1);
                        const f32x2 s0 = sc[0], s1 = sc[1], s2 = sc[2], s3 = sc[3];
                        f32x4 w0, w1;
                        w0[0] = v0[0] * s0[1] - v0[1] * s0[0]; w0[1] = v0[1] * s0[1] + v0[0] * s0[0];
                        w0[2] = v0[2] * s1[1] - v0[3] * s1[0]; w0[3] = v0[3] * s1[1] + v0[2] * s1[0];
                        w1[0] = v1[0] * s2[1] - v1[1] * s2[0]; w1[1] = v1[1] * s2[1] + v1[0] * s2[0];
                        w1[2] = v1[2] * s3[1] - v1[3] * s3[0]; w1[3] = v1[3] * s3[1] + v1[2] * s3[0];
                        h16* dst = (u.pn < 4) ? rq + r * 1024 + u.pn * 256 + c0 : rk + r * 1024 + (u.pn - 4) * 256 + c0;
                        *(h16x8*)dst = pack8(w0, w1);
                    } else if (u.pn < 16) {
                        *(h16x8*)(rv + r * 2048 + (u.pn - 8) * 256 + c0) = pack8(v0, v1);
                    } else {
#pragma unroll
                        for (int e = 0; e < 4; ++e) { v0[e] = siluf_(v0[e]); v1[e] = siluf_(v1[e]); }
                        *(h16x8*)(rg + r * 2048 + (u.pn - 16) * 256 + c0) = pack8(v0, v1);
                    }
                }
            }
    }
};

template <int MODE>
__device__ __forceinline__ void tr_item(const float* __restrict__ W, int K, int N, h16* Wt, int ld, int row_off, const float* ks, float scale, float* scr, int item, int lane) {
    const int nbn = (N + 31) >> 5, kb = item / nbn, nb = item % nbn, k0 = kb * 64, n0 = nb * 32;
    const int n4 = n0 + (lane & 7) * 4;
    f32x4 wv[8];
#pragma unroll
    for (int i = 0; i < 8; ++i) { const int kk = 8 * i + (lane >> 3); wv[i] = (n4 < N) ? *(const f32x4*)(W + (size_t)(k0 + kk) * N + n4) : (f32x4){0.f, 0.f, 0.f, 0.f}; }
#pragma unroll
    for (int i = 0; i < 8; ++i) { const int kk = 8 * i + (lane >> 3); const float kf = ks ? ks[k0 + kk] : 1.f;
#pragma unroll
        for (int e = 0; e < 4; ++e) scr[kk * 33 + (lane & 7) * 4 + e] = wv[i][e] * kf; }
    LDS_FENCE();
    const int c = lane & 7;
#pragma unroll
    for (int j = 0; j < 4; ++j) {
        const int nl = (lane >> 3) + 8 * j, n = n0 + nl;
        if (n < N) {
            int row = n; float sc = scale;
            if (MODE == 1) row = (n < 384) ? 256 + n : (n < 640) ? n - 384 : (n < 712) ? n : n + 56;
            if (MODE == 2 && n >= 1024 && n < 2048) sc *= 0.0625f;
            const float* s = scr + (8 * c) * 33 + nl;
            h16x8 o;
#pragma unroll
            for (int e = 0; e < 8; ++e) o[e] = (h16)(s[e * 33] * sc);
            *(h16x8*)(Wt + (size_t)(row_off + row) * ld + k0 + 8 * c) = o;
        }
    }
    LDS_FENCE();
}

__device__ __forceinline__ void p0_prologue(const Params& P, unsigned char* lds, int blk, int nblk, int wv) {
    const int tid = my_tid(wv), wid = __builtin_amdgcn_readfirstlane(tid >> 6), lane = tid & 63;
    float* scr = (float*)lds + wid * (64 * 33);
    const int gw = blk * NWAVES + wid, ngw = nblk * NWAVES;
    unsigned char* ws = opaque_ptr(P.ws);
    h16* WAIN = (h16*)(ws + WS_WAIN); h16* WQ = (h16*)(ws + WS_WQ); h16* WKV = (h16*)(ws + WS_WKV); h16* WAOUT = (h16*)(ws + WS_WAOUT);
    h16* WPG = (h16*)(ws + WS_WPG); h16* WPLE = (h16*)(ws + WS_WPLE); h16* WRIN = (h16*)(ws + WS_WRIN); h16* WROUT = (h16*)(ws + WS_WROUT);
    const float QSCALE = 0.08838834764831845f * 1.4426950408889634f;
    constexpr int I1 = 16 * 55, I2 = 6 * 32, I3 = 6 * 16, I4 = 8 * 16, I5 = 8 * 16, I6 = 16 * 32, I7 = 2 * 16 * 32, I8 = 2 * 4 * 32, I9 = 16 * 192, I10 = 32 * 32;
    constexpr int NIT = I1 + I2 + I3 + I4 + I5 + I6 + I7 + I8 + I9 + I10;
    for (int it = gw; it < NIT; it += ngw) {
        int r = it;
        if (r < I1) { tr_item<1>(P.in[3], 1024, 1736, WAIN, 1024, 0, nullptr, 1.f, scr, r, lane); continue; } r -= I1;
        if (r < I2) { tr_item<0>(P.in[6], 384, 1024, WQ, 384, 0, P.in[4], QSCALE, scr, r, lane); continue; } r -= I2;
        if (r < I3) { tr_item<0>(P.in[7], 384, 512, WQ, 384, 1024, P.in[4], 1.f, scr, r, lane); continue; } r -= I3;
        if (r < I4) { const int h = r / 16; tr_item<0>(P.in[10] + (size_t)h * 256 * 128, 256, 128, WKV, 256, h * 128, P.in[5], 1.f, scr, r % 16, lane); continue; } r -= I4;
        if (r < I5) { const int h = r / 16; tr_item<0>(P.in[11] + (size_t)h * 256 * 128, 256, 128, WKV, 256, 1024 + h * 128, P.in[5], 1.f, scr, r % 16, lane); continue; } r -= I5;
        if (r < I6) { tr_item<0>(P.in[12], 1024, 1024, WAOUT, 1024, 0, nullptr, 1.f, scr, r, lane); continue; } r -= I6;
        if (r < I7) { const int i = r / 512; tr_item<0>(P.in[15] + (size_t)i * 1024 * 1024, 1024, 1024, WPG + (size_t)i * 1024 * 1024, 1024, 0, P.in[16] + i * 1024, 1.f, scr, r % 512, lane); continue; } r -= I7;
        if (r < I8) { const int i = r / 128; tr_item<0>(P.in[17] + (size_t)i * 256 * 1024, 256, 1024, WPLE + (size_t)i * 1024 * 256, 256, 0, nullptr, 1.f, scr, r % 128, lane); continue; } r -= I8;
        if (r < I9) { tr_item<2>(P.in[13], 1024, 6144, WRIN, 1024, 0, P.in[2] + 1024, 1.f, scr, r, lane); continue; } r -= I9;
        tr_item<0>(P.in[14], 2048, 1024, WROUT, 2048, 0, nullptr, 1.f, scr, r, lane);
    }
    const int gt = blk * NTHREADS + tid, ngt = nblk * NTHREADS;
    { unsigned zz = 0u; asm volatile("" : "+v"(zz));
      for (int i = gt; i < 56 * 1024 / 8; i += ngt) ((u32x4*)(WAIN + 712 * 1024))[i] = (u32x4){zz, zz, zz, zz}; }
    {
        const float* x = P.in[0]; const f32x4* g4 = (const f32x4*)P.in[2]; h16* XN0 = (h16*)(ws + WS_R1);
        f32x4 gv[4];
#pragma unroll
        for (int j = 0; j < 4; ++j) gv[j] = g4[lane + 64 * j];
        for (int r0 = gw; r0 < T; r0 += 4 * ngw) {
            f32x4 v[4][4];
#pragma unroll
            for (int k = 0; k < 4; ++k) { const int r = (r0 + k * ngw < T) ? r0 + k * ngw : r0; const f32x4* xr = (const f32x4*)(x + (size_t)r * 1024) + lane;
#pragma unroll
                for (int j = 0; j < 4; ++j) v[k][j] = xr[64 * j]; }
#pragma unroll
            for (int k = 0; k < 4; ++k) { const int r = r0 + k * ngw; float s = 0.f;
#pragma unroll
                for (int j = 0; j < 4; ++j) s += dot4(v[k][j]);
                const float rstd = rsqrtf(wave_sum_dpp(s) * (1.0f / 1024.0f) + EPS);
                if (r < T) {
#pragma unroll
                    for (int j = 0; j < 4; ++j) { const f32x4 o = v[k][j] * rstd * gv[j]; *(h16x4*)(XN0 + (size_t)r * 1024 + (lane + 64 * j) * 4) = pack4(o); } } }
        }
    }
    {
        const f32x4* p4 = (const f32x4*)P.in[1]; h16* PH0 = (h16*)(ws + WS_PH0); h16* PH1 = (h16*)(ws + WS_PH1);
        const int nv = T * 256 / 8;
        for (int i0_ = gt; i0_ < 2 * nv; i0_ += 4 * ngt) {
            f32x4 a[4], b2[4];
#pragma unroll
            for (int k = 0; k < 4; ++k) { const int i = (i0_ + k * ngt < 2 * nv) ? i0_ + k * ngt : i0_; a[k] = p4[2 * (size_t)i]; b2[k] = p4[2 * (size_t)i + 1]; }
#pragma unroll
            for (int k = 0; k < 4; ++k) { const int i = i0_ + k * ngt; if (i < 2 * nv) { h16* dst = (i < nv) ? PH0 + (size_t)i * 8 : PH1 + (size_t)(i - nv) * 8; *(h16x8*)dst = pack8(a[k], b2[k]); } }
        }
    }
    {
        f32x2* SC = (f32x2*)(ws + WS_SINCOS);
        for (int i = gt; i < L * 128; i += ngt) {
            const int pos = i >> 7, fi = i & 127;
            const float th = (float)pos * kAngle[fi];
            double rev = (double)th * 0.15915494309189535; rev -= __builtin_rint(rev);
            const float r = (float)(rev * 6.283185307179586), r2 = r * r;
            float sn = 1.9572941e-20f;
            sn = sn * r2 - 8.2206352e-18f;
            sn = sn * r2 + 2.8114573e-15f;
            sn = sn * r2 - 7.6471637e-13f;
            sn = sn * r2 + 1.6059044e-10f;
            sn = sn * r2 - 2.5052108e-8f;
            sn = sn * r2 + 2.7557319e-6f;
            sn = sn * r2 - 1.9841270e-4f;
            sn = sn * r2 + 8.3333333e-3f;
            sn = sn * r2 - 1.6666667e-1f;
            sn = sn * r2 + 1.0f;
            sn = sn * r;
            float cs = 4.1103176e-19f;
            cs = cs * r2 - 1.5619207e-16f;
            cs = cs * r2 + 4.7794773e-14f;
            cs = cs * r2 - 1.1470746e-11f;
            cs = cs * r2 + 2.0876757e-9f;
            cs = cs * r2 - 2.7557319e-7f;
            cs = cs * r2 + 2.4801587e-5f;
            cs = cs * r2 - 1.3888889e-3f;
            cs = cs * r2 + 4.1666667e-2f;
            cs = cs * r2 - 0.5f;
            cs = cs * r2 + 1.0f;
            SC[i] = (f32x2){sn, cs};
        }
    }
}

__device__ __forceinline__ void p2_kidx(const Params& P, int blk, int nblk, int wv) {
    const h16* CQX = (const h16*)(P.ws + WS_CQX); h16* KIDXN = (h16*)(P.ws + WS_KIDXN); float* WIDX = (float*)(P.ws + WS_WIDX);
    const float* g = P.in[8]; const float* bb = P.in[9];
    for (int r = blk * NTHREADS + my_tid(wv); r < T; r += nblk * NTHREADS) {
        float v[64]; float s = 0.f;
#pragma unroll
        for (int c = 0; c < 8; ++c) { const h16x8 k = *(const h16x8*)(CQX + (size_t)r * 512 + 384 + c * 8);
#pragma unroll
            for (int e = 0; e < 8; ++e) { v[c * 8 + e] = (float)k[e]; s += v[c * 8 + e]; } }
        const float mu = s * (1.0f / 64.0f); float q = 0.f;
#pragma unroll
        for (int i = 0; i < 64; ++i) { v[i] -= mu; q += v[i] * v[i]; }
        const float rstd = rsqrtf(q * (1.0f / 64.0f) + EPS);
#pragma unroll
        for (int c = 0; c < 8; ++c) { h16x8 o;
#pragma unroll
            for (int e = 0; e < 8; ++e) o[e] = (h16)(v[c * 8 + e] * rstd * g[c * 8 + e] + bb[c * 8 + e]);
            *(h16x8*)(KIDXN + (size_t)r * 64 + c * 8) = o; }
        const h16x8 w = *(const h16x8*)(CQX + (size_t)r * 512 + 448);
        const float wsc = 0.04419417382415922f;
        f32x4 w0, w1;
#pragma unroll
        for (int e = 0; e < 4; ++e) { w0[e] = (float)w[e] * wsc; w1[e] = (float)w[4 + e] * wsc; }
        *(f32x4*)(WIDX + (size_t)r * 8) = w0; *(f32x4*)(WIDX + (size_t)r * 8 + 4) = w1;
    }
}

__device__ __forceinline__ unsigned fmap_u(float s) { s += 0.0f; const unsigned b = __float_as_uint(s); return (b & 0x80000000u) ? ~b : (b | 0x80000000u); }
__device__ __forceinline__ unsigned topk_select(const unsigned (&u)[32], int lane) {
    unsigned Tv = 0u;
    for (int bit = 31; bit >= 0; --bit) {
        const unsigned cand = Tv | (1u << bit); int cnt = 0;
#pragma unroll
        for (int i = 0; i < 32; ++i) cnt += __popcll(__ballot(u[i] >= cand));
        if (cnt >= 256) Tv = cand;
    }
    int gt = 0;
#pragma unroll
    for (int i = 0; i < 32; ++i) gt += __popcll(__ballot(u[i] > Tv));
    int need = 256 - gt;
    unsigned sel = 0u;
#pragma unroll
    for (int i = 0; i < 32; ++i) {
        const bool eq = (u[i] == Tv);
        const unsigned long long em = __ballot(eq);
        const int rank = (int)__builtin_amdgcn_mbcnt_hi((unsigned)(em >> 32), __builtin_amdgcn_mbcnt_lo((unsigned)em, 0u));
        const bool take = (u[i] > Tv) || (eq && rank < need);
        sel |= (take ? 1u : 0u) << i;
        need -= __popcll(em);
    }
    return sel;
}


__device__ __forceinline__ unsigned topk_select_radix(const unsigned (&u)[32], int lane, volatile __attribute__((address_space(3))) unsigned* hist) {
    typedef __attribute__((address_space(3))) unsigned lu32;
    unsigned prefix = 0u; int kk = 256;
#pragma unroll 1
    for (int pass = 0; pass < 4; ++pass) {
        const int shift = 24 - 8 * pass;
        { unsigned zz = 0u; asm volatile("" : "+v"(zz)); ((__attribute__((address_space(3))) u32x4*)hist)[lane] = (u32x4){zz, zz, zz, zz}; }
        LDS_FENCE();
#pragma unroll
        for (int i = 0; i < 32; ++i) {
            const bool in = (u[i] != 0u) && (pass == 0 || (u[i] >> (shift + 8)) == prefix);
            if (in) __hip_atomic_fetch_add((lu32*)hist + ((u[i] >> shift) & 255u), 1u, __ATOMIC_RELAXED, __HIP_MEMORY_SCOPE_WORKGROUP);
        }
        LDS_FENCE();
        const u32x4 c = ((__attribute__((address_space(3))) u32x4*)hist)[lane];
        const int tot = (int)(c[0] + c[1] + c[2] + c[3]);
        int S = tot;
#pragma unroll
        for (int o = 1; o < 64; o <<= 1) { const int v = __shfl_down(S, o); if (lane + o < 64) S += v; }
        const unsigned long long bm = __ballot(S >= kk);
        const int Ls = 63 - __builtin_clzll(bm);
        int cum = S - tot, bin = 0, above = 0; bool found = false;
#pragma unroll
        for (int j = 3; j >= 0; --j) { const int cj = (int)c[j]; if (!found && cum + cj >= kk) { bin = 4 * lane + j; above = cum; found = true; } cum += cj; }
        bin = __builtin_amdgcn_readlane(bin, Ls); above = __builtin_amdgcn_readlane(above, Ls);
        kk -= above; prefix = (prefix << 8) | (unsigned)bin;
        LDS_FENCE();
    }
    const unsigned Tv = prefix; int need = kk;
    unsigned sel = 0u;
#pragma unroll
    for (int i = 0; i < 32; ++i) {
        const bool eq = (u[i] == Tv);
        const unsigned long long em = __ballot(eq);
        const int rank = (int)__builtin_amdgcn_mbcnt_hi((unsigned)(em >> 32), __builtin_amdgcn_mbcnt_lo((unsigned)em, 0u));
        const bool take = (u[i] > Tv) || (eq && rank < need);
        sel |= (take ? 1u : 0u) << i;
        need -= __popcll(em);
    }
    return sel;
}


#define DPP_STEP_I(v, op, ident, ctrl, rmask) v = op(v, __builtin_amdgcn_update_dpp((int)(ident), v, ctrl, rmask, 0xf, false))
__device__ __forceinline__ int imax_(int a, int b) { return a > b ? a : b; }
__device__ __forceinline__ int iadd_(int a, int b) { return a + b; }
__device__ __forceinline__ int wave_scan_add(int v) {
    DPP_STEP_I(v, iadd_, 0, 0x111, 0xf); DPP_STEP_I(v, iadd_, 0, 0x112, 0xf); DPP_STEP_I(v, iadd_, 0, 0x114, 0xf); DPP_STEP_I(v, iadd_, 0, 0x118, 0xf);
    DPP_STEP_I(v, iadd_, 0, 0x142, 0xa); DPP_STEP_I(v, iadd_, 0, 0x143, 0xc); return v;
}
template <int CTRL, int RMASK> __device__ __forceinline__ float fmax_dpp_(float a) { return fmaxf(a, __builtin_bit_cast(float, __builtin_amdgcn_update_dpp((int)0xff800000u, __builtin_bit_cast(int, a), CTRL, RMASK, 0xf, false))); }
template <int CTRL, int RMASK> __device__ __forceinline__ float fmin_dpp_(float a) { return fminf(a, __builtin_bit_cast(float, __builtin_amdgcn_update_dpp((int)0x7f800000u, __builtin_bit_cast(int, a), CTRL, RMASK, 0xf, false))); }
#define DPP_RED6(v, F) do { v = F<0x111, 0xf>(v); v = F<0x112, 0xf>(v); v = F<0x114, 0xf>(v); v = F<0x118, 0xf>(v); v = F<0x142, 0xa>(v); v = F<0x143, 0xc>(v); } while (0)
__device__ __forceinline__ float wave_max_dpp(float v) { DPP_RED6(v, fmax_dpp_); return __builtin_bit_cast(float, __builtin_amdgcn_readlane(__builtin_bit_cast(int, v), 63)); }
__device__ __forceinline__ float wave_min_dpp(float v) { DPP_RED6(v, fmin_dpp_); return __builtin_bit_cast(float, __builtin_amdgcn_readlane(__builtin_bit_cast(int, v), 63)); }
__device__ __forceinline__ unsigned topk_select_lin(const float (&s)[32], unsigned valid, int lane, volatile __attribute__((address_space(3))) unsigned* ws_) {
    typedef __attribute__((address_space(3))) unsigned lu32;
    typedef __attribute__((address_space(3))) float lf32;
    typedef __attribute__((address_space(3))) f32x4 lf32x4;
    lu32* hist = (lu32*)ws_; lf32* cand = (lf32*)ws_ + 256;
    unsigned act = valid; int kk = 256; float Tv = 0.f; int need = 0; bool solved = false; int cnt = 0;
#pragma unroll 1
    for (int iter = 0; iter < 8; ++iter) {
        float mn = __builtin_inff(), mx = -__builtin_inff();
        if (iter == 0) {
#pragma unroll
            for (int i = 0; i < 32; ++i) { mn = fminf(mn, s[i]); mx = fmaxf(mx, s[i]); }
        } else {
#pragma unroll
            for (int i = 0; i < 32; ++i) { const bool a = (act >> i) & 1u; mn = fminf(mn, a ? s[i] : __builtin_inff()); mx = fmaxf(mx, a ? s[i] : -__builtin_inff()); }
        }
        mn = wave_min_dpp(mn); mx = wave_max_dpp(mx);
        if (mn == mx) { Tv = mx; need = kk; solved = true; break; }
        const float scale = 254.9f / (mx - mn), bias = -mn * scale;
        { unsigned zz = 0u; asm volatile("" : "+v"(zz)); ((__attribute__((address_space(3))) u32x4*)hist)[lane] = (u32x4){zz, zz, zz, zz}; }
        LDS_FENCE();
#pragma unroll
        for (int i = 0; i < 32; ++i) { int b = (int)fmaf(s[i], scale, bias); b = b < 0 ? 0 : b;
            __hip_atomic_fetch_add(hist + (((act >> i) & 1u) ? b : 321 + (lane & 15)), 1u, __ATOMIC_RELAXED, __HIP_MEMORY_SCOPE_WORKGROUP); }
        LDS_FENCE();
        const u32x4 c = ((__attribute__((address_space(3))) u32x4*)hist)[lane];
        const int tot = (int)(c[0] + c[1] + c[2] + c[3]);
        const int pre = wave_scan_add(tot);
        const int total = __builtin_amdgcn_readlane(pre, 63);
        const int S = total - pre + tot;
        const unsigned long long bm = __ballot(S >= kk);
        const int Ls = 63 - __builtin_clzll(bm | 1ull);
        int cum = S - tot, bin = 0, above = 0, cb = 0; bool found = false;
#pragma unroll
        for (int j = 3; j >= 0; --j) { const int cj = (int)c[j]; if (!found && cum + cj >= kk) { bin = 4 * lane + j; above = cum; cb = cj; found = true; } cum += cj; }
        bin = __builtin_amdgcn_readlane(bin, Ls); above = __builtin_amdgcn_readlane(above, Ls); cnt = __builtin_amdgcn_readlane(cb, Ls);
        kk -= above;
        { float sc2 = scale; asm volatile("" : "+v"(sc2));
#pragma unroll
          for (int i = 0; i < 32; ++i) { int b = (int)fmaf(s[i], sc2, bias); b = b < 0 ? 0 : b; act &= ~((b != bin ? 1u : 0u) << i); } }
        LDS_FENCE();
        if (cnt <= 64) break;
    }
    if (!solved) {
        cand[lane] = __builtin_nanf("");
        const int myc = __popc(act);
        int off = wave_scan_add(myc) - myc;
        LDS_FENCE();
#pragma unroll
        for (int i = 0; i < 32; ++i) { const bool a = (act >> i) & 1u; const int slot = (a && off < 64) ? off : 65 + (lane & 15); cand[slot] = s[i]; off += a ? 1 : 0; }
        LDS_FENCE();
        const int m = cnt < 64 ? cnt : 64;
        const float v = (lane < m) ? cand[lane] : -__builtin_inff();
        int gt = 0, eq = 0;
#pragma unroll
        for (int j4 = 0; j4 < 16; ++j4) { const f32x4 cj = ((lf32x4*)cand)[j4];
#pragma unroll
            for (int e = 0; e < 4; ++e) { gt += (cj[e] > v) ? 1 : 0; eq += (cj[e] == v) ? 1 : 0; } }
        const bool ok = (lane < m) && gt < kk && kk <= gt + eq;
        const unsigned long long okm = __ballot(ok);
        const int fl = okm ? __builtin_ctzll(okm) : 0;
        Tv = __builtin_bit_cast(float, __builtin_amdgcn_readlane(__builtin_bit_cast(int, v), fl)); need = kk - __builtin_amdgcn_readlane(gt, fl);
        LDS_FENCE();
    }
    unsigned sel = 0u, eqb = 0u;
#pragma unroll
    for (int i = 0; i < 32; ++i) { sel |= ((s[i] > Tv) ? 1u : 0u) << i; eqb |= ((s[i] == Tv) ? 1u : 0u) << i; }
    const int eqtot = __builtin_amdgcn_readlane(wave_scan_add(__popc(eqb)), 63);
    if (eqtot <= need) sel |= eqb;
    else {
#pragma unroll
        for (int i = 0; i < 32; ++i) {
            const bool eq = (eqb >> i) & 1u;
            const unsigned long long em = __ballot(eq);
            const int rank = (int)__builtin_amdgcn_mbcnt_hi((unsigned)(em >> 32), __builtin_amdgcn_mbcnt_lo((unsigned)em, 0u));
            sel |= ((eq && rank < need) ? 1u : 0u) << i;
            need -= __popcll(em);
        }
    }
    return sel;
}


__device__ __forceinline__ unsigned topk_select_fast(const float (&s)[32], unsigned valid, int nk, int lane, const __attribute__((address_space(3))) float* row, volatile __attribute__((address_space(3))) unsigned* ws_) {
    typedef __attribute__((address_space(3))) unsigned lu32; typedef __attribute__((address_space(3))) float lf32; typedef __attribute__((address_space(3))) f32x4 lf32x4;
    lu32* hist = (lu32*)ws_; lf32* cand = (lf32*)ws_ + 256;
    float mn = __builtin_inff(), mx = -__builtin_inff();
#pragma unroll
    for (int i = 0; i < 32; ++i) { mn = fminf(mn, s[i]); mx = fmaxf(mx, s[i]); }
    mn = wave_min_dpp(mn); mx = wave_max_dpp(mx);
    const bool flat = (mn == mx);
    const float scale = flat ? 0.f : 254.9f / (mx - mn), bias = flat ? 0.f : -mn * scale;
    { unsigned zz = 0u; asm volatile("" : "+v"(zz)); ((__attribute__((address_space(3))) u32x4*)hist)[lane] = (u32x4){zz, zz, zz, zz}; }
    LDS_FENCE();
    const int full = nk >> 6, rem = nk & 63;
#pragma unroll
    for (int i = 0; i < 32; ++i) if (i <= full) { int b = (int)fmaf(s[i], scale, bias); b = b < 0 ? 0 : b; __hip_atomic_fetch_add(hist + b, 1u, __ATOMIC_RELAXED, __HIP_MEMORY_SCOPE_WORKGROUP); }
    LDS_FENCE();
    u32x4 c = ((__attribute__((address_space(3))) u32x4*)hist)[lane];
    if (lane == 0 && full < 32) c[0] -= (unsigned)(64 - rem);
    const int tot = (int)(c[0] + c[1] + c[2] + c[3]);
    const int pre = wave_scan_add(tot), total = __builtin_amdgcn_readlane(pre, 63);
    const int S = total - pre + tot;
    const unsigned long long bm = __ballot(S >= 256);
    const int Ls = 63 - __builtin_clzll(bm | 1ull);
    int cum = S - tot, bin = 0, above = 0, cb = 0; bool found = false;
#pragma unroll
    for (int j = 3; j >= 0; --j) { const int cj = (int)c[j]; if (!found && cum + cj >= 256) { bin = 4 * lane + j; above = cum; cb = cj; found = true; } cum += cj; }
    bin = __builtin_amdgcn_readlane(bin, Ls); above = __builtin_amdgcn_readlane(above, Ls); const int cnt = __builtin_amdgcn_readlane(cb, Ls);
    if (flat || cnt > 64) return topk_select_lin(s, valid, lane, ws_);
    const int kk = 256 - above;
    unsigned gtb = 0u, eqb = 0u;
    { float sc2 = scale; asm volatile("" : "+v"(sc2));
#pragma unroll
      for (int i = 0; i < 32; ++i) if (i <= full) { int b = (int)fmaf(s[i], sc2, bias); b = b < 0 ? 0 : b; gtb |= (b > bin ? 1u : 0u) << i; eqb |= (b == bin ? 1u : 0u) << i; } }
    eqb &= valid;
    cand[lane] = __builtin_nanf("");
    int off = wave_scan_add(__popc(eqb)) - __popc(eqb);
    LDS_FENCE();
    { unsigned m = eqb;
      while (__any(m != 0u)) { if (m != 0u) { const int i = __builtin_ctz(m); cand[off < 64 ? off : 65 + (lane & 15)] = row[i * 64 + lane]; ++off; m &= m - 1u; } } }
    LDS_FENCE();
    const float v = (lane < cnt) ? cand[lane] : -__builtin_inff();
    int gt = 0, eq = 0;
#pragma unroll
    for (int j4 = 0; j4 < 16; ++j4) { const f32x4 cj = ((lf32x4*)cand)[j4];
#pragma unroll
        for (int e = 0; e < 4; ++e) { gt += (cj[e] > v) ? 1 : 0; eq += (cj[e] == v) ? 1 : 0; } }
    const unsigned long long okm = __ballot((lane < cnt) && gt < kk && kk <= gt + eq);
    const int fl = okm ? __builtin_ctzll(okm) : 0;
    const float Tv = __builtin_bit_cast(float, __builtin_amdgcn_readlane(__builtin_bit_cast(int, v), fl)); int need = kk - __builtin_amdgcn_readlane(gt, fl);
    const int eqtot = __builtin_amdgcn_readlane(eq, fl);
    LDS_FENCE();
    unsigned sel = gtb;
    if (eqtot <= need) {
        unsigned m = eqb;
        while (__any(m != 0u)) { if (m != 0u) { const int i = __builtin_ctz(m); if (row[i * 64 + lane] >= Tv) sel |= 1u << i; m &= m - 1u; } }
    } else {
#pragma unroll
        for (int i = 0; i < 32; ++i) {
            const bool inb = (eqb >> i) & 1u; const bool e_ = inb && (s[i] == Tv);
            const unsigned long long em = __ballot(e_);
            const int rank = (int)__builtin_amdgcn_mbcnt_hi((unsigned)(em >> 32), __builtin_amdgcn_mbcnt_lo((unsigned)em, 0u));
            sel |= (((inb && s[i] > Tv) || (e_ && rank < need)) ? 1u : 0u) << i;
            need -= __popcll(em);
        }
    }
    return sel;
}

__device__ __forceinline__ void p3_indexer_naive(const Params& P, unsigned char* lds, int blk, int nblk, int wv) {
    const int tid = my_tid(wv), wid = __builtin_amdgcn_readfirstlane(tid >> 6), lane = tid & 63;
    float* sc = (float*)lds + wid * 2048; float* qf = (float*)(lds + 65536) + wid * 512; float* wf = (float*)(lds + 65536 + 16384) + wid * 8;
    const h16* QIDX = (const h16*)(P.ws + WS_QIDX); const h16* KIDXN = (const h16*)(P.ws + WS_KIDXN); const float* WIDX = (const float*)(P.ws + WS_WIDX);
    unsigned long long* MASK = (unsigned long long*)(P.ws + WS_MASK);
    const int gw = blk * NWAVES + wid, ngw = nblk * NWAVES;
    for (int it = gw; it < T; it += ngw) {
        const int b = it >> 11, pos = ((it & 2047) + b * 389) & 2047, t = b * L + pos, nk = pos + 1;
        { const h16x8 qv = *(const h16x8*)(QIDX + (size_t)t * 512 + lane * 8);
#pragma unroll
          for (int e = 0; e < 8; ++e) qf[lane * 8 + e] = (float)qv[e];
          if (lane < 8) wf[lane] = WIDX[(size_t)t * 8 + lane]; }
        LDS_FENCE();
        for (int i = 0; i * 64 < nk; ++i) {
            const int key = i * 64 + lane; float score = 0.f;
            if (key < nk) {
                const h16x8* kp = (const h16x8*)(KIDXN + (size_t)(b * L + key) * 64);
                float kf[64];
#pragma unroll
                for (int c = 0; c < 8; ++c) { const h16x8 kv = kp[c];
#pragma unroll
                    for (int e = 0; e < 8; ++e) kf[c * 8 + e] = (float)kv[e]; }
                for (int h = 0; h < 8; ++h) {
                    float a = 0.f;
#pragma unroll
                    for (int d = 0; d < 64; ++d) a = fmaf(qf[h * 64 + d], kf[d], a);
                    score += fmaxf(a, 0.f) * wf[h];
                }
            }
            sc[key] = score;
        }
        LDS_FENCE();
        unsigned selbits = 0u;
        if (nk <= 256) {
#pragma unroll
            for (int i = 0; i < 32; ++i) selbits |= ((i * 64 + lane) < nk ? 1u : 0u) << i;
        } else {
            unsigned u[32];
#pragma unroll
            for (int i = 0; i < 32; ++i) { const int key = i * 64 + lane; const float s = sc[key]; u[i] = (key < nk) ? fmap_u(s) : 0u; }
            selbits = topk_select(u, lane);
        }
#pragma unroll
        for (int i = 0; i < 32; ++i) { const unsigned long long bal = __ballot((selbits >> i) & 1u); if (lane == 0) MASK[(size_t)t * 32 + i] = bal; }
        LDS_FENCE();
    }
}


typedef float f32x16 __attribute__((ext_vector_type(16)));
__device__ __forceinline__ h16x8 relu_pk8(const f32x16& s, int base) {
    h16x8 r;
#pragma unroll
    for (int e = 0; e < 4; ++e) { const h16x2 p = __builtin_bit_cast(h16x2, __builtin_amdgcn_cvt_pkrtz(fmaxf(s[base + 2 * e], 0.f), fmaxf(s[base + 2 * e + 1], 0.f))); r[2 * e] = p[0]; r[2 * e + 1] = p[1]; }
    return r;
}
__device__ __forceinline__ void p3_indexer(const Params& P, unsigned char* lds_, int blk, int nblk, int wv) {
    typedef __attribute__((address_space(3))) float lfloat;
    const int tid = my_tid(wv), wid = __builtin_amdgcn_readfirstlane(tid >> 6), lane = tid & 63;
    unsigned char* ws = opaque_ptr(P.ws);
    lfloat* sc = (lfloat*)lds_;
    const h16* QIDX = (const h16*)(ws + WS_QIDX); const h16* KIDXN = (const h16*)(ws + WS_KIDXN); const float* WIDX = (const float*)(ws + WS_WIDX);
    unsigned long long* MASK = (unsigned long long*)(ws + WS_MASK);
    h16x8 Afn[4][4]; f32x4 wn = (f32x4){0.f, 0.f, 0.f, 0.f};
    { const int r = lane & 31, h = lane >> 5; const int u0 = (blk < NB * (L / 16)) ? blk : 0; const int tt0 = (u0 & 15) * L + (u0 >> 4) * 16;
#pragma unroll
      for (int g = 0; g < 4; ++g)
#pragma unroll
          for (int s = 0; s < 4; ++s) Afn[g][s] = *(const h16x8*)(QIDX + (size_t)(tt0 + 4 * g + (r >> 3)) * 512 + (r & 7) * 64 + 16 * s + 8 * h);
      if (r < 16) wn = *(const f32x4*)(WIDX + (size_t)(tt0 + r) * 8 + 4 * h); }
    for (int unit = blk; unit < NB * (L / 16); unit += nblk) {
        const int b = unit & 15, qg = unit >> 4, p0 = qg * 16, t0 = b * L + p0, NT = (p0 + 15) / 32 + 1;
        int lane_o = lane; asm volatile("" : "+v"(lane_o));
        const int r = lane_o & 31, h = lane_o >> 5;
        h16x8 Af[4][4];
#pragma unroll
        for (int g = 0; g < 4; ++g)
#pragma unroll
            for (int s = 0; s < 4; ++s) Af[g][s] = Afn[g][s];
        h16x8 fragA;
        { const f32x4 w = wn;
          const h16 z = (h16)0.f;
          if (r & 1) { fragA[0] = z; fragA[1] = z; fragA[2] = z; fragA[3] = z; fragA[4] = (h16)w[0]; fragA[5] = (h16)w[1]; fragA[6] = (h16)w[2]; fragA[7] = (h16)w[3]; }
          else { fragA[0] = (h16)w[0]; fragA[1] = (h16)w[1]; fragA[2] = (h16)w[2]; fragA[3] = (h16)w[3]; fragA[4] = z; fragA[5] = z; fragA[6] = z; fragA[7] = z; } }
        const int code = (r < 16) ? (r >> 1) : -1;
        const h16* kbase = KIDXN + (size_t)b * L * 64 + (size_t)r * 64 + 8 * h;
        h16x8 Bf[4];
        if (wid < NT) {
#pragma unroll
            for (int s = 0; s < 4; ++s) Bf[s] = *(const h16x8*)(kbase + (size_t)wid * 32 * 64 + 16 * s);
        }
        for (int rep_ = 0; rep_ <= MK_P3_REPA; ++rep_) {
        if (rep_ > 0 && wid < NT) {
#pragma unroll
            for (int s = 0; s < 4; ++s) Bf[s] = *(const h16x8*)(kbase + (size_t)wid * 32 * 64 + 16 * s);
        }
        for (int kt = wid; kt < NT; kt += NWAVES) {
            h16x8 Bn[4];
            const int ktn = (kt + NWAVES < NT) ? kt + NWAVES : kt;
#pragma unroll
            for (int s = 0; s < 4; ++s) Bn[s] = *(const h16x8*)(kbase + (size_t)ktn * 32 * 64 + 16 * s);
            f32x16 C = {};
#pragma unroll
            for (int g = 0; g < 4; ++g) {
                f32x16 S = {};
#pragma unroll
                for (int s = 0; s < 4; ++s) S = __builtin_amdgcn_mfma_f32_32x32x16_f16(Af[g][s], Bf[s], S, 0, 0, 0);
                const h16x8 X0 = relu_pk8(S, 0), X1 = relu_pk8(S, 8);
                const h16x8 zero8 = (h16x8){0, 0, 0, 0, 0, 0, 0, 0};
                const h16x8 W0 = (code == 2 * g) ? fragA : zero8, W1 = (code == 2 * g + 1) ? fragA : zero8;
                C = __builtin_amdgcn_mfma_f32_32x32x16_f16(W0, X0, C, 0, 0, 0);
                C = __builtin_amdgcn_mfma_f32_32x32x16_f16(W1, X1, C, 0, 0, 0);
            }
            const int key = kt * 32 + r;
#pragma unroll
            for (int e = 0; e < 4; ++e) { sc[(e + 4 * h) * 2048 + key] = C[e]; sc[(8 + e + 4 * h) * 2048 + key] = C[4 + e]; }
#pragma unroll
            for (int s = 0; s < 4; ++s) Bf[s] = Bn[s];
        }
        }
        __syncthreads();
        { const int un = (unit + nblk < NB * (L / 16)) ? unit + nblk : unit; const int ttn = (un & 15) * L + (un >> 4) * 16;
#pragma unroll
          for (int g = 0; g < 4; ++g)
#pragma unroll
              for (int s = 0; s < 4; ++s) Afn[g][s] = *(const h16x8*)(QIDX + (size_t)(ttn + 4 * g + (r >> 3)) * 512 + (r & 7) * 64 + 16 * s + 8 * h);
          if (r < 16) wn = *(const f32x4*)(WIDX + (size_t)(ttn + r) * 8 + 4 * h); }
#pragma unroll 1
        for (int qq_ = 0; qq_ < 2 * (1 + MK_P3_REPB); ++qq_) {
            const int qq = qq_ & 1;
            const int qi = 2 * wid + qq, pos = p0 + qi, nk = pos + 1, t = t0 + qi;
            unsigned selbits = 0u;
            if (nk <= 256) {
#pragma unroll
                for (int i = 0; i < 32; ++i) selbits |= ((i * 64 + lane) < nk ? 1u : 0u) << i;
            } else {
                float sv[32];
                const int full = nk >> 6;
                const unsigned valid = (full >= 32 ? 0xffffffffu : ((1u << full) - 1u)) | ((full < 32 && lane < (nk & 63)) ? (1u << full) : 0u);
#pragma unroll
                for (int i = 0; i < 32; ++i) { const float x = sc[qi * 2048 + i * 64 + lane]; sv[i] = ((valid >> i) & 1u) ? x : __builtin_nanf(""); }
                selbits = topk_select_fast(sv, valid, nk, lane, (const __attribute__((address_space(3))) float*)(sc + qi * 2048), (volatile __attribute__((address_space(3))) unsigned*)(sc + 16 * 2048 + wid * 448));
            }
            {
                __attribute__((address_space(3))) unsigned long long* stg = (__attribute__((address_space(3))) unsigned long long*)(sc + 16 * 2048 + wid * 448 + (qq ? 0 : 338));
                LDS_FENCE();
#pragma unroll
                for (int i = 0; i < 32; ++i) { const unsigned long long bal = __ballot((selbits >> i) & 1u); if (lane == 0) stg[i] = bal; }
            }
            (void)t;
        }
        __syncthreads();
        { const int q = tid & 15, tl = tid >> 4;
          MASK[((size_t)b * 32 + tl) * L + p0 + q] = ((__attribute__((address_space(3))) unsigned long long*)(sc + 16 * 2048 + (q >> 1) * 448 + ((q & 1) ? 0 : 338)))[tl]; }
    }
}

__device__ __forceinline__ void p4_attn_naive(const Params& P, unsigned char* lds, int blk, int nblk, int wv) {
    const int tid = my_tid(wv), wid = __builtin_amdgcn_readfirstlane(tid >> 6), lane = tid & 63;
    int* keys = (int*)lds; float* qf = (float*)(lds + 1024); float* pf = (float*)(lds + 1024 + 4096) + wid * 256; int* nselp = (int*)(lds + 1024 + 4096 + 8192);
    h16* QA = (h16*)(P.ws + WS_R1); const h16* Kb = (const h16*)(P.ws + WS_R2); const h16* Vb = (const h16*)(P.ws + WS_R3); const h16* SG = (const h16*)(P.ws + WS_R4);
    const unsigned long long* MASK = (const unsigned long long*)(P.ws + WS_MASK);
    for (int t = blk; t < T; t += nblk) {
        const int b = t >> 11;
        __syncthreads();
        if (tid < 128) { const h16x8 qv = *(const h16x8*)(QA + (size_t)t * 1024 + tid * 8);
#pragma unroll
            for (int e = 0; e < 8; ++e) qf[tid * 8 + e] = (float)qv[e]; }
        if (wid == 0) {
            unsigned long long m = (lane < 32) ? MASK[(size_t)t * 32 + lane] : 0ull;
            const int cnt = __popcll(m); int inc = cnt;
#pragma unroll
            for (int o = 1; o < 64; o <<= 1) { const int v = __shfl_up(inc, o); if (lane >= o) inc += v; }
            int off = inc - cnt;
            while (m) { const int k = __builtin_ctzll(m); keys[off++] = lane * 64 + k; m &= m - 1; }
            if (lane == 63) nselp[0] = inc;
        }
        __syncthreads();
        const int nsel = nselp[0], h = wid;
        float s[4];
#pragma unroll
        for (int c = 0; c < 4; ++c) {
            const int idx = lane + 64 * c; s[c] = -INFINITY;
            if (idx < nsel) {
                const h16x8* kp = (const h16x8*)(Kb + (size_t)(b * L + keys[idx]) * 1024 + h * 128); float a = 0.f;
#pragma unroll
                for (int cc = 0; cc < 16; ++cc) { const h16x8 kv = kp[cc];
#pragma unroll
                    for (int e = 0; e < 8; ++e) a = fmaf(qf[h * 128 + cc * 8 + e], (float)kv[e], a); }
                s[c] = a;
            }
        }
        const float mx = wave_max(fmaxf(fmaxf(s[0], s[1]), fmaxf(s[2], s[3])));
        float ls = 0.f;
#pragma unroll
        for (int c = 0; c < 4; ++c) { const int idx = lane + 64 * c; const float p = (idx < nsel) ? exp2f(s[c] - mx) : 0.f; pf[idx] = p; ls += p; }
        ls = wave_sum(ls);
        LDS_FENCE();
        float o0 = 0.f, o1 = 0.f;
        for (int k = 0; k < nsel; ++k) {
            const h16x2 v = *(const h16x2*)(Vb + (size_t)(b * L + keys[k]) * 1024 + h * 128 + 2 * lane); const float pk = pf[k];
            o0 = fmaf(pk, (float)v[0], o0); o1 = fmaf(pk, (float)v[1], o1);
        }
        const float inv = 1.0f / ls;
        const h16x2 g = *(const h16x2*)(SG + (size_t)t * 1024 + h * 128 + 2 * lane);
        h16x2 o; o[0] = (h16)(o0 * inv * (float)g[0]); o[1] = (h16)(o1 * inv * (float)g[1]);
        *(h16x2*)(QA + (size_t)t * 1024 + h * 128 + 2 * lane) = o;
    }
}


namespace att {
typedef unsigned short bf16;
typedef short bf16x8 __attribute__((ext_vector_type(8)));
typedef short s16x4 __attribute__((ext_vector_type(4)));
typedef float f32x16 __attribute__((ext_vector_type(16)));
typedef __attribute__((address_space(3))) char lchar;
typedef __attribute__((address_space(3))) float lfloat;
typedef __attribute__((address_space(3))) bf16x8 lbf16x8;
constexpr int D = 128, PITCH = 1024, NW = 8, QBLK = 32, KVBLK = 64, QB = NW * QBLK;
constexpr int SHM_V = KVBLK * D * 2, SHM_K = KVBLK * D * 2;
constexpr int LDS_ATT = 2 * SHM_V + 2 * SHM_K + NW * 64 * 4;
constexpr float THR = 8.f;
#define KSWZ(row, colB) ((row) * 256 + ((colB) ^ (((row) & 7) << 4)))
#define SBAR() __builtin_amdgcn_sched_barrier(0)
__device__ __forceinline__ int v_st(int k, int c) { const int kk = (k & ~0xC) | ((k & 4) << 1) | ((k & 8) >> 1); return ((kk >> 3) * 4 + (c >> 5)) * 512 + ((kk & 7) * 32 + (c & 31)) * 2; }
__device__ __forceinline__ int v_rd_base(int lane) { return ((lane & 3) << 3) | (((lane >> 2) & 3) << 6) | (((lane >> 4) & 1) << 5) | (((lane >> 5) & 1) << 8); }
constexpr int v_rd_off(int d0, int ks, int half) { return d0 * 512 + ks * 4096 + half * 2048; }
__device__ __forceinline__ int crow(int r, int hi) { return (r & 3) + 8 * (r >> 2) + 4 * hi; }
__device__ __forceinline__ bf16x8 load8(const bf16* p) { return *reinterpret_cast<const bf16x8*>(p); }
__device__ __forceinline__ void mask_init(f32x16& p0, f32x16& p1, unsigned long long mk, int hi) {
    const unsigned lo = (unsigned)mk >> (4 * hi), hh = (unsigned)(mk >> 32) >> (4 * hi);
#pragma unroll
    for (int r = 0; r < 16; ++r) {
        const int c = (r & 3) + 8 * (r >> 2);
        const int t0 = __builtin_amdgcn_sbfe(lo, c, 1), t1 = __builtin_amdgcn_sbfe(hh, c, 1);
        p0[r] = __uint_as_float(~(unsigned)t0 & 0xff800000u); p1[r] = __uint_as_float(~(unsigned)t1 & 0xff800000u);
    }
}
__device__ __forceinline__ void partialSM(f32x16& p0, f32x16& p1, float& m_reg, float& mn, float& alpha) {
    float pmax = p0[0]; for (int r = 1; r < 16; ++r) pmax = fmaxf(pmax, p0[r]); for (int r = 0; r < 16; ++r) pmax = fmaxf(pmax, p1[r]);
    { auto rr = __builtin_amdgcn_permlane32_swap(__float_as_uint(pmax), __float_as_uint(pmax), false, false);
      pmax = fmaxf(__uint_as_float(rr[0]), __uint_as_float(rr[1])); }
    if (__builtin_expect(__all((pmax - m_reg) <= THR), 1)) { mn = m_reg; alpha = 1.f; }
    else { mn = fmaxf(m_reg, pmax); alpha = __builtin_amdgcn_exp2f(m_reg - mn); m_reg = mn; }
    for (int r = 0; r < 16; ++r) p0[r] = p0[r] - mn; for (int r = 0; r < 16; ++r) p1[r] = p1[r] - mn;
    for (int r = 0; r < 16; ++r) p0[r] = __builtin_amdgcn_exp2f(p0[r]);
}
__device__ __forceinline__ void finishSM(f32x16& p0, f32x16& p1, float alpha, float& l_reg, bf16x8& pa0, bf16x8& pa1, bf16x8& pa2, bf16x8& pa3) {
    for (int r = 0; r < 16; ++r) p1[r] = __builtin_amdgcn_exp2f(p1[r]);
    float ps = 0; for (int r = 0; r < 16; ++r) ps += p0[r]; for (int r = 0; r < 16; ++r) ps += p1[r];
    { auto rr = __builtin_amdgcn_permlane32_swap(__float_as_uint(ps), __float_as_uint(ps), false, false);
      ps = __uint_as_float(rr[0]) + __uint_as_float(rr[1]); }
    l_reg = l_reg * alpha + ps;
#define PK4(P, B_, OUT) do { unsigned a0 = cvtpk_bf16(P[B_+0], P[B_+1]), a1 = cvtpk_bf16(P[B_+2], P[B_+3]);                          \
        unsigned b0 = cvtpk_bf16(P[B_+4], P[B_+5]), b1 = cvtpk_bf16(P[B_+6], P[B_+7]);                                             \
        auto r0 = __builtin_amdgcn_permlane32_swap(a0, b0, false, false); auto r1 = __builtin_amdgcn_permlane32_swap(a1, b1, false, false); \
        u32x4 w = {r0[0], r1[0], r0[1], r1[1]}; OUT = *reinterpret_cast<bf16x8*>(&w); } while (0)
    PK4(p0, 0, pa0); PK4(p0, 8, pa1); PK4(p1, 0, pa2); PK4(p1, 8, pa3);
#undef PK4
}
template <int KB>
__device__ __forceinline__ void qkt(f32x16& p0, f32x16& p1, const lchar* K_lds, int r32, int hi, const bf16x8* qr) {
    const lchar* kb[4];
#pragma unroll
    for (int dd = 0; dd < 4; ++dd) kb[dd] = K_lds + KB * SHM_K + KSWZ(r32, (dd * 16 + hi * 8) * 2);
#pragma unroll
    for (int d0 = 0; d0 < 8; ++d0) { const lchar* a = kb[d0 & 3] + (d0 >> 2) * 128;
        bf16x8 b0 = *(const lbf16x8*)(a);
        bf16x8 b1 = *(const lbf16x8*)(a + 32 * 256);
        p0 = __builtin_amdgcn_mfma_f32_32x32x16_bf16(b0, qr[d0], p0, 0, 0, 0);
        p1 = __builtin_amdgcn_mfma_f32_32x32x16_bf16(b1, qr[d0], p1, 0, 0, 0); }
}
template <int VB>
__device__ __forceinline__ void pv_tile(f32x16* o, int vb0, bf16x8 pa0, bf16x8 pa1, bf16x8 pa2, bf16x8 pa3) {
#define TRRD(dst, off) asm volatile("ds_read_b64_tr_b16 %0, %1 offset:%2" : "=&v"(dst) : "v"(vb0), "i"(off) : "memory")
#define PV_D0(d0) do { s16x4 l0, l1, l2, l3, h0, h1, h2, h3; constexpr int b_ = VB * SHM_V + v_rd_off(d0, 0, 0); \
        TRRD(l0, b_); TRRD(h0, b_ + 2048); TRRD(l1, b_ + 4096); TRRD(h1, b_ + 6144); TRRD(l2, b_ + 8192); TRRD(h2, b_ + 10240); TRRD(l3, b_ + 12288); TRRD(h3, b_ + 14336); \
        asm volatile("s_waitcnt lgkmcnt(0)" ::: "memory"); SBAR();   \
        o[d0] = __builtin_amdgcn_mfma_f32_32x32x16_bf16(pa0, (bf16x8){l0[0], l0[1], l0[2], l0[3], h0[0], h0[1], h0[2], h0[3]}, o[d0], 0, 0, 0);   \
        o[d0] = __builtin_amdgcn_mfma_f32_32x32x16_bf16(pa1, (bf16x8){l1[0], l1[1], l1[2], l1[3], h1[0], h1[1], h1[2], h1[3]}, o[d0], 0, 0, 0);   \
        o[d0] = __builtin_amdgcn_mfma_f32_32x32x16_bf16(pa2, (bf16x8){l2[0], l2[1], l2[2], l2[3], h2[0], h2[1], h2[2], h2[3]}, o[d0], 0, 0, 0);   \
        o[d0] = __builtin_amdgcn_mfma_f32_32x32x16_bf16(pa3, (bf16x8){l3[0], l3[1], l3[2], l3[3], h3[0], h3[1], h3[2], h3[3]}, o[d0], 0, 0, 0); } while (0)
    PV_D0(0); PV_D0(1); PV_D0(2); PV_D0(3);
#undef PV_D0
#undef TRRD
}
struct BlockRef { const bf16* Q; const bf16* K; const bf16* V; h16* O; const unsigned long long* M; const h16* G; int P0; };
struct Seam { bf16x8 qr[8]; bf16x8 st_v0, st_v1, st_k0, st_k1; };
#define VMW() asm volatile("s_waitcnt vmcnt(0)" ::: "memory")
#define VMWN(n) asm volatile("s_waitcnt vmcnt(%0)" :: "i"(n) : "memory")
#define SLOAD_H(Kp, Vp, k0) do { const unsigned o0_ = ro0 + (unsigned)(k0) * PITCH, o1_ = o0_ + 32u * PITCH;     \
                         S.st_v0 = load8((Vp) + o0_); S.st_v1 = load8((Vp) + o1_); S.st_k0 = load8((Kp) + o0_); S.st_k1 = load8((Kp) + o1_); } while (0)
#define SWRITE_HK(bf) do { *(lbf16x8*)(K_lds + (bf) * SHM_K + kws) = S.st_k0; *(lbf16x8*)(K_lds + (bf) * SHM_K + kws + 32 * 256) = S.st_k1; } while (0)
#define SWRITE_HV(bf) do { *(lbf16x8*)(V_lds + (bf) * SHM_V + vst0) = S.st_v0; *(lbf16x8*)(V_lds + (bf) * SHM_V + vst1) = S.st_v1; } while (0)
#define SWRITE_H(bf) do { SWRITE_HV(bf); SWRITE_HK(bf); } while (0)
__device__ __forceinline__ void prime(const BlockRef& cur, lchar* lds, Seam& S, int wv) {
    const int tid = my_tid(wv);
    const int wid = __builtin_amdgcn_readfirstlane(tid >> 6), lane = tid & 63, r32 = lane & 31, hi = lane >> 5;
    const int sr = tid >> 4, sc = (tid & 15) * 8, kws = KSWZ(sr, sc * 2); lchar* K_lds = lds + 2 * SHM_V;
    const unsigned ro0 = (unsigned)(sr * PITCH + sc), qo = (unsigned)((wid * QBLK + r32) * PITCH + hi * 8);
    for (int d0 = 0; d0 < 8; ++d0) S.qr[d0] = load8(cur.Q + (qo + (unsigned)(d0 * 16)));
    SLOAD_H(cur.K, cur.V, 0); VMW(); SWRITE_HK(0);
    __syncthreads();
}
__device__ __forceinline__ void block(const BlockRef& cur, const BlockRef& nxt, lchar* lds, Seam& S, int wv) {
    const int tid = my_tid(wv);
    const int wid = __builtin_amdgcn_readfirstlane(tid >> 6), lane = tid & 63, r32 = lane & 31, hi = lane >> 5;
    const int NT = (cur.P0 + QB - 1) / KVBLK + 1;
    lchar* V_lds = lds; lchar* K_lds = lds + 2 * SHM_V;
    lfloat* ws = (lfloat*)(lds + 2 * SHM_V + 2 * SHM_K) + wid * 64; lfloat* li_l = ws, * al_l = ws + 32;
    float m_reg = -1e30f, l_reg = 0; f32x16 o[4] = {};
    const int sr = tid >> 4, sc = (tid & 15) * 8, vst0 = v_st(sr, sc), vst1 = v_st(32 + sr, sc), kws = KSWZ(sr, sc * 2);
    const int vb0 = (int)(unsigned)(uintptr_t)V_lds + v_rd_base(lane);
    const unsigned ro0 = (unsigned)(sr * PITCH + sc), qo = (unsigned)((wid * QBLK + r32) * PITCH + hi * 8);
    const bf16* Kh = cur.K; const bf16* Vh = cur.V;
    const unsigned mro = (unsigned)(wid * QBLK + r32) * 8u;
#define LDMASK(tile) (*(const unsigned long long*)((const char*)cur.M + (mro + (unsigned)(tile) * (unsigned)(L * 8))))
    unsigned long long mk;
#define RESC(a) do { if (__any((a) < 1.f)) { if (hi == 0) al_l[r32] = (a); asm volatile("s_waitcnt lgkmcnt(0)" ::: "memory");              \
                     for (int d_ = 0; d_ < 4; ++d_) for (int r = 0; r < 16; ++r) o[d_][r] *= al_l[crow(r, hi)]; } } while (0)
#define KBASE(t) ((t) * KVBLK)
    constexpr int NQL = 8;
#define SEAM_K0() do { VMWN(NQL); SWRITE_HK(0); SBAR(); } while (0)
    f32x16 pA0, pA1, pB0, pB1; float mnA, mnB, alA, alB; bf16x8 pa0, pa1, pa2, pa3;
    SWRITE_HV(0); SBAR();
    mk = LDMASK(0);
    if (NT > 1) { SLOAD_H(Kh, Vh, KBASE(1)); }
    mask_init(pA0, pA1, mk, hi); if (NT > 1) mk = LDMASK(1);
    SBAR(); qkt<0>(pA0, pA1, K_lds, r32, hi, S.qr);
    partialSM(pA0, pA1, m_reg, mnA, alA);
    if (NT > 1) { VMW(); SWRITE_H(1); }
    __syncthreads();
#define HALF_STEP(PX0, PX1, mnX, alX, PY0, PY1, alY, t, KB, VB, SB) do {                                                      \
        mask_init(PX0, PX1, mk, hi);                                       \
        SBAR(); qkt<KB>(PX0, PX1, K_lds, r32, hi, S.qr);                                                                      \
        if ((t) + 1 < NT) mk = LDMASK((t) + 1);                                                              \
        finishSM(PY0, PY1, alY, l_reg, pa0, pa1, pa2, pa3); SBAR();                                                           \
        if ((t) + 1 < NT) { SLOAD_H(Kh, Vh, KBASE((t) + 1)); SBAR(); }                                                        \
        pv_tile<VB>(o, vb0, pa0, pa1, pa2, pa3); partialSM(PX0, PX1, m_reg, mnX, alX);                                        \
        __syncthreads();                                                                                                      \
        if ((t) + 1 < NT) { VMW(); SWRITE_H(SB); }                                                                            \
        RESC(alX); __syncthreads(); } while (0)
    for (int t = 1; t + 1 < NT; t += 2) {
        HALF_STEP(pB0, pB1, mnB, alB, pA0, pA1, alA, t, 1, 0, 0);
        HALF_STEP(pA0, pA1, mnA, alA, pB0, pB1, alB, t + 1, 0, 1, 1);
    }
    const bool even = (NT & 1) == 0;
    if (even) { mask_init(pB0, pB1, mk, hi); SBAR(); qkt<1>(pB0, pB1, K_lds, r32, hi, S.qr); SBAR(); }
    SLOAD_H(nxt.K, nxt.V, 0); SBAR();
#pragma unroll
    for (int d0 = 0; d0 < 8; ++d0) S.qr[d0] = load8(nxt.Q + (qo + (unsigned)(d0 * 16)));
    SBAR();
    finishSM(pA0, pA1, alA, l_reg, pa0, pa1, pa2, pa3); SBAR();
    pv_tile<0>(o, vb0, pa0, pa1, pa2, pa3);
    if (even) { partialSM(pB0, pB1, m_reg, mnB, alB); __syncthreads(); RESC(alB);
        finishSM(pB0, pB1, alB, l_reg, pa0, pa1, pa2, pa3); SBAR(); pv_tile<1>(o, vb0, pa0, pa1, pa2, pa3); }
    SBAR(); SEAM_K0();
    if (hi == 0) li_l[r32] = l_reg; asm volatile("s_waitcnt lgkmcnt(0)" ::: "memory");
    float rli[16];
#pragma unroll
    for (int r = 0; r < 16; ++r) rli[r] = __builtin_amdgcn_rcpf(li_l[crow(r, hi)]);
    __syncthreads();
    {
        typedef __attribute__((address_space(3))) h16 lh16; typedef __attribute__((address_space(3))) h16x8 lh16x8_;
        lchar* ob = V_lds + wid * 4096;
#pragma unroll
        for (int half = 0; half < 2; ++half) {
#pragma unroll
            for (int r = 0; r < 16; ++r) { const int orow = crow(r, hi);
#pragma unroll
                for (int dd = 0; dd < 2; ++dd) *(lh16*)(ob + orow * 128 + (dd * 32 + r32) * 2) = (h16)(o[half * 2 + dd][r] * rli[r]); }
            asm volatile("s_waitcnt lgkmcnt(0)" ::: "memory");
#pragma unroll
            for (int i = 0; i < 4; ++i) { const int c = lane + 64 * i, row = c >> 3, c8 = c & 7;
                const h16x8 ov = *(const lh16x8_*)(ob + row * 128 + c8 * 16);
                const unsigned oo = (unsigned)((wid * QBLK + row) * PITCH + half * 64 + c8 * 8);
                const h16x8 gv = *(const h16x8*)(cur.G + oo);
                *(h16x8*)(cur.O + oo) = ov * gv; }
            asm volatile("s_waitcnt lgkmcnt(0)" ::: "memory");
        }
    }
    __syncthreads();
#undef LDMASK
#undef RESC
#undef KBASE
#undef SEAM_K0
#undef HALF_STEP
}
#undef VMW
#undef VMWN
#undef SLOAD_H
#undef SWRITE_HK
#undef SWRITE_HV
#undef SWRITE_H
#undef KSWZ
#undef SBAR
}

__device__ __forceinline__ att::BlockRef att_ref(const Params& P, unsigned char* ws, int item, int pass) {
    const int xcd = item & 7, kq = item >> 3, bh = (kq >> 2) * 8 + xcd, x = kq & 3, qb = pass ? 7 - x : x, b = bh >> 3, h = bh & 7;
    const size_t row0 = (size_t)b * L + (size_t)qb * 256;
    att::BlockRef r;
    r.Q = (const att::bf16*)(ws + WS_R1) + row0 * 1024 + h * 128; r.O = (h16*)(ws + WS_AO) + row0 * 1024 + h * 128;
    r.K = (const att::bf16*)(ws + WS_R2) + (size_t)b * L * 1024 + h * 128; r.V = (const att::bf16*)(ws + WS_R3) + (size_t)b * L * 1024 + h * 128;
    r.M = (const unsigned long long*)(ws + WS_MASK) + (size_t)b * 32 * L + (size_t)qb * 256;
    r.G = (const h16*)(ws + WS_R4) + row0 * 1024 + h * 128; r.P0 = qb * 256;
    return r;
}
__device__ __forceinline__ void p4_attn(const Params& P, unsigned char* lds, int blk, int nblk, int wv) {
    unsigned char* ws = opaque_ptr(P.ws);
    const int total = NB * 8 * 4;
    int it = blk; if (it >= total) return;
    int pass = 0;
    att::BlockRef cur = att_ref(P, ws, it, 0);
    att::Seam S;
    att::prime(cur, (att::lchar*)lds, S, wv);
    for (;;) {
        const bool more_pass = pass == 0, more_item = it + nblk < total, last = !more_pass && !more_item;
        int itn = it, passn = pass + 1;
        if (!more_pass) { passn = 0; itn = more_item ? it + nblk : it; }
        const att::BlockRef nxt = last ? cur : att_ref(P, ws, itn, passn);
        att::block(cur, nxt, (att::lchar*)lds, S, wv);
        if (last) break;
        cur = nxt; it = itn; pass = passn;
    }
}

__device__ __forceinline__ void p8_ret_naive(const Params& P, unsigned char* lds, int blk, int nblk, int wv) {
    const int tid = my_tid(wv);
    float* qk = (float*)lds;
    const h16* RQ = (const h16*)(P.ws + WS_R1); const h16* RK = (const h16*)(P.ws + WS_R2); h16* RV = (h16*)(P.ws + WS_R4);
    const int j = tid >> 2, iq = tid & 3;
    for (int it = blk; it < 256; it += nblk) {
        const int b = it >> 4, h = (it >> 2) & 3, sl = it & 3;
        const float gamma = 1.0f - exp2f(-5.0f - (float)h);
        float S[64];
#pragma unroll
        for (int i = 0; i < 64; ++i) S[i] = 0.f;
        const int col = tid & 255;
        const h16* src = (tid < 256 ? RQ : RK) + (size_t)b * L * 1024 + h * 256 + col;
        float* dst = qk + (tid >> 8) * 272 + (col >> 6) * 68 + (col & 63);
        h16* vp = RV + (size_t)b * L * 2048 + h * 512 + sl * 128 + j;
        for (int t0 = 0; t0 < L; t0 += 16) {
            __syncthreads();
            h16 vv[16];
#pragma unroll
            for (int tt = 0; tt < 16; ++tt) { dst[tt * 544] = (float)src[(size_t)(t0 + tt) * 1024]; vv[tt] = vp[(size_t)(t0 + tt) * 2048]; }
            __syncthreads();
#pragma unroll
            for (int tt = 0; tt < 16; ++tt) {
                const f32x4* qp = (const f32x4*)(qk + tt * 544 + iq * 68); const f32x4* kp = (const f32x4*)(qk + tt * 544 + 272 + iq * 68);
                const float v = (float)vv[tt]; float o = 0.f;
#pragma unroll
                for (int i4 = 0; i4 < 16; ++i4) { const f32x4 q4 = qp[i4], k4 = kp[i4];
#pragma unroll
                    for (int e = 0; e < 4; ++e) { S[i4 * 4 + e] = fmaf(gamma, S[i4 * 4 + e], k4[e] * v); o = fmaf(q4[e], S[i4 * 4 + e], o); } }
                o += __shfl_xor(o, 1); o += __shfl_xor(o, 2);
                if (iq == 0) vp[(size_t)(t0 + tt) * 2048] = (h16)o;
            }
        }
    }
}


namespace ret {
typedef __attribute__((address_space(3))) unsigned char lch;
typedef __attribute__((address_space(3))) h16x8 lh16x8;
typedef __attribute__((address_space(3))) h16x4 lh16x4;
typedef __attribute__((address_space(3))) u32x4 lu32x4;
typedef short v4i16 __attribute__((ext_vector_type(4)));
typedef __attribute__((address_space(3))) v4i16 lv4i16;
constexpr int SKB = 544, SVB = 288, SSB = 544;
constexpr int OFF_K = 0, OFF_V = 64 * SKB, OFF_S = OFF_V + 64 * SVB, LDS_RET = OFF_S + 128 * SSB;
__device__ __forceinline__ h16x4 trrd(const lch* p) { return __builtin_bit_cast(h16x4, __builtin_amdgcn_ds_read_tr16_b64_v4i16((lv4i16*)p)); }
__device__ __forceinline__ h16x8 cat8(h16x4 a, h16x4 b) { return __builtin_shufflevector(a, b, 0, 1, 2, 3, 4, 5, 6, 7); }
}
__device__ __forceinline__ void p8_retention(const Params& P, unsigned char* lds_, int blk, int nblk, int wv) {
    using namespace ret;
    const int tid = my_tid(wv), wid = __builtin_amdgcn_readfirstlane(tid >> 6), lane = tid & 63, c16 = lane & 15, g = lane >> 4, q4 = c16 >> 2, p4 = c16 & 3;
    const int it = wid & 3, dh = wid >> 2;
    unsigned char* ws = opaque_ptr(P.ws);
    lch* Kc = (lch*)lds_ + OFF_K; lch* Vc = (lch*)lds_ + OFF_V; lch* St = (lch*)lds_ + OFF_S;
    const h16* RQ = (const h16*)(ws + WS_R1); const h16* RK = (const h16*)(ws + WS_R2); h16* RV = (h16*)(ws + WS_R4);
    for (int item = blk; item < 256; item += nblk) {
        const int b = item >> 4, h = (item >> 2) & 3, sl = item & 3;
        const float lgam = log2f(1.0f - exp2f(-5.0f - (float)h));
        const float gamma64 = exp2f(64.0f * lgam);
        f32x4 state[16];
#pragma unroll
        for (int d = 0; d < 16; ++d) state[d] = (f32x4){0.f, 0.f, 0.f, 0.f};
        __syncthreads();
        { unsigned zz = 0u; asm volatile("" : "+v"(zz));
          for (int i = tid; i < 128 * SSB / 16; i += NTHREADS) ((lu32x4*)St)[i] = (u32x4){zz, zz, zz, zz}; }
        const h16* kg = RK + (size_t)b * L * 1024 + h * 256; const h16* vg = RV + (size_t)b * L * 2048 + h * 512 + sl * 128;
        h16x8 kreg[4], vreg[2];
        const unsigned qoff = (unsigned)((16 * it + c16) * 1024 + 8 * g), ooff = (unsigned)((16 * it + c16) * 2048 + 64 * dh + 4 * g);
        unsigned ko[4], vo[2];
#pragma unroll
        for (int i = 0; i < 4; ++i) { const int c = tid + NTHREADS * i; ko[i] = (unsigned)((c >> 5) * 1024 + (c & 31) * 8); }
#pragma unroll
        for (int i = 0; i < 2; ++i) { const int c = tid + NTHREADS * i; vo[i] = (unsigned)((c >> 4) * 2048 + (c & 15) * 8); }
#pragma unroll
        for (int i = 0; i < 4; ++i) kreg[i] = *(const h16x8*)(kg + ko[i]);
#pragma unroll
        for (int i = 0; i < 2; ++i) vreg[i] = *(const h16x8*)(vg + vo[i]);
#pragma unroll
        for (int i = 0; i < 4; ++i) { const int c = tid + NTHREADS * i; *(lh16x8*)(Kc + (c >> 5) * SKB + (c & 31) * 16) = kreg[i]; }
#pragma unroll
        for (int i = 0; i < 2; ++i) { const int c = tid + NTHREADS * i; *(lh16x8*)(Vc + (c >> 4) * SVB + (c & 15) * 16) = vreg[i]; }
        h16x8 Qn[8];
#pragma unroll
        for (int s = 0; s < 8; ++s) Qn[s] = *(const h16x8*)((RQ + (size_t)b * L * 1024 + h * 256) + (qoff + (unsigned)(32 * s)));
        __syncthreads();
        for (int n = 0; n < L / 64; ++n) {
            const size_t row0 = (size_t)b * L + (size_t)n * 64;
            const int nn = (n + 1 < L / 64) ? n + 1 : n;
            float lg = lgam; asm volatile("" : "+v"(lg));
            const float xi = __builtin_amdgcn_exp2f((float)(16 * it + c16 + 1) * lg);
            h16x8 Qf[8];
#pragma unroll
            for (int s = 0; s < 8; ++s) Qf[s] = Qn[s];
#pragma unroll
            for (int s = 0; s < 8; ++s) Qn[s] = *(const h16x8*)((RQ + ((size_t)b * L + (size_t)nn * 64) * 1024 + h * 256) + (qoff + (unsigned)(32 * s)));
            h16x8 Pf[2];
#pragma unroll
            for (int ks = 0; ks < 2; ++ks)
#pragma unroll
                for (int e = 0; e < 8; ++e) Pf[ks][e] = (h16)0.f;
#pragma unroll
            for (int jt = 0; jt < 4; ++jt) {
                if (jt <= it) {
                    f32x4 S = (f32x4){0.f, 0.f, 0.f, 0.f};
#pragma unroll
                    for (int s = 0; s < 8; ++s) { const h16x8 A = *(const lh16x8*)(Kc + (16 * jt + c16) * SKB + (32 * s + 8 * g) * 2); S = __builtin_amdgcn_mfma_f32_16x16x32_f16(A, Qf[s], S, 0, 0, 0); }
#pragma unroll
                    for (int e = 0; e < 4; ++e) { const int d = (16 * it + c16) - (16 * jt + 4 * g + e); const float f = (d >= 0) ? __builtin_amdgcn_exp2f((float)d * lg) : 0.f; Pf[jt >> 1][(jt & 1) * 4 + e] = (h16)(S[e] * f); }
                }
            }
            f32x4 acc[4];
#pragma unroll
            for (int dt = 0; dt < 4; ++dt) {
                acc[dt] = (f32x4){0.f, 0.f, 0.f, 0.f};
#pragma unroll
                for (int s = 0; s < 8; ++s) { const h16x8 A = *(const lh16x8*)(St + (16 * (4 * dh + dt) + c16) * SSB + (32 * s + 8 * g) * 2); acc[dt] = __builtin_amdgcn_mfma_f32_16x16x32_f16(A, Qf[s], acc[dt], 0, 0, 0); }
                acc[dt] = acc[dt] * xi;
            }
#pragma unroll
            for (int ks = 0; ks < 2; ++ks) {
                if (2 * ks <= it) {
#pragma unroll
                    for (int dt = 0; dt < 4; ++dt) {
                        const lch* vp = Vc + (32 * ks + 4 * g + q4) * SVB + (16 * (4 * dh + dt) + 4 * p4) * 2;
                        const h16x8 A = cat8(trrd(vp), trrd(vp + 16 * SVB));
                        acc[dt] = __builtin_amdgcn_mfma_f32_16x16x32_f16(A, Pf[ks], acc[dt], 0, 0, 0);
                    }
                }
            }
#pragma unroll
            for (int dt = 0; dt < 4; ++dt) *(h16x4*)((vg + (size_t)n * 64 * 2048) + (ooff + (unsigned)(16 * dt))) = pack4(acc[dt]);
#pragma unroll
            for (int i = 0; i < 4; ++i) kreg[i] = *(const h16x8*)((kg + (size_t)nn * 64 * 1024) + ko[i]);
#pragma unroll
            for (int i = 0; i < 2; ++i) vreg[i] = *(const h16x8*)((vg + (size_t)nn * 64 * 2048) + vo[i]);
            h16x8 Bv[2];
#pragma unroll
            for (int ks = 0; ks < 2; ++ks) { const lch* vp = Vc + (32 * ks + 8 * g + q4) * SVB + (16 * wid + 4 * p4) * 2; h16x8 zf;
#pragma unroll
                for (int e = 0; e < 8; ++e) zf[e] = (h16)__builtin_amdgcn_exp2f((float)(63 - (32 * ks + 8 * g + e)) * lg);
                Bv[ks] = cat8(trrd(vp), trrd(vp + 4 * SVB)) * zf; }
#pragma unroll
            for (int dkt = 0; dkt < 16; ++dkt) {
                state[dkt] = state[dkt] * gamma64;
#pragma unroll
                for (int ks = 0; ks < 2; ++ks) { const lch* kp = Kc + (32 * ks + 8 * g + q4) * SKB + (16 * dkt + 4 * p4) * 2;
                    const h16x8 A = cat8(trrd(kp), trrd(kp + 4 * SKB)); state[dkt] = __builtin_amdgcn_mfma_f32_16x16x32_f16(A, Bv[ks], state[dkt], 0, 0, 0); }
            }
            __syncthreads();
#pragma unroll
            for (int dkt = 0; dkt < 16; ++dkt) *(lh16x4*)(St + (16 * wid + c16) * SSB + (16 * dkt + 4 * g) * 2) = pack4(state[dkt]);
#pragma unroll
            for (int i = 0; i < 4; ++i) { const int c = tid + NTHREADS * i; *(lh16x8*)(Kc + (c >> 5) * SKB + (c & 31) * 16) = kreg[i]; }
#pragma unroll
            for (int i = 0; i < 2; ++i) { const int c = tid + NTHREADS * i; *(lh16x8*)(Vc + (c >> 4) * SVB + (c & 15) * 16) = vreg[i]; }
            __syncthreads();
        }
    }
}

__device__ __forceinline__ void p9_gnorm(const Params& P, int blk, int nblk, int wv) {
    const int tid = my_tid(wv), wid = tid >> 6, lane = tid & 63;
    unsigned char* ws = opaque_ptr(P.ws);
    h16* RO = (h16*)(ws + WS_R4); const h16* RG = (const h16*)(ws + WS_RG);
    const int gw = blk * NWAVES + wid, ngw = nblk * NWAVES;
    for (int t0 = gw; t0 < T; t0 += 2 * ngw) {
        h16x8 xv[2][4], gv[2][4];
#pragma unroll
        for (int k = 0; k < 2; ++k) { const int t = (t0 + k * ngw < T) ? t0 + k * ngw : t0;
#pragma unroll
            for (int h = 0; h < 4; ++h) { const size_t o = (size_t)t * 2048 + h * 512 + lane * 8; xv[k][h] = *(const h16x8*)(RO + o); gv[k][h] = *(const h16x8*)(RG + o); } }
#pragma unroll
        for (int k = 0; k < 2; ++k) { const int t = t0 + k * ngw;
#pragma unroll
            for (int h = 0; h < 4; ++h) {
                float v[8]; float s = 0.f;
#pragma unroll
                for (int e = 0; e < 8; ++e) { v[e] = (float)xv[k][h][e]; s += v[e]; }
                const float mu = wave_sum_dpp(s) * (1.0f / 512.0f); float q = 0.f;
#pragma unroll
                for (int e = 0; e < 8; ++e) { v[e] -= mu; q += v[e] * v[e]; }
                const float rstd = rsqrtf(wave_sum_dpp(q) * (1.0f / 512.0f) + EPS);
                h16x8 y;
#pragma unroll
                for (int e = 0; e < 8; ++e) y[e] = (h16)(v[e] * rstd * (float)gv[k][h][e]);
                if (t < T) *(h16x8*)(RO + (size_t)t * 2048 + h * 512 + lane * 8) = y;
            } }
    }
}

__device__ __forceinline__ void p12_final(const Params& P, int blk, int nblk, int wv) {
    const int tid = my_tid(wv), wid = tid >> 6, lane = tid & 63;
    unsigned char* ws = opaque_ptr(P.ws);
    const float* sq = (const float*)(ws + WS_SQH) + (size_t)3 * T * 16; const f32x4* g4 = (const f32x4*)P.in[18]; const h16* H4 = (const h16*)(ws + WS_R1);
    const int gw = blk * NWAVES + wid, ngw = nblk * NWAVES;
    for (int r0 = gw; r0 < T; r0 += 4 * ngw) {
        h16x8 hv[4][2]; f32x4 qv[4][4];
#pragma unroll
        for (int k = 0; k < 4; ++k) { const int r = r0 + k * ngw; if (r < T) {
#pragma unroll
            for (int j = 0; j < 2; ++j) hv[k][j] = *(const h16x8*)(H4 + (size_t)r * 1024 + (lane + 64 * j) * 8);
#pragma unroll
            for (int j = 0; j < 4; ++j) qv[k][j] = ((const f32x4*)(sq + (size_t)r * 16))[j]; } }
#pragma unroll
        for (int k = 0; k < 4; ++k) { const int r = r0 + k * ngw; if (r < T) {
            float s = 0.f;
#pragma unroll
            for (int j = 0; j < 4; ++j) s += (qv[k][j][0] + qv[k][j][1]) + (qv[k][j][2] + qv[k][j][3]);
            const float rstd = rsqrtf(s * (1.0f / 1024.0f) + EPS);
            f32x4* orow = (f32x4*)(P.out + (size_t)r * 1024);
#pragma unroll
            for (int j = 0; j < 2; ++j) { const int c4 = (lane + 64 * j) * 2; const f32x4 ga = g4[c4], gb = g4[c4 + 1]; f32x4 a, b2;
#pragma unroll
                for (int e = 0; e < 4; ++e) { a[e] = (float)hv[k][j][e] * rstd * ga[e]; b2[e] = (float)hv[k][j][4 + e] * rstd * gb[e]; }
                orow[c4] = a; orow[c4 + 1] = b2; } } }
    }
}

#define XB_TMO      128
#define XB_XCNT(j)  (256  + 64 * (j))
#define XB_XSUB(j)  (1280 + 64 * (j))
#define XB_XGEN(j)  (2304 + 64 * (j))
#define XB_TOP      3328
#define XB_TOPGEN   3392
#define XCD_BAR_WORDS 3456
#define XB_SPIN_CAP (1u << 18)
__device__ __forceinline__ unsigned xb_ld(unsigned* p)              { return __hip_atomic_load(p, __ATOMIC_RELAXED, __HIP_MEMORY_SCOPE_AGENT); }
__device__ __forceinline__ unsigned xb_add(unsigned* p, unsigned v) { return __hip_atomic_fetch_add(p, v, __ATOMIC_RELAXED, __HIP_MEMORY_SCOPE_AGENT); }
__device__ __forceinline__ unsigned xb_xcc_id() { return (unsigned)__builtin_amdgcn_s_getreg((3 << 11) | 20) & 0xFu; }
#define XB_SPIN(cond, bar) do { unsigned _sp = 0; while (cond) { __builtin_amdgcn_s_sleep(1); \
    if ((++_sp & 255u) == 0u) { if (xb_ld(&(bar)[XB_TMO])) break; if (_sp > XB_SPIN_CAP) { atomicAdd(&(bar)[XB_TMO], 1u); break; } } } } while (0)
typedef volatile __attribute__((address_space(3))) unsigned lvu32;
__device__ __forceinline__ void xcd_barrier_complete(unsigned* bar, unsigned x, unsigned G, unsigned& nloc, unsigned& nx) {
    unsigned sum, cnt, mine, sp = 0u;
    for (;;) {
        sum = 0u; cnt = 0u; mine = 0u;
#pragma unroll
        for (unsigned j = 0; j < 16; ++j) { const unsigned c = xb_ld(&bar[XB_XCNT(j)]); sum += c; cnt += (c > 0u) ? 1u : 0u; mine = (j == x) ? c : mine; }
        if (sum == G) break;
        __builtin_amdgcn_s_sleep(1);
        if ((++sp & 255u) == 0u) { if (xb_ld(&bar[XB_TMO])) break; if (sp > XB_SPIN_CAP) { atomicAdd(&bar[XB_TMO], 1u); break; } }
    }
    nloc = mine > 0u ? mine : 1u; nx = cnt > 0u ? cnt : 1u;
}
__device__ __forceinline__ void xcd_barrier(unsigned* bar_, unsigned x_, lvu32* st, unsigned G, int wv) {
    unsigned x = x_; asm volatile("" : "+s"(x));
    unsigned* bar = opaque_ptr(bar_);
    asm volatile("s_waitcnt vmcnt(0)" ::: "memory");
    __syncthreads();
    if (my_tid(wv) == 0) {
        __builtin_amdgcn_s_waitcnt(0);
        unsigned nloc = st[0], nx = st[1];
        if (nloc == 0u) { xcd_barrier_complete(bar, x, G, nloc, nx); st[0] = nloc; st[1] = nx; }
        const unsigned old = xb_add(&bar[XB_XSUB(x)], 1u);
        const unsigned gen = old / nloc;
        if (old + 1u == (gen + 1u) * nloc) {
            __builtin_amdgcn_fence(__ATOMIC_RELEASE, "agent");
            asm volatile("s_waitcnt vmcnt(0)" ::: "memory");
            const unsigned og = xb_add(&bar[XB_TOP], 1u);
            const unsigned tg = og / nx;
            if (og + 1u == (tg + 1u) * nx) xb_add(&bar[XB_TOPGEN], 1u);
            else XB_SPIN(xb_ld(&bar[XB_TOPGEN]) == tg, bar);
            __builtin_amdgcn_fence(__ATOMIC_ACQUIRE, "agent");
            xb_add(&bar[XB_XGEN(x)], 1u);
            asm volatile("s_waitcnt vmcnt(0)" ::: "memory");
        } else {
            XB_SPIN(xb_ld(&bar[XB_XGEN(x)]) == gen, bar);
            __builtin_amdgcn_fence(__ATOMIC_ACQUIRE, "agent");
            asm volatile("s_waitcnt vmcnt(0)" ::: "memory");
        }
    }
    __syncthreads();
}

__device__ __forceinline__ void run_gemm_job(const Params& P, unsigned char* lds, int ph, int j, int blk, int nblk, int wv) {
    unsigned char* ws = opaque_ptr(P.ws);
    float* SQKV = (float*)(ws + WS_SQKV); float* SQQ = (float*)(ws + WS_SQQ); float* SQH = (float*)(ws + WS_SQH);
    int kind = 0; Gemm g; g.M = T; g.A = nullptr; g.Bt = nullptr; g.lda = g.ldb = g.N = g.K = 0;
    h16 *h0 = nullptr, *h1 = nullptr; const h16* ch0 = nullptr; const h16* ch1 = nullptr; const float* cf0 = nullptr; float* f0 = nullptr; float* f1 = nullptr; int i0 = 0, i1 = 0, i2 = 0, i3 = 0, i4 = 0; float x0 = 0.f;
    if (ph == 1) { kind = 0; g.A = (const h16*)(ws + WS_R1); g.Bt = (const h16*)(ws + WS_WAIN); g.lda = 1024; g.ldb = 1024; g.N = 1792; g.K = 1024; }
    else if (ph == 2) {
        kind = 1;
        if (j == 0) { g.A = (const h16*)(ws + WS_CQX); g.Bt = (const h16*)(ws + WS_WQ); g.lda = 512; g.ldb = 384; g.N = 1536; g.K = 384;
                      cf0 = SQQ; i0 = 8; x0 = 1.0f / 384.0f; h0 = (h16*)(ws + WS_R1); h1 = (h16*)(ws + WS_QIDX); i1 = 1024; i2 = 512; i3 = 1; i4 = 0; }
        else if (j == 1) { g.A = (const h16*)(ws + WS_CKV); g.Bt = (const h16*)(ws + WS_WKV); g.lda = 256; g.ldb = 256; g.N = 2048; g.K = 256;
                      cf0 = SQKV; i0 = 4; x0 = 1.0f / 256.0f; h0 = (h16*)(ws + WS_R2); h1 = (h16*)(ws + WS_R3); i1 = 1024; i2 = 1024; i3 = 1; i4 = 1; }
        else { g.A = (const h16*)(ws + WS_PH0); g.Bt = (const h16*)(ws + WS_WPLE); g.lda = 256; g.ldb = 256; g.N = 1024; g.K = 256;
                      cf0 = nullptr; i0 = 0; x0 = 0.f; h0 = (h16*)(ws + WS_R5); h1 = nullptr; i1 = 1024; i2 = 1024; }
    }
    else if (ph == 5) { kind = 2; g.A = (const h16*)(ws + WS_AO); g.Bt = (const h16*)(ws + WS_WAOUT); g.lda = 1024; g.ldb = 1024; g.N = 1024; g.K = 1024;
                      cf0 = P.in[0]; ch0 = nullptr; h0 = (h16*)(ws + WS_R2); f1 = SQH; }
    else if (ph == 6) { kind = 3; g.A = (const h16*)(ws + WS_R2); g.Bt = (const h16*)(ws + WS_WPG); g.lda = 1024; g.ldb = 1024; g.N = 1024; g.K = 1024;
                      ch1 = (const h16*)(ws + WS_R2); ch0 = (const h16*)(ws + WS_R5); h0 = (h16*)(ws + WS_R3); cf0 = SQH; f1 = SQH + (size_t)T * 16; }
    else if (ph == 7) { kind = 4; g.A = (const h16*)(ws + WS_R3); g.Bt = (const h16*)(ws + WS_WRIN); g.lda = 1024; g.ldb = 1024; g.N = 6144; g.K = 1024; }
    else if (ph == 10) {
        if (j == 0) { kind = 2; g.A = (const h16*)(ws + WS_R4); g.Bt = (const h16*)(ws + WS_WROUT); g.lda = 2048; g.ldb = 2048; g.N = 1024; g.K = 2048;
                      cf0 = nullptr; ch0 = (const h16*)(ws + WS_R3); h0 = (h16*)(ws + WS_R2); f1 = SQH + (size_t)2 * T * 16; }
        else { kind = 1; g.A = (const h16*)(ws + WS_PH1); g.Bt = (const h16*)(ws + WS_WPLE) + (size_t)1024 * 256; g.lda = 256; g.ldb = 256; g.N = 1024; g.K = 256;
                      cf0 = nullptr; i0 = 0; x0 = 0.f; h0 = (h16*)(ws + WS_R1); h1 = nullptr; i1 = 1024; i2 = 1024; }
    }
    else { kind = 5; g.A = (const h16*)(ws + WS_R2); g.Bt = (const h16*)(ws + WS_WPG) + (size_t)1024 * 1024; g.lda = 1024; g.ldb = 1024; g.N = 1024; g.K = 1024;
                      ch1 = (const h16*)(ws + WS_R2); ch0 = (const h16*)(ws + WS_R1); h0 = (h16*)(ws + WS_R1); cf0 = SQH + (size_t)2 * T * 16; f1 = SQH + (size_t)3 * T * 16; }
    switch (kind) {
        case 0: { EpiInA E{(h16*)(ws + WS_CKV), (h16*)(ws + WS_CQX), (h16*)(ws + WS_R4), SQKV, SQQ, nullptr, 0, 0.f}; gemm_run(lds, g, E, blk, nblk, wv); break; }
        case 1: { EpiScale E{cf0, i0, x0, h0, h1, 4, i1, i2, i3, i4}; gemm_run(lds, g, E, blk, nblk, wv); break; }
        case 2: { EpiRes E{cf0, ch0, h0, f1, nullptr, 0, 0.f}; gemm_run(lds, g, E, blk, nblk, wv); break; }
        case 3: { EpiPle E{ch1, ch0, h0, cf0, f1, 16, 1.0f / 1024.0f}; gemm_run(lds, g, E, blk, nblk, wv); break; }
        case 5: { EpiPleFinal E{ch1, ch0, cf0, 16, 1.0f / 1024.0f, P.in[18], P.out, (unsigned*)(SQH + (size_t)3 * T * 16), (unsigned*)(ws + WS_BAR + 16384), (unsigned*)(ws + WS_BAR) + XB_TMO}; gemm_run(lds, g, E, blk, nblk, wv); break; }
        default: { EpiInR E{SQH + (size_t)T * 16, (const f32x2*)(ws + WS_SINCOS), (h16*)(ws + WS_R1), (h16*)(ws + WS_R2), (h16*)(ws + WS_R4), (h16*)(ws + WS_RG), 16, 1.0f / 1024.0f}; gemm_run(lds, g, E, blk, nblk, wv); break; }
    }
}

__global__ void __launch_bounds__(NTHREADS, 2) mk_fwd(Params P_) {
    extern __shared__ __attribute__((aligned(16))) unsigned char lds[];
    cg::grid_group grid = cg::this_grid();
    const int wv = __builtin_amdgcn_readfirstlane((int)(threadIdx.x >> 6));
    lvu32* bst = (lvu32*)(lds + LDS_BYTES - 16);
    unsigned* bar = (unsigned*)(P_.ws + WS_BAR);
    const unsigned xcc = xb_xcc_id();
    if (threadIdx.x == 0) { bst[0] = 0u; bst[1] = 0u; if (P_.ph_hi - P_.ph_lo > 1) (void)xb_add(&bar[XB_XCNT(xcc)], 1u); }
    __syncthreads();
    int dup_cnt = 0; (void)dup_cnt;
    const int blk_k = blockIdx.x, nblk_k = gridDim.x; const int ph_lo = P_.ph_lo, ph_hi = P_.ph_hi;
    for (int ph = ph_lo; ph < ph_hi; ++ph) {
        int blk = blk_k, nblk = nblk_k; asm volatile("" : "+s"(blk), "+s"(nblk));
        const Params& P = P_;
        if (ph == 0) p0_prologue(P, lds, blk, nblk, wv);
        else if (ph == 3) p3_indexer(P, lds, blk, nblk, wv);
        else if (ph == 4) p4_attn(P, lds, blk, nblk, wv);
        else if (ph == 8) p8_retention(P, lds, blk, nblk, wv);
        else if (ph == 9) p9_gnorm(P, blk, nblk, wv);
        else {
            if (ph == 2) p2_kidx(P, blk, nblk, wv);
            const int nj = (ph == 2) ? 3 : (ph == 10) ? 2 : 1;
            for (int j = 0; j < nj; ++j) run_gemm_job(P, lds, ph, j, blk, nblk, wv);
        }
        if (ph + 1 < ph_hi) { if (ph_hi < 0) grid.sync(); else xcd_barrier(bar, xcc, bst, (unsigned)nblk, wv); }
#if MK_DUP_MASK
        if (((MK_DUP_MASK >> ph) & 1) && dup_cnt < MK_DUP_N) { ++dup_cnt; --ph; } else dup_cnt = 0;
#endif
    }
}

#ifndef MK_FUSED
#define MK_FUSED 1
#endif
extern "C" void kernel_launch(void* const* d_in, const int* in_sizes, int n_in, void* d_out, int out_size, void* d_ws, size_t ws_size, hipStream_t stream) {
    static int grid = 0;
    if (grid == 0) {
        if (n_in != 19 || out_size != T * D || ws_size < WS_END) { fprintf(stderr, "kernel_launch: unexpected shapes (n_in %d, out %d, ws %zu)\n", n_in, out_size, ws_size); grid = -1; return; }
        int dev = 0, cus = 0, per_cu = 0;
        hipGetDevice(&dev);
        hipDeviceGetAttribute(&cus, hipDeviceAttributeMultiprocessorCount, dev);
        if (hipFuncSetAttribute((const void*)mk_fwd, hipFuncAttributeMaxDynamicSharedMemorySize, LDS_BYTES) != hipSuccess) { fprintf(stderr, "kernel_launch: hipFuncSetAttribute failed\n"); grid = -1; return; }
        hipOccupancyMaxActiveBlocksPerMultiprocessor(&per_cu, (const void*)mk_fwd, NTHREADS, LDS_BYTES);
        if (per_cu < 1) { fprintf(stderr, "kernel_launch: occupancy query says %d blocks per CU\n", per_cu); grid = -1; return; }
        grid = cus * 1;
    }
    if (grid < 0) return;
    (void)hipMemsetAsync((char*)d_ws + WS_BAR, 0, 16384 + 32768, stream);
    Params P{};
    for (int i = 0; i < 19; ++i) P.in[i] = (const float*)d_in[i];
    P.out = (float*)d_out; P.ws = (unsigned char*)d_ws;
#if MK_FUSED
    P.ph_lo = 0; P.ph_hi = NPH;
    void* args[] = {&P};
    hipError_t e = hipLaunchCooperativeKernel((const void*)mk_fwd, dim3(grid), dim3(NTHREADS), args, LDS_BYTES, stream);
    if (e != hipSuccess) fprintf(stderr, "cooperative launch failed: %s (grid %d)\n", hipGetErrorString(e), grid);
#else
    for (int ph = 0; ph < NPH; ++ph) {
        P.ph_lo = ph; P.ph_hi = ph + 1;
        hipLaunchKernelGGL(mk_fwd, dim3(grid), dim3(NTHREADS), LDS_BYTES, stream, P);
    }
#endif
}
```

```cpp
#include <hip/hip_runtime.h>
#include <hip/hip_cooperative_groups.h>
#include <cstdio>
#include <cstdint>
namespace cg = cooperative_groups;
#ifndef MK_DUP_MASK
#define MK_DUP_MASK 0
#endif
#ifndef MK_P3_REPA
#define MK_P3_REPA 0
#endif
#ifndef MK_P3_REPB
#define MK_P3_REPB 0
#endif
#ifndef MK_EPI_REP
#define MK_EPI_REP 0
#endif
#ifndef MK_DUP_N
#define MK_DUP_N 3
#endif

typedef _Float16 h16;
typedef _Float16 h16x2 __attribute__((ext_vector_type(2)));
typedef _Float16 h16x4 __attribute__((ext_vector_type(4)));
typedef _Float16 h16x8 __attribute__((ext_vector_type(8)));
typedef float f32x2 __attribute__((ext_vector_type(2)));
typedef float f32x4 __attribute__((ext_vector_type(4)));
typedef unsigned u32x4 __attribute__((ext_vector_type(4)));

constexpr int NB = 16, L = 2048, T = NB * L, D = 1024;
constexpr float EPS = 1e-6f;
constexpr int NPH = 12;
constexpr int NTHREADS = 512, NWAVES = 8;
constexpr int LDS_BYTES = 163840;

constexpr size_t MiB = (size_t)1 << 20;
constexpr size_t WS_WAIN = 0 * MiB;
constexpr size_t WS_WQ = 4 * MiB;
constexpr size_t WS_WKV = 6 * MiB;
constexpr size_t WS_WAOUT = 7 * MiB;
constexpr size_t WS_WPG = 9 * MiB;
constexpr size_t WS_WPLE = 13 * MiB;
constexpr size_t WS_WRIN = 14 * MiB;
constexpr size_t WS_WROUT = 26 * MiB;
constexpr size_t WS_SINCOS = 30 * MiB;
constexpr size_t WS_SQKV = 32 * MiB;
constexpr size_t WS_SQQ = 33 * MiB;
constexpr size_t WS_SQH = 34 * MiB;
constexpr size_t WS_KIDXN = 42 * MiB;
constexpr size_t WS_WIDX = 46 * MiB;
constexpr size_t WS_BAR = 47 * MiB;
constexpr size_t WS_PH1 = 48 * MiB;
constexpr size_t WS_R1 = 64 * MiB;
constexpr size_t WS_R2 = 128 * MiB;
constexpr size_t WS_R3 = 192 * MiB;
constexpr size_t WS_R4 = 256 * MiB;
constexpr size_t WS_R5 = 320 * MiB;
constexpr size_t WS_PH0 = 384 * MiB;
constexpr size_t WS_CQX = 400 * MiB;
constexpr size_t WS_CKV = 432 * MiB;
constexpr size_t WS_QIDX = 448 * MiB;
constexpr size_t WS_MASK = 480 * MiB;
constexpr size_t WS_AO = 400 * MiB;
constexpr size_t WS_RG = 384 * MiB;
constexpr size_t WS_END = 512 * MiB;

struct Params { const float* in[19]; float* out; unsigned char* ws; int ph_lo, ph_hi; };

__constant__ float kAngle[128] = {
    1.000000000e+00f, 9.300450087e-01f, 8.649836779e-01f, 8.044736385e-01f, 7.481966019e-01f, 6.958565116e-01f, 6.471778154e-01f, 6.019044518e-01f,
    5.597981811e-01f, 5.206375122e-01f, 4.842162728e-01f, 4.503428936e-01f, 4.188391268e-01f, 3.895392120e-01f, 3.622889817e-01f, 3.369450271e-01f,
    3.133740425e-01f, 2.914519310e-01f, 2.710633874e-01f, 2.521011233e-01f, 2.344653904e-01f, 2.180633694e-01f, 2.028087080e-01f, 1.886212230e-01f,
    1.754262149e-01f, 1.631542742e-01f, 1.517407894e-01f, 1.411257535e-01f, 1.312533021e-01f, 1.220714748e-01f, 1.135319397e-01f, 1.055898219e-01f,
    9.820328653e-02f, 9.133346379e-02f, 8.494423330e-02f, 7.900195569e-02f, 7.347535342e-02f, 6.833537668e-02f, 6.355497986e-02f, 5.910899118e-02f,
    5.497401953e-02f, 5.112830922e-02f, 4.755162448e-02f, 4.422515258e-02f, 4.113136977e-02f, 3.825402260e-02f, 3.557796404e-02f, 3.308910504e-02f,
    3.077435680e-02f, 2.862153389e-02f, 2.661931701e-02f, 2.475716174e-02f, 2.302526683e-02f, 2.141453326e-02f, 1.991648041e-02f, 1.852322184e-02f,
    1.722742990e-02f, 1.602228358e-02f, 1.490144618e-02f, 1.385901403e-02f, 1.288950257e-02f, 1.198781747e-02f, 1.114920899e-02f, 1.036926545e-02f,
    9.643883444e-03f, 8.969245479e-03f, 8.341802284e-03f, 7.758250926e-03f, 7.215522230e-03f, 6.710760761e-03f, 6.241309457e-03f, 5.804697983e-03f,
    5.398627371e-03f, 5.020966288e-03f, 4.669724498e-03f, 4.343053792e-03f, 4.039235413e-03f, 3.756670747e-03f, 3.493872471e-03f, 3.249458736e-03f,
    3.022142686e-03f, 2.810728736e-03f, 2.614103956e-03f, 2.431234345e-03f, 2.261157380e-03f, 2.102978062e-03f, 1.955864020e-03f, 1.819041790e-03f,
    1.691789716e-03f, 1.573440502e-03f, 1.463370281e-03f, 1.361000235e-03f, 1.265791478e-03f, 1.177242957e-03f, 1.094888896e-03f, 1.018295996e-03f,
    9.470609948e-04f, 8.808093844e-04f, 8.191923262e-04f, 7.618857198e-04f, 7.085879333e-04f, 6.590186385e-04f, 6.129170069e-04f, 5.700403708e-04f,
    5.301629426e-04f, 4.930753494e-04f, 4.585822753e-04f, 4.265021416e-04f, 3.966661752e-04f, 3.689173318e-04f, 3.431097430e-04f, 3.191074939e-04f,
    2.967843320e-04f, 2.760227653e-04f, 2.567135962e-04f, 2.387551940e-04f, 2.220530587e-04f, 2.065193403e-04f, 1.920722716e-04f, 1.786358480e-04f,
    1.661392889e-04f, 1.545170089e-04f, 1.437077590e-04f, 1.336546848e-04f, 1.243048755e-04f, 1.156091312e-04f, 1.075216787e-04f, 9.999999747e-05f,
};

__device__ __forceinline__ float wave_sum(float v) {
#pragma unroll
    for (int o = 1; o < 64; o <<= 1) v += __shfl_xor(v, o);
    return v;
}
__device__ __forceinline__ float wave_max(float v) {
#pragma unroll
    for (int o = 1; o < 64; o <<= 1) v = fmaxf(v, __shfl_xor(v, o));
    return v;
}
#define DPP_RED6S(v, F) do { v = F<0x111, 0xf>(v); v = F<0x112, 0xf>(v); v = F<0x114, 0xf>(v); v = F<0x118, 0xf>(v); v = F<0x142, 0xa>(v); v = F<0x143, 0xc>(v); } while (0)
template <int CTRL, int RMASK> __device__ __forceinline__ float fadd_dpp_(float a) { return a + __builtin_bit_cast(float, __builtin_amdgcn_update_dpp(0, __builtin_bit_cast(int, a), CTRL, RMASK, 0xf, false)); }
__device__ __forceinline__ float wave_sum_dpp(float v) { DPP_RED6S(v, fadd_dpp_); return __builtin_bit_cast(float, __builtin_amdgcn_readlane(__builtin_bit_cast(int, v), 63)); }
__device__ __forceinline__ float dot4(f32x4 a) { return (a[0] * a[0] + a[1] * a[1]) + (a[2] * a[2] + a[3] * a[3]); }
__device__ __forceinline__ float fq_sum(float s) {
    { auto rr = __builtin_amdgcn_permlane16_swap(__float_as_uint(s), __float_as_uint(s), false, false); s = __uint_as_float(rr[0]) + __uint_as_float(rr[1]); }
    { auto rr = __builtin_amdgcn_permlane32_swap(__float_as_uint(s), __float_as_uint(s), false, false); s = __uint_as_float(rr[0]) + __uint_as_float(rr[1]); }
    return s;
}
__device__ __forceinline__ h16x8 pack8(f32x4 a, f32x4 b) {
    h16x8 r; r[0] = (h16)a[0]; r[1] = (h16)a[1]; r[2] = (h16)a[2]; r[3] = (h16)a[3]; r[4] = (h16)b[0]; r[5] = (h16)b[1]; r[6] = (h16)b[2]; r[7] = (h16)b[3]; return r;
}
__device__ __forceinline__ h16x4 pack4(f32x4 a) { h16x4 r; r[0] = (h16)a[0]; r[1] = (h16)a[1]; r[2] = (h16)a[2]; r[3] = (h16)a[3]; return r; }
__device__ __forceinline__ float sigmoidf_(float x) { return __builtin_amdgcn_rcpf(1.0f + __builtin_amdgcn_exp2f(-1.4426950408889634f * x)); }
__device__ __forceinline__ float siluf_(float x) { return x * __builtin_amdgcn_rcpf(1.0f + __builtin_amdgcn_exp2f(-1.4426950408889634f * x)); }
#define LDS_FENCE() do { asm volatile("s_waitcnt lgkmcnt(0)" ::: "memory"); } while (0)
__device__ __forceinline__ int my_tid(int wv) { unsigned m = ~0u; asm volatile("" : "+s"(m)); int t = wv * 64 + (int)__builtin_amdgcn_mbcnt_hi(m, __builtin_amdgcn_mbcnt_lo(m, 0u)); asm volatile("" : "+v"(t)); return t; }
template <class Tp> __device__ __forceinline__ Tp* opaque_ptr(Tp* p) { size_t z = 0; asm volatile("" : "+s"(z)); return p + z; }

#define PG8_LAS __attribute__((address_space(3)))
__device__ __forceinline__ constexpr int pg8_stage_bytes() { return 131072; }
struct Unit { int pm, pn; };
struct Gemm { const h16* A; const h16* Bt; int lda, ldb, M, N, K; };
__device__ __forceinline__ int perm32(int rho) { const int n = rho >> 4, i = rho & 15; return 8 * (i >> 2) + 4 * n + (i & 3); }

template <class Epi>
__device__ __forceinline__ void gemm_simple(const Gemm g, const Epi& E, int blk, int nblk, int wv) {
    const int tid = my_tid(wv), wid = __builtin_amdgcn_readfirstlane(tid >> 6), lane = tid & 63, wr = wid >> 2, wc = wid & 3, fr = lane & 15, fq = lane >> 4;
    const int nN = g.N / 256, nU = (g.M / 256) * nN;
    for (int u = blk; u < nU; u += nblk) {
        Unit un; un.pm = u / nN; un.pn = u % nN;
        f32x4 acc[2][2][4][2];
#pragma unroll
        for (int a = 0; a < 2; ++a)
#pragma unroll
            for (int b = 0; b < 2; ++b)
#pragma unroll
                for (int m = 0; m < 4; ++m)
#pragma unroll
                    for (int n = 0; n < 2; ++n) acc[a][b][m][n] = (f32x4){0.f, 0.f, 0.f, 0.f};
        const h16* Ap = g.A + (size_t)(un.pm * 256 + wr * 64 + fr) * g.lda + fq * 8;
        const h16* Bp[2];
#pragma unroll
        for (int n = 0; n < 2; ++n) Bp[n] = g.Bt + (size_t)(un.pn * 256 + wc * 32 + (Epi::PERM ? perm32(16 * n + fr) : 16 * n + fr)) * g.ldb + fq * 8;
        for (int k0 = 0; k0 < g.K; k0 += 32) {
            h16x8 At[2][4], Bt[2][2];
#pragma unroll
            for (int ai = 0; ai < 2; ++ai)
#pragma unroll
                for (int m = 0; m < 4; ++m) At[ai][m] = *(const h16x8*)(Ap + (size_t)(ai * 128 + m * 16) * g.lda + k0);
#pragma unroll
            for (int bj = 0; bj < 2; ++bj)
#pragma unroll
                for (int n = 0; n < 2; ++n) Bt[bj][n] = *(const h16x8*)(Bp[n] + (size_t)(bj * 128) * g.ldb + k0);
#pragma unroll
            for (int ai = 0; ai < 2; ++ai)
#pragma unroll
                for (int bj = 0; bj < 2; ++bj)
#pragma unroll
                    for (int m = 0; m < 4; ++m)
#pragma unroll
                        for (int n = 0; n < 2; ++n) acc[ai][bj][m][n] = __builtin_amdgcn_mfma_f32_16x16x32_f16(Bt[bj][n], At[ai][m], acc[ai][bj][m][n], 0, 0, 0);
        }
        E(acc, un, wr, wc, fr, fq, nullptr);
    }
}

template <class E_> struct epi_fused { template <class X> static constexpr bool g(decltype(X::FUSED_FINAL)*) { return X::FUSED_FINAL; } template <class X> static constexpr bool g(...) { return false; } static constexpr bool v = g<E_>(nullptr); };
namespace pg8 {
constexpr int BM = 256, BK = 64, HALF = 128, HTB = HALF * BK * 2  , STAGE_BYTES = 8 * HTB, NXCD = 8, WGM = 8;
__host__ __device__ __forceinline__ int lds_byte(int r, int c) { const int st = (r >> 4) * 2 + (c >> 5), rr = r & 15, cc = c & 31, ob = rr * 64 + cc * 2; return st * 1024 + (ob ^ (((ob >> 9) & 1) << 5)); }
__host__ __device__ __forceinline__ void stage_rc(int b, int& R, int& C) { const int st = b / 1024, sb = b % 1024, swz = sb ^ (((sb >> 9) & 1) << 5); R = (st >> 1) * 16 + swz / 64; C = (st & 1) * 32 + (swz % 64) / 2; }
struct StaticOrder {
    int nM, nN, nwg, G, c;
    __host__ __device__ void init(int M, int N, int G_, int c_) { nM = M / BM; nN = N / BM; nwg = nM * nN; G = G_; c = c_; }
    __host__ __device__ bool next(int i, Unit& u) const {
        const long Lq = (long)i * G + c; if (Lq >= nwg) return false;
        int wgid = (int)Lq; { const int q = nwg / NXCD, r = nwg % NXCD, xcd = wgid % NXCD, off = wgid / NXCD; wgid = (xcd < r ? xcd * (q + 1) : r * (q + 1) + (xcd - r) * q) + off; }
        const int nig = WGM * nN, gid = wgid / nig, fm = gid * WGM, gsz = (nM - fm) < WGM ? (nM - fm) : WGM;
        u.pm = fm + ((wgid % nig) % gsz); u.pn = (wgid % nig) / gsz; return true;
    }
};
template <class Epi, bool ALIGN_EPI = true>
__device__ __forceinline__ void gemm_phase(PG8_LAS unsigned char* lds, const Gemm g, const StaticOrder& S, const Epi& E, int wv) {
    const int tid = my_tid(wv), wid = __builtin_amdgcn_readfirstlane(tid >> 6), lane = tid & 63, wr = wid >> 2, wc = wid & 3, fr = lane & 15, fq = lane >> 4;
    const int K = g.K, nt = K / BK;
    unsigned voffA[2], voffB[2];
#pragma unroll
    for (int i = 0; i < 2; ++i) { int R, C; stage_rc(tid * 16 + i * 8192, R, C); const int Rb = Epi::PERM ? ((R & ~31) + perm32(R & 31)) : R;
        voffA[i] = (unsigned)(R * g.lda + C) * 2u; voffB[i] = (unsigned)(Rb * g.ldb + C) * 2u; }
    const size_t kstep = (size_t)(BK * 2);
    const size_t hstepA = (size_t)HALF * g.lda * 2, hstepB = (size_t)HALF * g.ldb * 2;
    const size_t tstepA = 2 * hstepA, tstepB = 2 * hstepB;
    const unsigned ldsw = (unsigned)wid * 1024u;
    const int aoff = lds_byte(wr * 64 + fr, fq * 8), boff = lds_byte(wc * 32 + fr, fq * 8);
#define PG8_SA(b, h) (((b) * 2 + (h)) * HTB)
#define PG8_SB(b, h) ((4 + (b) * 2 + (h)) * HTB)
#define PG8_STAGE(bufoff, gbase, voff) do { _Pragma("unroll") for (int _i = 0; _i < 2; ++_i) \
        __builtin_amdgcn_global_load_lds((const unsigned*)((const char*)(gbase) + (voff)[_i]), (PG8_LAS unsigned*)(lds + (bufoff) + ldsw + _i * 8192), 16, 0, 0); } while (0)
#define PG8_LDA(dst, b, h) do { _Pragma("unroll") for (int m = 0; m < 4; ++m) _Pragma("unroll") for (int k = 0; k < 2; ++k) dst[m][k] = *(const PG8_LAS h16x8*)(lds + PG8_SA(b, h) + aoff + m * 2048 + k * 1024); } while (0)
#define PG8_LDB(dst, b, h) do { _Pragma("unroll") for (int n = 0; n < 2; ++n) _Pragma("unroll") for (int k = 0; k < 2; ++k) dst[n][k] = *(const PG8_LAS h16x8*)(lds + PG8_SB(b, h) + boff + n * 2048 + k * 1024); } while (0)
#define PG8_MMA(ai, bj, At, Bt) do { __builtin_amdgcn_s_setprio(1); _Pragma("unroll") for (int m = 0; m < 4; ++m) _Pragma("unroll") for (int n = 0; n < 2; ++n) _Pragma("unroll") for (int k = 0; k < 2; ++k) \
        acc[ai][bj][m][n] = __builtin_amdgcn_mfma_f32_16x16x32_f16(Bt[n][k], At[m][k], acc[ai][bj][m][n], 0, 0, 0); __builtin_amdgcn_s_setprio(0); } while (0)
#define PG8_WAIT_V(n) asm volatile("s_waitcnt vmcnt(" #n ")" ::: "memory")
#define PG8_WAIT_L(n) asm volatile("s_waitcnt lgkmcnt(" #n ")" ::: "memory")
#define PG8_BAR __builtin_amdgcn_s_barrier()
#define PG8_SCHED __builtin_amdgcn_sched_barrier(0)
    Unit cur, nxt; int ui = 0;
    if (!S.next(0, cur)) return;
    PG8_LAS float* rtab = (PG8_LAS float*)(lds + STAGE_BYTES);
#define PG8_FILL(U, PAR) do { const int tf_ = my_tid(wv); if (E.sqp != nullptr && tf_ < 256) { const size_t r_ = (size_t)(U).pm * 256 + tf_; float s_ = 0.f; \
        for (int j_ = 0; j_ < E.sqn; j_ += 4) { const f32x4 q_ = *(const f32x4*)(E.sqp + r_ * E.sqn + j_); s_ += (q_[0] + q_[1]) + (q_[2] + q_[3]); } \
        rtab[(PAR) * 256 + tf_] = rsqrtf(s_ * E.sqi + EPS); } } while (0)
    PG8_FILL(cur, 0);
    f32x4 acc[2][2][4][2];
#pragma unroll
    for (int a = 0; a < 2; ++a)
#pragma unroll
        for (int b = 0; b < 2; ++b)
#pragma unroll
            for (int m = 0; m < 4; ++m)
#pragma unroll
                for (int n = 0; n < 2; ++n) acc[a][b][m][n] = (f32x4){0.f, 0.f, 0.f, 0.f};
    h16x8 At[4][2], B0[2][2], B1[2][2];
    const char* cA = (const char*)g.A + (size_t)cur.pm * tstepA; const char* cB = (const char*)g.Bt + (size_t)cur.pn * tstepB;
    PG8_STAGE(PG8_SB(0, 0), cB, voffB); PG8_STAGE(PG8_SB(0, 1), cB + hstepB, voffB); PG8_STAGE(PG8_SA(0, 0), cA, voffA); PG8_STAGE(PG8_SA(0, 1), cA + hstepA, voffA);
    if (wr == 1) PG8_BAR;
    PG8_WAIT_V(2); PG8_BAR;
    PG8_STAGE(PG8_SB(1, 0), cB + kstep, voffB); PG8_STAGE(PG8_SA(1, 0), cA + kstep, voffA); PG8_STAGE(PG8_SB(1, 1), cB + hstepB + kstep, voffB);
    PG8_WAIT_V(6); PG8_BAR;
    for (;;) {
        const bool has_next = S.next(ui + 1, nxt);
        const char* nA = has_next ? (const char*)g.A + (size_t)nxt.pm * tstepA : cA; const char* nB = has_next ? (const char*)g.Bt + (size_t)nxt.pn * tstepB : cB;
        for (int t = 0; t < nt; t += 2) {
            const bool last = (t == nt - 2);
            const char* a1 = cA + (size_t)(t + 1) * kstep;
            const char* a2 = last ? nA : cA + (size_t)(t + 2) * kstep; const char* b2 = last ? nB : cB + (size_t)(t + 2) * kstep;
            const char* a3 = a2 + kstep; const char* b3 = b2 + kstep;
            PG8_LDB(B0, 0, 0); PG8_LDB(B1, 0, 1); PG8_SCHED; PG8_LDA(At, 0, 0); PG8_STAGE(PG8_SA(1, 1), a1 + hstepA, voffA);
            PG8_WAIT_V(8); PG8_WAIT_L(0); PG8_BAR; PG8_MMA(0, 0, At, B0); PG8_MMA(0, 1, At, B1); PG8_BAR; PG8_SCHED;
            PG8_LDA(At, 0, 1); PG8_STAGE(PG8_SB(0, 0), b2, voffB); PG8_STAGE(PG8_SB(0, 1), b2 + hstepB, voffB); PG8_STAGE(PG8_SA(0, 0), a2, voffA);
            PG8_WAIT_V(8); PG8_WAIT_L(0); PG8_BAR; PG8_MMA(1, 0, At, B0); PG8_MMA(1, 1, At, B1); PG8_BAR; PG8_SCHED;
            PG8_LDB(B0, 1, 0); PG8_LDB(B1, 1, 1); PG8_SCHED; PG8_LDA(At, 1, 0); PG8_STAGE(PG8_SA(0, 1), a2 + hstepA, voffA);
            PG8_WAIT_V(8); PG8_WAIT_L(0); PG8_BAR; PG8_MMA(0, 0, At, B0); PG8_MMA(0, 1, At, B1); PG8_BAR; PG8_SCHED;
            PG8_LDA(At, 1, 1); PG8_STAGE(PG8_SB(1, 0), b3, voffB); PG8_STAGE(PG8_SB(1, 1), b3 + hstepB, voffB); PG8_STAGE(PG8_SA(1, 0), a3, voffA);
            PG8_WAIT_V(8); PG8_WAIT_L(0); PG8_BAR; PG8_MMA(1, 0, At, B0); PG8_MMA(1, 1, At, B1); PG8_BAR; PG8_SCHED;
        }
        if constexpr (ALIGN_EPI) { if (wr == 0) PG8_BAR; }
        { const int te_ = my_tid(wv), le_ = te_ & 63;
          if constexpr (epi_fused<Epi>::v) E.final(acc, cur, wr, wc, le_ & 15, le_ >> 4, rtab + (ui & 1) * 256, lds, te_); else E(acc, cur, wr, wc, le_ & 15, le_ >> 4, rtab + (ui & 1) * 256); }
        if (has_next) PG8_FILL(nxt, (ui + 1) & 1);
        if (!has_next) break;
#pragma unroll
        for (int a = 0; a < 2; ++a)
#pragma unroll
            for (int b = 0; b < 2; ++b)
#pragma unroll
                for (int m = 0; m < 4; ++m)
#pragma unroll
                    for (int n = 0; n < 2; ++n) acc[a][b][m][n] = (f32x4){0.f, 0.f, 0.f, 0.f};
        cur = nxt; cA = nA; cB = nB; ++ui;
        if constexpr (ALIGN_EPI) { if (wr == 1) PG8_BAR; }
    }
    PG8_WAIT_V(0);
    if constexpr (!ALIGN_EPI) { if (wr == 0) PG8_BAR; }
    PG8_BAR;
#undef PG8_FILL
#undef PG8_SA
#undef PG8_SB
#undef PG8_STAGE
#undef PG8_LDA
#undef PG8_LDB
#undef PG8_MMA
#undef PG8_WAIT_V
#undef PG8_WAIT_L
#undef PG8_BAR
#undef PG8_SCHED
}
}
template <class Epi>
__device__ __forceinline__ void gemm_run(unsigned char* lds, const Gemm g, const Epi& E, int blk, int nblk, int wv) {
    pg8::StaticOrder S; S.init(g.M, g.N, nblk, blk);
    pg8::gemm_phase<Epi, true>((PG8_LAS unsigned char*)lds, g, S, E, wv);
}

struct EpiInA {
    static constexpr bool PERM = true;
    h16* ckv; h16* cqx; h16* sg; float* sqkv; float* sqq; const float* sqp; int sqn; float sqi;
    __device__ __forceinline__ void operator()(const f32x4 (&acc)[2][2][4][2], const Unit& u, int wr, int wc, int fr, int fq, const PG8_LAS float* rtab) const {
        asm volatile("" : "+v"(fr), "+v"(fq));
#pragma unroll
        for (int ai = 0; ai < 2; ++ai)
#pragma unroll
            for (int m = 0; m < 4; ++m) {
                const size_t r = (size_t)u.pm * 256 + ai * 128 + wr * 64 + m * 16 + fr;
                float ss = 0.f;
#pragma unroll
                for (int bj = 0; bj < 2; ++bj) {
                    const int c0 = bj * 128 + wc * 32 + 8 * fq;
                    f32x4 v0 = acc[ai][bj][m][0], v1 = acc[ai][bj][m][1];
                    if (u.pn == 0) { *(h16x8*)(ckv + r * 256 + c0) = pack8(v0, v1); ss += dot4(v0) + dot4(v1); }
                    else if (u.pn <= 2) { const int cq = (u.pn - 1) * 256 + c0; *(h16x8*)(cqx + r * 512 + cq) = pack8(v0, v1); if (cq < 384) ss += dot4(v0) + dot4(v1); }
                    else {
#pragma unroll
                        for (int e = 0; e < 4; ++e) { v0[e] = siluf_(v0[e]); v1[e] = siluf_(v1[e]); }
                        *(h16x8*)(sg + r * 1024 + (u.pn - 3) * 256 + c0) = pack8(v0, v1);
                    }
                }
                if (u.pn <= 2) {
                    ss = fq_sum(ss);
                    if (fq == 0) { if (u.pn == 0) sqkv[r * 4 + wc] = ss; else sqq[r * 8 + (u.pn - 1) * 4 + wc] = ss; }
                }
            }
    }
};
__device__ __forceinline__ unsigned cvtpk_bf16(float lo, float hi) { unsigned r; asm volatile("v_cvt_pk_bf16_f32 %0, %1, %2" : "=v"(r) : "v"(lo), "v"(hi)); return r; }
struct EpiScale {
    static constexpr bool PERM = true;
    const float* sqp; int sqn; float sqi; h16* d0; h16* d1; int split, ld0, ld1, bf0, bf1;
    __device__ __forceinline__ void operator()(const f32x4 (&acc)[2][2][4][2], const Unit& u, int wr, int wc, int fr, int fq, const PG8_LAS float* rtab) const {
        asm volatile("" : "+v"(fr), "+v"(fq));
#pragma unroll
        for (int ai = 0; ai < 2; ++ai)
#pragma unroll
            for (int m = 0; m < 4; ++m) {
                const size_t r = (size_t)u.pm * 256 + ai * 128 + wr * 64 + m * 16 + fr;
                float rs = 1.f;
                if (sqp) rs = rtab[ai * 128 + wr * 64 + m * 16 + fr];
#pragma unroll
                for (int bj = 0; bj < 2; ++bj) {
                    const int c0 = bj * 128 + wc * 32 + 8 * fq;
                    const f32x4 v0 = acc[ai][bj][m][0] * rs, v1 = acc[ai][bj][m][1] * rs;
                    const bool first = u.pn < split;
                    h16* dst = first ? d0 + r * ld0 + u.pn * 256 + c0 : d1 + r * ld1 + (u.pn - split) * 256 + c0;
                    if (first ? bf0 : bf1) { u32x4 w; w[0] = cvtpk_bf16(v0[0], v0[1]); w[1] = cvtpk_bf16(v0[2], v0[3]); w[2] = cvtpk_bf16(v1[0], v1[1]); w[3] = cvtpk_bf16(v1[2], v1[3]); *(u32x4*)dst = w; }
                    else *(h16x8*)dst = pack8(v0, v1);
                }
            }
    }
};
struct EpiRes {
    static constexpr bool PERM = true;
    const float* basef; const h16* baseh; h16* HH; float* sq; const float* sqp; int sqn; float sqi;
    __device__ __forceinline__ void operator()(const f32x4 (&acc)[2][2][4][2], const Unit& u, int wr, int wc, int fr, int fq, const PG8_LAS float* rtab) const {
        asm volatile("" : "+v"(fr), "+v"(fq));
#pragma unroll
        for (int ai = 0; ai < 2; ++ai)
#pragma unroll
            for (int m = 0; m < 4; ++m) {
                const size_t r = (size_t)u.pm * 256 + ai * 128 + wr * 64 + m * 16 + fr;
                float ss = 0.f;
#pragma unroll
                for (int bj = 0; bj < 2; ++bj) {
                    const size_t o = r * 1024 + u.pn * 256 + bj * 128 + wc * 32 + 8 * fq;
                    f32x4 h0, h1;
                    if (basef) { h0 = *(const f32x4*)(basef + o); h1 = *(const f32x4*)(basef + o + 4); }
                    else { const h16x8 b = *(const h16x8*)(baseh + o); h0 = (f32x4){(float)b[0], (float)b[1], (float)b[2], (float)b[3]}; h1 = (f32x4){(float)b[4], (float)b[5], (float)b[6], (float)b[7]}; }
                    h0 = h0 + acc[ai][bj][m][0]; h1 = h1 + acc[ai][bj][m][1];
                    *(h16x8*)(HH + o) = pack8(h0, h1); ss += dot4(h0) + dot4(h1);
                }
                ss = fq_sum(ss);
                if (fq == 0) sq[r * 16 + u.pn * 4 + wc] = ss;
            }
    }
};
struct EpiPle {
    static constexpr bool PERM = true;
    const h16* Hin; const h16* U; h16* Hout; const float* sqp; float* sqout; int sqn; float sqi;
    __device__ __forceinline__ void operator()(const f32x4 (&acc)[2][2][4][2], const Unit& u, int wr, int wc, int fr, int fq, const PG8_LAS float* rtab) const {
        asm volatile("" : "+v"(fr), "+v"(fq));
#pragma unroll
        for (int ai = 0; ai < 2; ++ai)
#pragma unroll
            for (int m = 0; m < 4; ++m) {
                const size_t r = (size_t)u.pm * 256 + ai * 128 + wr * 64 + m * 16 + fr;
                const float rs = rtab[ai * 128 + wr * 64 + m * 16 + fr];
                float ss = 0.f;
#pragma unroll
                for (int bj = 0; bj < 2; ++bj) {
                    const size_t o = r * 1024 + u.pn * 256 + bj * 128 + wc * 32 + 8 * fq;
                    const h16x8 uu = *(const h16x8*)(U + o); const h16x8 hh = *(const h16x8*)(Hin + o);
                    const f32x4 a0 = acc[ai][bj][m][0] * rs, a1 = acc[ai][bj][m][1] * rs; f32x4 h0, h1;
#pragma unroll
                    for (int e = 0; e < 4; ++e) { h0[e] = (float)hh[e] + (float)uu[e] * sigmoidf_(a0[e]); h1[e] = (float)hh[4 + e] + (float)uu[4 + e] * sigmoidf_(a1[e]); }
                    *(h16x8*)(Hout + o) = pack8(h0, h1); ss += dot4(h0) + dot4(h1);
                }
                ss = fq_sum(ss);
                if (fq == 0) sqout[r * 16 + u.pn * 4 + wc] = ss;
            }
    }
};
struct EpiPleFinal {
    static constexpr bool PERM = true, FUSED_FINAL = true;
    const h16* Hin; const h16* U; const float* sqp; int sqn; float sqi; const float* gfin; float* out; unsigned* xslot; unsigned* pcnt; unsigned* tmo;
    __device__ __forceinline__ void final(f32x4 (&acc)[2][2][4][2], const Unit& u, int wr, int wc, int fr, int fq, const PG8_LAS float* rtab, PG8_LAS unsigned char* lds, int tid) const {
        PG8_LAS float* Pt = (PG8_LAS float*)(lds + pg8_stage_bytes() + 2048);
        PG8_LAS float* St = Pt + 1024;
        const int wid = tid >> 6, lane = tid & 63;
        asm volatile("" : "+v"(fr), "+v"(fq));
#pragma unroll
        for (int ai = 0; ai < 2; ++ai)
#pragma unroll
            for (int m = 0; m < 4; ++m) {
                const int rl = ai * 128 + wr * 64 + m * 16 + fr; const size_t r = (size_t)u.pm * 256 + rl;
                const float rs = rtab[rl]; float ss = 0.f;
#pragma unroll
                for (int bj = 0; bj < 2; ++bj) {
                    const size_t o = r * 1024 + u.pn * 256 + bj * 128 + wc * 32 + 8 * fq;
                    const h16x8 uu = *(const h16x8*)(U + o); const h16x8 hh = *(const h16x8*)(Hin + o);
                    const f32x4 a0 = acc[ai][bj][m][0] * rs, a1 = acc[ai][bj][m][1] * rs; f32x4 h0, h1;
#pragma unroll
                    for (int e = 0; e < 4; ++e) { h0[e] = (float)hh[e] + (float)uu[e] * sigmoidf_(a0[e]); h1[e] = (float)hh[4 + e] + (float)uu[4 + e] * sigmoidf_(a1[e]); }
                    acc[ai][bj][m][0] = h0; acc[ai][bj][m][1] = h1; ss += dot4(h0) + dot4(h1);
                }
                ss = fq_sum(ss);
                if (fq == 0) Pt[rl * 4 + wc] = ss;
                asm volatile("" : "+v"(acc[ai][0][m][0]), "+v"(acc[ai][0][m][1]), "+v"(acc[ai][1][m][0]), "+v"(acc[ai][1][m][1]) :: "memory");
            }
        asm volatile("s_waitcnt lgkmcnt(0)" ::: "memory"); __builtin_amdgcn_s_barrier(); asm volatile("" ::: "memory");
        if (tid < 256) {
            const f32x4 p = *(const PG8_LAS f32x4*)(Pt + tid * 4);
            __hip_atomic_store(xslot + ((size_t)u.pm * 256 + tid) * 4 + u.pn, __float_as_uint((p[0] + p[1]) + (p[2] + p[3])), __ATOMIC_RELAXED, __HIP_MEMORY_SCOPE_AGENT);
            asm volatile("s_waitcnt vmcnt(0)" ::: "memory");
            if (lane == 0) __hip_atomic_fetch_add(pcnt + 64 * u.pm, 1u, __ATOMIC_RELAXED, __HIP_MEMORY_SCOPE_AGENT);
        }
        if (wid == 0) {
            unsigned sp = 0u;
            while (__hip_atomic_load(pcnt + 64 * u.pm, __ATOMIC_RELAXED, __HIP_MEMORY_SCOPE_AGENT) < 16u) {
                __builtin_amdgcn_s_sleep(2);
                if (++sp > (1u << 22)) { if (lane == 0) __hip_atomic_store(tmo, 1u, __ATOMIC_RELAXED, __HIP_MEMORY_SCOPE_AGENT); break; }
            }
            __builtin_amdgcn_fence(__ATOMIC_ACQUIRE, "agent");
        }
        asm volatile("s_waitcnt vmcnt(0) lgkmcnt(0)" ::: "memory"); __builtin_amdgcn_s_barrier(); asm volatile("" ::: "memory");
        if (tid < 256) {
            const unsigned* sl = xslot + ((size_t)u.pm * 256 + tid) * 4; float s = 0.f;
#pragma unroll
            for (int t = 0; t < 4; ++t) s += __uint_as_float(__hip_atomic_load(sl + t, __ATOMIC_RELAXED, __HIP_MEMORY_SCOPE_AGENT));
            St[tid] = rsqrtf(s * (1.0f / 1024.0f) + EPS);
        }
        asm volatile("s_waitcnt vmcnt(0) lgkmcnt(0)" ::: "memory"); __builtin_amdgcn_s_barrier(); asm volatile("" ::: "memory");
#pragma unroll
        for (int ai = 0; ai < 2; ++ai)
#pragma unroll
            for (int m = 0; m < 4; ++m) {
                const int rl = ai * 128 + wr * 64 + m * 16 + fr; const size_t r = (size_t)u.pm * 256 + rl;
                const float rr = St[rl];
#pragma unroll
                for (int bj = 0; bj < 2; ++bj) {
                    const int c = u.pn * 256 + bj * 128 + wc * 32 + 8 * fq;
                    const f32x4 g0 = *(const f32x4*)(gfin + c), g1 = *(const f32x4*)(gfin + c + 4);
                    *(f32x4*)(out + r * 1024 + c) = acc[ai][bj][m][0] * rr * g0; *(f32x4*)(out + r * 1024 + c + 4) = acc[ai][bj][m][1] * rr * g1;
                }
            }
    }
};
struct EpiInR {
    static constexpr bool PERM = true;
    const float* sqp; const f32x2* sincos; h16* rq; h16* rk; h16* rv; h16* rg; int sqn; float sqi;
    __device__ __forceinline__ void operator()(const f32x4 (&acc)[2][2][4][2], const Unit& u, int wr, int wc, int fr, int fq, const PG8_LAS float* rtab) const {
        asm volatile("" : "+v"(fr), "+v"(fq));
#pragma unroll
        for (int ai = 0; ai < 2; ++ai)
#pragma unroll
            for (int m = 0; m < 4; ++m) {
                const size_t r = (size_t)u.pm * 256 + ai * 128 + wr * 64 + m * 16 + fr;
                const float rs = rtab[ai * 128 + wr * 64 + m * 16 + fr];
                const int pos = (int)(r & (L - 1));
#pragma unroll
                for (int bj = 0; bj < 2; ++bj) {
                    const int c0 = bj * 128 + wc * 32 + 8 * fq;
                    f32x4 v0 = acc[ai][bj][m][0] * rs, v1 = acc[ai][bj][m][1] * rs;
                    if (u.pn < 8) {
                        const f32x2* sc = sincos + (size_t)pos * 128 + (c0 >> 1);
                        const f32x2 s0 = sc[0], s1 = sc[1], s2 = sc[2], s3 = sc[3];
                        f32x4 w0, w1;
                        w0[0] = v0[0] * s0[1] - v0[1] * s0[0]; w0[1] = v0[1] * s0[1] + v0[0] * s0[0];
                        w0[2] = v0[2] * s1[1] - v0[3] * s1[0]; w0[3] = v0[3] * s1[1] + v0[2] * s1[0];
                        w1[0] = v1[0] * s2[1] - v1[1] * s2[0]; w1[1] = v1[1] * s2[1] + v1[0] * s2[0];
                        w1[2] = v1[2] * s3[1] - v1[3] * s3[0]; w1[3] = v1[3] * s3[1] + v1[2] * s3[0];
                        h16* dst = (u.pn < 4) ? rq + r * 1024 + u.pn * 256 + c0 : rk + r * 1024 + (u.pn - 4) * 256 + c0;
                        *(h16x8*)dst = pack8(w0, w1);
                    } else if (u.pn < 16) {
                        *(h16x8*)(rv + r * 2048 + (u.pn - 8) * 256 + c0) = pack8(v0, v1);
                    } else {
#pragma unroll
                        for (int e = 0; e < 4; ++e) { v0[e] = siluf_(v0[e]); v1[e] = siluf_(v1[e]); }
                        *(h16x8*)(rg + r * 2048 + (u.pn - 16) * 256 + c0) = pack8(v0, v1);
                    }
                }
            }
    }
};

template <int MODE>
__device__ __forceinline__ void tr_item(const float* __restrict__ W, int K, int N, h16* Wt, int ld, int row_off, const float* ks, float scale, float* scr, int item, int lane) {
    const int nbn = (N + 31) >> 5, kb = item / nbn, nb = item % nbn, k0 = kb * 64, n0 = nb * 32;
    const int n4 = n0 + (lane & 7) * 4;
    f32x4 wv[8];
#pragma unroll
    for (int i = 0; i < 8; ++i) { const int kk = 8 * i + (lane >> 3); wv[i] = (n4 < N) ? *(const f32x4*)(W + (size_t)(k0 + kk) * N + n4) : (f32x4){0.f, 0.f, 0.f, 0.f}; }
#pragma unroll
    for (int i = 0; i < 8; ++i) { const int kk = 8 * i + (lane >> 3); const float kf = ks ? ks[k0 + kk] : 1.f;
#pragma unroll
        for (int e = 0; e < 4; ++e) scr[kk * 33 + (lane & 7) * 4 + e] = wv[i][e] * kf; }
    LDS_FENCE();
    const int c = lane & 7;
#pragma unroll
    for (int j = 0; j < 4; ++j) {
        const int nl = (lane >> 3) + 8 * j, n = n0 + nl;
        if (n < N) {
            int row = n; float sc = scale;
            if (MODE == 1) row = (n < 384) ? 256 + n : (n < 640) ? n - 384 : (n < 712) ? n : n + 56;
            if (MODE == 2 && n >= 1024 && n < 2048) sc *= 0.0625f;
            const float* s = scr + (8 * c) * 33 + nl;
            h16x8 o;
#pragma unroll
            for (int e = 0; e < 8; ++e) o[e] = (h16)(s[e * 33] * sc);
            *(h16x8*)(Wt + (size_t)(row_off + row) * ld + k0 + 8 * c) = o;
        }
    }
    LDS_FENCE();
}

__device__ __forceinline__ void p0_prologue(const Params& P, unsigned char* lds, int blk, int nblk, int wv) {
    const int tid = my_tid(wv), wid = __builtin_amdgcn_readfirstlane(tid >> 6), lane = tid & 63;
    float* scr = (float*)lds + wid * (64 * 33);
    const int gw = blk * NWAVES + wid, ngw = nblk * NWAVES;
    unsigned char* ws = opaque_ptr(P.ws);
    h16* WAIN = (h16*)(ws + WS_WAIN); h16* WQ = (h16*)(ws + WS_WQ); h16* WKV = (h16*)(ws + WS_WKV); h16* WAOUT = (h16*)(ws + WS_WAOUT);
    h16* WPG = (h16*)(ws + WS_WPG); h16* WPLE = (h16*)(ws + WS_WPLE); h16* WRIN = (h16*)(ws + WS_WRIN); h16* WROUT = (h16*)(ws + WS_WROUT);
    const float QSCALE = 0.08838834764831845f * 1.4426950408889634f;
    constexpr int I1 = 16 * 55, I2 = 6 * 32, I3 = 6 * 16, I4 = 8 * 16, I5 = 8 * 16, I6 = 16 * 32, I7 = 2 * 16 * 32, I8 = 2 * 4 * 32, I9 = 16 * 192, I10 = 32 * 32;
    constexpr int NIT = I1 + I2 + I3 + I4 + I5 + I6 + I7 + I8 + I9 + I10;
    for (int it = gw; it < NIT; it += ngw) {
        int r = it;
        if (r < I1) { tr_item<1>(P.in[3], 1024, 1736, WAIN, 1024, 0, nullptr, 1.f, scr, r, lane); continue; } r -= I1;
        if (r < I2) { tr_item<0>(P.in[6], 384, 1024, WQ, 384, 0, P.in[4], QSCALE, scr, r, lane); continue; } r -= I2;
        if (r < I3) { tr_item<0>(P.in[7], 384, 512, WQ, 384, 1024, P.in[4], 1.f, scr, r, lane); continue; } r -= I3;
        if (r < I4) { const int h = r / 16; tr_item<0>(P.in[10] + (size_t)h * 256 * 128, 256, 128, WKV, 256, h * 128, P.in[5], 1.f, scr, r % 16, lane); continue; } r -= I4;
        if (r < I5) { const int h = r / 16; tr_item<0>(P.in[11] + (size_t)h * 256 * 128, 256, 128, WKV, 256, 1024 + h * 128, P.in[5], 1.f, scr, r % 16, lane); continue; } r -= I5;
        if (r < I6) { tr_item<0>(P.in[12], 1024, 1024, WAOUT, 1024, 0, nullptr, 1.f, scr, r, lane); continue; } r -= I6;
        if (r < I7) { const int i = r / 512; tr_item<0>(P.in[15] + (size_t)i * 1024 * 1024, 1024, 1024, WPG + (size_t)i * 1024 * 1024, 1024, 0, P.in[16] + i * 1024, 1.f, scr, r % 512, lane); continue; } r -= I7;
        if (r < I8) { const int i = r / 128; tr_item<0>(P.in[17] + (size_t)i * 256 * 1024, 256, 1024, WPLE + (size_t)i * 1024 * 256, 256, 0, nullptr, 1.f, scr, r % 128, lane); continue; } r -= I8;
        if (r < I9) { tr_item<2>(P.in[13], 1024, 6144, WRIN, 1024, 0, P.in[2] + 1024, 1.f, scr, r, lane); continue; } r -= I9;
        tr_item<0>(P.in[14], 2048, 1024, WROUT, 2048, 0, nullptr, 1.f, scr, r, lane);
    }
    const int gt = blk * NTHREADS + tid, ngt = nblk * NTHREADS;
    { unsigned zz = 0u; asm volatile("" : "+v"(zz));
      for (int i = gt; i < 56 * 1024 / 8; i += ngt) ((u32x4*)(WAIN + 712 * 1024))[i] = (u32x4){zz, zz, zz, zz}; }
    {
        const float* x = P.in[0]; const f32x4* g4 = (const f32x4*)P.in[2]; h16* XN0 = (h16*)(ws + WS_R1);
        f32x4 gv[4];
#pragma unroll
        for (int j = 0; j < 4; ++j) gv[j] = g4[lane + 64 * j];
        for (int r0 = gw; r0 < T; r0 += 4 * ngw) {
            f32x4 v[4][4];
#pragma unroll
            for (int k = 0; k < 4; ++k) { const int r = (r0 + k * ngw < T) ? r0 + k * ngw : r0; const f32x4* xr = (const f32x4*)(x + (size_t)r * 1024) + lane;
#pragma unroll
                for (int j = 0; j < 4; ++j) v[k][j] = xr[64 * j]; }
#pragma unroll
            for (int k = 0; k < 4; ++k) { const int r = r0 + k * ngw; float s = 0.f;
#pragma unroll
                for (int j = 0; j < 4; ++j) s += dot4(v[k][j]);
                const float rstd = rsqrtf(wave_sum_dpp(s) * (1.0f / 1024.0f) + EPS);
                if (r < T) {
#pragma unroll
                    for (int j = 0; j < 4; ++j) { const f32x4 o = v[k][j] * rstd * gv[j]; *(h16x4*)(XN0 + (size_t)r * 1024 + (lane + 64 * j) * 4) = pack4(o); } } }
        }
    }
    {
        const f32x4* p4 = (const f32x4*)P.in[1]; h16* PH0 = (h16*)(ws + WS_PH0); h16* PH1 = (h16*)(ws + WS_PH1);
        const int nv = T * 256 / 8;
        for (int i0_ = gt; i0_ < 2 * nv; i0_ += 4 * ngt) {
            f32x4 a[4], b2[4];
#pragma unroll
            for (int k = 0; k < 4; ++k) { const int i = (i0_ + k * ngt < 2 * nv) ? i0_ + k * ngt : i0_; a[k] = p4[2 * (size_t)i]; b2[k] = p4[2 * (size_t)i + 1]; }
#pragma unroll
            for (int k = 0; k < 4; ++k) { const int i = i0_ + k * ngt; if (i < 2 * nv) { h16* dst = (i < nv) ? PH0 + (size_t)i * 8 : PH1 + (size_t)(i - nv) * 8; *(h16x8*)dst = pack8(a[k], b2[k]); } }
        }
    }
    {
        f32x2* SC = (f32x2*)(ws + WS_SINCOS);
        for (int i = gt; i < L * 128; i += ngt) {
            const int pos = i >> 7, fi = i & 127;
            const float th = (float)pos * kAngle[fi];
            double rev = (double)th * 0.15915494309189535; rev -= __builtin_rint(rev);
            const float r = (float)(rev * 6.283185307179586), r2 = r * r;
            float sn = 1.9572941e-20f;
            sn = sn * r2 - 8.2206352e-18f;
            sn = sn * r2 + 2.8114573e-15f;
            sn = sn * r2 - 7.6471637e-13f;
            sn = sn * r2 + 1.6059044e-10f;
            sn = sn * r2 - 2.5052108e-8f;
            sn = sn * r2 + 2.7557319e-6f;
            sn = sn * r2 - 1.9841270e-4f;
            sn = sn * r2 + 8.3333333e-3f;
            sn = sn * r2 - 1.6666667e-1f;
            sn = sn * r2 + 1.0f;
            sn = sn * r;
            float cs = 4.1103176e-19f;
            cs = cs * r2 - 1.5619207e-16f;
            cs = cs * r2 + 4.7794773e-14f;
            cs = cs * r2 - 1.1470746e-11f;
            cs = cs * r2 + 2.0876757e-9f;
            cs = cs * r2 - 2.7557319e-7f;
            cs = cs * r2 + 2.4801587e-5f;
            cs = cs * r2 - 1.3888889e-3f;
            cs = cs * r2 + 4.1666667e-2f;
            cs = cs * r2 - 0.5f;
            cs = cs * r2 + 1.0f;
            SC[i] = (f32x2){sn, cs};
        }
    }
}

__device__ __forceinline__ void p2_kidx(const Params& P, int blk, int nblk, int wv) {
    const h16* CQX = (const h16*)(P.ws + WS_CQX); h16* KIDXN = (h16*)(P.ws + WS_KIDXN); float* WIDX = (float*)(P.ws + WS_WIDX);
    const float* g = P.in[8]; const float* bb = P.in[9];
    for (int r = blk * NTHREADS + my_tid(wv); r < T; r += nblk * NTHREADS) {
        float v[64]; float s = 0.f;
#pragma unroll
        for (int c = 0; c < 8; ++c) { const h16x8 k = *(const h16x8*)(CQX + (size_t)r * 512 + 384 + c * 8);
#pragma unroll
            for (int e = 0; e < 8; ++e) { v[c * 8 + e] = (float)k[e]; s += v[c * 8 + e]; } }
        const float mu = s * (1.0f / 64.0f); float q = 0.f;
#pragma unroll
        for (int i = 0; i < 64; ++i) { v[i] -= mu; q += v[i] * v[i]; }
        const float rstd = rsqrtf(q * (1.0f / 64.0f) + EPS);
#pragma unroll
        for (int c = 0; c < 8; ++c) { h16x8 o;
#pragma unroll
            for (int e = 0; e < 8; ++e) o[e] = (h16)(v[c * 8 + e] * rstd * g[c * 8 + e] + bb[c * 8 + e]);
            *(h16x8*)(KIDXN + (size_t)r * 64 + c * 8) = o; }
        const h16x8 w = *(const h16x8*)(CQX + (size_t)r * 512 + 448);
        const float wsc = 0.04419417382415922f;
        f32x4 w0, w1;
#pragma unroll
        for (int e = 0; e < 4; ++e) { w0[e] = (float)w[e] * wsc; w1[e] = (float)w[4 + e] * wsc; }
        *(f32x4*)(WIDX + (size_t)r * 8) = w0; *(f32x4*)(WIDX + (size_t)r * 8 + 4) = w1;
    }
}

__device__ __forceinline__ unsigned fmap_u(float s) { s += 0.0f; const unsigned b = __float_as_uint(s); return (b & 0x80000000u) ? ~b : (b | 0x80000000u); }
__device__ __forceinline__ unsigned topk_select(const unsigned (&u)[32], int lane) {
    unsigned Tv = 0u;
    for (int bit = 31; bit >= 0; --bit) {
        const unsigned cand = Tv | (1u << bit); int cnt = 0;
#pragma unroll
        for (int i = 0; i < 32; ++i) cnt += __popcll(__ballot(u[i] >= cand));
        if (cnt >= 256) Tv = cand;
    }
    int gt = 0;
#pragma unroll
    for (int i = 0; i < 32; ++i) gt += __popcll(__ballot(u[i] > Tv));
    int need = 256 - gt;
    unsigned sel = 0u;
#pragma unroll
    for (int i = 0; i < 32; ++i) {
        const bool eq = (u[i] == Tv);
        const unsigned long long em = __ballot(eq);
        const int rank = (int)__builtin_amdgcn_mbcnt_hi((unsigned)(em >> 32), __builtin_amdgcn_mbcnt_lo((unsigned)em, 0u));
        const bool take = (u[i] > Tv) || (eq && rank < need);
        sel |= (take ? 1u : 0u) << i;
        need -= __popcll(em);
    }
    return sel;
}


__device__ __forceinline__ unsigned topk_select_radix(const unsigned (&u)[32], int lane, volatile __attribute__((address_space(3))) unsigned* hist) {
    typedef __attribute__((address_space(3))) unsigned lu32;
    unsigned prefix = 0u; int kk = 256;
#pragma unroll 1
    for (int pass = 0; pass < 4; ++pass) {
        const int shift = 24 - 8 * pass;
        { unsigned zz = 0u; asm volatile("" : "+v"(zz)); ((__attribute__((address_space(3))) u32x4*)hist)[lane] = (u32x4){zz, zz, zz, zz}; }
        LDS_FENCE();
#pragma unroll
        for (int i = 0; i < 32; ++i) {
            const bool in = (u[i] != 0u) && (pass == 0 || (u[i] >> (shift + 8)) == prefix);
            if (in) __hip_atomic_fetch_add((lu32*)hist + ((u[i] >> shift) & 255u), 1u, __ATOMIC_RELAXED, __HIP_MEMORY_SCOPE_WORKGROUP);
        }
        LDS_FENCE();
        const u32x4 c = ((__attribute__((address_space(3))) u32x4*)hist)[lane];
        const int tot = (int)(c[0] + c[1] + c[2] + c[3]);
        int S = tot;
#pragma unroll
        for (int o = 1; o < 64; o <<= 1) { const int v = __shfl_down(S, o); if (lane + o < 64) S += v; }
        const unsigned long long bm = __ballot(S >= kk);
        const int Ls = 63 - __builtin_clzll(bm);
        int cum = S - tot, bin = 0, above = 0; bool found = false;
#pragma unroll
        for (int j = 3; j >= 0; --j) { const int cj = (int)c[j]; if (!found && cum + cj >= kk) { bin = 4 * lane + j; above = cum; found = true; } cum += cj; }
        bin = __builtin_amdgcn_readlane(bin, Ls); above = __builtin_amdgcn_readlane(above, Ls);
        kk -= above; prefix = (prefix << 8) | (unsigned)bin;
        LDS_FENCE();
    }
    const unsigned Tv = prefix; int need = kk;
    unsigned sel = 0u;
#pragma unroll
    for (int i = 0; i < 32; ++i) {
        const bool eq = (u[i] == Tv);
        const unsigned long long em = __ballot(eq);
        const int rank = (int)__builtin_amdgcn_mbcnt_hi((unsigned)(em >> 32), __builtin_amdgcn_mbcnt_lo((unsigned)em, 0u));
        const bool take = (u[i] > Tv) || (eq && rank < need);
        sel |= (take ? 1u : 0u) << i;
        need -= __popcll(em);
    }
    return sel;
}


#define DPP_STEP_I(v, op, ident, ctrl, rmask) v = op(v, __builtin_amdgcn_update_dpp((int)(ident), v, ctrl, rmask, 0xf, false))
__device__ __forceinline__ int imax_(int a, int b) { return a > b ? a : b; }
__device__ __forceinline__ int iadd_(int a, int b) { return a + b; }
__device__ __forceinline__ int wave_scan_add(int v) {
    DPP_STEP_I(v, iadd_, 0, 0x111, 0xf); DPP_STEP_I(v, iadd_, 0, 0x112, 0xf); DPP_STEP_I(v, iadd_, 0, 0x114, 0xf); DPP_STEP_I(v, iadd_, 0, 0x118, 0xf);
    DPP_STEP_I(v, iadd_, 0, 0x142, 0xa); DPP_STEP_I(v, iadd_, 0, 0x143, 0xc); return v;
}
template <int CTRL, int RMASK> __device__ __forceinline__ float fmax_dpp_(float a) { return fmaxf(a, __builtin_bit_cast(float, __builtin_amdgcn_update_dpp((int)0xff800000u, __builtin_bit_cast(int, a), CTRL, RMASK, 0xf, false))); }
template <int CTRL, int RMASK> __device__ __forceinline__ float fmin_dpp_(float a) { return fminf(a, __builtin_bit_cast(float, __builtin_amdgcn_update_dpp((int)0x7f800000u, __builtin_bit_cast(int, a), CTRL, RMASK, 0xf, false))); }
#define DPP_RED6(v, F) do { v = F<0x111, 0xf>(v); v = F<0x112, 0xf>(v); v = F<0x114, 0xf>(v); v = F<0x118, 0xf>(v); v = F<0x142, 0xa>(v); v = F<0x143, 0xc>(v); } while (0)
__device__ __forceinline__ float wave_max_dpp(float v) { DPP_RED6(v, fmax_dpp_); return __builtin_bit_cast(float, __builtin_amdgcn_readlane(__builtin_bit_cast(int, v), 63)); }
__device__ __forceinline__ float wave_min_dpp(float v) { DPP_RED6(v, fmin_dpp_); return __builtin_bit_cast(float, __builtin_amdgcn_readlane(__builtin_bit_cast(int, v), 63)); }
__device__ __forceinline__ unsigned topk_select_lin(const float (&s)[32], unsigned valid, int lane, volatile __attribute__((address_space(3))) unsigned* ws_) {
    typedef __attribute__((address_space(3))) unsigned lu32;
    typedef __attribute__((address_space(3))) float lf32;
    typedef __attribute__((address_space(3))) f32x4 lf32x4;
    lu32* hist = (lu32*)ws_; lf32* cand = (lf32*)ws_ + 256;
    unsigned act = valid; int kk = 256; float Tv = 0.f; int need = 0; bool solved = false; int cnt = 0;
#pragma unroll 1
    for (int iter = 0; iter < 8; ++iter) {
        float mn = __builtin_inff(), mx = -__builtin_inff();
        if (iter == 0) {
#pragma unroll
            for (int i = 0; i < 32; ++i) { mn = fminf(mn, s[i]); mx = fmaxf(mx, s[i]); }
        } else {
#pragma unroll
            for (int i = 0; i < 32; ++i) { const bool a = (act >> i) & 1u; mn = fminf(mn, a ? s[i] : __builtin_inff()); mx = fmaxf(mx, a ? s[i] : -__builtin_inff()); }
        }
        mn = wave_min_dpp(mn); mx = wave_max_dpp(mx);
        if (mn == mx) { Tv = mx; need = kk; solved = true; break; }
        const float scale = 254.9f / (mx - mn), bias = -mn * scale;
        { unsigned zz = 0u; asm volatile("" : "+v"(zz)); ((__attribute__((address_space(3))) u32x4*)hist)[lane] = (u32x4){zz, zz, zz, zz}; }
        LDS_FENCE();
#pragma unroll
        for (int i = 0; i < 32; ++i) { int b = (int)fmaf(s[i], scale, bias); b = b < 0 ? 0 : b;
            __hip_atomic_fetch_add(hist + (((act >> i) & 1u) ? b : 321 + (lane & 15)), 1u, __ATOMIC_RELAXED, __HIP_MEMORY_SCOPE_WORKGROUP); }
        LDS_FENCE();
        const u32x4 c = ((__attribute__((address_space(3))) u32x4*)hist)[lane];
        const int tot = (int)(c[0] + c[1] + c[2] + c[3]);
        const int pre = wave_scan_add(tot);
        const int total = __builtin_amdgcn_readlane(pre, 63);
        const int S = total - pre + tot;
        const unsigned long long bm = __ballot(S >= kk);
        const int Ls = 63 - __builtin_clzll(bm | 1ull);
        int cum = S - tot, bin = 0, above = 0, cb = 0; bool found = false;
#pragma unroll
        for (int j = 3; j >= 0; --j) { const int cj = (int)c[j]; if (!found && cum + cj >= kk) { bin = 4 * lane + j; above = cum; cb = cj; found = true; } cum += cj; }
        bin = __builtin_amdgcn_readlane(bin, Ls); above = __builtin_amdgcn_readlane(above, Ls); cnt = __builtin_amdgcn_readlane(cb, Ls);
        kk -= above;
        { float sc2 = scale; asm volatile("" : "+v"(sc2));
#pragma unroll
          for (int i = 0; i < 32; ++i) { int b = (int)fmaf(s[i], sc2, bias); b = b < 0 ? 0 : b; act &= ~((b != bin ? 1u : 0u) << i); } }
        LDS_FENCE();
        if (cnt <= 64) break;
    }
    if (!solved) {
        cand[lane] = __builtin_nanf("");
        const int myc = __popc(act);
        int off = wave_scan_add(myc) - myc;
        LDS_FENCE();
#pragma unroll
        for (int i = 0; i < 32; ++i) { const bool a = (act >> i) & 1u; const int slot = (a && off < 64) ? off : 65 + (lane & 15); cand[slot] = s[i]; off += a ? 1 : 0; }
        LDS_FENCE();
        const int m = cnt < 64 ? cnt : 64;
        const float v = (lane < m) ? cand[lane] : -__builtin_inff();
        int gt = 0, eq = 0;
#pragma unroll
        for (int j4 = 0; j4 < 16; ++j4) { const f32x4 cj = ((lf32x4*)cand)[j4];
#pragma unroll
            for (int e = 0; e < 4; ++e) { gt += (cj[e] > v) ? 1 : 0; eq += (cj[e] == v) ? 1 : 0; } }
        const bool ok = (lane < m) && gt < kk && kk <= gt + eq;
        const unsigned long long okm = __ballot(ok);
        const int fl = okm ? __builtin_ctzll(okm) : 0;
        Tv = __builtin_bit_cast(float, __builtin_amdgcn_readlane(__builtin_bit_cast(int, v), fl)); need = kk - __builtin_amdgcn_readlane(gt, fl);
        LDS_FENCE();
    }
    unsigned sel = 0u, eqb = 0u;
#pragma unroll
    for (int i = 0; i < 32; ++i) { sel |= ((s[i] > Tv) ? 1u : 0u) << i; eqb |= ((s[i] == Tv) ? 1u : 0u) << i; }
    const int eqtot = __builtin_amdgcn_readlane(wave_scan_add(__popc(eqb)), 63);
    if (eqtot <= need) sel |= eqb;
    else {
#pragma unroll
        for (int i = 0; i < 32; ++i) {
            const bool eq = (eqb >> i) & 1u;
            const unsigned long long em = __ballot(eq);
            const int rank = (int)__builtin_amdgcn_mbcnt_hi((unsigned)(em >> 32), __builtin_amdgcn_mbcnt_lo((unsigned)em, 0u));
            sel |= ((eq && rank < need) ? 1u : 0u) << i;
            need -= __popcll(em);
        }
    }
    return sel;
}


__device__ __forceinline__ unsigned topk_select_fast(const float (&s)[32], unsigned valid, int nk, int lane, const __attribute__((address_space(3))) float* row, volatile __attribute__((address_space(3))) unsigned* ws_) {
    typedef __attribute__((address_space(3))) unsigned lu32; typedef __attribute__((address_space(3))) float lf32; typedef __attribute__((address_space(3))) f32x4 lf32x4;
    lu32* hist = (lu32*)ws_; lf32* cand = (lf32*)ws_ + 256;
    float mn = __builtin_inff(), mx = -__builtin_inff();
#pragma unroll
    for (int i = 0; i < 32; ++i) { mn = fminf(mn, s[i]); mx = fmaxf(mx, s[i]); }
    mn = wave_min_dpp(mn); mx = wave_max_dpp(mx);
    const bool flat = (mn == mx);
    const float scale = flat ? 0.f : 254.9f / (mx - mn), bias = flat ? 0.f : -mn * scale;
    { unsigned zz = 0u; asm volatile("" : "+v"(zz)); ((__attribute__((address_space(3))) u32x4*)hist)[lane] = (u32x4){zz, zz, zz, zz}; }
    LDS_FENCE();
    const int full = nk >> 6, rem = nk & 63;
#pragma unroll
    for (int i = 0; i < 32; ++i) if (i <= full) { int b = (int)fmaf(s[i], scale, bias); b = b < 0 ? 0 : b; __hip_atomic_fetch_add(hist + b, 1u, __ATOMIC_RELAXED, __HIP_MEMORY_SCOPE_WORKGROUP); }
    LDS_FENCE();
    u32x4 c = ((__attribute__((address_space(3))) u32x4*)hist)[lane];
    if (lane == 0 && full < 32) c[0] -= (unsigned)(64 - rem);
    const int tot = (int)(c[0] + c[1] + c[2] + c[3]);
    const int pre = wave_scan_add(tot), total = __builtin_amdgcn_readlane(pre, 63);
    const int S = total - pre + tot;
    const unsigned long long bm = __ballot(S >= 256);
    const int Ls = 63 - __builtin_clzll(bm | 1ull);
    int cum = S - tot, bin = 0, above = 0, cb = 0; bool found = false;
#pragma unroll
    for (int j = 3; j >= 0; --j) { const int cj = (int)c[j]; if (!found && cum + cj >= 256) { bin = 4 * lane + j; above = cum; cb = cj; found = true; } cum += cj; }
    bin = __builtin_amdgcn_readlane(bin, Ls); above = __builtin_amdgcn_readlane(above, Ls); const int cnt = __builtin_amdgcn_readlane(cb, Ls);
    if (flat || cnt > 64) return topk_select_lin(s, valid, lane, ws_);
    const int kk = 256 - above;
    unsigned gtb = 0u, eqb = 0u;
    { float sc2 = scale; asm volatile("" : "+v"(sc2));
#pragma unroll
      for (int i = 0; i < 32; ++i) if (i <= full) { int b = (int)fmaf(s[i], sc2, bias); b = b < 0 ? 0 : b; gtb |= (b > bin ? 1u : 0u) << i; eqb |= (b == bin ? 1u : 0u) << i; } }
    eqb &= valid;
    cand[lane] = __builtin_nanf("");
    int off = wave_scan_add(__popc(eqb)) - __popc(eqb);
    LDS_FENCE();
    { unsigned m = eqb;
      while (__any(m != 0u)) { if (m != 0u) { const int i = __builtin_ctz(m); cand[off < 64 ? off : 65 + (lane & 15)] = row[i * 64 + lane]; ++off; m &= m - 1u; } } }
    LDS_FENCE();
    const float v = (lane < cnt) ? cand[lane] : -__builtin_inff();
    int gt = 0, eq = 0;
#pragma unroll
    for (int j4 = 0; j4 < 16; ++j4) { const f32x4 cj = ((lf32x4*)cand)[j4];
#pragma unroll
        for (int e = 0; e < 4; ++e) { gt += (cj[e] > v) ? 1 : 0; eq += (cj[e] == v) ? 1 : 0; } }
    const unsigned long long okm = __ballot((lane < cnt) && gt < kk && kk <= gt + eq);
    const int fl = okm ? __builtin_ctzll(okm) : 0;
    const float Tv = __builtin_bit_cast(float, __builtin_amdgcn_readlane(__builtin_bit_cast(int, v), fl)); int need = kk - __builtin_amdgcn_readlane(gt, fl);
    const int eqtot = __builtin_amdgcn_readlane(eq, fl);
    LDS_FENCE();
    unsigned sel = gtb;
    if (eqtot <= need) {
        unsigned m = eqb;
        while (__any(m != 0u)) { if (m != 0u) { const int i = __builtin_ctz(m); if (row[i * 64 + lane] >= Tv) sel |= 1u << i; m &= m - 1u; } }
    } else {
#pragma unroll
        for (int i = 0; i < 32; ++i) {
            const bool inb = (eqb >> i) & 1u; const bool e_ = inb && (s[i] == Tv);
            const unsigned long long em = __ballot(e_);
            const int rank = (int)__builtin_amdgcn_mbcnt_hi((unsigned)(em >> 32), __builtin_amdgcn_mbcnt_lo((unsigned)em, 0u));
            sel |= (((inb && s[i] > Tv) || (e_ && rank < need)) ? 1u : 0u) << i;
            need -= __popcll(em);
        }
    }
    return sel;
}

__device__ __forceinline__ void p3_indexer_naive(const Params& P, unsigned char* lds, int blk, int nblk, int wv) {
    const int tid = my_tid(wv), wid = __builtin_amdgcn_readfirstlane(tid >> 6), lane = tid & 63;
    float* sc = (float*)lds + wid * 2048; float* qf = (float*)(lds + 65536) + wid * 512; float* wf = (float*)(lds + 65536 + 16384) + wid * 8;
    const h16* QIDX = (const h16*)(P.ws + WS_QIDX); const h16* KIDXN = (const h16*)(P.ws + WS_KIDXN); const float* WIDX = (const float*)(P.ws + WS_WIDX);
    unsigned long long* MASK = (unsigned long long*)(P.ws + WS_MASK);
    const int gw = blk * NWAVES + wid, ngw = nblk * NWAVES;
    for (int it = gw; it < T; it += ngw) {
        const int b = it >> 11, pos = ((it & 2047) + b * 389) & 2047, t = b * L + pos, nk = pos + 1;
        { const h16x8 qv = *(const h16x8*)(QIDX + (size_t)t * 512 + lane * 8);
#pragma unroll
          for (int e = 0; e < 8; ++e) qf[lane * 8 + e] = (float)qv[e];
          if (lane < 8) wf[lane] = WIDX[(size_t)t * 8 + lane]; }
        LDS_FENCE();
        for (int i = 0; i * 64 < nk; ++i) {
            const int key = i * 64 + lane; float score = 0.f;
            if (key < nk) {
                const h16x8* kp = (const h16x8*)(KIDXN + (size_t)(b * L + key) * 64);
                float kf[64];
#pragma unroll
                for (int c = 0; c < 8; ++c) { const h16x8 kv = kp[c];
#pragma unroll
                    for (int e = 0; e < 8; ++e) kf[c * 8 + e] = (float)kv[e]; }
                for (int h = 0; h < 8; ++h) {
                    float a = 0.f;
#pragma unroll
                    for (int d = 0; d < 64; ++d) a = fmaf(qf[h * 64 + d], kf[d], a);
                    score += fmaxf(a, 0.f) * wf[h];
                }
            }
            sc[key] = score;
        }
        LDS_FENCE();
        unsigned selbits = 0u;
        if (nk <= 256) {
#pragma unroll
            for (int i = 0; i < 32; ++i) selbits |= ((i * 64 + lane) < nk ? 1u : 0u) << i;
        } else {
            unsigned u[32];
#pragma unroll
            for (int i = 0; i < 32; ++i) { const int key = i * 64 + lane; const float s = sc[key]; u[i] = (key < nk) ? fmap_u(s) : 0u; }
            selbits = topk_select(u, lane);
        }
#pragma unroll
        for (int i = 0; i < 32; ++i) { const unsigned long long bal = __ballot((selbits >> i) & 1u); if (lane == 0) MASK[(size_t)t * 32 + i] = bal; }
        LDS_FENCE();
    }
}


typedef float f32x16 __attribute__((ext_vector_type(16)));
__device__ __forceinline__ h16x8 relu_pk8(const f32x16& s, int base) {
    h16x8 r;
#pragma unroll
    for (int e = 0; e < 4; ++e) { const h16x2 p = __builtin_bit_cast(h16x2, __builtin_amdgcn_cvt_pkrtz(fmaxf(s[base + 2 * e], 0.f), fmaxf(s[base + 2 * e + 1], 0.f))); r[2 * e] = p[0]; r[2 * e + 1] = p[1]; }
    return r;
}
__device__ __forceinline__ void p3_indexer(const Params& P, unsigned char* lds_, int blk, int nblk, int wv) {
    typedef __attribute__((address_space(3))) float lfloat;
    const int tid = my_tid(wv), wid = __builtin_amdgcn_readfirstlane(tid >> 6), lane = tid & 63;
    unsigned char* ws = opaque_ptr(P.ws);
    lfloat* sc = (lfloat*)lds_;
    const h16* QIDX = (const h16*)(ws + WS_QIDX); const h16* KIDXN = (const h16*)(ws + WS_KIDXN); const float* WIDX = (const float*)(ws + WS_WIDX);
    unsigned long long* MASK = (unsigned long long*)(ws + WS_MASK);
    h16x8 Afn[4][4]; f32x4 wn = (f32x4){0.f, 0.f, 0.f, 0.f};
    { const int r = lane & 31, h = lane >> 5; const int u0 = (blk < NB * (L / 16)) ? blk : 0; const int tt0 = (u0 & 15) * L + (u0 >> 4) * 16;
#pragma unroll
      for (int g = 0; g < 4; ++g)
#pragma unroll
          for (int s = 0; s < 4; ++s) Afn[g][s] = *(const h16x8*)(QIDX + (size_t)(tt0 + 4 * g + (r >> 3)) * 512 + (r & 7) * 64 + 16 * s + 8 * h);
      if (r < 16) wn = *(const f32x4*)(WIDX + (size_t)(tt0 + r) * 8 + 4 * h); }
    for (int unit = blk; unit < NB * (L / 16); unit += nblk) {
        const int b = unit & 15, qg = unit >> 4, p0 = qg * 16, t0 = b * L + p0, NT = (p0 + 15) / 32 + 1;
        int lane_o = lane; asm volatile("" : "+v"(lane_o));
        const int r = lane_o & 31, h = lane_o >> 5;
        h16x8 Af[4][4];
#pragma unroll
        for (int g = 0; g < 4; ++g)
#pragma unroll
            for (int s = 0; s < 4; ++s) Af[g][s] = Afn[g][s];
        h16x8 fragA;
        { const f32x4 w = wn;
          const h16 z = (h16)0.f;
          if (r & 1) { fragA[0] = z; fragA[1] = z; fragA[2] = z; fragA[3] = z; fragA[4] = (h16)w[0]; fragA[5] = (h16)w[1]; fragA[6] = (h16)w[2]; fragA[7] = (h16)w[3]; }
          else { fragA[0] = (h16)w[0]; fragA[1] = (h16)w[1]; fragA[2] = (h16)w[2]; fragA[3] = (h16)w[3]; fragA[4] = z; fragA[5] = z; fragA[6] = z; fragA[7] = z; } }
        const int code = (r < 16) ? (r >> 1) : -1;
        const h16* kbase = KIDXN + (size_t)b * L * 64 + (size_t)r * 64 + 8 * h;
        h16x8 Bf[4];
        if (wid < NT) {
#pragma unroll
            for (int s = 0; s < 4; ++s) Bf[s] = *(const h16x8*)(kbase + (size_t)wid * 32 * 64 + 16 * s);
        }
        for (int rep_ = 0; rep_ <= MK_P3_REPA; ++rep_) {
        if (rep_ > 0 && wid < NT) {
#pragma unroll
            for (int s = 0; s < 4; ++s) Bf[s] = *(const h16x8*)(kbase + (size_t)wid * 32 * 64 + 16 * s);
        }
        for (int kt = wid; kt < NT; kt += NWAVES) {
            h16x8 Bn[4];
            const int ktn = (kt + NWAVES < NT) ? kt + NWAVES : kt;
#pragma unroll
            for (int s = 0; s < 4; ++s) Bn[s] = *(const h16x8*)(kbase + (size_t)ktn * 32 * 64 + 16 * s);
            f32x16 C = {};
#pragma unroll
            for (int g = 0; g < 4; ++g) {
                f32x16 S = {};
#pragma unroll
                for (int s = 0; s < 4; ++s) S = __builtin_amdgcn_mfma_f32_32x32x16_f16(Af[g][s], Bf[s], S, 0, 0, 0);
                const h16x8 X0 = relu_pk8(S, 0), X1 = relu_pk8(S, 8);
                const h16x8 zero8 = (h16x8){0, 0, 0, 0, 0, 0, 0, 0};
                const h16x8 W0 = (code == 2 * g) ? fragA : zero8, W1 = (code == 2 * g + 1) ? fragA : zero8;
                C = __builtin_amdgcn_mfma_f32_32x32x16_f16(W0, X0, C, 0, 0, 0);
                C = __builtin_amdgcn_mfma_f32_32x32x16_f16(W1, X1, C, 0, 0, 0);
            }
            const int key = kt * 32 + r;
#pragma unroll
            for (int e = 0; e < 4; ++e) { sc[(e + 4 * h) * 2048 + key] = C[e]; sc[(8 + e + 4 * h) * 2048 + key] = C[4 + e]; }
#pragma unroll
            for (int s = 0; s < 4; ++s) Bf[s] = Bn[s];
        }
        }
        __syncthreads();
        { const int un = (unit + nblk < NB * (L / 16)) ? unit + nblk : unit; const int ttn = (un & 15) * L + (un >> 4) * 16;
#pragma unroll
          for (int g = 0; g < 4; ++g)
#pragma unroll
              for (int s = 0; s < 4; ++s) Afn[g][s] = *(const h16x8*)(QIDX + (size_t)(ttn + 4 * g + (r >> 3)) * 512 + (r & 7) * 64 + 16 * s + 8 * h);
          if (r < 16) wn = *(const f32x4*)(WIDX + (size_t)(ttn + r) * 8 + 4 * h); }
#pragma unroll 1
        for (int qq_ = 0; qq_ < 2 * (1 + MK_P3_REPB); ++qq_) {
            const int qq = qq_ & 1;
            const int qi = 2 * wid + qq, pos = p0 + qi, nk = pos + 1, t = t0 + qi;
            unsigned selbits = 0u;
            if (nk <= 256) {
#pragma unroll
                for (int i = 0; i < 32; ++i) selbits |= ((i * 64 + lane) < nk ? 1u : 0u) << i;
            } else {
                float sv[32];
                const int full = nk >> 6;
                const unsigned valid = (full >= 32 ? 0xffffffffu : ((1u << full) - 1u)) | ((full < 32 && lane < (nk & 63)) ? (1u << full) : 0u);
#pragma unroll
                for (int i = 0; i < 32; ++i) { const float x = sc[qi * 2048 + i * 64 + lane]; sv[i] = ((valid >> i) & 1u) ? x : __builtin_nanf(""); }
                selbits = topk_select_fast(sv, valid, nk, lane, (const __attribute__((address_space(3))) float*)(sc + qi * 2048), (volatile __attribute__((address_space(3))) unsigned*)(sc + 16 * 2048 + wid * 448));
            }
            {
                __attribute__((address_space(3))) unsigned long long* stg = (__attribute__((address_space(3))) unsigned long long*)(sc + 16 * 2048 + wid * 448 + (qq ? 0 : 338));
                LDS_FENCE();
#pragma unroll
                for (int i = 0; i < 32; ++i) { const unsigned long long bal = __ballot((selbits >> i) & 1u); if (lane == 0) stg[i] = bal; }
            }
            (void)t;
        }
        __syncthreads();
        { const int q = tid & 15, tl = tid >> 4;
          MASK[((size_t)b * 32 + tl) * L + p0 + q] = ((__attribute__((address_space(3))) unsigned long long*)(sc + 16 * 2048 + (q >> 1) * 448 + ((q & 1) ? 0 : 338)))[tl]; }
    }
}

__device__ __forceinline__ void p4_attn_naive(const Params& P, unsigned char* lds, int blk, int nblk, int wv) {
    const int tid = my_tid(wv), wid = __builtin_amdgcn_readfirstlane(tid >> 6), lane = tid & 63;
    int* keys = (int*)lds; float* qf = (float*)(lds + 1024); float* pf = (float*)(lds + 1024 + 4096) + wid * 256; int* nselp = (int*)(lds + 1024 + 4096 + 8192);
    h16* QA = (h16*)(P.ws + WS_R1); const h16* Kb = (const h16*)(P.ws + WS_R2); const h16* Vb = (const h16*)(P.ws + WS_R3); const h16* SG = (const h16*)(P.ws + WS_R4);
    const unsigned long long* MASK = (const unsigned long long*)(P.ws + WS_MASK);
    for (int t = blk; t < T; t += nblk) {
        const int b = t >> 11;
        __syncthreads();
        if (tid < 128) { const h16x8 qv = *(const h16x8*)(QA + (size_t)t * 1024 + tid * 8);
#pragma unroll
            for (int e = 0; e < 8; ++e) qf[tid * 8 + e] = (float)qv[e]; }
        if (wid == 0) {
            unsigned long long m = (lane < 32) ? MASK[(size_t)t * 32 + lane] : 0ull;
            const int cnt = __popcll(m); int inc = cnt;
#pragma unroll
            for (int o = 1; o < 64; o <<= 1) { const int v = __shfl_up(inc, o); if (lane >= o) inc += v; }
            int off = inc - cnt;
            while (m) { const int k = __builtin_ctzll(m); keys[off++] = lane * 64 + k; m &= m - 1; }
            if (lane == 63) nselp[0] = inc;
        }
        __syncthreads();
        const int nsel = nselp[0], h = wid;
        float s[4];
#pragma unroll
        for (int c = 0; c < 4; ++c) {
            const int idx = lane + 64 * c; s[c] = -INFINITY;
            if (idx < nsel) {
                const h16x8* kp = (const h16x8*)(Kb + (size_t)(b * L + keys[idx]) * 1024 + h * 128); float a = 0.f;
#pragma unroll
                for (int cc = 0; cc < 16; ++cc) { const h16x8 kv = kp[cc];
#pragma unroll
                    for (int e = 0; e < 8; ++e) a = fmaf(qf[h * 128 + cc * 8 + e], (float)kv[e], a); }
                s[c] = a;
            }
        }
        const float mx = wave_max(fmaxf(fmaxf(s[0], s[1]), fmaxf(s[2], s[3])));
        float ls = 0.f;
#pragma unroll
        for (int c = 0; c < 4; ++c) { const int idx = lane + 64 * c; const float p = (idx < nsel) ? exp2f(s[c] - mx) : 0.f; pf[idx] = p; ls += p; }
        ls = wave_sum(ls);
        LDS_FENCE();
        float o0 = 0.f, o1 = 0.f;
        for (int k = 0; k < nsel; ++k) {
            const h16x2 v = *(const h16x2*)(Vb + (size_t)(b * L + keys[k]) * 1024 + h * 128 + 2 * lane); const float pk = pf[k];
            o0 = fmaf(pk, (float)v[0], o0); o1 = fmaf(pk, (float)v[1], o1);
        }
        const float inv = 1.0f / ls;
        const h16x2 g = *(const h16x2*)(SG + (size_t)t * 1024 + h * 128 + 2 * lane);
        h16x2 o; o[0] = (h16)(o0 * inv * (float)g[0]); o[1] = (h16)(o1 * inv * (float)g[1]);
        *(h16x2*)(QA + (size_t)t * 1024 + h * 128 + 2 * lane) = o;
    }
}


namespace att {
typedef unsigned short bf16;
typedef short bf16x8 __attribute__((ext_vector_type(8)));
typedef short s16x4 __attribute__((ext_vector_type(4)));
typedef float f32x16 __attribute__((ext_vector_type(16)));
typedef __attribute__((address_space(3))) char lchar;
typedef __attribute__((address_space(3))) float lfloat;
typedef __attribute__((address_space(3))) bf16x8 lbf16x8;
constexpr int D = 128, PITCH = 1024, NW = 8, QBLK = 32, KVBLK = 64, QB = NW * QBLK;
constexpr int SHM_V = KVBLK * D * 2, SHM_K = KVBLK * D * 2;
constexpr int LDS_ATT = 2 * SHM_V + 2 * SHM_K + NW * 64 * 4;
constexpr float THR = 8.f;
#define KSWZ(row, colB) ((row) * 256 + ((colB) ^ (((row) & 7) << 4)))
#define SBAR() __builtin_amdgcn_sched_barrier(0)
__device__ __forceinline__ int v_st(int k, int c) { const int kk = (k & ~0xC) | ((k & 4) << 1) | ((k & 8) >> 1); return ((kk >> 3) * 4 + (c >> 5)) * 512 + ((kk & 7) * 32 + (c & 31)) * 2; }
__device__ __forceinline__ int v_rd_base(int lane) { return ((lane & 3) << 3) | (((lane >> 2) & 3) << 6) | (((lane >> 4) & 1) << 5) | (((lane >> 5) & 1) << 8); }
constexpr int v_rd_off(int d0, int ks, int half) { return d0 * 512 + ks * 4096 + half * 2048; }
__device__ __forceinline__ int crow(int r, int hi) { return (r & 3) + 8 * (r >> 2) + 4 * hi; }
__device__ __forceinline__ bf16x8 load8(const bf16* p) { return *reinterpret_cast<const bf16x8*>(p); }
__device__ __forceinline__ void mask_init(f32x16& p0, f32x16& p1, unsigned long long mk, int hi) {
    const unsigned lo = (unsigned)mk >> (4 * hi), hh = (unsigned)(mk >> 32) >> (4 * hi);
#pragma unroll
    for (int r = 0; r < 16; ++r) {
        const int c = (r & 3) + 8 * (r >> 2);
        const int t0 = __builtin_amdgcn_sbfe(lo, c, 1), t1 = __builtin_amdgcn_sbfe(hh, c, 1);
        p0[r] = __uint_as_float(~(unsigned)t0 & 0xff800000u); p1[r] = __uint_as_float(~(unsigned)t1 & 0xff800000u);
    }
}
__device__ __forceinline__ void partialSM(f32x16& p0, f32x16& p1, float& m_reg, float& mn, float& alpha) {
    float pmax = p0[0]; for (int r = 1; r < 16; ++r) pmax = fmaxf(pmax, p0[r]); for (int r = 0; r < 16; ++r) pmax = fmaxf(pmax, p1[r]);
    { auto rr = __builtin_amdgcn_permlane32_swap(__float_as_uint(pmax), __float_as_uint(pmax), false, false);
      pmax = fmaxf(__uint_as_float(rr[0]), __uint_as_float(rr[1])); }
    if (__builtin_expect(__all((pmax - m_reg) <= THR), 1)) { mn = m_reg; alpha = 1.f; }
    else { mn = fmaxf(m_reg, pmax); alpha = __builtin_amdgcn_exp2f(m_reg - mn); m_reg = mn; }
    for (int r = 0; r < 16; ++r) p0[r] = p0[r] - mn; for (int r = 0; r < 16; ++r) p1[r] = p1[r] - mn;
    for (int r = 0; r < 16; ++r) p0[r] = __builtin_amdgcn_exp2f(p0[r]);
}
__device__ __forceinline__ void finishSM(f32x16& p0, f32x16& p1, float alpha, float& l_reg, bf16x8& pa0, bf16x8& pa1, bf16x8& pa2, bf16x8& pa3) {
    for (int r = 0; r < 16; ++r) p1[r] = __builtin_amdgcn_exp2f(p1[r]);
    float ps = 0; for (int r = 0; r < 16; ++r) ps += p0[r]; for (int r = 0; r < 16; ++r) ps += p1[r];
    { auto rr = __builtin_amdgcn_permlane32_swap(__float_as_uint(ps), __float_as_uint(ps), false, false);
      ps = __uint_as_float(rr[0]) + __uint_as_float(rr[1]); }
    l_reg = l_reg * alpha + ps;
#define PK4(P, B_, OUT) do { unsigned a0 = cvtpk_bf16(P[B_+0], P[B_+1]), a1 = cvtpk_bf16(P[B_+2], P[B_+3]);                          \
        unsigned b0 = cvtpk_bf16(P[B_+4], P[B_+5]), b1 = cvtpk_bf16(P[B_+6], P[B_+7]);                                             \
        auto r0 = __builtin_amdgcn_permlane32_swap(a0, b0, false, false); auto r1 = __builtin_amdgcn_permlane32_swap(a1, b1, false, false); \
        u32x4 w = {r0[0], r1[0], r0[1], r1[1]}; OUT = *reinterpret_cast<bf16x8*>(&w); } while (0)
    PK4(p0, 0, pa0); PK4(p0, 8, pa1); PK4(p1, 0, pa2); PK4(p1, 8, pa3);
#undef PK4
}
template <int KB>
__device__ __forceinline__ void qkt(f32x16& p0, f32x16& p1, const lchar* K_lds, int r32, int hi, const bf16x8* qr) {
    const lchar* kb[4];
#pragma unroll
    for (int dd = 0; dd < 4; ++dd) kb[dd] = K_lds + KB * SHM_K + KSWZ(r32, (dd * 16 + hi * 8) * 2);
#pragma unroll
    for (int d0 = 0; d0 < 8; ++d0) { const lchar* a = kb[d0 & 3] + (d0 >> 2) * 128;
        bf16x8 b0 = *(const lbf16x8*)(a);
        bf16x8 b1 = *(const lbf16x8*)(a + 32 * 256);
        p0 = __builtin_amdgcn_mfma_f32_32x32x16_bf16(b0, qr[d0], p0, 0, 0, 0);
        p1 = __builtin_amdgcn_mfma_f32_32x32x16_bf16(b1, qr[d0], p1, 0, 0, 0); }
}
template <int VB>
__device__ __forceinline__ void pv_tile(f32x16* o, int vb0, bf16x8 pa0, bf16x8 pa1, bf16x8 pa2, bf16x8 pa3) {
#define TRRD(dst, off) asm volatile("ds_read_b64_tr_b16 %0, %1 offset:%2" : "=&v"(dst) : "v"(vb0), "i"(off) : "memory")
#define PV_D0(d0) do { s16x4 l0, l1, l2, l3, h0, h1, h2, h3; constexpr int b_ = VB * SHM_V + v_rd_off(d0, 0, 0); \
        TRRD(l0, b_); TRRD(h0, b_ + 2048); TRRD(l1, b_ + 4096); TRRD(h1, b_ + 6144); TRRD(l2, b_ + 8192); TRRD(h2, b_ + 10240); TRRD(l3, b_ + 12288); TRRD(h3, b_ + 14336); \
        asm volatile("s_waitcnt lgkmcnt(0)" ::: "memory"); SBAR();   \
        o[d0] = __builtin_amdgcn_mfma_f32_32x32x16_bf16(pa0, (bf16x8){l0[0], l0[1], l0[2], l0[3], h0[0], h0[1], h0[2], h0[3]}, o[d0], 0, 0, 0);   \
        o[d0] = __builtin_amdgcn_mfma_f32_32x32x16_bf16(pa1, (bf16x8){l1[0], l1[1], l1[2], l1[3], h1[0], h1[1], h1[2], h1[3]}, o[d0], 0, 0, 0);   \
        o[d0] = __builtin_amdgcn_mfma_f32_32x32x16_bf16(pa2, (bf16x8){l2[0], l2[1], l2[2], l2[3], h2[0], h2[1], h2[2], h2[3]}, o[d0], 0, 0, 0);   \
        o[d0] = __builtin_amdgcn_mfma_f32_32x32x16_bf16(pa3, (bf16x8){l3[0], l3[1], l3[2], l3[3], h3[0], h3[1], h3[2], h3[3]}, o[d0], 0, 0, 0); } while (0)
    PV_D0(0); PV_D0(1); PV_D0(2); PV_D0(3);
#undef PV_D0
#undef TRRD
}
struct BlockRef { const bf16* Q; const bf16* K; const bf16* V; h16* O; const unsigned long long* M; const h16* G; int P0; };
struct Seam { bf16x8 qr[8]; bf16x8 st_v0, st_v1, st_k0, st_k1; };
#define VMW() asm volatile("s_waitcnt vmcnt(0)" ::: "memory")
#define VMWN(n) asm volatile("s_waitcnt vmcnt(%0)" :: "i"(n) : "memory")
#define SLOAD_H(Kp, Vp, k0) do { const unsigned o0_ = ro0 + (unsigned)(k0) * PITCH, o1_ = o0_ + 32u * PITCH;     \
                         S.st_v0 = load8((Vp) + o0_); S.st_v1 = load8((Vp) + o1_); S.st_k0 = load8((Kp) + o0_); S.st_k1 = load8((Kp) + o1_); } while (0)
#define SWRITE_HK(bf) do { *(lbf16x8*)(K_lds + (bf) * SHM_K + kws) = S.st_k0; *(lbf16x8*)(K_lds + (bf) * SHM_K + kws + 32 * 256) = S.st_k1; } while (0)
#define SWRITE_HV(bf) do { *(lbf16x8*)(V_lds + (bf) * SHM_V + vst0) = S.st_v0; *(lbf16x8*)(V_lds + (bf) * SHM_V + vst1) = S.st_v1; } while (0)
#define SWRITE_H(bf) do { SWRITE_HV(bf); SWRITE_HK(bf); } while (0)
__device__ __forceinline__ void prime(const BlockRef& cur, lchar* lds, Seam& S, int wv) {
    const int tid = my_tid(wv);
    const int wid = __builtin_amdgcn_readfirstlane(tid >> 6), lane = tid & 63, r32 = lane & 31, hi = lane >> 5;
    const int sr = tid >> 4, sc = (tid & 15) * 8, kws = KSWZ(sr, sc * 2); lchar* K_lds = lds + 2 * SHM_V;
    const unsigned ro0 = (unsigned)(sr * PITCH + sc), qo = (unsigned)((wid * QBLK + r32) * PITCH + hi * 8);
    for (int d0 = 0; d0 < 8; ++d0) S.qr[d0] = load8(cur.Q + (qo + (unsigned)(d0 * 16)));
    SLOAD_H(cur.K, cur.V, 0); VMW(); SWRITE_HK(0);
    __syncthreads();
}
__device__ __forceinline__ void block(const BlockRef& cur, const BlockRef& nxt, lchar* lds, Seam& S, int wv) {
    const int tid = my_tid(wv);
    const int wid = __builtin_amdgcn_readfirstlane(tid >> 6), lane = tid & 63, r32 = lane & 31, hi = lane >> 5;
    const int NT = (cur.P0 + QB - 1) / KVBLK + 1;
    lchar* V_lds = lds; lchar* K_lds = lds + 2 * SHM_V;
    lfloat* ws = (lfloat*)(lds + 2 * SHM_V + 2 * SHM_K) + wid * 64; lfloat* li_l = ws, * al_l = ws + 32;
    float m_reg = -1e30f, l_reg = 0; f32x16 o[4] = {};
    const int sr = tid >> 4, sc = (tid & 15) * 8, vst0 = v_st(sr, sc), vst1 = v_st(32 + sr, sc), kws = KSWZ(sr, sc * 2);
    const int vb0 = (int)(unsigned)(uintptr_t)V_lds + v_rd_base(lane);
    const unsigned ro0 = (unsigned)(sr * PITCH + sc), qo = (unsigned)((wid * QBLK + r32) * PITCH + hi * 8);
    const bf16* Kh = cur.K; const bf16* Vh = cur.V;
    const unsigned mro = (unsigned)(wid * QBLK + r32) * 8u;
#define LDMASK(tile) (*(const unsigned long long*)((const char*)cur.M + (mro + (unsigned)(tile) * (unsigned)(L * 8))))
    unsigned long long mk;
#define RESC(a) do { if (__any((a) < 1.f)) { if (hi == 0) al_l[r32] = (a); asm volatile("s_waitcnt lgkmcnt(0)" ::: "memory");              \
                     for (int d_ = 0; d_ < 4; ++d_) for (int r = 0; r < 16; ++r) o[d_][r] *= al_l[crow(r, hi)]; } } while (0)
#define KBASE(t) ((t) * KVBLK)
    constexpr int NQL = 8;
#define SEAM_K0() do { VMWN(NQL); SWRITE_HK(0); SBAR(); } while (0)
    f32x16 pA0, pA1, pB0, pB1; float mnA, mnB, alA, alB; bf16x8 pa0, pa1, pa2, pa3;
    SWRITE_HV(0); SBAR();
    mk = LDMASK(0);
    if (NT > 1) { SLOAD_H(Kh, Vh, KBASE(1)); }
    mask_init(pA0, pA1, mk, hi); if (NT > 1) mk = LDMASK(1);
    SBAR(); qkt<0>(pA0, pA1, K_lds, r32, hi, S.qr);
    partialSM(pA0, pA1, m_reg, mnA, alA);
    if (NT > 1) { VMW(); SWRITE_H(1); }
    __syncthreads();
#define HALF_STEP(PX0, PX1, mnX, alX, PY0, PY1, alY, t, KB, VB, SB) do {                                                      \
        mask_init(PX0, PX1, mk, hi);                                       \
        SBAR(); qkt<KB>(PX0, PX1, K_lds, r32, hi, S.qr);                                                                      \
        if ((t) + 1 < NT) mk = LDMASK((t) + 1);                                                              \
        finishSM(PY0, PY1, alY, l_reg, pa0, pa1, pa2, pa3); SBAR();                                                           \
        if ((t) + 1 < NT) { SLOAD_H(Kh, Vh, KBASE((t) + 1)); SBAR(); }                                                        \
        pv_tile<VB>(o, vb0, pa0, pa1, pa2, pa3); partialSM(PX0, PX1, m_reg, mnX, alX);                                        \
        __syncthreads();                                                                                                      \
        if ((t) + 1 < NT) { VMW(); SWRITE_H(SB); }                                                                            \
        RESC(alX); __syncthreads(); } while (0)
    for (int t = 1; t + 1 < NT; t += 2) {
        HALF_STEP(pB0, pB1, mnB, alB, pA0, pA1, alA, t, 1, 0, 0);
        HALF_STEP(pA0, pA1, mnA, alA, pB0, pB1, alB, t + 1, 0, 1, 1);
    }
    const bool even = (NT & 1) == 0;
    if (even) { mask_init(pB0, pB1, mk, hi); SBAR(); qkt<1>(pB0, pB1, K_lds, r32, hi, S.qr); SBAR(); }
    SLOAD_H(nxt.K, nxt.V, 0); SBAR();
#pragma unroll
    for (int d0 = 0; d0 < 8; ++d0) S.qr[d0] = load8(nxt.Q + (qo + (unsigned)(d0 * 16)));
    SBAR();
    finishSM(pA0, pA1, alA, l_reg, pa0, pa1, pa2, pa3); SBAR();
    pv_tile<0>(o, vb0, pa0, pa1, pa2, pa3);
    if (even) { partialSM(pB0, pB1, m_reg, mnB, alB); __syncthreads(); RESC(alB);
        finishSM(pB0, pB1, alB, l_reg, pa0, pa1, pa2, pa3); SBAR(); pv_tile<1>(o, vb0, pa0, pa1, pa2, pa3); }
    SBAR(); SEAM_K0();
    if (hi == 0) li_l[r32] = l_reg; asm volatile("s_waitcnt lgkmcnt(0)" ::: "memory");
    float rli[16];
#pragma unroll
    for (int r = 0; r < 16; ++r) rli[r] = __builtin_amdgcn_rcpf(li_l[crow(r, hi)]);
    __syncthreads();
    {
        typedef __attribute__((address_space(3))) h16 lh16; typedef __attribute__((address_space(3))) h16x8 lh16x8_;
        lchar* ob = V_lds + wid * 4096;
#pragma unroll
        for (int half = 0; half < 2; ++half) {
#pragma unroll
            for (int r = 0; r < 16; ++r) { const int orow = crow(r, hi);
#pragma unroll
                for (int dd = 0; dd < 2; ++dd) *(lh16*)(ob + orow * 128 + (dd * 32 + r32) * 2) = (h16)(o[half * 2 + dd][r] * rli[r]); }
            asm volatile("s_waitcnt lgkmcnt(0)" ::: "memory");
#pragma unroll
            for (int i = 0; i < 4; ++i) { const int c = lane + 64 * i, row = c >> 3, c8 = c & 7;
                const h16x8 ov = *(const lh16x8_*)(ob + row * 128 + c8 * 16);
                const unsigned oo = (unsigned)((wid * QBLK + row) * PITCH + half * 64 + c8 * 8);
                const h16x8 gv = *(const h16x8*)(cur.G + oo);
                *(h16x8*)(cur.O + oo) = ov * gv; }
            asm volatile("s_waitcnt lgkmcnt(0)" ::: "memory");
        }
    }
    __syncthreads();
#undef LDMASK
#undef RESC
#undef KBASE
#undef SEAM_K0
#undef HALF_STEP
}
#undef VMW
#undef VMWN
#undef SLOAD_H
#undef SWRITE_HK
#undef SWRITE_HV
#undef SWRITE_H
#undef KSWZ
#undef SBAR
}

__device__ __forceinline__ att::BlockRef att_ref(const Params& P, unsigned char* ws, int item, int pass) {
    const int xcd = item & 7, kq = item >> 3, bh = (kq >> 2) * 8 + xcd, x = kq & 3, qb = pass ? 7 - x : x, b = bh >> 3, h = bh & 7;
    const size_t row0 = (size_t)b * L + (size_t)qb * 256;
    att::BlockRef r;
    r.Q = (const att::bf16*)(ws + WS_R1) + row0 * 1024 + h * 128; r.O = (h16*)(ws + WS_AO) + row0 * 1024 + h * 128;
    r.K = (const att::bf16*)(ws + WS_R2) + (size_t)b * L * 1024 + h * 128; r.V = (const att::bf16*)(ws + WS_R3) + (size_t)b * L * 1024 + h * 128;
    r.M = (const unsigned long long*)(ws + WS_MASK) + (size_t)b * 32 * L + (size_t)qb * 256;
    r.G = (const h16*)(ws + WS_R4) + row0 * 1024 + h * 128; r.P0 = qb * 256;
    return r;
}
__device__ __forceinline__ void p4_attn(const Params& P, unsigned char* lds, int blk, int nblk, int wv) {
    unsigned char* ws = opaque_ptr(P.ws);
    const int total = NB * 8 * 4;
    int it = blk; if (it >= total) return;
    int pass = 0;
    att::BlockRef cur = att_ref(P, ws, it, 0);
    att::Seam S;
    att::prime(cur, (att::lchar*)lds, S, wv);
    for (;;) {
        const bool more_pass = pass == 0, more_item = it + nblk < total, last = !more_pass && !more_item;
        int itn = it, passn = pass + 1;
        if (!more_pass) { passn = 0; itn = more_item ? it + nblk : it; }
        const att::BlockRef nxt = last ? cur : att_ref(P, ws, itn, passn);
        att::block(cur, nxt, (att::lchar*)lds, S, wv);
        if (last) break;
        cur = nxt; it = itn; pass = passn;
    }
}

__device__ __forceinline__ void p8_ret_naive(const Params& P, unsigned char* lds, int blk, int nblk, int wv) {
    const int tid = my_tid(wv);
    float* qk = (float*)lds;
    const h16* RQ = (const h16*)(P.ws + WS_R1); const h16* RK = (const h16*)(P.ws + WS_R2); h16* RV = (h16*)(P.ws + WS_R4);
    const int j = tid >> 2, iq = tid & 3;
    for (int it = blk; it < 256; it += nblk) {
        const int b = it >> 4, h = (it >> 2) & 3, sl = it & 3;
        const float gamma = 1.0f - exp2f(-5.0f - (float)h);
        float S[64];
#pragma unroll
        for (int i = 0; i < 64; ++i) S[i] = 0.f;
        const int col = tid & 255;
        const h16* src = (tid < 256 ? RQ : RK) + (size_t)b * L * 1024 + h * 256 + col;
        float* dst = qk + (tid >> 8) * 272 + (col >> 6) * 68 + (col & 63);
        h16* vp = RV + (size_t)b * L * 2048 + h * 512 + sl * 128 + j;
        for (int t0 = 0; t0 < L; t0 += 16) {
            __syncthreads();
            h16 vv[16];
#pragma unroll
            for (int tt = 0; tt < 16; ++tt) { dst[tt * 544] = (float)src[(size_t)(t0 + tt) * 1024]; vv[tt] = vp[(size_t)(t0 + tt) * 2048]; }
            __syncthreads();
#pragma unroll
            for (int tt = 0; tt < 16; ++tt) {
                const f32x4* qp = (const f32x4*)(qk + tt * 544 + iq * 68); const f32x4* kp = (const f32x4*)(qk + tt * 544 + 272 + iq * 68);
                const float v = (float)vv[tt]; float o = 0.f;
#pragma unroll
                for (int i4 = 0; i4 < 16; ++i4) { const f32x4 q4 = qp[i4], k4 = kp[i4];
#pragma unroll
                    for (int e = 0; e < 4; ++e) { S[i4 * 4 + e] = fmaf(gamma, S[i4 * 4 + e], k4[e] * v); o = fmaf(q4[e], S[i4 * 4 + e], o); } }
                o += __shfl_xor(o, 1); o += __shfl_xor(o, 2);
                if (iq == 0) vp[(size_t)(t0 + tt) * 2048] = (h16)o;
            }
        }
    }
}


namespace ret {
typedef __attribute__((address_space(3))) unsigned char lch;
typedef __attribute__((address_space(3))) h16x8 lh16x8;
typedef __attribute__((address_space(3))) h16x4 lh16x4;
typedef __attribute__((address_space(3))) u32x4 lu32x4;
typedef short v4i16 __attribute__((ext_vector_type(4)));
typedef __attribute__((address_space(3))) v4i16 lv4i16;
constexpr int SKB = 544, SVB = 288, SSB = 544;
constexpr int OFF_K = 0, OFF_V = 64 * SKB, OFF_S = OFF_V + 64 * SVB, LDS_RET = OFF_S + 128 * SSB;
__device__ __forceinline__ h16x4 trrd(const lch* p) { return __builtin_bit_cast(h16x4, __builtin_amdgcn_ds_read_tr16_b64_v4i16((lv4i16*)p)); }
__device__ __forceinline__ h16x8 cat8(h16x4 a, h16x4 b) { return __builtin_shufflevector(a, b, 0, 1, 2, 3, 4, 5, 6, 7); }
}
#define P8_GATE(m_, ro_) do { const char* gp_ = (const char*)(RG + ((size_t)b * L + (size_t)(m_) * 64) * 2048 + h * 512 + sl * 128) + (ro_); gt0 = *(const h16x8*)gp_; gt1 = *(const h16x8*)(gp_ + 16); } while (0)
#define P8_XSLD(m_, rw_) do { _Pragma("unroll") for (int s_ = 0; s_ < 4; ++s_) xsv[s_] = __hip_atomic_load((const unsigned long long*)((const char*)(XS + (size_t)(grp0 + (m_)) * 256) + (unsigned)(s_ * 512 + (rw_) * 8)), __ATOMIC_RELAXED, __HIP_MEMORY_SCOPE_AGENT); } while (0)
#define P8_XSOK() (((unsigned)xsv[0] != 0xffffffffu) && ((unsigned)xsv[1] != 0xffffffffu) && ((unsigned)xsv[2] != 0xffffffffu) && ((unsigned)xsv[3] != 0xffffffffu))
#define P8_WAIT(m_, rw_) do { unsigned sp_ = 0u; while (!__all(P8_XSOK())) { __builtin_amdgcn_s_sleep(1); P8_XSLD(m_, rw_); \
        if (++sp_ > (1u << 20)) { if (lane == 0) __hip_atomic_store((unsigned*)(ws + WS_BAR) + XB_TMO_W, 1u, __ATOMIC_RELAXED, __HIP_MEMORY_SCOPE_AGENT); break; } } } while (0)
#define P8_FINAL(m_, rw_, ro_, lo_) do { const int mm_ = (m_); P8_WAIT(mm_, rw_); float S1_ = 0.f, S2_ = 0.f; \
        _Pragma("unroll") for (int s_ = 0; s_ < 4; ++s_) { S1_ += __uint_as_float((unsigned)xsv[s_]); S2_ += __uint_as_float((unsigned)(xsv[s_] >> 32)); } \
        const float mu_ = S1_ * (1.0f / 512.0f); const float var_ = fmaxf(S2_ * (1.0f / 512.0f) - mu_ * mu_, 0.f); const float rs_ = rsqrtf(var_ + EPS); const float nb_ = -mu_ * rs_; \
        const lch* op_ = OT + (mm_ & 1) * OT_BYTES + (lo_); const h16x8 o0_ = *(const lh16x8*)op_, o1_ = *(const lh16x8*)(op_ + 16); h16x8 y0_, y1_; \
        _Pragma("unroll") for (int e = 0; e < 8; ++e) { y0_[e] = (h16)(fmaf((float)o0_[e], rs_, nb_) * (float)gt0[e]); y1_[e] = (h16)(fmaf((float)o1_[e], rs_, nb_) * (float)gt1[e]); } \
        char* dp_ = (char*)(vg + (size_t)mm_ * 64 * 2048) + (ro_); *(h16x8*)dp_ = y0_; *(h16x8*)(dp_ + 16) = y1_; } while (0)
#define XB_TMO_W 128
__device__ __forceinline__ void p8_retention(const Params& P, unsigned char* lds_, int blk, int nblk, int wv) {
    using namespace ret;
    const int tid = my_tid(wv), wid = __builtin_amdgcn_readfirstlane(tid >> 6), lane = tid & 63, c16 = lane & 15, g = lane >> 4, q4 = c16 >> 2, p4 = c16 & 3;
    const int it = wid & 3, dh = wid >> 2;
    unsigned char* ws = opaque_ptr(P.ws);
    lch* Kc = (lch*)lds_ + OFF_K; lch* Vc = (lch*)lds_ + OFF_V; lch* St = (lch*)lds_ + OFF_S;
    const h16* RQ = (const h16*)(ws + WS_R1); const h16* RK = (const h16*)(ws + WS_R2); h16* RV = (h16*)(ws + WS_R4);
    const bool fusedgn = (nblk == 256);
    const h16* RG = (const h16*)(ws + WS_RG);
    unsigned long long* XS = (unsigned long long*)(ws + WS_KIDXN);
    typedef __attribute__((address_space(3))) f32x2 lf32x2;
    lf32x2* PS = (lf32x2*)((lch*)lds_ + LDS_RET);
    for (int item = blk; item < 256; item += nblk) {
        const int b = item >> 4, h = (item >> 2) & 3, sl = item & 3;
        const int grp0 = (b * 4 + h) * 32;
        constexpr int OT_PITCH = 272, OT_BYTES = 64 * OT_PITCH;
        lch* OT = (lch*)lds_ + LDS_RET + 1024;
        h16x8 gt0 = (h16x8){0, 0, 0, 0, 0, 0, 0, 0}, gt1 = gt0;
        const float lgam = log2f(1.0f - exp2f(-5.0f - (float)h));
        const float gamma64 = exp2f(64.0f * lgam);
        f32x4 state[16];
#pragma unroll
        for (int d = 0; d < 16; ++d) state[d] = (f32x4){0.f, 0.f, 0.f, 0.f};
        __syncthreads();
        { unsigned zz = 0u; asm volatile("" : "+v"(zz));
          for (int i = tid; i < 128 * SSB / 16; i += NTHREADS) ((lu32x4*)St)[i] = (u32x4){zz, zz, zz, zz}; }
        const h16* kg = RK + (size_t)b * L * 1024 + h * 256; const h16* vg = RV + (size_t)b * L * 2048 + h * 512 + sl * 128;
        h16x8 kreg[4], vreg[2];
        const unsigned qoff = (unsigned)((16 * it + c16) * 1024 + 8 * g) * 2u, ooff = (unsigned)((16 * it + c16) * 2048 + 64 * dh + 4 * g) * 2u;
        unsigned ko[4], vo[2];
#pragma unroll
        for (int i = 0; i < 4; ++i) { const int c = tid + NTHREADS * i; ko[i] = (unsigned)((c >> 5) * 1024 + (c & 31) * 8) * 2u; }
#pragma unroll
        for (int i = 0; i < 2; ++i) { const int c = tid + NTHREADS * i; vo[i] = (unsigned)((c >> 4) * 2048 + (c & 15) * 8) * 2u; }
#pragma unroll
        for (int i = 0; i < 4; ++i) kreg[i] = *(const h16x8*)((const char*)kg + ko[i]);
#pragma unroll
        for (int i = 0; i < 2; ++i) vreg[i] = *(const h16x8*)((const char*)vg + vo[i]);
#pragma unroll
        for (int i = 0; i < 4; ++i) { const int c = tid + NTHREADS * i; *(lh16x8*)(Kc + (c >> 5) * SKB + (c & 31) * 16) = kreg[i]; }
#pragma unroll
        for (int i = 0; i < 2; ++i) { const int c = tid + NTHREADS * i; *(lh16x8*)(Vc + (c >> 4) * SVB + (c & 15) * 16) = vreg[i]; }
        h16x8 Qn[8];
#pragma unroll
        for (int s = 0; s < 8; ++s) Qn[s] = *(const h16x8*)((const char*)(RQ + (size_t)b * L * 1024 + h * 256) + (qoff + (unsigned)(64 * s)));
        __syncthreads();
        for (int n = 0; n < L / 64; ++n) {
            const size_t row0 = (size_t)b * L + (size_t)n * 64;
            const int nn = (n + 1 < L / 64) ? n + 1 : n;
            unsigned kO[4] = {ko[0], ko[1], ko[2], ko[3]}, vO[2] = {vo[0], vo[1]}, qO = qoff, oO = ooff;
            asm volatile("" : "+v"(kO[0]), "+v"(kO[1]), "+v"(kO[2]), "+v"(kO[3]), "+v"(vO[0]), "+v"(vO[1]), "+v"(qO), "+v"(oO));
            int gO = g, cO = c16; asm volatile("" : "+v"(gO), "+v"(cO));
            float lg = lgam; asm volatile("" : "+v"(lg));
            const float xi = __builtin_amdgcn_exp2f((float)(16 * it + cO + 1) * lg);
            h16x8 Qf[8];
#pragma unroll
            for (int s = 0; s < 8; ++s) Qf[s] = Qn[s];
#pragma unroll
            for (int s = 0; s < 8; ++s) Qn[s] = *(const h16x8*)((const char*)(RQ + ((size_t)b * L + (size_t)nn * 64) * 1024 + h * 256) + (qO + (unsigned)(64 * s)));
            unsigned long long xsv[4] = {0ull, 0ull, 0ull, 0ull};
            const int tF_ = my_tid(wv); const unsigned rowF = (unsigned)(tF_ >> 3), roF = rowF * 4096u + (unsigned)(tF_ & 7) * 32u, loF = rowF * (unsigned)OT_PITCH + (unsigned)(tF_ & 7) * 32u;
            if (fusedgn && n > 0) { P8_GATE(n - 1, roF); }
            h16x8 Pf[2];
#pragma unroll
            for (int ks = 0; ks < 2; ++ks)
#pragma unroll
                for (int e = 0; e < 8; ++e) Pf[ks][e] = (h16)0.f;
#pragma unroll
            for (int jt = 0; jt < 4; ++jt) {
                if (jt <= it) {
                    f32x4 S = (f32x4){0.f, 0.f, 0.f, 0.f};
#pragma unroll
                    for (int s = 0; s < 8; ++s) { const h16x8 A = *(const lh16x8*)(Kc + (16 * jt + c16) * SKB + (32 * s + 8 * g) * 2); S = __builtin_amdgcn_mfma_f32_16x16x32_f16(A, Qf[s], S, 0, 0, 0); }
#pragma unroll
                    for (int e = 0; e < 4; ++e) { const int d = (16 * it + cO) - (16 * jt + 4 * gO + e); const float f = (d >= 0) ? __builtin_amdgcn_exp2f((float)d * lg) : 0.f; Pf[jt >> 1][(jt & 1) * 4 + e] = (h16)(S[e] * f); }
                }
            }
            if (fusedgn && n > 0) { P8_XSLD(n - 1, rowF); }
            f32x4 acc[4];
#pragma unroll
            for (int dt = 0; dt < 4; ++dt) {
                acc[dt] = (f32x4){0.f, 0.f, 0.f, 0.f};
#pragma unroll
                for (int s = 0; s < 8; ++s) { const h16x8 A = *(const lh16x8*)(St + (16 * (4 * dh + dt) + c16) * SSB + (32 * s + 8 * g) * 2); acc[dt] = __builtin_amdgcn_mfma_f32_16x16x32_f16(A, Qf[s], acc[dt], 0, 0, 0); }
                acc[dt] = acc[dt] * xi;
            }
#pragma unroll
            for (int ks = 0; ks < 2; ++ks) {
                if (2 * ks <= it) {
#pragma unroll
                    for (int dt = 0; dt < 4; ++dt) {
                        const lch* vp = Vc + (32 * ks + 4 * g + q4) * SVB + (16 * (4 * dh + dt) + 4 * p4) * 2;
                        const h16x8 A = cat8(trrd(vp), trrd(vp + 16 * SVB));
                        acc[dt] = __builtin_amdgcn_mfma_f32_16x16x32_f16(A, Pf[ks], acc[dt], 0, 0, 0);
                    }
                }
            }
            if (!fusedgn) {
#pragma unroll
                for (int dt = 0; dt < 4; ++dt) *(h16x4*)((char*)(vg + (size_t)n * 64 * 2048) + (oO + (unsigned)(32 * dt))) = pack4(acc[dt]);
            } else {
                float s1 = 0.f, s2 = 0.f;
#pragma unroll
                for (int dt = 0; dt < 4; ++dt)
#pragma unroll
                    for (int e = 0; e < 4; ++e) { s1 += acc[dt][e]; s2 = fmaf(acc[dt][e], acc[dt][e], s2); }
                s1 = fq_sum(s1); s2 = fq_sum(s2);
                const int tk = (int)(oO >> 12);
                if ((oO & 24u) == 0u) PS[dh * 64 + tk] = (f32x2){s1, s2};
                { lch* wp_ = OT + (n & 1) * OT_BYTES + (unsigned)tk * (unsigned)OT_PITCH + (oO & 4095u);
#pragma unroll
                  for (int dt = 0; dt < 4; ++dt) *(lh16x4*)(wp_ + 32 * dt) = pack4(acc[dt]); }
            }
#pragma unroll
            for (int i = 0; i < 4; ++i) kreg[i] = *(const h16x8*)((const char*)(kg + (size_t)nn * 64 * 1024) + kO[i]);
#pragma unroll
            for (int i = 0; i < 2; ++i) vreg[i] = *(const h16x8*)((const char*)(vg + (size_t)nn * 64 * 2048) + vO[i]);
            h16x8 Bv[2];
#pragma unroll
            for (int ks = 0; ks < 2; ++ks) { const lch* vp = Vc + (32 * ks + 8 * g + q4) * SVB + (16 * wid + 4 * p4) * 2; h16x8 zf;
#pragma unroll
                for (int e = 0; e < 8; ++e) zf[e] = (h16)__builtin_amdgcn_exp2f((float)(63 - (32 * ks + 8 * gO + e)) * lg);
                Bv[ks] = cat8(trrd(vp), trrd(vp + 4 * SVB)) * zf; }
#pragma unroll
            for (int dkt = 0; dkt < 16; ++dkt) {
                state[dkt] = state[dkt] * gamma64;
#pragma unroll
                for (int ks = 0; ks < 2; ++ks) { const lch* kp = Kc + (32 * ks + 8 * g + q4) * SKB + (16 * dkt + 4 * p4) * 2;
                    const h16x8 A = cat8(trrd(kp), trrd(kp + 4 * SKB)); state[dkt] = __builtin_amdgcn_mfma_f32_16x16x32_f16(A, Bv[ks], state[dkt], 0, 0, 0); }
            }
            if (fusedgn && n > 0) { P8_FINAL(n - 1, rowF, roF, loF); }
            __syncthreads();
            if (fusedgn && wid == 0) {
                int lO = lane; asm volatile("" : "+v"(lO));
                const f32x2 pa = PS[lO], pb = PS[64 + lO];
                const unsigned long long pk = (unsigned long long)__float_as_uint(pa[0] + pb[0]) | ((unsigned long long)__float_as_uint(pa[1] + pb[1]) << 32);
                __hip_atomic_store((unsigned long long*)((char*)(XS + ((size_t)(grp0 + n) * 4 + sl) * 64) + (unsigned)(lO * 8)), pk, __ATOMIC_RELAXED, __HIP_MEMORY_SCOPE_AGENT);
            }
#pragma unroll
            for (int dkt = 0; dkt < 16; ++dkt) *(lh16x4*)(St + (16 * wid + c16) * SSB + (16 * dkt + 4 * g) * 2) = pack4(state[dkt]);
#pragma unroll
            for (int i = 0; i < 4; ++i) { const int c = tid + NTHREADS * i; *(lh16x8*)(Kc + (c >> 5) * SKB + (c & 31) * 16) = kreg[i]; }
#pragma unroll
            for (int i = 0; i < 2; ++i) { const int c = tid + NTHREADS * i; *(lh16x8*)(Vc + (c >> 4) * SVB + (c & 15) * 16) = vreg[i]; }
            __syncthreads();
        }
        if (fusedgn) {
            const int tF_ = my_tid(wv); const unsigned rowF = (unsigned)(tF_ >> 3), roF = rowF * 4096u + (unsigned)(tF_ & 7) * 32u, loF = rowF * (unsigned)OT_PITCH + (unsigned)(tF_ & 7) * 32u;
            unsigned long long xsv[4]; P8_GATE(L / 64 - 1, roF); P8_XSLD(L / 64 - 1, rowF); P8_FINAL(L / 64 - 1, rowF, roF, loF);
        }
    }
#undef P8_FINAL
#undef P8_XSLD
#undef P8_GATE
#undef P8_WAIT
#undef P8_XSOK
}

__device__ __forceinline__ void p9_gnorm(const Params& P, int blk, int nblk, int wv) {
    const int tid = my_tid(wv), wid = tid >> 6, lane = tid & 63;
    unsigned char* ws = opaque_ptr(P.ws);
    h16* RO = (h16*)(ws + WS_R4); const h16* RG = (const h16*)(ws + WS_RG);
    const int gw = blk * NWAVES + wid, ngw = nblk * NWAVES;
    for (int t0 = gw; t0 < T; t0 += 2 * ngw) {
        h16x8 xv[2][4], gv[2][4];
#pragma unroll
        for (int k = 0; k < 2; ++k) { const int t = (t0 + k * ngw < T) ? t0 + k * ngw : t0;
#pragma unroll
            for (int h = 0; h < 4; ++h) { const size_t o = (size_t)t * 2048 + h * 512 + lane * 8; xv[k][h] = *(const h16x8*)(RO + o); gv[k][h] = *(const h16x8*)(RG + o); } }
#pragma unroll
        for (int k = 0; k < 2; ++k) { const int t = t0 + k * ngw;
#pragma unroll
            for (int h = 0; h < 4; ++h) {
                float v[8]; float s = 0.f;
#pragma unroll
                for (int e = 0; e < 8; ++e) { v[e] = (float)xv[k][h][e]; s += v[e]; }
                const float mu = wave_sum_dpp(s) * (1.0f / 512.0f); float q = 0.f;
#pragma unroll
                for (int e = 0; e < 8; ++e) { v[e] -= mu; q += v[e] * v[e]; }
                const float rstd = rsqrtf(wave_sum_dpp(q) * (1.0f / 512.0f) + EPS);
                h16x8 y;
#pragma unroll
                for (int e = 0; e < 8; ++e) y[e] = (h16)(v[e] * rstd * (float)gv[k][h][e]);
                if (t < T) *(h16x8*)(RO + (size_t)t * 2048 + h * 512 + lane * 8) = y;
            } }
    }
}

__device__ __forceinline__ void p12_final(const Params& P, int blk, int nblk, int wv) {
    const int tid = my_tid(wv), wid = tid >> 6, lane = tid & 63;
    unsigned char* ws = opaque_ptr(P.ws);
    const float* sq = (const float*)(ws + WS_SQH) + (size_t)3 * T * 16; const f32x4* g4 = (const f32x4*)P.in[18]; const h16* H4 = (const h16*)(ws + WS_R1);
    const int gw = blk * NWAVES + wid, ngw = nblk * NWAVES;
    for (int r0 = gw; r0 < T; r0 += 4 * ngw) {
        h16x8 hv[4][2]; f32x4 qv[4][4];
#pragma unroll
        for (int k = 0; k < 4; ++k) { const int r = r0 + k * ngw; if (r < T) {
#pragma unroll
            for (int j = 0; j < 2; ++j) hv[k][j] = *(const h16x8*)(H4 + (size_t)r * 1024 + (lane + 64 * j) * 8);
#pragma unroll
            for (int j = 0; j < 4; ++j) qv[k][j] = ((const f32x4*)(sq + (size_t)r * 16))[j]; } }
#pragma unroll
        for (int k = 0; k < 4; ++k) { const int r = r0 + k * ngw; if (r < T) {
            float s = 0.f;
#pragma unroll
            for (int j = 0; j < 4; ++j) s += (qv[k][j][0] + qv[k][j][1]) + (qv[k][j][2] + qv[k][j][3]);
            const float rstd = rsqrtf(s * (1.0f / 1024.0f) + EPS);
            f32x4* orow = (f32x4*)(P.out + (size_t)r * 1024);
#pragma unroll
            for (int j = 0; j < 2; ++j) { const int c4 = (lane + 64 * j) * 2; const f32x4 ga = g4[c4], gb = g4[c4 + 1]; f32x4 a, b2;
#pragma unroll
                for (int e = 0; e < 4; ++e) { a[e] = (float)hv[k][j][e] * rstd * ga[e]; b2[e] = (float)hv[k][j][4 + e] * rstd * gb[e]; }
                orow[c4] = a; orow[c4 + 1] = b2; } } }
    }
}

#define XB_TMO      128
#define XB_XCNT(j)  (256  + 64 * (j))
#define XB_XSUB(j)  (1280 + 64 * (j))
#define XB_XGEN(j)  (2304 + 64 * (j))
#define XB_TOP      3328
#define XB_TOPGEN   3392
#define XCD_BAR_WORDS 3456
#define XB_SPIN_CAP (1u << 18)
__device__ __forceinline__ unsigned xb_ld(unsigned* p)              { return __hip_atomic_load(p, __ATOMIC_RELAXED, __HIP_MEMORY_SCOPE_AGENT); }
__device__ __forceinline__ unsigned xb_add(unsigned* p, unsigned v) { return __hip_atomic_fetch_add(p, v, __ATOMIC_RELAXED, __HIP_MEMORY_SCOPE_AGENT); }
__device__ __forceinline__ unsigned xb_xcc_id() { return (unsigned)__builtin_amdgcn_s_getreg((3 << 11) | 20) & 0xFu; }
#define XB_SPIN(cond, bar) do { unsigned _sp = 0; while (cond) { __builtin_amdgcn_s_sleep(1); \
    if ((++_sp & 255u) == 0u) { if (xb_ld(&(bar)[XB_TMO])) break; if (_sp > XB_SPIN_CAP) { atomicAdd(&(bar)[XB_TMO], 1u); break; } } } } while (0)
typedef volatile __attribute__((address_space(3))) unsigned lvu32;
__device__ __forceinline__ void xcd_barrier_complete(unsigned* bar, unsigned x, unsigned G, unsigned& nloc, unsigned& nx) {
    unsigned sum, cnt, mine, sp = 0u;
    for (;;) {
        sum = 0u; cnt = 0u; mine = 0u;
#pragma unroll
        for (unsigned j = 0; j < 16; ++j) { const unsigned c = xb_ld(&bar[XB_XCNT(j)]); sum += c; cnt += (c > 0u) ? 1u : 0u; mine = (j == x) ? c : mine; }
        if (sum == G) break;
        __builtin_amdgcn_s_sleep(1);
        if ((++sp & 255u) == 0u) { if (xb_ld(&bar[XB_TMO])) break; if (sp > XB_SPIN_CAP) { atomicAdd(&bar[XB_TMO], 1u); break; } }
    }
    nloc = mine > 0u ? mine : 1u; nx = cnt > 0u ? cnt : 1u;
}
__device__ __forceinline__ void xcd_barrier(unsigned* bar_, unsigned x_, lvu32* st, unsigned G, int wv) {
    unsigned x = x_; asm volatile("" : "+s"(x));
    unsigned* bar = opaque_ptr(bar_);
    asm volatile("s_waitcnt vmcnt(0)" ::: "memory");
    __syncthreads();
    if (my_tid(wv) == 0) {
        __builtin_amdgcn_s_waitcnt(0);
        unsigned nloc = st[0], nx = st[1];
        if (nloc == 0u) { xcd_barrier_complete(bar, x, G, nloc, nx); st[0] = nloc; st[1] = nx; }
        const unsigned old = xb_add(&bar[XB_XSUB(x)], 1u);
        const unsigned gen = old / nloc;
        if (old + 1u == (gen + 1u) * nloc) {
            __builtin_amdgcn_fence(__ATOMIC_RELEASE, "agent");
            asm volatile("s_waitcnt vmcnt(0)" ::: "memory");
            const unsigned og = xb_add(&bar[XB_TOP], 1u);
            const unsigned tg = og / nx;
            if (og + 1u == (tg + 1u) * nx) xb_add(&bar[XB_TOPGEN], 1u);
            else XB_SPIN(xb_ld(&bar[XB_TOPGEN]) == tg, bar);
            __builtin_amdgcn_fence(__ATOMIC_ACQUIRE, "agent");
            xb_add(&bar[XB_XGEN(x)], 1u);
            asm volatile("s_waitcnt vmcnt(0)" ::: "memory");
        } else {
            XB_SPIN(xb_ld(&bar[XB_XGEN(x)]) == gen, bar);
            __builtin_amdgcn_fence(__ATOMIC_ACQUIRE, "agent");
            asm volatile("s_waitcnt vmcnt(0)" ::: "memory");
        }
    }
    __syncthreads();
}

__device__ __forceinline__ void run_gemm_job(const Params& P, unsigned char* lds, int ph, int j, int blk, int nblk, int wv) {
    unsigned char* ws = opaque_ptr(P.ws);
    float* SQKV = (float*)(ws + WS_SQKV); float* SQQ = (float*)(ws + WS_SQQ); float* SQH = (float*)(ws + WS_SQH);
    int kind = 0; Gemm g; g.M = T; g.A = nullptr; g.Bt = nullptr; g.lda = g.ldb = g.N = g.K = 0;
    h16 *h0 = nullptr, *h1 = nullptr; const h16* ch0 = nullptr; const h16* ch1 = nullptr; const float* cf0 = nullptr; float* f0 = nullptr; float* f1 = nullptr; int i0 = 0, i1 = 0, i2 = 0, i3 = 0, i4 = 0; float x0 = 0.f;
    if (ph == 1) { kind = 0; g.A = (const h16*)(ws + WS_R1); g.Bt = (const h16*)(ws + WS_WAIN); g.lda = 1024; g.ldb = 1024; g.N = 1792; g.K = 1024; }
    else if (ph == 2) {
        kind = 1;
        if (j == 0) { g.A = (const h16*)(ws + WS_CQX); g.Bt = (const h16*)(ws + WS_WQ); g.lda = 512; g.ldb = 384; g.N = 1536; g.K = 384;
                      cf0 = SQQ; i0 = 8; x0 = 1.0f / 384.0f; h0 = (h16*)(ws + WS_R1); h1 = (h16*)(ws + WS_QIDX); i1 = 1024; i2 = 512; i3 = 1; i4 = 0; }
        else if (j == 1) { g.A = (const h16*)(ws + WS_CKV); g.Bt = (const h16*)(ws + WS_WKV); g.lda = 256; g.ldb = 256; g.N = 2048; g.K = 256;
                      cf0 = SQKV; i0 = 4; x0 = 1.0f / 256.0f; h0 = (h16*)(ws + WS_R2); h1 = (h16*)(ws + WS_R3); i1 = 1024; i2 = 1024; i3 = 1; i4 = 1; }
        else { g.A = (const h16*)(ws + WS_PH0); g.Bt = (const h16*)(ws + WS_WPLE); g.lda = 256; g.ldb = 256; g.N = 1024; g.K = 256;
                      cf0 = nullptr; i0 = 0; x0 = 0.f; h0 = (h16*)(ws + WS_R5); h1 = nullptr; i1 = 1024; i2 = 1024; }
    }
    else if (ph == 5) { kind = 2; g.A = (const h16*)(ws + WS_AO); g.Bt = (const h16*)(ws + WS_WAOUT); g.lda = 1024; g.ldb = 1024; g.N = 1024; g.K = 1024;
                      cf0 = P.in[0]; ch0 = nullptr; h0 = (h16*)(ws + WS_R2); f1 = SQH; }
    else if (ph == 6) { kind = 3; g.A = (const h16*)(ws + WS_R2); g.Bt = (const h16*)(ws + WS_WPG); g.lda = 1024; g.ldb = 1024; g.N = 1024; g.K = 1024;
                      ch1 = (const h16*)(ws + WS_R2); ch0 = (const h16*)(ws + WS_R5); h0 = (h16*)(ws + WS_R3); cf0 = SQH; f1 = SQH + (size_t)T * 16; }
    else if (ph == 7) { kind = 4; g.A = (const h16*)(ws + WS_R3); g.Bt = (const h16*)(ws + WS_WRIN); g.lda = 1024; g.ldb = 1024; g.N = 6144; g.K = 1024; }
    else if (ph == 10) {
        if (j == 0) { kind = 2; g.A = (const h16*)(ws + WS_R4); g.Bt = (const h16*)(ws + WS_WROUT); g.lda = 2048; g.ldb = 2048; g.N = 1024; g.K = 2048;
                      cf0 = nullptr; ch0 = (const h16*)(ws + WS_R3); h0 = (h16*)(ws + WS_R2); f1 = SQH + (size_t)2 * T * 16; }
        else { kind = 1; g.A = (const h16*)(ws + WS_PH1); g.Bt = (const h16*)(ws + WS_WPLE) + (size_t)1024 * 256; g.lda = 256; g.ldb = 256; g.N = 1024; g.K = 256;
                      cf0 = nullptr; i0 = 0; x0 = 0.f; h0 = (h16*)(ws + WS_R1); h1 = nullptr; i1 = 1024; i2 = 1024; }
    }
    else { kind = 5; g.A = (const h16*)(ws + WS_R2); g.Bt = (const h16*)(ws + WS_WPG) + (size_t)1024 * 1024; g.lda = 1024; g.ldb = 1024; g.N = 1024; g.K = 1024;
                      ch1 = (const h16*)(ws + WS_R2); ch0 = (const h16*)(ws + WS_R1); h0 = (h16*)(ws + WS_R1); cf0 = SQH + (size_t)2 * T * 16; f1 = SQH + (size_t)3 * T * 16; }
    switch (kind) {
        case 0: { EpiInA E{(h16*)(ws + WS_CKV), (h16*)(ws + WS_CQX), (h16*)(ws + WS_R4), SQKV, SQQ, nullptr, 0, 0.f}; gemm_run(lds, g, E, blk, nblk, wv); break; }
        case 1: { EpiScale E{cf0, i0, x0, h0, h1, 4, i1, i2, i3, i4}; gemm_run(lds, g, E, blk, nblk, wv); break; }
        case 2: { EpiRes E{cf0, ch0, h0, f1, nullptr, 0, 0.f}; gemm_run(lds, g, E, blk, nblk, wv); break; }
        case 3: { EpiPle E{ch1, ch0, h0, cf0, f1, 16, 1.0f / 1024.0f}; gemm_run(lds, g, E, blk, nblk, wv); break; }
        case 5: { EpiPleFinal E{ch1, ch0, cf0, 16, 1.0f / 1024.0f, P.in[18], P.out, (unsigned*)(SQH + (size_t)3 * T * 16), (unsigned*)(ws + WS_BAR + 16384), (unsigned*)(ws + WS_BAR) + XB_TMO}; gemm_run(lds, g, E, blk, nblk, wv); break; }
        default: { EpiInR E{SQH + (size_t)T * 16, (const f32x2*)(ws + WS_SINCOS), (h16*)(ws + WS_R1), (h16*)(ws + WS_R2), (h16*)(ws + WS_R4), (h16*)(ws + WS_RG), 16, 1.0f / 1024.0f}; gemm_run(lds, g, E, blk, nblk, wv); break; }
    }
}

__global__ void __launch_bounds__(NTHREADS, 2) mk_fwd(Params P_) {
    extern __shared__ __attribute__((aligned(16))) unsigned char lds[];
    cg::grid_group grid = cg::this_grid();
    const int wv = __builtin_amdgcn_readfirstlane((int)(threadIdx.x >> 6));
    lvu32* bst = (lvu32*)(lds + LDS_BYTES - 16);
    unsigned* bar = (unsigned*)(P_.ws + WS_BAR);
    const unsigned xcc = xb_xcc_id();
    if (threadIdx.x == 0) { bst[0] = 0u; bst[1] = 0u; if (P_.ph_hi - P_.ph_lo > 1) (void)xb_add(&bar[XB_XCNT(xcc)], 1u); }
    __syncthreads();
    int dup_cnt = 0; (void)dup_cnt;
    const int blk_k = blockIdx.x, nblk_k = gridDim.x; const int ph_lo = P_.ph_lo, ph_hi = P_.ph_hi;
    for (int ph = ph_lo; ph < ph_hi; ++ph) {
        int blk = blk_k, nblk = nblk_k; asm volatile("" : "+s"(blk), "+s"(nblk));
        const Params& P = P_;
        if (ph == 0) p0_prologue(P, lds, blk, nblk, wv);
        else if (ph == 3) p3_indexer(P, lds, blk, nblk, wv);
        else if (ph == 4) p4_attn(P, lds, blk, nblk, wv);
        else if (ph == 8) p8_retention(P, lds, blk, nblk, wv);
        else if (ph == 9) { if (nblk != 256) p9_gnorm(P, blk, nblk, wv); }
        else {
            if (ph == 2) p2_kidx(P, blk, nblk, wv);
            if (ph == 5) {
                unsigned ones = ~0u; asm volatile("" : "+v"(ones)); u32x4* xs_ = (u32x4*)(opaque_ptr(P.ws) + WS_KIDXN);
                for (int i = blk * NTHREADS + my_tid(wv); i < (4 << 20) / 16; i += nblk * NTHREADS) xs_[i] = (u32x4){ones, ones, ones, ones};
            }
            const int nj = (ph == 2) ? 3 : (ph == 10) ? 2 : 1;
            for (int j = 0; j < nj; ++j) run_gemm_job(P, lds, ph, j, blk, nblk, wv);
        }
        if (ph + 1 < ph_hi && !(ph == 8 && nblk == 256)) { if (ph_hi < 0) grid.sync(); else xcd_barrier(bar, xcc, bst, (unsigned)nblk, wv); }
#if MK_DUP_MASK
        if (((MK_DUP_MASK >> ph) & 1) && dup_cnt < MK_DUP_N) { ++dup_cnt; --ph; } else dup_cnt = 0;
#endif
    }
}

#ifndef MK_FUSED
#define MK_FUSED 1
#endif
extern "C" void kernel_launch(void* const* d_in, const int* in_sizes, int n_in, void* d_out, int out_size, void* d_ws, size_t ws_size, hipStream_t stream) {
    static int grid = 0;
    if (grid == 0) {
        if (n_in != 19 || out_size != T * D || ws_size < WS_END) { fprintf(stderr, "kernel_launch: unexpected shapes (n_in %d, out %d, ws %zu)\n", n_in, out_size, ws_size); grid = -1; return; }
        int dev = 0, cus = 0, per_cu = 0;
        hipGetDevice(&dev);
        hipDeviceGetAttribute(&cus, hipDeviceAttributeMultiprocessorCount, dev);
        if (hipFuncSetAttribute((const void*)mk_fwd, hipFuncAttributeMaxDynamicSharedMemorySize, LDS_BYTES) != hipSuccess) { fprintf(stderr, "kernel_launch: hipFuncSetAttribute failed\n"); grid = -1; return; }
        hipOccupancyMaxActiveBlocksPerMultiprocessor(&per_cu, (const void*)mk_fwd, NTHREADS, LDS_BYTES);
        if (per_cu < 1) { fprintf(stderr, "kernel_launch: occupancy query says %d blocks per CU\n", per_cu); grid = -1; return; }
        grid = cus * 1;
    }
    if (grid < 0) return;
    (void)hipMemsetAsync((char*)d_ws + WS_BAR, 0, 16384 + 32768, stream);
    Params P{};
    for (int i = 0; i < 19; ++i) P.in[i] = (const float*)d_in[i];
    P.out = (float*)d_out; P.ws = (unsigned char*)d_ws;
#if MK_FUSED
    P.ph_lo = 0; P.ph_hi = NPH;
    void* args[] = {&P};
    hipError_t e = hipLaunchCooperativeKernel((const void*)mk_fwd, dim3(grid), dim3(NTHREADS), args, LDS_BYTES, stream);
    if (e != hipSuccess) fprintf(stderr, "cooperative launch failed: %s (grid %d)\n", hipGetErrorString(e), grid);
#else
    for (int ph = 0; ph < NPH; ++ph) {
        P.ph_lo = ph; P.ph_hi = ph + 1;
        hipLaunchKernelGGL(mk_fwd, dim3(grid), dim3(NTHREADS), LDS_BYTES, stream, P);
    }
#endif
}
```

```cpp
#include <hip/hip_runtime.h>
#include <hip/hip_cooperative_groups.h>
#include <cstdio>
#include <cstdint>
namespace cg = cooperative_groups;
#ifndef MK_DUP_MASK
#define MK_DUP_MASK 0
#endif
#ifndef MK_P3_REPA
#define MK_P3_REPA 0
#endif
#ifndef MK_P3_REPB
#define MK_P3_REPB 0
#endif
#ifndef MK_EPI_REP
#define MK_EPI_REP 0
#endif
#ifndef MK_DUP_N
#define MK_DUP_N 3
#endif

typedef _Float16 h16;
typedef _Float16 h16x2 __attribute__((ext_vector_type(2)));
typedef _Float16 h16x4 __attribute__((ext_vector_type(4)));
typedef _Float16 h16x8 __attribute__((ext_vector_type(8)));
typedef float f32x2 __attribute__((ext_vector_type(2)));
typedef float f32x4 __attribute__((ext_vector_type(4)));
typedef unsigned u32x4 __attribute__((ext_vector_type(4)));

constexpr int NB = 16, L = 2048, T = NB * L, D = 1024;
constexpr float EPS = 1e-6f;
constexpr int NPH = 12;
constexpr int NTHREADS = 512, NWAVES = 8;
constexpr int LDS_BYTES = 163840;

constexpr size_t MiB = (size_t)1 << 20;
constexpr size_t WS_WAIN = 0 * MiB;
constexpr size_t WS_WQ = 4 * MiB;
constexpr size_t WS_WKV = 6 * MiB;
constexpr size_t WS_WAOUT = 7 * MiB;
constexpr size_t WS_WPG = 9 * MiB;
constexpr size_t WS_WPLE = 13 * MiB;
constexpr size_t WS_WRIN = 14 * MiB;
constexpr size_t WS_WROUT = 26 * MiB;
constexpr size_t WS_SINCOS = 30 * MiB;
constexpr size_t WS_SQKV = 32 * MiB;
constexpr size_t WS_SQQ = 33 * MiB;
constexpr size_t WS_SQH = 34 * MiB;
constexpr size_t WS_KIDXN = 42 * MiB;
constexpr size_t WS_WIDX = 46 * MiB;
constexpr size_t WS_BAR = 47 * MiB;
constexpr size_t WS_PH1 = 48 * MiB;
constexpr size_t WS_R1 = 64 * MiB;
constexpr size_t WS_R2 = 128 * MiB;
constexpr size_t WS_R3 = 192 * MiB;
constexpr size_t WS_R4 = 256 * MiB;
constexpr size_t WS_R5 = 320 * MiB;
constexpr size_t WS_PH0 = 384 * MiB;
constexpr size_t WS_CQX = 400 * MiB;
constexpr size_t WS_CKV = 432 * MiB;
constexpr size_t WS_QIDX = 448 * MiB;
constexpr size_t WS_MASK = 480 * MiB;
constexpr size_t WS_AO = 400 * MiB;
constexpr size_t WS_RG = 384 * MiB;
constexpr size_t WS_END = 512 * MiB;

struct Params { const float* in[19]; float* out; unsigned char* ws; int ph_lo, ph_hi; };

__constant__ float kAngle[128] = {
    1.000000000e+00f, 9.300450087e-01f, 8.649836779e-01f, 8.044736385e-01f, 7.481966019e-01f, 6.958565116e-01f, 6.471778154e-01f, 6.019044518e-01f,
    5.597981811e-01f, 5.206375122e-01f, 4.842162728e-01f, 4.503428936e-01f, 4.188391268e-01f, 3.895392120e-01f, 3.622889817e-01f, 3.369450271e-01f,
    3.133740425e-01f, 2.914519310e-01f, 2.710633874e-01f, 2.521011233e-01f, 2.344653904e-01f, 2.180633694e-01f, 2.028087080e-01f, 1.886212230e-01f,
    1.754262149e-01f, 1.631542742e-01f, 1.517407894e-01f, 1.411257535e-01f, 1.312533021e-01f, 1.220714748e-01f, 1.135319397e-01f, 1.055898219e-01f,
    9.820328653e-02f, 9.133346379e-02f, 8.494423330e-02f, 7.900195569e-02f, 7.347535342e-02f, 6.833537668e-02f, 6.355497986e-02f, 5.910899118e-02f,
    5.497401953e-02f, 5.112830922e-02f, 4.755162448e-02f, 4.422515258e-02f, 4.113136977e-02f, 3.825402260e-02f, 3.557796404e-02f, 3.308910504e-02f,
    3.077435680e-02f, 2.862153389e-02f, 2.661931701e-02f, 2.475716174e-02f, 2.302526683e-02f, 2.141453326e-02f, 1.991648041e-02f, 1.852322184e-02f,
    1.722742990e-02f, 1.602228358e-02f, 1.490144618e-02f, 1.385901403e-02f, 1.288950257e-02f, 1.198781747e-02f, 1.114920899e-02f, 1.036926545e-02f,
    9.643883444e-03f, 8.969245479e-03f, 8.341802284e-03f, 7.758250926e-03f, 7.215522230e-03f, 6.710760761e-03f, 6.241309457e-03f, 5.804697983e-03f,
    5.398627371e-03f, 5.020966288e-03f, 4.669724498e-03f, 4.343053792e-03f, 4.039235413e-03f, 3.756670747e-03f, 3.493872471e-03f, 3.249458736e-03f,
    3.022142686e-03f, 2.810728736e-03f, 2.614103956e-03f, 2.431234345e-03f, 2.261157380e-03f, 2.102978062e-03f, 1.955864020e-03f, 1.819041790e-03f,
    1.691789716e-03f, 1.573440502e-03f, 1.463370281e-03f, 1.361000235e-03f, 1.265791478e-03f, 1.177242957e-03f, 1.094888896e-03f, 1.018295996e-03f,
    9.470609948e-04f, 8.808093844e-04f, 8.191923262e-04f, 7.618857198e-04f, 7.085879333e-04f, 6.590186385e-04f, 6.129170069e-04f, 5.700403708e-04f,
    5.301629426e-04f, 4.930753494e-04f, 4.585822753e-04f, 4.265021416e-04f, 3.966661752e-04f, 3.689173318e-04f, 3.431097430e-04f, 3.191074939e-04f,
    2.967843320e-04f, 2.760227653e-04f, 2.567135962e-04f, 2.387551940e-04f, 2.220530587e-04f, 2.065193403e-04f, 1.920722716e-04f, 1.786358480e-04f,
    1.661392889e-04f, 1.545170089e-04f, 1.437077590e-04f, 1.336546848e-04f, 1.243048755e-04f, 1.156091312e-04f, 1.075216787e-04f, 9.999999747e-05f,
};

__device__ __forceinline__ float wave_sum(float v) {
#pragma unroll
    for (int o = 1; o < 64; o <<= 1) v += __shfl_xor(v, o);
    return v;
}
__device__ __forceinline__ float wave_max(float v) {
#pragma unroll
    for (int o = 1; o < 64; o <<= 1) v = fmaxf(v, __shfl_xor(v, o));
    return v;
}
#define DPP_RED6S(v, F) do { v = F<0x111, 0xf>(v); v = F<0x112, 0xf>(v); v = F<0x114, 0xf>(v); v = F<0x118, 0xf>(v); v = F<0x142, 0xa>(v); v = F<0x143, 0xc>(v); } while (0)
template <int CTRL, int RMASK> __device__ __forceinline__ float fadd_dpp_(float a) { return a + __builtin_bit_cast(float, __builtin_amdgcn_update_dpp(0, __builtin_bit_cast(int, a), CTRL, RMASK, 0xf, false)); }
__device__ __forceinline__ float wave_sum_dpp(float v) { DPP_RED6S(v, fadd_dpp_); return __builtin_bit_cast(float, __builtin_amdgcn_readlane(__builtin_bit_cast(int, v), 63)); }
__device__ __forceinline__ float dot4(f32x4 a) { return (a[0] * a[0] + a[1] * a[1]) + (a[2] * a[2] + a[3] * a[3]); }
__device__ __forceinline__ float fq_sum(float s) {
    { auto rr = __builtin_amdgcn_permlane16_swap(__float_as_uint(s), __float_as_uint(s), false, false); s = __uint_as_float(rr[0]) + __uint_as_float(rr[1]); }
    { auto rr = __builtin_amdgcn_permlane32_swap(__float_as_uint(s), __float_as_uint(s), false, false); s = __uint_as_float(rr[0]) + __uint_as_float(rr[1]); }
    return s;
}
__device__ __forceinline__ h16x8 pack8(f32x4 a, f32x4 b) {
    h16x8 r; r[0] = (h16)a[0]; r[1] = (h16)a[1]; r[2] = (h16)a[2]; r[3] = (h16)a[3]; r[4] = (h16)b[0]; r[5] = (h16)b[1]; r[6] = (h16)b[2]; r[7] = (h16)b[3]; return r;
}
__device__ __forceinline__ h16x4 pack4(f32x4 a) { h16x4 r; r[0] = (h16)a[0]; r[1] = (h16)a[1]; r[2] = (h16)a[2]; r[3] = (h16)a[3]; return r; }
__device__ __forceinline__ float sigmoidf_(float x) { return __builtin_amdgcn_rcpf(1.0f + __builtin_amdgcn_exp2f(-1.4426950408889634f * x)); }
__device__ __forceinline__ float siluf_(float x) { return x * __builtin_amdgcn_rcpf(1.0f + __builtin_amdgcn_exp2f(-1.4426950408889634f * x)); }
#define LDS_FENCE() do { asm volatile("s_waitcnt lgkmcnt(0)" ::: "memory"); } while (0)
__device__ __forceinline__ int my_tid(int wv) { unsigned m = ~0u; asm volatile("" : "+s"(m)); int t = wv * 64 + (int)__builtin_amdgcn_mbcnt_hi(m, __builtin_amdgcn_mbcnt_lo(m, 0u)); asm volatile("" : "+v"(t)); return t; }
template <class Tp> __device__ __forceinline__ Tp* opaque_ptr(Tp* p) { size_t z = 0; asm volatile("" : "+s"(z)); return p + z; }

#define PG8_LAS __attribute__((address_space(3)))
__device__ __forceinline__ constexpr int pg8_stage_bytes() { return 131072; }
struct Unit { int pm, pn; };
struct Gemm { const h16* A; const h16* Bt; int lda, ldb, M, N, K; };
__device__ __forceinline__ int perm32(int rho) { const int n = rho >> 4, i = rho & 15; return 8 * (i >> 2) + 4 * n + (i & 3); }

template <class Epi>
__device__ __forceinline__ void gemm_simple(const Gemm g, const Epi& E, int blk, int nblk, int wv) {
    const int tid = my_tid(wv), wid = __builtin_amdgcn_readfirstlane(tid >> 6), lane = tid & 63, wr = wid >> 2, wc = wid & 3, fr = lane & 15, fq = lane >> 4;
    const int nN = g.N / 256, nU = (g.M / 256) * nN;
    for (int u = blk; u < nU; u += nblk) {
        Unit un; un.pm = u / nN; un.pn = u % nN;
        f32x4 acc[2][2][4][2];
#pragma unroll
        for (int a = 0; a < 2; ++a)
#pragma unroll
            for (int b = 0; b < 2; ++b)
#pragma unroll
                for (int m = 0; m < 4; ++m)
#pragma unroll
                    for (int n = 0; n < 2; ++n) acc[a][b][m][n] = (f32x4){0.f, 0.f, 0.f, 0.f};
        const h16* Ap = g.A + (size_t)(un.pm * 256 + wr * 64 + fr) * g.lda + fq * 8;
        const h16* Bp[2];
#pragma unroll
        for (int n = 0; n < 2; ++n) Bp[n] = g.Bt + (size_t)(un.pn * 256 + wc * 32 + (Epi::PERM ? perm32(16 * n + fr) : 16 * n + fr)) * g.ldb + fq * 8;
        for (int k0 = 0; k0 < g.K; k0 += 32) {
            h16x8 At[2][4], Bt[2][2];
#pragma unroll
            for (int ai = 0; ai < 2; ++ai)
#pragma unroll
                for (int m = 0; m < 4; ++m) At[ai][m] = *(const h16x8*)(Ap + (size_t)(ai * 128 + m * 16) * g.lda + k0);
#pragma unroll
            for (int bj = 0; bj < 2; ++bj)
#pragma unroll
                for (int n = 0; n < 2; ++n) Bt[bj][n] = *(const h16x8*)(Bp[n] + (size_t)(bj * 128) * g.ldb + k0);
#pragma unroll
            for (int ai = 0; ai < 2; ++ai)
#pragma unroll
                for (int bj = 0; bj < 2; ++bj)
#pragma unroll
                    for (int m = 0; m < 4; ++m)
#pragma unroll
                        for (int n = 0; n < 2; ++n) acc[ai][bj][m][n] = __builtin_amdgcn_mfma_f32_16x16x32_f16(Bt[bj][n], At[ai][m], acc[ai][bj][m][n], 0, 0, 0);
        }
        E(acc, un, wr, wc, fr, fq, nullptr);
    }
}

template <class E_> struct epi_fused { template <class X> static constexpr bool g(decltype(X::FUSED_FINAL)*) { return X::FUSED_FINAL; } template <class X> static constexpr bool g(...) { return false; } static constexpr bool v = g<E_>(nullptr); };
namespace pg8 {
constexpr int BM = 256, BK = 64, HALF = 128, HTB = HALF * BK * 2  , STAGE_BYTES = 8 * HTB, NXCD = 8, WGM = 8;
__host__ __device__ __forceinline__ int lds_byte(int r, int c) { const int st = (r >> 4) * 2 + (c >> 5), rr = r & 15, cc = c & 31, ob = rr * 64 + cc * 2; return st * 1024 + (ob ^ (((ob >> 9) & 1) << 5)); }
__host__ __device__ __forceinline__ void stage_rc(int b, int& R, int& C) { const int st = b / 1024, sb = b % 1024, swz = sb ^ (((sb >> 9) & 1) << 5); R = (st >> 1) * 16 + swz / 64; C = (st & 1) * 32 + (swz % 64) / 2; }
struct StaticOrder {
    int nM, nN, nwg, G, c;
    __host__ __device__ void init(int M, int N, int G_, int c_) { nM = M / BM; nN = N / BM; nwg = nM * nN; G = G_; c = c_; }
    __host__ __device__ bool next(int i, Unit& u) const {
        const long Lq = (long)i * G + c; if (Lq >= nwg) return false;
        int wgid = (int)Lq; { const int q = nwg / NXCD, r = nwg % NXCD, xcd = wgid % NXCD, off = wgid / NXCD; wgid = (xcd < r ? xcd * (q + 1) : r * (q + 1) + (xcd - r) * q) + off; }
        const int nig = WGM * nN, gid = wgid / nig, fm = gid * WGM, gsz = (nM - fm) < WGM ? (nM - fm) : WGM;
        u.pm = fm + ((wgid % nig) % gsz); u.pn = (wgid % nig) / gsz; return true;
    }
};
template <class Epi, bool ALIGN_EPI = true>
__device__ __forceinline__ void gemm_phase(PG8_LAS unsigned char* lds, const Gemm g, const StaticOrder& S, const Epi& E, int wv) {
    const int tid = my_tid(wv), wid = __builtin_amdgcn_readfirstlane(tid >> 6), lane = tid & 63, wr = wid >> 2, wc = wid & 3, fr = lane & 15, fq = lane >> 4;
    const int K = g.K, nt = K / BK;
    unsigned voffA[2], voffB[2];
#pragma unroll
    for (int i = 0; i < 2; ++i) { int R, C; stage_rc(tid * 16 + i * 8192, R, C); const int Rb = Epi::PERM ? ((R & ~31) + perm32(R & 31)) : R;
        voffA[i] = (unsigned)(R * g.lda + C) * 2u; voffB[i] = (unsigned)(Rb * g.ldb + C) * 2u; }
    const size_t kstep = (size_t)(BK * 2);
    const size_t hstepA = (size_t)HALF * g.lda * 2, hstepB = (size_t)HALF * g.ldb * 2;
    const size_t tstepA = 2 * hstepA, tstepB = 2 * hstepB;
    const unsigned ldsw = (unsigned)wid * 1024u;
    const int aoff = lds_byte(wr * 64 + fr, fq * 8), boff = lds_byte(wc * 32 + fr, fq * 8);
#define PG8_SA(b, h) (((b) * 2 + (h)) * HTB)
#define PG8_SB(b, h) ((4 + (b) * 2 + (h)) * HTB)
#define PG8_STAGE(bufoff, gbase, voff) do { _Pragma("unroll") for (int _i = 0; _i < 2; ++_i) \
        __builtin_amdgcn_global_load_lds((const unsigned*)((const char*)(gbase) + (voff)[_i]), (PG8_LAS unsigned*)(lds + (bufoff) + ldsw + _i * 8192), 16, 0, 0); } while (0)
#define PG8_LDA(dst, b, h) do { _Pragma("unroll") for (int m = 0; m < 4; ++m) _Pragma("unroll") for (int k = 0; k < 2; ++k) dst[m][k] = *(const PG8_LAS h16x8*)(lds + PG8_SA(b, h) + aoff + m * 2048 + k * 1024); } while (0)
#define PG8_LDB(dst, b, h) do { _Pragma("unroll") for (int n = 0; n < 2; ++n) _Pragma("unroll") for (int k = 0; k < 2; ++k) dst[n][k] = *(const PG8_LAS h16x8*)(lds + PG8_SB(b, h) + boff + n * 2048 + k * 1024); } while (0)
#define PG8_MMA(ai, bj, At, Bt) do { __builtin_amdgcn_s_setprio(1); _Pragma("unroll") for (int m = 0; m < 4; ++m) _Pragma("unroll") for (int n = 0; n < 2; ++n) _Pragma("unroll") for (int k = 0; k < 2; ++k) \
        acc[ai][bj][m][n] = __builtin_amdgcn_mfma_f32_16x16x32_f16(Bt[n][k], At[m][k], acc[ai][bj][m][n], 0, 0, 0); __builtin_amdgcn_s_setprio(0); } while (0)
#define PG8_WAIT_V(n) asm volatile("s_waitcnt vmcnt(" #n ")" ::: "memory")
#define PG8_WAIT_L(n) asm volatile("s_waitcnt lgkmcnt(" #n ")" ::: "memory")
#define PG8_BAR __builtin_amdgcn_s_barrier()
#define PG8_SCHED __builtin_amdgcn_sched_barrier(0)
    Unit cur, nxt; int ui = 0;
    if (!S.next(0, cur)) return;
    PG8_LAS float* rtab = (PG8_LAS float*)(lds + STAGE_BYTES);
#define PG8_FILL(U, PAR) do { const int tf_ = my_tid(wv); if (E.sqp != nullptr && tf_ < 256) { const size_t r_ = (size_t)(U).pm * 256 + tf_; float s_ = 0.f; \
        for (int j_ = 0; j_ < E.sqn; j_ += 4) { const f32x4 q_ = *(const f32x4*)(E.sqp + r_ * E.sqn + j_); s_ += (q_[0] + q_[1]) + (q_[2] + q_[3]); } \
        rtab[(PAR) * 256 + tf_] = rsqrtf(s_ * E.sqi + EPS); } } while (0)
    PG8_FILL(cur, 0);
    f32x4 acc[2][2][4][2];
#pragma unroll
    for (int a = 0; a < 2; ++a)
#pragma unroll
        for (int b = 0; b < 2; ++b)
#pragma unroll
            for (int m = 0; m < 4; ++m)
#pragma unroll
                for (int n = 0; n < 2; ++n) acc[a][b][m][n] = (f32x4){0.f, 0.f, 0.f, 0.f};
    h16x8 At[4][2], B0[2][2], B1[2][2];
    const char* cA = (const char*)g.A + (size_t)cur.pm * tstepA; const char* cB = (const char*)g.Bt + (size_t)cur.pn * tstepB;
    PG8_STAGE(PG8_SB(0, 0), cB, voffB); PG8_STAGE(PG8_SB(0, 1), cB + hstepB, voffB); PG8_STAGE(PG8_SA(0, 0), cA, voffA); PG8_STAGE(PG8_SA(0, 1), cA + hstepA, voffA);
    if (wr == 1) PG8_BAR;
    PG8_WAIT_V(2); PG8_BAR;
    PG8_STAGE(PG8_SB(1, 0), cB + kstep, voffB); PG8_STAGE(PG8_SA(1, 0), cA + kstep, voffA); PG8_STAGE(PG8_SB(1, 1), cB + hstepB + kstep, voffB);
    PG8_WAIT_V(6); PG8_BAR;
    for (;;) {
        const bool has_next = S.next(ui + 1, nxt);
        const char* nA = has_next ? (const char*)g.A + (size_t)nxt.pm * tstepA : cA; const char* nB = has_next ? (const char*)g.Bt + (size_t)nxt.pn * tstepB : cB;
        for (int t = 0; t < nt; t += 2) {
            const bool last = (t == nt - 2);
            const char* a1 = cA + (size_t)(t + 1) * kstep;
            const char* a2 = last ? nA : cA + (size_t)(t + 2) * kstep; const char* b2 = last ? nB : cB + (size_t)(t + 2) * kstep;
            const char* a3 = a2 + kstep; const char* b3 = b2 + kstep;
            PG8_LDB(B0, 0, 0); PG8_LDB(B1, 0, 1); PG8_SCHED; PG8_LDA(At, 0, 0); PG8_STAGE(PG8_SA(1, 1), a1 + hstepA, voffA);
            PG8_WAIT_V(8); PG8_WAIT_L(0); PG8_BAR; PG8_MMA(0, 0, At, B0); PG8_MMA(0, 1, At, B1); PG8_BAR; PG8_SCHED;
            PG8_LDA(At, 0, 1); PG8_STAGE(PG8_SB(0, 0), b2, voffB); PG8_STAGE(PG8_SB(0, 1), b2 + hstepB, voffB); PG8_STAGE(PG8_SA(0, 0), a2, voffA);
            PG8_WAIT_V(8); PG8_WAIT_L(0); PG8_BAR; PG8_MMA(1, 0, At, B0); PG8_MMA(1, 1, At, B1); PG8_BAR; PG8_SCHED;
            PG8_LDB(B0, 1, 0); PG8_LDB(B1, 1, 1); PG8_SCHED; PG8_LDA(At, 1, 0); PG8_STAGE(PG8_SA(0, 1), a2 + hstepA, voffA);
            PG8_WAIT_V(8); PG8_WAIT_L(0); PG8_BAR; PG8_MMA(0, 0, At, B0); PG8_MMA(0, 1, At, B1); PG8_BAR; PG8_SCHED;
            PG8_LDA(At, 1, 1); PG8_STAGE(PG8_SB(1, 0), b3, voffB); PG8_STAGE(PG8_SB(1, 1), b3 + hstepB, voffB); PG8_STAGE(PG8_SA(1, 0), a3, voffA);
            PG8_WAIT_V(8); PG8_WAIT_L(0); PG8_BAR; PG8_MMA(1, 0, At, B0); PG8_MMA(1, 1, At, B1); PG8_BAR; PG8_SCHED;
        }
        if constexpr (ALIGN_EPI) { if (wr == 0) PG8_BAR; }
        { const int te_ = my_tid(wv), le_ = te_ & 63;
          if constexpr (epi_fused<Epi>::v) E.final(acc, cur, wr, wc, le_ & 15, le_ >> 4, rtab + (ui & 1) * 256, lds, te_); else E(acc, cur, wr, wc, le_ & 15, le_ >> 4, rtab + (ui & 1) * 256); }
        if (has_next) PG8_FILL(nxt, (ui + 1) & 1);
        if (!has_next) break;
#pragma unroll
        for (int a = 0; a < 2; ++a)
#pragma unroll
            for (int b = 0; b < 2; ++b)
#pragma unroll
                for (int m = 0; m < 4; ++m)
#pragma unroll
                    for (int n = 0; n < 2; ++n) acc[a][b][m][n] = (f32x4){0.f, 0.f, 0.f, 0.f};
        cur = nxt; cA = nA; cB = nB; ++ui;
        if constexpr (ALIGN_EPI) { if (wr == 1) PG8_BAR; }
    }
    PG8_WAIT_V(0);
    if constexpr (!ALIGN_EPI) { if (wr == 0) PG8_BAR; }
    PG8_BAR;
#undef PG8_FILL
#undef PG8_SA
#undef PG8_SB
#undef PG8_STAGE
#undef PG8_LDA
#undef PG8_LDB
#undef PG8_MMA
#undef PG8_WAIT_V
#undef PG8_WAIT_L
#undef PG8_BAR
#undef PG8_SCHED
}
}
template <class Epi>
__device__ __forceinline__ void gemm_run(unsigned char* lds, const Gemm g, const Epi& E, int blk, int nblk, int wv) {
    pg8::StaticOrder S; S.init(g.M, g.N, nblk, blk);
    pg8::gemm_phase<Epi, true>((PG8_LAS unsigned char*)lds, g, S, E, wv);
}

struct EpiInA {
    static constexpr bool PERM = true;
    h16* ckv; h16* cqx; h16* sg; float* sqkv; float* sqq; const float* sqp; int sqn; float sqi;
    __device__ __forceinline__ void operator()(const f32x4 (&acc)[2][2][4][2], const Unit& u, int wr, int wc, int fr, int fq, const PG8_LAS float* rtab) const {
        asm volatile("" : "+v"(fr), "+v"(fq));
#pragma unroll
        for (int ai = 0; ai < 2; ++ai)
#pragma unroll
            for (int m = 0; m < 4; ++m) {
                const size_t r = (size_t)u.pm * 256 + ai * 128 + wr * 64 + m * 16 + fr;
                float ss = 0.f;
#pragma unroll
                for (int bj = 0; bj < 2; ++bj) {
                    const int c0 = bj * 128 + wc * 32 + 8 * fq;
                    f32x4 v0 = acc[ai][bj][m][0], v1 = acc[ai][bj][m][1];
                    if (u.pn == 0) { *(h16x8*)(ckv + r * 256 + c0) = pack8(v0, v1); ss += dot4(v0) + dot4(v1); }
                    else if (u.pn <= 2) { const int cq = (u.pn - 1) * 256 + c0; *(h16x8*)(cqx + r * 512 + cq) = pack8(v0, v1); if (cq < 384) ss += dot4(v0) + dot4(v1); }
                    else {
#pragma unroll
                        for (int e = 0; e < 4; ++e) { v0[e] = siluf_(v0[e]); v1[e] = siluf_(v1[e]); }
                        *(h16x8*)(sg + r * 1024 + (u.pn - 3) * 256 + c0) = pack8(v0, v1);
                    }
                }
                if (u.pn <= 2) {
                    ss = fq_sum(ss);
                    if (fq == 0) { if (u.pn == 0) sqkv[r * 4 + wc] = ss; else sqq[r * 8 + (u.pn - 1) * 4 + wc] = ss; }
                }
            }
    }
};
__device__ __forceinline__ unsigned cvtpk_bf16(float lo, float hi) { unsigned r; asm volatile("v_cvt_pk_bf16_f32 %0, %1, %2" : "=v"(r) : "v"(lo), "v"(hi)); return r; }
struct EpiScale {
    static constexpr bool PERM = true;
    const float* sqp; int sqn; float sqi; h16* d0; h16* d1; int split, ld0, ld1, bf0, bf1;
    __device__ __forceinline__ void operator()(const f32x4 (&acc)[2][2][4][2], const Unit& u, int wr, int wc, int fr, int fq, const PG8_LAS float* rtab) const {
        asm volatile("" : "+v"(fr), "+v"(fq));
#pragma unroll
        for (int ai = 0; ai < 2; ++ai)
#pragma unroll
            for (int m = 0; m < 4; ++m) {
                const size_t r = (size_t)u.pm * 256 + ai * 128 + wr * 64 + m * 16 + fr;
                float rs = 1.f;
                if (sqp) rs = rtab[ai * 128 + wr * 64 + m * 16 + fr];
#pragma unroll
                for (int bj = 0; bj < 2; ++bj) {
                    const int c0 = bj * 128 + wc * 32 + 8 * fq;
                    const f32x4 v0 = acc[ai][bj][m][0] * rs, v1 = acc[ai][bj][m][1] * rs;
                    const bool first = u.pn < split;
                    h16* dst = first ? d0 + r * ld0 + u.pn * 256 + c0 : d1 + r * ld1 + (u.pn - split) * 256 + c0;
                    if (first ? bf0 : bf1) { u32x4 w; w[0] = cvtpk_bf16(v0[0], v0[1]); w[1] = cvtpk_bf16(v0[2], v0[3]); w[2] = cvtpk_bf16(v1[0], v1[1]); w[3] = cvtpk_bf16(v1[2], v1[3]); *(u32x4*)dst = w; }
                    else *(h16x8*)dst = pack8(v0, v1);
                }
            }
    }
};
struct EpiRes {
    static constexpr bool PERM = true;
    const float* basef; const h16* baseh; h16* HH; float* sq; const float* sqp; int sqn; float sqi;
    __device__ __forceinline__ void operator()(const f32x4 (&acc)[2][2][4][2], const Unit& u, int wr, int wc, int fr, int fq, const PG8_LAS float* rtab) const {
        asm volatile("" : "+v"(fr), "+v"(fq));
#pragma unroll
        for (int ai = 0; ai < 2; ++ai)
#pragma unroll
            for (int m = 0; m < 4; ++m) {
                const size_t r = (size_t)u.pm * 256 + ai * 128 + wr * 64 + m * 16 + fr;
                float ss = 0.f;
#pragma unroll
                for (int bj = 0; bj < 2; ++bj) {
                    const size_t o = r * 1024 + u.pn * 256 + bj * 128 + wc * 32 + 8 * fq;
                    f32x4 h0, h1;
                    if (basef) { h0 = *(const f32x4*)(basef + o); h1 = *(const f32x4*)(basef + o + 4); }
                    else { const h16x8 b = *(const h16x8*)(baseh + o); h0 = (f32x4){(float)b[0], (float)b[1], (float)b[2], (float)b[3]}; h1 = (f32x4){(float)b[4], (float)b[5], (float)b[6], (float)b[7]}; }
                    h0 = h0 + acc[ai][bj][m][0]; h1 = h1 + acc[ai][bj][m][1];
                    *(h16x8*)(HH + o) = pack8(h0, h1); ss += dot4(h0) + dot4(h1);
                }
                ss = fq_sum(ss);
                if (fq == 0) sq[r * 16 + u.pn * 4 + wc] = ss;
            }
    }
};
struct EpiPle {
    static constexpr bool PERM = true;
    const h16* Hin; const h16* U; h16* Hout; const float* sqp; float* sqout; int sqn; float sqi;
    __device__ __forceinline__ void operator()(const f32x4 (&acc)[2][2][4][2], const Unit& u, int wr, int wc, int fr, int fq, const PG8_LAS float* rtab) const {
        asm volatile("" : "+v"(fr), "+v"(fq));
#pragma unroll
        for (int ai = 0; ai < 2; ++ai)
#pragma unroll
            for (int m = 0; m < 4; ++m) {
                const size_t r = (size_t)u.pm * 256 + ai * 128 + wr * 64 + m * 16 + fr;
                const float rs = rtab[ai * 128 + wr * 64 + m * 16 + fr];
                float ss = 0.f;
#pragma unroll
                for (int bj = 0; bj < 2; ++bj) {
                    const size_t o = r * 1024 + u.pn * 256 + bj * 128 + wc * 32 + 8 * fq;
                    const h16x8 uu = *(const h16x8*)(U + o); const h16x8 hh = *(const h16x8*)(Hin + o);
                    const f32x4 a0 = acc[ai][bj][m][0] * rs, a1 = acc[ai][bj][m][1] * rs; f32x4 h0, h1;
#pragma unroll
                    for (int e = 0; e < 4; ++e) { h0[e] = (float)hh[e] + (float)uu[e] * sigmoidf_(a0[e]); h1[e] = (float)hh[4 + e] + (float)uu[4 + e] * sigmoidf_(a1[e]); }
                    *(h16x8*)(Hout + o) = pack8(h0, h1); ss += dot4(h0) + dot4(h1);
                }
                ss = fq_sum(ss);
                if (fq == 0) sqout[r * 16 + u.pn * 4 + wc] = ss;
            }
    }
};
struct EpiPleFinal {
    static constexpr bool PERM = true, FUSED_FINAL = true;
    const h16* Hin; const h16* U; const float* sqp; int sqn; float sqi; const float* gfin; float* out; unsigned* xslot; unsigned* pcnt; unsigned* tmo;
    __device__ __forceinline__ void final(f32x4 (&acc)[2][2][4][2], const Unit& u, int wr, int wc, int fr, int fq, const PG8_LAS float* rtab, PG8_LAS unsigned char* lds, int tid) const {
        PG8_LAS float* Pt = (PG8_LAS float*)(lds + pg8_stage_bytes() + 2048);
        PG8_LAS float* St = Pt + 1024;
        const int wid = tid >> 6, lane = tid & 63;
        asm volatile("" : "+v"(fr), "+v"(fq));
#pragma unroll
        for (int ai = 0; ai < 2; ++ai)
#pragma unroll
            for (int m = 0; m < 4; ++m) {
                const int rl = ai * 128 + wr * 64 + m * 16 + fr; const size_t r = (size_t)u.pm * 256 + rl;
                const float rs = rtab[rl]; float ss = 0.f;
#pragma unroll
                for (int bj = 0; bj < 2; ++bj) {
                    const size_t o = r * 1024 + u.pn * 256 + bj * 128 + wc * 32 + 8 * fq;
                    const h16x8 uu = *(const h16x8*)(U + o); const h16x8 hh = *(const h16x8*)(Hin + o);
                    const f32x4 a0 = acc[ai][bj][m][0] * rs, a1 = acc[ai][bj][m][1] * rs; f32x4 h0, h1;
#pragma unroll
                    for (int e = 0; e < 4; ++e) { h0[e] = (float)hh[e] + (float)uu[e] * sigmoidf_(a0[e]); h1[e] = (float)hh[4 + e] + (float)uu[4 + e] * sigmoidf_(a1[e]); }
                    acc[ai][bj][m][0] = h0; acc[ai][bj][m][1] = h1; ss += dot4(h0) + dot4(h1);
                }
                ss = fq_sum(ss);
                if (fq == 0) Pt[rl * 4 + wc] = ss;
                asm volatile("" : "+v"(acc[ai][0][m][0]), "+v"(acc[ai][0][m][1]), "+v"(acc[ai][1][m][0]), "+v"(acc[ai][1][m][1]) :: "memory");
            }
        asm volatile("s_waitcnt lgkmcnt(0)" ::: "memory"); __builtin_amdgcn_s_barrier(); asm volatile("" ::: "memory");
        if (tid < 256) {
            const f32x4 p = *(const PG8_LAS f32x4*)(Pt + tid * 4);
            __hip_atomic_store(xslot + ((size_t)u.pm * 256 + tid) * 4 + u.pn, __float_as_uint((p[0] + p[1]) + (p[2] + p[3])), __ATOMIC_RELAXED, __HIP_MEMORY_SCOPE_AGENT);
            asm volatile("s_waitcnt vmcnt(0)" ::: "memory");
            if (lane == 0) __hip_atomic_fetch_add(pcnt + 64 * u.pm, 1u, __ATOMIC_RELAXED, __HIP_MEMORY_SCOPE_AGENT);
        }
        if (wid == 0) {
            unsigned sp = 0u;
            while (__hip_atomic_load(pcnt + 64 * u.pm, __ATOMIC_RELAXED, __HIP_MEMORY_SCOPE_AGENT) < 16u) {
                __builtin_amdgcn_s_sleep(2);
                if (++sp > (1u << 22)) { if (lane == 0) __hip_atomic_store(tmo, 1u, __ATOMIC_RELAXED, __HIP_MEMORY_SCOPE_AGENT); break; }
            }
            __builtin_amdgcn_fence(__ATOMIC_ACQUIRE, "agent");
        }
        asm volatile("s_waitcnt vmcnt(0) lgkmcnt(0)" ::: "memory"); __builtin_amdgcn_s_barrier(); asm volatile("" ::: "memory");
        if (tid < 256) {
            const unsigned* sl = xslot + ((size_t)u.pm * 256 + tid) * 4; float s = 0.f;
#pragma unroll
            for (int t = 0; t < 4; ++t) s += __uint_as_float(__hip_atomic_load(sl + t, __ATOMIC_RELAXED, __HIP_MEMORY_SCOPE_AGENT));
            St[tid] = rsqrtf(s * (1.0f / 1024.0f) + EPS);
        }
        asm volatile("s_waitcnt vmcnt(0) lgkmcnt(0)" ::: "memory"); __builtin_amdgcn_s_barrier(); asm volatile("" ::: "memory");
#pragma unroll
        for (int ai = 0; ai < 2; ++ai)
#pragma unroll
            for (int m = 0; m < 4; ++m) {
                const int rl = ai * 128 + wr * 64 + m * 16 + fr; const size_t r = (size_t)u.pm * 256 + rl;
                const float rr = St[rl];
#pragma unroll
                for (int bj = 0; bj < 2; ++bj) {
                    const int c = u.pn * 256 + bj * 128 + wc * 32 + 8 * fq;
                    const f32x4 g0 = *(const f32x4*)(gfin + c), g1 = *(const f32x4*)(gfin + c + 4);
                    *(f32x4*)(out + r * 1024 + c) = acc[ai][bj][m][0] * rr * g0; *(f32x4*)(out + r * 1024 + c + 4) = acc[ai][bj][m][1] * rr * g1;
                }
            }
    }
};
struct EpiInR {
    static constexpr bool PERM = true;
    const float* sqp; const f32x2* sincos; h16* rq; h16* rk; h16* rv; h16* rg; int sqn; float sqi;
    __device__ __forceinline__ void operator()(const f32x4 (&acc)[2][2][4][2], const Unit& u, int wr, int wc, int fr, int fq, const PG8_LAS float* rtab) const {
        asm volatile("" : "+v"(fr), "+v"(fq));
#pragma unroll
        for (int ai = 0; ai < 2; ++ai)
#pragma unroll
            for (int m = 0; m < 4; ++m) {
                const size_t r = (size_t)u.pm * 256 + ai * 128 + wr * 64 + m * 16 + fr;
                const float rs = rtab[ai * 128 + wr * 64 + m * 16 + fr];
                const int pos = (int)(r & (L - 1));
#pragma unroll
                for (int bj = 0; bj < 2; ++bj) {
                    const int c0 = bj * 128 + wc * 32 + 8 * fq;
                    f32x4 v0 = acc[ai][bj][m][0] * rs, v1 = acc[ai][bj][m][1] * rs;
                    if (u.pn < 8) {
                        const f32x2* sc = sincos + (size_t)pos * 128 + (c0 >> 1);
                        const f32x2 s0 = sc[0], s1 = sc[1], s2 = sc[2], s3 = sc[3];
                        f32x4 w0, w1;
                        w0[0] = v0[0] * s0[1] - v0[1] * s0[0]; w0[1] = v0[1] * s0[1] + v0[0] * s0[0];
                        w0[2] = v0[2] * s1[1] - v0[3] * s1[0]; w0[3] = v0[3] * s1[1] + v0[2] * s1[0];
                        w1[0] = v1[0] * s2[1] - v1[1] * s2[0]; w1[1] = v1[1] * s2[1] + v1[0] * s2[0];
                        w1[2] = v1[2] * s3[1] - v1[3] * s3[0]; w1[3] = v1[3] * s3[1] + v1[2] * s3[0];
                        h16* dst = (u.pn < 4) ? rq + r * 1024 + u.pn * 256 + c0 : rk + r * 1024 + (u.pn - 4) * 256 + c0;
                        *(h16x8*)dst = pack8(w0, w1);
                    } else if (u.pn < 16) {
                        *(h16x8*)(rv + r * 2048 + (u.pn - 8) * 256 + c0) = pack8(v0, v1);
                    } else {
#pragma unroll
                        for (int e = 0; e < 4; ++e) { v0[e] = siluf_(v0[e]); v1[e] = siluf_(v1[e]); }
                        *(h16x8*)(rg + r * 2048 + (u.pn - 16) * 256 + c0) = pack8(v0, v1);
                    }
                }
            }
    }
};

template <int MODE>
__device__ __forceinline__ void tr_item(const float* __restrict__ W, int K, int N, h16* Wt, int ld, int row_off, const float* ks, float scale, float* scr, int item, int lane) {
    const int nbn = (N + 31) >> 5, kb = item / nbn, nb = item % nbn, k0 = kb * 64, n0 = nb * 32;
    const int n4 = n0 + (lane & 7) * 4;
    f32x4 wv[8];
#pragma unroll
    for (int i = 0; i < 8; ++i) { const int kk = 8 * i + (lane >> 3); wv[i] = (n4 < N) ? *(const f32x4*)(W + (size_t)(k0 + kk) * N + n4) : (f32x4){0.f, 0.f, 0.f, 0.f}; }
#pragma unroll
    for (int i = 0; i < 8; ++i) { const int kk = 8 * i + (lane >> 3); const float kf = ks ? ks[k0 + kk] : 1.f;
#pragma unroll
        for (int e = 0; e < 4; ++e) scr[kk * 33 + (lane & 7) * 4 + e] = wv[i][e] * kf; }
    LDS_FENCE();
    const int c = lane & 7;
#pragma unroll
    for (int j = 0; j < 4; ++j) {
        const int nl = (lane >> 3) + 8 * j, n = n0 + nl;
        if (n < N) {
            int row = n; float sc = scale;
            if (MODE == 1) row = (n < 384) ? 256 + n : (n < 640) ? n - 384 : (n < 712) ? n : n + 56;
            if (MODE == 2 && n >= 1024 && n < 2048) sc *= 0.0625f;
            const float* s = scr + (8 * c) * 33 + nl;
            h16x8 o;
#pragma unroll
            for (int e = 0; e < 8; ++e) o[e] = (h16)(s[e * 33] * sc);
            *(h16x8*)(Wt + (size_t)(row_off + row) * ld + k0 + 8 * c) = o;
        }
    }
    LDS_FENCE();
}

__device__ __forceinline__ void p0_prologue(const Params& P, unsigned char* lds, int blk, int nblk, int wv) {
    const int tid = my_tid(wv), wid = __builtin_amdgcn_readfirstlane(tid >> 6), lane = tid & 63;
    float* scr = (float*)lds + wid * (64 * 33);
    const int gw = blk * NWAVES + wid, ngw = nblk * NWAVES;
    unsigned char* ws = opaque_ptr(P.ws);
    h16* WAIN = (h16*)(ws + WS_WAIN); h16* WQ = (h16*)(ws + WS_WQ); h16* WKV = (h16*)(ws + WS_WKV); h16* WAOUT = (h16*)(ws + WS_WAOUT);
    h16* WPG = (h16*)(ws + WS_WPG); h16* WPLE = (h16*)(ws + WS_WPLE); h16* WRIN = (h16*)(ws + WS_WRIN); h16* WROUT = (h16*)(ws + WS_WROUT);
    const float QSCALE = 0.08838834764831845f * 1.4426950408889634f;
    constexpr int I1 = 16 * 55, I2 = 6 * 32, I3 = 6 * 16, I4 = 8 * 16, I5 = 8 * 16, I6 = 16 * 32, I7 = 2 * 16 * 32, I8 = 2 * 4 * 32, I9 = 16 * 192, I10 = 32 * 32;
    constexpr int NIT = I1 + I2 + I3 + I4 + I5 + I6 + I7 + I8 + I9 + I10;
    for (int it = gw; it < NIT; it += ngw) {
        int r = it;
        if (r < I1) { tr_item<1>(P.in[3], 1024, 1736, WAIN, 1024, 0, nullptr, 1.f, scr, r, lane); continue; } r -= I1;
        if (r < I2) { tr_item<0>(P.in[6], 384, 1024, WQ, 384, 0, P.in[4], QSCALE, scr, r, lane); continue; } r -= I2;
        if (r < I3) { tr_item<0>(P.in[7], 384, 512, WQ, 384, 1024, P.in[4], 1.f, scr, r, lane); continue; } r -= I3;
        if (r < I4) { const int h = r / 16; tr_item<0>(P.in[10] + (size_t)h * 256 * 128, 256, 128, WKV, 256, h * 128, P.in[5], 1.f, scr, r % 16, lane); continue; } r -= I4;
        if (r < I5) { const int h = r / 16; tr_item<0>(P.in[11] + (size_t)h * 256 * 128, 256, 128, WKV, 256, 1024 + h * 128, P.in[5], 1.f, scr, r % 16, lane); continue; } r -= I5;
        if (r < I6) { tr_item<0>(P.in[12], 1024, 1024, WAOUT, 1024, 0, nullptr, 1.f, scr, r, lane); continue; } r -= I6;
        if (r < I7) { const int i = r / 512; tr_item<0>(P.in[15] + (size_t)i * 1024 * 1024, 1024, 1024, WPG + (size_t)i * 1024 * 1024, 1024, 0, P.in[16] + i * 1024, 1.f, scr, r % 512, lane); continue; } r -= I7;
        if (r < I8) { const int i = r / 128; tr_item<0>(P.in[17] + (size_t)i * 256 * 1024, 256, 1024, WPLE + (size_t)i * 1024 * 256, 256, 0, nullptr, 1.f, scr, r % 128, lane); continue; } r -= I8;
        if (r < I9) { tr_item<2>(P.in[13], 1024, 6144, WRIN, 1024, 0, P.in[2] + 1024, 1.f, scr, r, lane); continue; } r -= I9;
        tr_item<0>(P.in[14], 2048, 1024, WROUT, 2048, 0, nullptr, 1.f, scr, r, lane);
    }
    const int gt = blk * NTHREADS + tid, ngt = nblk * NTHREADS;
    { unsigned zz = 0u; asm volatile("" : "+v"(zz));
      for (int i = gt; i < 56 * 1024 / 8; i += ngt) ((u32x4*)(WAIN + 712 * 1024))[i] = (u32x4){zz, zz, zz, zz}; }
    {
        const float* x = P.in[0]; const f32x4* g4 = (const f32x4*)P.in[2]; h16* XN0 = (h16*)(ws + WS_R1);
        f32x4 gv[4];
#pragma unroll
        for (int j = 0; j < 4; ++j) gv[j] = g4[lane + 64 * j];
        for (int r0 = gw; r0 < T; r0 += 4 * ngw) {
            f32x4 v[4][4];
#pragma unroll
            for (int k = 0; k < 4; ++k) { const int r = (r0 + k * ngw < T) ? r0 + k * ngw : r0; const f32x4* xr = (const f32x4*)(x + (size_t)r * 1024) + lane;
#pragma unroll
                for (int j = 0; j < 4; ++j) v[k][j] = xr[64 * j]; }
#pragma unroll
            for (int k = 0; k < 4; ++k) { const int r = r0 + k * ngw; float s = 0.f;
#pragma unroll
                for (int j = 0; j < 4; ++j) s += dot4(v[k][j]);
                const float rstd = rsqrtf(wave_sum_dpp(s) * (1.0f / 1024.0f) + EPS);
                if (r < T) {
#pragma unroll
                    for (int j = 0; j < 4; ++j) { const f32x4 o = v[k][j] * rstd * gv[j]; *(h16x4*)(XN0 + (size_t)r * 1024 + (lane + 64 * j) * 4) = pack4(o); } } }
        }
    }
    {
        const f32x4* p4 = (const f32x4*)P.in[1]; h16* PH0 = (h16*)(ws + WS_PH0); h16* PH1 = (h16*)(ws + WS_PH1);
        const int nv = T * 256 / 8;
        for (int i0_ = gt; i0_ < 2 * nv; i0_ += 4 * ngt) {
            f32x4 a[4], b2[4];
#pragma unroll
            for (int k = 0; k < 4; ++k) { const int i = (i0_ + k * ngt < 2 * nv) ? i0_ + k * ngt : i0_; a[k] = p4[2 * (size_t)i]; b2[k] = p4[2 * (size_t)i + 1]; }
#pragma unroll
            for (int k = 0; k < 4; ++k) { const int i = i0_ + k * ngt; if (i < 2 * nv) { h16* dst = (i < nv) ? PH0 + (size_t)i * 8 : PH1 + (size_t)(i - nv) * 8; *(h16x8*)dst = pack8(a[k], b2[k]); } }
        }
    }
    {
        f32x2* SC = (f32x2*)(ws + WS_SINCOS);
        for (int i = gt; i < L * 128; i += ngt) {
            const int pos = i >> 7, fi = i & 127;
            const float th = (float)pos * kAngle[fi];
            double rev = (double)th * 0.15915494309189535; rev -= __builtin_rint(rev);
            const float r = (float)(rev * 6.283185307179586), r2 = r * r;
            float sn = 1.9572941e-20f;
            sn = sn * r2 - 8.2206352e-18f;
            sn = sn * r2 + 2.8114573e-15f;
            sn = sn * r2 - 7.6471637e-13f;
            sn = sn * r2 + 1.6059044e-10f;
            sn = sn * r2 - 2.5052108e-8f;
            sn = sn * r2 + 2.7557319e-6f;
            sn = sn * r2 - 1.9841270e-4f;
            sn = sn * r2 + 8.3333333e-3f;
            sn = sn * r2 - 1.6666667e-1f;
            sn = sn * r2 + 1.0f;
            sn = sn * r;
            float cs = 4.1103176e-19f;
            cs = cs * r2 - 1.5619207e-16f;
            cs = cs * r2 + 4.7794773e-14f;
            cs = cs * r2 - 1.1470746e-11f;
            cs = cs * r2 + 2.0876757e-9f;
            cs = cs * r2 - 2.7557319e-7f;
            cs = cs * r2 + 2.4801587e-5f;
            cs = cs * r2 - 1.3888889e-3f;
            cs = cs * r2 + 4.1666667e-2f;
            cs = cs * r2 - 0.5f;
            cs = cs * r2 + 1.0f;
            SC[i] = (f32x2){sn, cs};
        }
    }
}

__device__ __forceinline__ void p2_kidx(const Params& P, int blk, int nblk, int wv) {
    const h16* CQX = (const h16*)(P.ws + WS_CQX); h16* KIDXN = (h16*)(P.ws + WS_KIDXN); float* WIDX = (float*)(P.ws + WS_WIDX);
    const float* g = P.in[8]; const float* bb = P.in[9];
    for (int r = blk * NTHREADS + my_tid(wv); r < T; r += nblk * NTHREADS) {
        float v[64]; float s = 0.f;
#pragma unroll
        for (int c = 0; c < 8; ++c) { const h16x8 k = *(const h16x8*)(CQX + (size_t)r * 512 + 384 + c * 8);
#pragma unroll
            for (int e = 0; e < 8; ++e) { v[c * 8 + e] = (float)k[e]; s += v[c * 8 + e]; } }
        const float mu = s * (1.0f / 64.0f); float q = 0.f;
#pragma unroll
        for (int i = 0; i < 64; ++i) { v[i] -= mu; q += v[i] * v[i]; }
        const float rstd = rsqrtf(q * (1.0f / 64.0f) + EPS);
#pragma unroll
        for (int c = 0; c < 8; ++c) { h16x8 o;
#pragma unroll
            for (int e = 0; e < 8; ++e) o[e] = (h16)(v[c * 8 + e] * rstd * g[c * 8 + e] + bb[c * 8 + e]);
            *(h16x8*)(KIDXN + (size_t)r * 64 + c * 8) = o; }
        const h16x8 w = *(const h16x8*)(CQX + (size_t)r * 512 + 448);
        const float wsc = 0.04419417382415922f;
        f32x4 w0, w1;
#pragma unroll
        for (int e = 0; e < 4; ++e) { w0[e] = (float)w[e] * wsc; w1[e] = (float)w[4 + e] * wsc; }
        *(f32x4*)(WIDX + (size_t)r * 8) = w0; *(f32x4*)(WIDX + (size_t)r * 8 + 4) = w1;
    }
}

__device__ __forceinline__ unsigned fmap_u(float s) { s += 0.0f; const unsigned b = __float_as_uint(s); return (b & 0x80000000u) ? ~b : (b | 0x80000000u); }
__device__ __forceinline__ unsigned topk_select(const unsigned (&u)[32], int lane) {
    unsigned Tv = 0u;
    for (int bit = 31; bit >= 0; --bit) {
        const unsigned cand = Tv | (1u << bit); int cnt = 0;
#pragma unroll
        for (int i = 0; i < 32; ++i) cnt += __popcll(__ballot(u[i] >= cand));
        if (cnt >= 256) Tv = cand;
    }
    int gt = 0;
#pragma unroll
    for (int i = 0; i < 32; ++i) gt += __popcll(__ballot(u[i] > Tv));
    int need = 256 - gt;
    unsigned sel = 0u;
#pragma unroll
    for (int i = 0; i < 32; ++i) {
        const bool eq = (u[i] == Tv);
        const unsigned long long em = __ballot(eq);
        const int rank = (int)__builtin_amdgcn_mbcnt_hi((unsigned)(em >> 32), __builtin_amdgcn_mbcnt_lo((unsigned)em, 0u));
        const bool take = (u[i] > Tv) || (eq && rank < need);
        sel |= (take ? 1u : 0u) << i;
        need -= __popcll(em);
    }
    return sel;
}


__device__ __forceinline__ unsigned topk_select_radix(const unsigned (&u)[32], int lane, volatile __attribute__((address_space(3))) unsigned* hist) {
    typedef __attribute__((address_space(3))) unsigned lu32;
    unsigned prefix = 0u; int kk = 256;
#pragma unroll 1
    for (int pass = 0; pass < 4; ++pass) {
        const int shift = 24 - 8 * pass;
        { unsigned zz = 0u; asm volatile("" : "+v"(zz)); ((__attribute__((address_space(3))) u32x4*)hist)[lane] = (u32x4){zz, zz, zz, zz}; }
        LDS_FENCE();
#pragma unroll
        for (int i = 0; i < 32; ++i) {
            const bool in = (u[i] != 0u) && (pass == 0 || (u[i] >> (shift + 8)) == prefix);
            if (in) __hip_atomic_fetch_add((lu32*)hist + ((u[i] >> shift) & 255u), 1u, __ATOMIC_RELAXED, __HIP_MEMORY_SCOPE_WORKGROUP);
        }
        LDS_FENCE();
        const u32x4 c = ((__attribute__((address_space(3))) u32x4*)hist)[lane];
        const int tot = (int)(c[0] + c[1] + c[2] + c[3]);
        int S = tot;
#pragma unroll
        for (int o = 1; o < 64; o <<= 1) { const int v = __shfl_down(S, o); if (lane + o < 64) S += v; }
        const unsigned long long bm = __ballot(S >= kk);
        const int Ls = 63 - __builtin_clzll(bm);
        int cum = S - tot, bin = 0, above = 0; bool found = false;
#pragma unroll
        for (int j = 3; j >= 0; --j) { const int cj = (int)c[j]; if (!found && cum + cj >= kk) { bin = 4 * lane + j; above = cum; found = true; } cum += cj; }
        bin = __builtin_amdgcn_readlane(bin, Ls); above = __builtin_amdgcn_readlane(above, Ls);
        kk -= above; prefix = (prefix << 8) | (unsigned)bin;
        LDS_FENCE();
    }
    const unsigned Tv = prefix; int need = kk;
    unsigned sel = 0u;
#pragma unroll
    for (int i = 0; i < 32; ++i) {
        const bool eq = (u[i] == Tv);
        const unsigned long long em = __ballot(eq);
        const int rank = (int)__builtin_amdgcn_mbcnt_hi((unsigned)(em >> 32), __builtin_amdgcn_mbcnt_lo((unsigned)em, 0u));
        const bool take = (u[i] > Tv) || (eq && rank < need);
        sel |= (take ? 1u : 0u) << i;
        need -= __popcll(em);
    }
    return sel;
}


#define DPP_STEP_I(v, op, ident, ctrl, rmask) v = op(v, __builtin_amdgcn_update_dpp((int)(ident), v, ctrl, rmask, 0xf, false))
__device__ __forceinline__ int imax_(int a, int b) { return a > b ? a : b; }
__device__ __forceinline__ int iadd_(int a, int b) { return a + b; }
__device__ __forceinline__ int wave_scan_add(int v) {
    DPP_STEP_I(v, iadd_, 0, 0x111, 0xf); DPP_STEP_I(v, iadd_, 0, 0x112, 0xf); DPP_STEP_I(v, iadd_, 0, 0x114, 0xf); DPP_STEP_I(v, iadd_, 0, 0x118, 0xf);
    DPP_STEP_I(v, iadd_, 0, 0x142, 0xa); DPP_STEP_I(v, iadd_, 0, 0x143, 0xc); return v;
}
template <int CTRL, int RMASK> __device__ __forceinline__ float fmax_dpp_(float a) { return fmaxf(a, __builtin_bit_cast(float, __builtin_amdgcn_update_dpp((int)0xff800000u, __builtin_bit_cast(int, a), CTRL, RMASK, 0xf, false))); }
template <int CTRL, int RMASK> __device__ __forceinline__ float fmin_dpp_(float a) { return fminf(a, __builtin_bit_cast(float, __builtin_amdgcn_update_dpp((int)0x7f800000u, __builtin_bit_cast(int, a), CTRL, RMASK, 0xf, false))); }
#define DPP_RED6(v, F) do { v = F<0x111, 0xf>(v); v = F<0x112, 0xf>(v); v = F<0x114, 0xf>(v); v = F<0x118, 0xf>(v); v = F<0x142, 0xa>(v); v = F<0x143, 0xc>(v); } while (0)
__device__ __forceinline__ float wave_max_dpp(float v) { DPP_RED6(v, fmax_dpp_); return __builtin_bit_cast(float, __builtin_amdgcn_readlane(__builtin_bit_cast(int, v), 63)); }
__device__ __forceinline__ float wave_min_dpp(float v) { DPP_RED6(v, fmin_dpp_); return __builtin_bit_cast(float, __builtin_amdgcn_readlane(__builtin_bit_cast(int, v), 63)); }
__device__ __forceinline__ unsigned topk_select_lin(const float (&s)[32], unsigned valid, int lane, volatile __attribute__((address_space(3))) unsigned* ws_) {
    typedef __attribute__((address_space(3))) unsigned lu32;
    typedef __attribute__((address_space(3))) float lf32;
    typedef __attribute__((address_space(3))) f32x4 lf32x4;
    lu32* hist = (lu32*)ws_; lf32* cand = (lf32*)ws_ + 256;
    unsigned act = valid; int kk = 256; float Tv = 0.f; int need = 0; bool solved = false; int cnt = 0;
#pragma unroll 1
    for (int iter = 0; iter < 8; ++iter) {
        float mn = __builtin_inff(), mx = -__builtin_inff();
        if (iter == 0) {
#pragma unroll
            for (int i = 0; i < 32; ++i) { mn = fminf(mn, s[i]); mx = fmaxf(mx, s[i]); }
        } else {
#pragma unroll
            for (int i = 0; i < 32; ++i) { const bool a = (act >> i) & 1u; mn = fminf(mn, a ? s[i] : __builtin_inff()); mx = fmaxf(mx, a ? s[i] : -__builtin_inff()); }
        }
        mn = wave_min_dpp(mn); mx = wave_max_dpp(mx);
        if (mn == mx) { Tv = mx; need = kk; solved = true; break; }
        const float scale = 254.9f / (mx - mn), bias = -mn * scale;
        { unsigned zz = 0u; asm volatile("" : "+v"(zz)); ((__attribute__((address_space(3))) u32x4*)hist)[lane] = (u32x4){zz, zz, zz, zz}; }
        LDS_FENCE();
#pragma unroll
        for (int i = 0; i < 32; ++i) { int b = (int)fmaf(s[i], scale, bias); b = b < 0 ? 0 : b;
            __hip_atomic_fetch_add(hist + (((act >> i) & 1u) ? b : 321 + (lane & 15)), 1u, __ATOMIC_RELAXED, __HIP_MEMORY_SCOPE_WORKGROUP); }
        LDS_FENCE();
        const u32x4 c = ((__attribute__((address_space(3))) u32x4*)hist)[lane];
        const int tot = (int)(c[0] + c[1] + c[2] + c[3]);
        const int pre = wave_scan_add(tot);
        const int total = __builtin_amdgcn_readlane(pre, 63);
        const int S = total - pre + tot;
        const unsigned long long bm = __ballot(S >= kk);
        const int Ls = 63 - __builtin_clzll(bm | 1ull);
        int cum = S - tot, bin = 0, above = 0, cb = 0; bool found = false;
#pragma unroll
        for (int j = 3; j >= 0; --j) { const int cj = (int)c[j]; if (!found && cum + cj >= kk) { bin = 4 * lane + j; above = cum; cb = cj; found = true; } cum += cj; }
        bin = __builtin_amdgcn_readlane(bin, Ls); above = __builtin_amdgcn_readlane(above, Ls); cnt = __builtin_amdgcn_readlane(cb, Ls);
        kk -= above;
        { float sc2 = scale; asm volatile("" : "+v"(sc2));
#pragma unroll
          for (int i = 0; i < 32; ++i) { int b = (int)fmaf(s[i], sc2, bias); b = b < 0 ? 0 : b; act &= ~((b != bin ? 1u : 0u) << i); } }
        LDS_FENCE();
        if (cnt <= 64) break;
    }
    if (!solved) {
        cand[lane] = __builtin_nanf("");
        const int myc = __popc(act);
        int off = wave_scan_add(myc) - myc;
        LDS_FENCE();
#pragma unroll
        for (int i = 0; i < 32; ++i) { const bool a = (act >> i) & 1u; const int slot = (a && off < 64) ? off : 65 + (lane & 15); cand[slot] = s[i]; off += a ? 1 : 0; }
        LDS_FENCE();
        const int m = cnt < 64 ? cnt : 64;
        const float v = (lane < m) ? cand[lane] : -__builtin_inff();
        int gt = 0, eq = 0;
#pragma unroll
        for (int j4 = 0; j4 < 16; ++j4) { const f32x4 cj = ((lf32x4*)cand)[j4];
#pragma unroll
            for (int e = 0; e < 4; ++e) { gt += (cj[e] > v) ? 1 : 0; eq += (cj[e] == v) ? 1 : 0; } }
        const bool ok = (lane < m) && gt < kk && kk <= gt + eq;
        const unsigned long long okm = __ballot(ok);
        const int fl = okm ? __builtin_ctzll(okm) : 0;
        Tv = __builtin_bit_cast(float, __builtin_amdgcn_readlane(__builtin_bit_cast(int, v), fl)); need = kk - __builtin_amdgcn_readlane(gt, fl);
        LDS_FENCE();
    }
    unsigned sel = 0u, eqb = 0u;
#pragma unroll
    for (int i = 0; i < 32; ++i) { sel |= ((s[i] > Tv) ? 1u : 0u) << i; eqb |= ((s[i] == Tv) ? 1u : 0u) << i; }
    const int eqtot = __builtin_amdgcn_readlane(wave_scan_add(__popc(eqb)), 63);
    if (eqtot <= need) sel |= eqb;
    else {
#pragma unroll
        for (int i = 0; i < 32; ++i) {
            const bool eq = (eqb >> i) & 1u;
            const unsigned long long em = __ballot(eq);
            const int rank = (int)__builtin_amdgcn_mbcnt_hi((unsigned)(em >> 32), __builtin_amdgcn_mbcnt_lo((unsigned)em, 0u));
            sel |= ((eq && rank < need) ? 1u : 0u) << i;
            need -= __popcll(em);
        }
    }
    return sel;
}


__device__ __forceinline__ unsigned topk_select_fast(const float (&s)[32], unsigned valid, int nk, int lane, const __attribute__((address_space(3))) float* row, volatile __attribute__((address_space(3))) unsigned* ws_) {
    typedef __attribute__((address_space(3))) unsigned lu32; typedef __attribute__((address_space(3))) float lf32; typedef __attribute__((address_space(3))) f32x4 lf32x4;
    lu32* hist = (lu32*)ws_; lf32* cand = (lf32*)ws_ + 256;
    float mn = __builtin_inff(), mx = -__builtin_inff();
#pragma unroll
    for (int i = 0; i < 32; ++i) { mn = fminf(mn, s[i]); mx = fmaxf(mx, s[i]); }
    mn = wave_min_dpp(mn); mx = wave_max_dpp(mx);
    const bool flat = (mn == mx);
    const float scale = flat ? 0.f : 254.9f / (mx - mn), bias = flat ? 0.f : -mn * scale;
    { unsigned zz = 0u; asm volatile("" : "+v"(zz)); ((__attribute__((address_space(3))) u32x4*)hist)[lane] = (u32x4){zz, zz, zz, zz}; }
    LDS_FENCE();
    const int full = nk >> 6, rem = nk & 63;
#pragma unroll
    for (int i = 0; i < 32; ++i) if (i <= full) { int b = (int)fmaf(s[i], scale, bias); b = b < 0 ? 0 : b; __hip_atomic_fetch_add(hist + b, 1u, __ATOMIC_RELAXED, __HIP_MEMORY_SCOPE_WORKGROUP); }
    LDS_FENCE();
    u32x4 c = ((__attribute__((address_space(3))) u32x4*)hist)[lane];
    if (lane == 0 && full < 32) c[0] -= (unsigned)(64 - rem);
    const int tot = (int)(c[0] + c[1] + c[2] + c[3]);
    const int pre = wave_scan_add(tot), total = __builtin_amdgcn_readlane(pre, 63);
    const int S = total - pre + tot;
    const unsigned long long bm = __ballot(S >= 256);
    const int Ls = 63 - __builtin_clzll(bm | 1ull);
    int cum = S - tot, bin = 0, above = 0, cb = 0; bool found = false;
#pragma unroll
    for (int j = 3; j >= 0; --j) { const int cj = (int)c[j]; if (!found && cum + cj >= 256) { bin = 4 * lane + j; above = cum; cb = cj; found = true; } cum += cj; }
    bin = __builtin_amdgcn_readlane(bin, Ls); above = __builtin_amdgcn_readlane(above, Ls); const int cnt = __builtin_amdgcn_readlane(cb, Ls);
    if (flat || cnt > 64) return topk_select_lin(s, valid, lane, ws_);
    const int kk = 256 - above;
    unsigned gtb = 0u, eqb = 0u;
    { float sc2 = scale; asm volatile("" : "+v"(sc2));
#pragma unroll
      for (int i = 0; i < 32; ++i) if (i <= full) { int b = (int)fmaf(s[i], sc2, bias); b = b < 0 ? 0 : b; gtb |= (b > bin ? 1u : 0u) << i; eqb |= (b == bin ? 1u : 0u) << i; } }
    eqb &= valid;
    cand[lane] = __builtin_nanf("");
    int off = wave_scan_add(__popc(eqb)) - __popc(eqb);
    LDS_FENCE();
    { unsigned m = eqb;
      while (__any(m != 0u)) { if (m != 0u) { const int i = __builtin_ctz(m); cand[off < 64 ? off : 65 + (lane & 15)] = row[i * 64 + lane]; ++off; m &= m - 1u; } } }
    LDS_FENCE();
    const float v = (lane < cnt) ? cand[lane] : -__builtin_inff();
    int gt = 0, eq = 0;
#pragma unroll
    for (int j4 = 0; j4 < 16; ++j4) { const f32x4 cj = ((lf32x4*)cand)[j4];
#pragma unroll
        for (int e = 0; e < 4; ++e) { gt += (cj[e] > v) ? 1 : 0; eq += (cj[e] == v) ? 1 : 0; } }
    const unsigned long long okm = __ballot((lane < cnt) && gt < kk && kk <= gt + eq);
    const int fl = okm ? __builtin_ctzll(okm) : 0;
    const float Tv = __builtin_bit_cast(float, __builtin_amdgcn_readlane(__builtin_bit_cast(int, v), fl)); int need = kk - __builtin_amdgcn_readlane(gt, fl);
    const int eqtot = __builtin_amdgcn_readlane(eq, fl);
    LDS_FENCE();
    unsigned sel = gtb;
    if (eqtot <= need) {
        unsigned m = eqb;
        while (__any(m != 0u)) { if (m != 0u) { const int i = __builtin_ctz(m); if (row[i * 64 + lane] >= Tv) sel |= 1u << i; m &= m - 1u; } }
    } else {
#pragma unroll
        for (int i = 0; i < 32; ++i) {
            const bool inb = (eqb >> i) & 1u; const bool e_ = inb && (s[i] == Tv);
            const unsigned long long em = __ballot(e_);
            const int rank = (int)__builtin_amdgcn_mbcnt_hi((unsigned)(em >> 32), __builtin_amdgcn_mbcnt_lo((unsigned)em, 0u));
            sel |= (((inb && s[i] > Tv) || (e_ && rank < need)) ? 1u : 0u) << i;
            need -= __popcll(em);
        }
    }
    return sel;
}

__device__ __forceinline__ void p3_indexer_naive(const Params& P, unsigned char* lds, int blk, int nblk, int wv) {
    const int tid = my_tid(wv), wid = __builtin_amdgcn_readfirstlane(tid >> 6), lane = tid & 63;
    float* sc = (float*)lds + wid * 2048; float* qf = (float*)(lds + 65536) + wid * 512; float* wf = (float*)(lds + 65536 + 16384) + wid * 8;
    const h16* QIDX = (const h16*)(P.ws + WS_QIDX); const h16* KIDXN = (const h16*)(P.ws + WS_KIDXN); const float* WIDX = (const float*)(P.ws + WS_WIDX);
    unsigned long long* MASK = (unsigned long long*)(P.ws + WS_MASK);
    const int gw = blk * NWAVES + wid, ngw = nblk * NWAVES;
    for (int it = gw; it < T; it += ngw) {
        const int b = it >> 11, pos = ((it & 2047) + b * 389) & 2047, t = b * L + pos, nk = pos + 1;
        { const h16x8 qv = *(const h16x8*)(QIDX + (size_t)t * 512 + lane * 8);
#pragma unroll
          for (int e = 0; e < 8; ++e) qf[lane * 8 + e] = (float)qv[e];
          if (lane < 8) wf[lane] = WIDX[(size_t)t * 8 + lane]; }
        LDS_FENCE();
        for (int i = 0; i * 64 < nk; ++i) {
            const int key = i * 64 + lane; float score = 0.f;
            if (key < nk) {
                const h16x8* kp = (const h16x8*)(KIDXN + (size_t)(b * L + key) * 64);
                float kf[64];
#pragma unroll
                for (int c = 0; c < 8; ++c) { const h16x8 kv = kp[c];
#pragma unroll
                    for (int e = 0; e < 8; ++e) kf[c * 8 + e] = (float)kv[e]; }
                for (int h = 0; h < 8; ++h) {
                    float a = 0.f;
#pragma unroll
                    for (int d = 0; d < 64; ++d) a = fmaf(qf[h * 64 + d], kf[d], a);
                    score += fmaxf(a, 0.f) * wf[h];
                }
            }
            sc[key] = score;
        }
        LDS_FENCE();
        unsigned selbits = 0u;
        if (nk <= 256) {
#pragma unroll
            for (int i = 0; i < 32; ++i) selbits |= ((i * 64 + lane) < nk ? 1u : 0u) << i;
        } else {
            unsigned u[32];
#pragma unroll
            for (int i = 0; i < 32; ++i) { const int key = i * 64 + lane; const float s = sc[key]; u[i] = (key < nk) ? fmap_u(s) : 0u; }
            selbits = topk_select(u, lane);
        }
#pragma unroll
        for (int i = 0; i < 32; ++i) { const unsigned long long bal = __ballot((selbits >> i) & 1u); if (lane == 0) MASK[(size_t)t * 32 + i] = bal; }
        LDS_FENCE();
    }
}


typedef float f32x16 __attribute__((ext_vector_type(16)));
__device__ __forceinline__ h16x8 relu_pk8(const f32x16& s, int base) {
    h16x8 r;
#pragma unroll
    for (int e = 0; e < 4; ++e) { const h16x2 p = __builtin_bit_cast(h16x2, __builtin_amdgcn_cvt_pkrtz(fmaxf(s[base + 2 * e], 0.f), fmaxf(s[base + 2 * e + 1], 0.f))); r[2 * e] = p[0]; r[2 * e + 1] = p[1]; }
    return r;
}
__device__ __forceinline__ void p3_indexer(const Params& P, unsigned char* lds_, int blk, int nblk, int wv) {
    typedef __attribute__((address_space(3))) float lfloat;
    const int tid = my_tid(wv), wid = __builtin_amdgcn_readfirstlane(tid >> 6), lane = tid & 63;
    unsigned char* ws = opaque_ptr(P.ws);
    lfloat* sc = (lfloat*)lds_;
    const h16* QIDX = (const h16*)(ws + WS_QIDX); const h16* KIDXN = (const h16*)(ws + WS_KIDXN); const float* WIDX = (const float*)(ws + WS_WIDX);
    unsigned long long* MASK = (unsigned long long*)(ws + WS_MASK);
    h16x8 Afn[4][4]; f32x4 wn = (f32x4){0.f, 0.f, 0.f, 0.f};
    { const int r = lane & 31, h = lane >> 5; const int u0 = (blk < NB * (L / 16)) ? blk : 0; const int tt0 = (u0 & 15) * L + (u0 >> 4) * 16;
#pragma unroll
      for (int g = 0; g < 4; ++g)
#pragma unroll
          for (int s = 0; s < 4; ++s) Afn[g][s] = *(const h16x8*)(QIDX + (size_t)(tt0 + 4 * g + (r >> 3)) * 512 + (r & 7) * 64 + 16 * s + 8 * h);
      if (r < 16) wn = *(const f32x4*)(WIDX + (size_t)(tt0 + r) * 8 + 4 * h); }
    for (int unit = blk; unit < NB * (L / 16); unit += nblk) {
        const int b = unit & 15, qg = unit >> 4, p0 = qg * 16, t0 = b * L + p0, NT = (p0 + 15) / 32 + 1;
        int lane_o = lane; asm volatile("" : "+v"(lane_o));
        const int r = lane_o & 31, h = lane_o >> 5;
        h16x8 Af[4][4];
#pragma unroll
        for (int g = 0; g < 4; ++g)
#pragma unroll
            for (int s = 0; s < 4; ++s) Af[g][s] = Afn[g][s];
        h16x8 fragA;
        { const f32x4 w = wn;
          const h16 z = (h16)0.f;
          if (r & 1) { fragA[0] = z; fragA[1] = z; fragA[2] = z; fragA[3] = z; fragA[4] = (h16)w[0]; fragA[5] = (h16)w[1]; fragA[6] = (h16)w[2]; fragA[7] = (h16)w[3]; }
          else { fragA[0] = (h16)w[0]; fragA[1] = (h16)w[1]; fragA[2] = (h16)w[2]; fragA[3] = (h16)w[3]; fragA[4] = z; fragA[5] = z; fragA[6] = z; fragA[7] = z; } }
        const int code = (r < 16) ? (r >> 1) : -1;
        const h16* kbase = KIDXN + (size_t)b * L * 64 + (size_t)r * 64 + 8 * h;
        h16x8 Bf[4];
        if (wid < NT) {
#pragma unroll
            for (int s = 0; s < 4; ++s) Bf[s] = *(const h16x8*)(kbase + (size_t)wid * 32 * 64 + 16 * s);
        }
        for (int rep_ = 0; rep_ <= MK_P3_REPA; ++rep_) {
        if (rep_ > 0 && wid < NT) {
#pragma unroll
            for (int s = 0; s < 4; ++s) Bf[s] = *(const h16x8*)(kbase + (size_t)wid * 32 * 64 + 16 * s);
        }
        for (int kt = wid; kt < NT; kt += NWAVES) {
            h16x8 Bn[4];
            const int ktn = (kt + NWAVES < NT) ? kt + NWAVES : kt;
#pragma unroll
            for (int s = 0; s < 4; ++s) Bn[s] = *(const h16x8*)(kbase + (size_t)ktn * 32 * 64 + 16 * s);
            f32x16 C = {};
#pragma unroll
            for (int g = 0; g < 4; ++g) {
                f32x16 S = {};
#pragma unroll
                for (int s = 0; s < 4; ++s) S = __builtin_amdgcn_mfma_f32_32x32x16_f16(Af[g][s], Bf[s], S, 0, 0, 0);
                const h16x8 X0 = relu_pk8(S, 0), X1 = relu_pk8(S, 8);
                const h16x8 zero8 = (h16x8){0, 0, 0, 0, 0, 0, 0, 0};
                const h16x8 W0 = (code == 2 * g) ? fragA : zero8, W1 = (code == 2 * g + 1) ? fragA : zero8;
                C = __builtin_amdgcn_mfma_f32_32x32x16_f16(W0, X0, C, 0, 0, 0);
                C = __builtin_amdgcn_mfma_f32_32x32x16_f16(W1, X1, C, 0, 0, 0);
            }
            const int key = kt * 32 + r;
#pragma unroll
            for (int e = 0; e < 4; ++e) { sc[(e + 4 * h) * 2048 + key] = C[e]; sc[(8 + e + 4 * h) * 2048 + key] = C[4 + e]; }
#pragma unroll
            for (int s = 0; s < 4; ++s) Bf[s] = Bn[s];
        }
        }
        __syncthreads();
        { const int un = (unit + nblk < NB * (L / 16)) ? unit + nblk : unit; const int ttn = (un & 15) * L + (un >> 4) * 16;
#pragma unroll
          for (int g = 0; g < 4; ++g)
#pragma unroll
              for (int s = 0; s < 4; ++s) Afn[g][s] = *(const h16x8*)(QIDX + (size_t)(ttn + 4 * g + (r >> 3)) * 512 + (r & 7) * 64 + 16 * s + 8 * h);
          if (r < 16) wn = *(const f32x4*)(WIDX + (size_t)(ttn + r) * 8 + 4 * h); }
#pragma unroll 1
        for (int qq_ = 0; qq_ < 2 * (1 + MK_P3_REPB); ++qq_) {
            const int qq = qq_ & 1;
            const int qi = 2 * wid + qq, pos = p0 + qi, nk = pos + 1, t = t0 + qi;
            unsigned selbits = 0u;
            if (nk <= 256) {
#pragma unroll
                for (int i = 0; i < 32; ++i) selbits |= ((i * 64 + lane) < nk ? 1u : 0u) << i;
            } else {
                float sv[32];
                const int full = nk >> 6;
                const unsigned valid = (full >= 32 ? 0xffffffffu : ((1u << full) - 1u)) | ((full < 32 && lane < (nk & 63)) ? (1u << full) : 0u);
#pragma unroll
                for (int i = 0; i < 32; ++i) { const float x = sc[qi * 2048 + i * 64 + lane]; sv[i] = ((valid >> i) & 1u) ? x : __builtin_nanf(""); }
                selbits = topk_select_fast(sv, valid, nk, lane, (const __attribute__((address_space(3))) float*)(sc + qi * 2048), (volatile __attribute__((address_space(3))) unsigned*)(sc + 16 * 2048 + wid * 448));
            }
            {
                __attribute__((address_space(3))) unsigned long long* stg = (__attribute__((address_space(3))) unsigned long long*)(sc + 16 * 2048 + wid * 448 + (qq ? 0 : 338));
                LDS_FENCE();
#pragma unroll
                for (int i = 0; i < 32; ++i) { const unsigned long long bal = __ballot((selbits >> i) & 1u); if (lane == 0) stg[i] = bal; }
            }
            (void)t;
        }
        __syncthreads();
        { const int q = tid & 15, tl = tid >> 4;
          MASK[((size_t)b * 32 + tl) * L + p0 + q] = ((__attribute__((address_space(3))) unsigned long long*)(sc + 16 * 2048 + (q >> 1) * 448 + ((q & 1) ? 0 : 338)))[tl]; }
    }
}

__device__ __forceinline__ void p4_attn_naive(const Params& P, unsigned char* lds, int blk, int nblk, int wv) {
    const int tid = my_tid(wv), wid = __builtin_amdgcn_readfirstlane(tid >> 6), lane = tid & 63;
    int* keys = (int*)lds; float* qf = (float*)(lds + 1024); float* pf = (float*)(lds + 1024 + 4096) + wid * 256; int* nselp = (int*)(lds + 1024 + 4096 + 8192);
    h16* QA = (h16*)(P.ws + WS_R1); const h16* Kb = (const h16*)(P.ws + WS_R2); const h16* Vb = (const h16*)(P.ws + WS_R3); const h16* SG = (const h16*)(P.ws + WS_R4);
    const unsigned long long* MASK = (const unsigned long long*)(P.ws + WS_MASK);
    for (int t = blk; t < T; t += nblk) {
        const int b = t >> 11;
        __syncthreads();
        if (tid < 128) { const h16x8 qv = *(const h16x8*)(QA + (size_t)t * 1024 + tid * 8);
#pragma unroll
            for (int e = 0; e < 8; ++e) qf[tid * 8 + e] = (float)qv[e]; }
        if (wid == 0) {
            unsigned long long m = (lane < 32) ? MASK[(size_t)t * 32 + lane] : 0ull;
            const int cnt = __popcll(m); int inc = cnt;
#pragma unroll
            for (int o = 1; o < 64; o <<= 1) { const int v = __shfl_up(inc, o); if (lane >= o) inc += v; }
            int off = inc - cnt;
            while (m) { const int k = __builtin_ctzll(m); keys[off++] = lane * 64 + k; m &= m - 1; }
            if (lane == 63) nselp[0] = inc;
        }
        __syncthreads();
        const int nsel = nselp[0], h = wid;
        float s[4];
#pragma unroll
        for (int c = 0; c < 4; ++c) {
            const int idx = lane + 64 * c; s[c] = -INFINITY;
            if (idx < nsel) {
                const h16x8* kp = (const h16x8*)(Kb + (size_t)(b * L + keys[idx]) * 1024 + h * 128); float a = 0.f;
#pragma unroll
                for (int cc = 0; cc < 16; ++cc) { const h16x8 kv = kp[cc];
#pragma unroll
                    for (int e = 0; e < 8; ++e) a = fmaf(qf[h * 128 + cc * 8 + e], (float)kv[e], a); }
                s[c] = a;
            }
        }
        const float mx = wave_max(fmaxf(fmaxf(s[0], s[1]), fmaxf(s[2], s[3])));
        float ls = 0.f;
#pragma unroll
        for (int c = 0; c < 4; ++c) { const int idx = lane + 64 * c; const float p = (idx < nsel) ? exp2f(s[c] - mx) : 0.f; pf[idx] = p; ls += p; }
        ls = wave_sum(ls);
        LDS_FENCE();
        float o0 = 0.f, o1 = 0.f;
        for (int k = 0; k < nsel; ++k) {
            const h16x2 v = *(const h16x2*)(Vb + (size_t)(b * L + keys[k]) * 1024 + h * 128 + 2 * lane); const float pk = pf[k];
            o0 = fmaf(pk, (float)v[0], o0); o1 = fmaf(pk, (float)v[1], o1);
        }
        const float inv = 1.0f / ls;
        const h16x2 g = *(const h16x2*)(SG + (size_t)t * 1024 + h * 128 + 2 * lane);
        h16x2 o; o[0] = (h16)(o0 * inv * (float)g[0]); o[1] = (h16)(o1 * inv * (float)g[1]);
        *(h16x2*)(QA + (size_t)t * 1024 + h * 128 + 2 * lane) = o;
    }
}


namespace att {
typedef unsigned short bf16;
typedef short bf16x8 __attribute__((ext_vector_type(8)));
typedef short s16x4 __attribute__((ext_vector_type(4)));
typedef float f32x16 __attribute__((ext_vector_type(16)));
typedef __attribute__((address_space(3))) char lchar;
typedef __attribute__((address_space(3))) float lfloat;
typedef __attribute__((address_space(3))) bf16x8 lbf16x8;
constexpr int D = 128, PITCH = 1024, NW = 8, QBLK = 32, KVBLK = 64, QB = NW * QBLK;
constexpr int SHM_V = KVBLK * D * 2, SHM_K = KVBLK * D * 2;
constexpr int LDS_ATT = 2 * SHM_V + 2 * SHM_K + NW * 64 * 4;
constexpr float THR = 8.f;
#define KSWZ(row, colB) ((row) * 256 + ((colB) ^ (((row) & 7) << 4)))
#define SBAR() __builtin_amdgcn_sched_barrier(0)
__device__ __forceinline__ int v_st(int k, int c) { const int kk = (k & ~0xC) | ((k & 4) << 1) | ((k & 8) >> 1); return ((kk >> 3) * 4 + (c >> 5)) * 512 + ((kk & 7) * 32 + (c & 31)) * 2; }
__device__ __forceinline__ int v_rd_base(int lane) { return ((lane & 3) << 3) | (((lane >> 2) & 3) << 6) | (((lane >> 4) & 1) << 5) | (((lane >> 5) & 1) << 8); }
constexpr int v_rd_off(int d0, int ks, int half) { return d0 * 512 + ks * 4096 + half * 2048; }
__device__ __forceinline__ int crow(int r, int hi) { return (r & 3) + 8 * (r >> 2) + 4 * hi; }
__device__ __forceinline__ bf16x8 load8(const bf16* p) { return *reinterpret_cast<const bf16x8*>(p); }
__device__ __forceinline__ void mask_init(f32x16& p0, f32x16& p1, unsigned long long mk, int hi) {
    const unsigned lo = (unsigned)mk >> (4 * hi), hh = (unsigned)(mk >> 32) >> (4 * hi);
#pragma unroll
    for (int r = 0; r < 16; ++r) {
        const int c = (r & 3) + 8 * (r >> 2);
        const int t0 = __builtin_amdgcn_sbfe(lo, c, 1), t1 = __builtin_amdgcn_sbfe(hh, c, 1);
        p0[r] = __uint_as_float(~(unsigned)t0 & 0xff800000u); p1[r] = __uint_as_float(~(unsigned)t1 & 0xff800000u);
    }
}
__device__ __forceinline__ void partialSM(f32x16& p0, f32x16& p1, float& m_reg, float& mn, float& alpha) {
    float pmax = p0[0]; for (int r = 1; r < 16; ++r) pmax = fmaxf(pmax, p0[r]); for (int r = 0; r < 16; ++r) pmax = fmaxf(pmax, p1[r]);
    { auto rr = __builtin_amdgcn_permlane32_swap(__float_as_uint(pmax), __float_as_uint(pmax), false, false);
      pmax = fmaxf(__uint_as_float(rr[0]), __uint_as_float(rr[1])); }
    if (__builtin_expect(__all((pmax - m_reg) <= THR), 1)) { mn = m_reg; alpha = 1.f; }
    else { mn = fmaxf(m_reg, pmax); alpha = __builtin_amdgcn_exp2f(m_reg - mn); m_reg = mn; }
    for (int r = 0; r < 16; ++r) p0[r] = p0[r] - mn; for (int r = 0; r < 16; ++r) p1[r] = p1[r] - mn;
    for (int r = 0; r < 16; ++r) p0[r] = __builtin_amdgcn_exp2f(p0[r]);
}
__device__ __forceinline__ void finishSM(f32x16& p0, f32x16& p1, float alpha, float& l_reg, bf16x8& pa0, bf16x8& pa1, bf16x8& pa2, bf16x8& pa3) {
    for (int r = 0; r < 16; ++r) p1[r] = __builtin_amdgcn_exp2f(p1[r]);
    float ps = 0; for (int r = 0; r < 16; ++r) ps += p0[r]; for (int r = 0; r < 16; ++r) ps += p1[r];
    { auto rr = __builtin_amdgcn_permlane32_swap(__float_as_uint(ps), __float_as_uint(ps), false, false);
      ps = __uint_as_float(rr[0]) + __uint_as_float(rr[1]); }
    l_reg = l_reg * alpha + ps;
#define PK4(P, B_, OUT) do { unsigned a0 = cvtpk_bf16(P[B_+0], P[B_+1]), a1 = cvtpk_bf16(P[B_+2], P[B_+3]);                          \
        unsigned b0 = cvtpk_bf16(P[B_+4], P[B_+5]), b1 = cvtpk_bf16(P[B_+6], P[B_+7]);                                             \
        auto r0 = __builtin_amdgcn_permlane32_swap(a0, b0, false, false); auto r1 = __builtin_amdgcn_permlane32_swap(a1, b1, false, false); \
        u32x4 w = {r0[0], r1[0], r0[1], r1[1]}; OUT = *reinterpret_cast<bf16x8*>(&w); } while (0)
    PK4(p0, 0, pa0); PK4(p0, 8, pa1); PK4(p1, 0, pa2); PK4(p1, 8, pa3);
#undef PK4
}
template <int KB>
__device__ __forceinline__ void qkt(f32x16& p0, f32x16& p1, const lchar* K_lds, int r32, int hi, const bf16x8* qr) {
    const lchar* kb[4];
#pragma unroll
    for (int dd = 0; dd < 4; ++dd) kb[dd] = K_lds + KB * SHM_K + KSWZ(r32, (dd * 16 + hi * 8) * 2);
#pragma unroll
    for (int d0 = 0; d0 < 8; ++d0) { const lchar* a = kb[d0 & 3] + (d0 >> 2) * 128;
        bf16x8 b0 = *(const lbf16x8*)(a);
        bf16x8 b1 = *(const lbf16x8*)(a + 32 * 256);
        p0 = __builtin_amdgcn_mfma_f32_32x32x16_bf16(b0, qr[d0], p0, 0, 0, 0);
        p1 = __builtin_amdgcn_mfma_f32_32x32x16_bf16(b1, qr[d0], p1, 0, 0, 0); }
}
template <int VB>
__device__ __forceinline__ void pv_tile(f32x16* o, int vb0, bf16x8 pa0, bf16x8 pa1, bf16x8 pa2, bf16x8 pa3) {
#define TRRD(dst, off) asm volatile("ds_read_b64_tr_b16 %0, %1 offset:%2" : "=&v"(dst) : "v"(vb0), "i"(off) : "memory")
#define PV_D0(d0) do { s16x4 l0, l1, l2, l3, h0, h1, h2, h3; constexpr int b_ = VB * SHM_V + v_rd_off(d0, 0, 0); \
        TRRD(l0, b_); TRRD(h0, b_ + 2048); TRRD(l1, b_ + 4096); TRRD(h1, b_ + 6144); TRRD(l2, b_ + 8192); TRRD(h2, b_ + 10240); TRRD(l3, b_ + 12288); TRRD(h3, b_ + 14336); \
        asm volatile("s_waitcnt lgkmcnt(0)" ::: "memory"); SBAR();   \
        o[d0] = __builtin_amdgcn_mfma_f32_32x32x16_bf16(pa0, (bf16x8){l0[0], l0[1], l0[2], l0[3], h0[0], h0[1], h0[2], h0[3]}, o[d0], 0, 0, 0);   \
        o[d0] = __builtin_amdgcn_mfma_f32_32x32x16_bf16(pa1, (bf16x8){l1[0], l1[1], l1[2], l1[3], h1[0], h1[1], h1[2], h1[3]}, o[d0], 0, 0, 0);   \
        o[d0] = __builtin_amdgcn_mfma_f32_32x32x16_bf16(pa2, (bf16x8){l2[0], l2[1], l2[2], l2[3], h2[0], h2[1], h2[2], h2[3]}, o[d0], 0, 0, 0);   \
        o[d0] = __builtin_amdgcn_mfma_f32_32x32x16_bf16(pa3, (bf16x8){l3[0], l3[1], l3[2], l3[3], h3[0], h3[1], h3[2], h3[3]}, o[d0], 0, 0, 0); } while (0)
    PV_D0(0); PV_D0(1); PV_D0(2); PV_D0(3);
#undef PV_D0
#undef TRRD
}
struct BlockRef { const bf16* Q; const bf16* K; const bf16* V; h16* O; const unsigned long long* M; const h16* G; int P0; };
struct Seam { bf16x8 qr[8]; bf16x8 st_v0, st_v1, st_k0, st_k1; };
#define VMW() asm volatile("s_waitcnt vmcnt(0)" ::: "memory")
#define VMWN(n) asm volatile("s_waitcnt vmcnt(%0)" :: "i"(n) : "memory")
#define SLOAD_H(Kp, Vp, k0) do { const unsigned o0_ = ro0 + (unsigned)(k0) * PITCH, o1_ = o0_ + 32u * PITCH;     \
                         S.st_v0 = load8((Vp) + o0_); S.st_v1 = load8((Vp) + o1_); S.st_k0 = load8((Kp) + o0_); S.st_k1 = load8((Kp) + o1_); } while (0)
#define SWRITE_HK(bf) do { *(lbf16x8*)(K_lds + (bf) * SHM_K + kws) = S.st_k0; *(lbf16x8*)(K_lds + (bf) * SHM_K + kws + 32 * 256) = S.st_k1; } while (0)
#define SWRITE_HV(bf) do { *(lbf16x8*)(V_lds + (bf) * SHM_V + vst0) = S.st_v0; *(lbf16x8*)(V_lds + (bf) * SHM_V + vst1) = S.st_v1; } while (0)
#define SWRITE_H(bf) do { SWRITE_HV(bf); SWRITE_HK(bf); } while (0)
__device__ __forceinline__ void prime(const BlockRef& cur, lchar* lds, Seam& S, int wv) {
    const int tid = my_tid(wv);
    const int wid = __builtin_amdgcn_readfirstlane(tid >> 6), lane = tid & 63, r32 = lane & 31, hi = lane >> 5;
    const int sr = tid >> 4, sc = (tid & 15) * 8, kws = KSWZ(sr, sc * 2); lchar* K_lds = lds + 2 * SHM_V;
    const unsigned ro0 = (unsigned)(sr * PITCH + sc), qo = (unsigned)((wid * QBLK + r32) * PITCH + hi * 8);
    for (int d0 = 0; d0 < 8; ++d0) S.qr[d0] = load8(cur.Q + (qo + (unsigned)(d0 * 16)));
    SLOAD_H(cur.K, cur.V, 0); VMW(); SWRITE_HK(0);
    __syncthreads();
}
__device__ __forceinline__ void block(const BlockRef& cur, const BlockRef& nxt, lchar* lds, Seam& S, int wv) {
    const int tid = my_tid(wv);
    const int wid = __builtin_amdgcn_readfirstlane(tid >> 6), lane = tid & 63, r32 = lane & 31, hi = lane >> 5;
    const int NT = (cur.P0 + QB - 1) / KVBLK + 1;
    lchar* V_lds = lds; lchar* K_lds = lds + 2 * SHM_V;
    lfloat* ws = (lfloat*)(lds + 2 * SHM_V + 2 * SHM_K) + wid * 64; lfloat* li_l = ws, * al_l = ws + 32;
    float m_reg = -1e30f, l_reg = 0; f32x16 o[4] = {};
    const int sr = tid >> 4, sc = (tid & 15) * 8, vst0 = v_st(sr, sc), vst1 = v_st(32 + sr, sc), kws = KSWZ(sr, sc * 2);
    const int vb0 = (int)(unsigned)(uintptr_t)V_lds + v_rd_base(lane);
    const unsigned ro0 = (unsigned)(sr * PITCH + sc), qo = (unsigned)((wid * QBLK + r32) * PITCH + hi * 8);
    const bf16* Kh = cur.K; const bf16* Vh = cur.V;
    const unsigned mro = (unsigned)(wid * QBLK + r32) * 8u;
#define LDMASK(tile) (*(const unsigned long long*)((const char*)cur.M + (mro + (unsigned)(tile) * (unsigned)(L * 8))))
    unsigned long long mk;
#define RESC(a) do { if (__any((a) < 1.f)) { if (hi == 0) al_l[r32] = (a); asm volatile("s_waitcnt lgkmcnt(0)" ::: "memory");              \
                     for (int d_ = 0; d_ < 4; ++d_) for (int r = 0; r < 16; ++r) o[d_][r] *= al_l[crow(r, hi)]; } } while (0)
#define KBASE(t) ((t) * KVBLK)
    constexpr int NQL = 8;
#define SEAM_K0() do { VMWN(NQL); SWRITE_HK(0); SBAR(); } while (0)
    f32x16 pA0, pA1, pB0, pB1; float mnA, mnB, alA, alB; bf16x8 pa0, pa1, pa2, pa3;
    SWRITE_HV(0); SBAR();
    mk = LDMASK(0);
    if (NT > 1) { SLOAD_H(Kh, Vh, KBASE(1)); }
    mask_init(pA0, pA1, mk, hi); if (NT > 1) mk = LDMASK(1);
    SBAR(); qkt<0>(pA0, pA1, K_lds, r32, hi, S.qr);
    partialSM(pA0, pA1, m_reg, mnA, alA);
    if (NT > 1) { VMW(); SWRITE_H(1); }
    __syncthreads();
#define HALF_STEP(PX0, PX1, mnX, alX, PY0, PY1, alY, t, KB, VB, SB) do {                                                      \
        mask_init(PX0, PX1, mk, hi);                                       \
        SBAR(); qkt<KB>(PX0, PX1, K_lds, r32, hi, S.qr);                                                                      \
        if ((t) + 1 < NT) mk = LDMASK((t) + 1);                                                              \
        finishSM(PY0, PY1, alY, l_reg, pa0, pa1, pa2, pa3); SBAR();                                                           \
        if ((t) + 1 < NT) { SLOAD_H(Kh, Vh, KBASE((t) + 1)); SBAR(); }                                                        \
        pv_tile<VB>(o, vb0, pa0, pa1, pa2, pa3); partialSM(PX0, PX1, m_reg, mnX, alX);                                        \
        __syncthreads();                                                                                                      \
        if ((t) + 1 < NT) { VMW(); SWRITE_H(SB); }                                                                            \
        RESC(alX); __syncthreads(); } while (0)
    for (int t = 1; t + 1 < NT; t += 2) {
        HALF_STEP(pB0, pB1, mnB, alB, pA0, pA1, alA, t, 1, 0, 0);
        HALF_STEP(pA0, pA1, mnA, alA, pB0, pB1, alB, t + 1, 0, 1, 1);
    }
    const bool even = (NT & 1) == 0;
    if (even) { mask_init(pB0, pB1, mk, hi); SBAR(); qkt<1>(pB0, pB1, K_lds, r32, hi, S.qr); SBAR(); }
    SLOAD_H(nxt.K, nxt.V, 0); SBAR();
#pragma unroll
    for (int d0 = 0; d0 < 8; ++d0) S.qr[d0] = load8(nxt.Q + (qo + (unsigned)(d0 * 16)));
    SBAR();
    finishSM(pA0, pA1, alA, l_reg, pa0, pa1, pa2, pa3); SBAR();
    pv_tile<0>(o, vb0, pa0, pa1, pa2, pa3);
    if (even) { partialSM(pB0, pB1, m_reg, mnB, alB); __syncthreads(); RESC(alB);
        finishSM(pB0, pB1, alB, l_reg, pa0, pa1, pa2, pa3); SBAR(); pv_tile<1>(o, vb0, pa0, pa1, pa2, pa3); }
    SBAR(); SEAM_K0();
    if (hi == 0) li_l[r32] = l_reg; asm volatile("s_waitcnt lgkmcnt(0)" ::: "memory");
    float rli[16];
#pragma unroll
    for (int r = 0; r < 16; ++r) rli[r] = __builtin_amdgcn_rcpf(li_l[crow(r, hi)]);
    __syncthreads();
    {
        typedef __attribute__((address_space(3))) h16 lh16; typedef __attribute__((address_space(3))) h16x8 lh16x8_;
        lchar* ob = V_lds + wid * 4096;
#pragma unroll
        for (int half = 0; half < 2; ++half) {
#pragma unroll
            for (int r = 0; r < 16; ++r) { const int orow = crow(r, hi);
#pragma unroll
                for (int dd = 0; dd < 2; ++dd) *(lh16*)(ob + orow * 128 + (dd * 32 + r32) * 2) = (h16)(o[half * 2 + dd][r] * rli[r]); }
            asm volatile("s_waitcnt lgkmcnt(0)" ::: "memory");
#pragma unroll
            for (int i = 0; i < 4; ++i) { const int c = lane + 64 * i, row = c >> 3, c8 = c & 7;
                const h16x8 ov = *(const lh16x8_*)(ob + row * 128 + c8 * 16);
                const unsigned oo = (unsigned)((wid * QBLK + row) * PITCH + half * 64 + c8 * 8);
                const h16x8 gv = *(const h16x8*)(cur.G + oo);
                *(h16x8*)(cur.O + oo) = ov * gv; }
            asm volatile("s_waitcnt lgkmcnt(0)" ::: "memory");
        }
    }
    __syncthreads();
#undef LDMASK
#undef RESC
#undef KBASE
#undef SEAM_K0
#undef HALF_STEP
}
#undef VMW
#undef VMWN
#undef SLOAD_H
#undef SWRITE_HK
#undef SWRITE_HV
#undef SWRITE_H
#undef KSWZ
#undef SBAR
}

__device__ __forceinline__ att::BlockRef att_ref(const Params& P, unsigned char* ws, int item, int pass) {
    const int xcd = item & 7, kq = item >> 3, bh = (kq >> 2) * 8 + xcd, x = kq & 3, qb = pass ? 7 - x : x, b = bh >> 3, h = bh & 7;
    const size_t row0 = (size_t)b * L + (size_t)qb * 256;
    att::BlockRef r;
    r.Q = (const att::bf16*)(ws + WS_R1) + row0 * 1024 + h * 128; r.O = (h16*)(ws + WS_AO) + row0 * 1024 + h * 128;
    r.K = (const att::bf16*)(ws + WS_R2) + (size_t)b * L * 1024 + h * 128; r.V = (const att::bf16*)(ws + WS_R3) + (size_t)b * L * 1024 + h * 128;
    r.M = (const unsigned long long*)(ws + WS_MASK) + (size_t)b * 32 * L + (size_t)qb * 256;
    r.G = (const h16*)(ws + WS_R4) + row0 * 1024 + h * 128; r.P0 = qb * 256;
    return r;
}
__device__ __forceinline__ void p4_attn(const Params& P, unsigned char* lds, int blk, int nblk, int wv) {
    unsigned char* ws = opaque_ptr(P.ws);
    const int total = NB * 8 * 4;
    int it = blk; if (it >= total) return;
    int pass = 0;
    att::BlockRef cur = att_ref(P, ws, it, 0);
    att::Seam S;
    att::prime(cur, (att::lchar*)lds, S, wv);
    for (;;) {
        const bool more_pass = pass == 0, more_item = it + nblk < total, last = !more_pass && !more_item;
        int itn = it, passn = pass + 1;
        if (!more_pass) { passn = 0; itn = more_item ? it + nblk : it; }
        const att::BlockRef nxt = last ? cur : att_ref(P, ws, itn, passn);
        att::block(cur, nxt, (att::lchar*)lds, S, wv);
        if (last) break;
        cur = nxt; it = itn; pass = passn;
    }
}

__device__ __forceinline__ void p8_ret_naive(const Params& P, unsigned char* lds, int blk, int nblk, int wv) {
    const int tid = my_tid(wv);
    float* qk = (float*)lds;
    const h16* RQ = (const h16*)(P.ws + WS_R1); const h16* RK = (const h16*)(P.ws + WS_R2); h16* RV = (h16*)(P.ws + WS_R4);
    const int j = tid >> 2, iq = tid & 3;
    for (int it = blk; it < 256; it += nblk) {
        const int b = it >> 4, h = (it >> 2) & 3, sl = it & 3;
        const float gamma = 1.0f - exp2f(-5.0f - (float)h);
        float S[64];
#pragma unroll
        for (int i = 0; i < 64; ++i) S[i] = 0.f;
        const int col = tid & 255;
        const h16* src = (tid < 256 ? RQ : RK) + (size_t)b * L * 1024 + h * 256 + col;
        float* dst = qk + (tid >> 8) * 272 + (col >> 6) * 68 + (col & 63);
        h16* vp = RV + (size_t)b * L * 2048 + h * 512 + sl * 128 + j;
        for (int t0 = 0; t0 < L; t0 += 16) {
            __syncthreads();
            h16 vv[16];
#pragma unroll
            for (int tt = 0; tt < 16; ++tt) { dst[tt * 544] = (float)src[(size_t)(t0 + tt) * 1024]; vv[tt] = vp[(size_t)(t0 + tt) * 2048]; }
            __syncthreads();
#pragma unroll
            for (int tt = 0; tt < 16; ++tt) {
                const f32x4* qp = (const f32x4*)(qk + tt * 544 + iq * 68); const f32x4* kp = (const f32x4*)(qk + tt * 544 + 272 + iq * 68);
                const float v = (float)vv[tt]; float o = 0.f;
#pragma unroll
                for (int i4 = 0; i4 < 16; ++i4) { const f32x4 q4 = qp[i4], k4 = kp[i4];
#pragma unroll
                    for (int e = 0; e < 4; ++e) { S[i4 * 4 + e] = fmaf(gamma, S[i4 * 4 + e], k4[e] * v); o = fmaf(q4[e], S[i4 * 4 + e], o); } }
                o += __shfl_xor(o, 1); o += __shfl_xor(o, 2);
                if (iq == 0) vp[(size_t)(t0 + tt) * 2048] = (h16)o;
            }
        }
    }
}


namespace ret {
typedef __attribute__((address_space(3))) unsigned char lch;
typedef __attribute__((address_space(3))) h16x8 lh16x8;
typedef __attribute__((address_space(3))) h16x4 lh16x4;
typedef __attribute__((address_space(3))) u32x4 lu32x4;
typedef short v4i16 __attribute__((ext_vector_type(4)));
typedef __attribute__((address_space(3))) v4i16 lv4i16;
constexpr int SKB = 544, SVB = 288, SSB = 544;
constexpr int OFF_K = 0, OFF_V = 64 * SKB, OFF_S = OFF_V + 64 * SVB, LDS_RET = OFF_S + 128 * SSB;
__device__ __forceinline__ h16x4 trrd(const lch* p) { return __builtin_bit_cast(h16x4, __builtin_amdgcn_ds_read_tr16_b64_v4i16((lv4i16*)p)); }
__device__ __forceinline__ h16x8 cat8(h16x4 a, h16x4 b) { return __builtin_shufflevector(a, b, 0, 1, 2, 3, 4, 5, 6, 7); }
}
#define P8_GATE(m_, ro_) do { const char* gp_ = (const char*)(RG + ((size_t)b * L + (size_t)(m_) * 64) * 2048 + h * 512 + sl * 128) + (ro_); gt0 = *(const h16x8*)gp_; gt1 = *(const h16x8*)(gp_ + 16); } while (0)
#define P8_XSLD(m_, rw_) do { _Pragma("unroll") for (int s_ = 0; s_ < 4; ++s_) xsv[s_] = __hip_atomic_load((const unsigned long long*)((const char*)(XS + (size_t)(grp0 + (m_)) * 256) + (unsigned)(s_ * 512 + (rw_) * 8)), __ATOMIC_RELAXED, __HIP_MEMORY_SCOPE_AGENT); } while (0)
#define P8_XSOK() (((unsigned)xsv[0] != 0xffffffffu) && ((unsigned)xsv[1] != 0xffffffffu) && ((unsigned)xsv[2] != 0xffffffffu) && ((unsigned)xsv[3] != 0xffffffffu))
#define P8_WAIT(m_, rw_) do { unsigned sp_ = 0u; while (!__all(P8_XSOK())) { __builtin_amdgcn_s_sleep(1); P8_XSLD(m_, rw_); \
        if (++sp_ > (1u << 20)) { if (lane == 0) __hip_atomic_store((unsigned*)(ws + WS_BAR) + XB_TMO_W, 1u, __ATOMIC_RELAXED, __HIP_MEMORY_SCOPE_AGENT); break; } } } while (0)
#define P8_FINAL(m_, rw_, ro_, lo_) do { const int mm_ = (m_); P8_WAIT(mm_, rw_); float S1_ = 0.f, S2_ = 0.f; \
        _Pragma("unroll") for (int s_ = 0; s_ < 4; ++s_) { S1_ += __uint_as_float((unsigned)xsv[s_]); S2_ += __uint_as_float((unsigned)(xsv[s_] >> 32)); } \
        const float mu_ = S1_ * (1.0f / 512.0f); const float var_ = fmaxf(S2_ * (1.0f / 512.0f) - mu_ * mu_, 0.f); const float rs_ = rsqrtf(var_ + EPS); const float nb_ = -mu_ * rs_; \
        const lch* op_ = OT + (mm_ & 1) * OT_BYTES + (lo_); const h16x8 o0_ = *(const lh16x8*)op_, o1_ = *(const lh16x8*)(op_ + 16); h16x8 y0_, y1_; \
        _Pragma("unroll") for (int e = 0; e < 8; ++e) { y0_[e] = (h16)(fmaf((float)o0_[e], rs_, nb_) * (float)gt0[e]); y1_[e] = (h16)(fmaf((float)o1_[e], rs_, nb_) * (float)gt1[e]); } \
        char* dp_ = (char*)(vg + (size_t)mm_ * 64 * 2048) + (ro_); *(h16x8*)dp_ = y0_; *(h16x8*)(dp_ + 16) = y1_; } while (0)
#define XB_TMO_W 128
__device__ __forceinline__ void p8_retention(const Params& P, unsigned char* lds_, int blk, int nblk, int wv) {
    using namespace ret;
    const int tid = my_tid(wv), wid = __builtin_amdgcn_readfirstlane(tid >> 6), lane = tid & 63, c16 = lane & 15, g = lane >> 4, q4 = c16 >> 2, p4 = c16 & 3;
    const int it = wid & 3, dh = wid >> 2;
    unsigned char* ws = opaque_ptr(P.ws);
    lch* Kc = (lch*)lds_ + OFF_K; lch* Vc = (lch*)lds_ + OFF_V; lch* St = (lch*)lds_ + OFF_S;
    const h16* RQ = (const h16*)(ws + WS_R1); const h16* RK = (const h16*)(ws + WS_R2); h16* RV = (h16*)(ws + WS_R4);
    const bool fusedgn = (nblk == 256);
    const h16* RG = (const h16*)(ws + WS_RG);
    unsigned long long* XS = (unsigned long long*)(ws + WS_KIDXN);
    typedef __attribute__((address_space(3))) f32x2 lf32x2;
    lf32x2* PS = (lf32x2*)((lch*)lds_ + LDS_RET);
    for (int item = blk; item < 256; item += nblk) {
        const int b = item >> 4, h = (item >> 2) & 3, sl = item & 3;
        const int grp0 = (b * 4 + h) * 32;
        constexpr int OT_PITCH = 272, OT_BYTES = 64 * OT_PITCH;
        lch* OT = (lch*)lds_ + LDS_RET + 1024;
        h16x8 gt0 = (h16x8){0, 0, 0, 0, 0, 0, 0, 0}, gt1 = gt0;
        const float lgam = log2f(1.0f - exp2f(-5.0f - (float)h));
        const float gamma64 = exp2f(64.0f * lgam);
        f32x4 state[16];
#pragma unroll
        for (int d = 0; d < 16; ++d) state[d] = (f32x4){0.f, 0.f, 0.f, 0.f};
        __syncthreads();
        { unsigned zz = 0u; asm volatile("" : "+v"(zz));
          for (int i = tid; i < 128 * SSB / 16; i += NTHREADS) ((lu32x4*)St)[i] = (u32x4){zz, zz, zz, zz}; }
        const h16* kg = RK + (size_t)b * L * 1024 + h * 256; const h16* vg = RV + (size_t)b * L * 2048 + h * 512 + sl * 128;
        h16x8 kreg[4], vreg[2];
        const unsigned qoff = (unsigned)((16 * it + c16) * 1024 + 8 * g) * 2u, ooff = (unsigned)((16 * it + c16) * 2048 + 64 * dh + 4 * g) * 2u;
        unsigned ko[4], vo[2];
#pragma unroll
        for (int i = 0; i < 4; ++i) { const int c = tid + NTHREADS * i; ko[i] = (unsigned)((c >> 5) * 1024 + (c & 31) * 8) * 2u; }
#pragma unroll
        for (int i = 0; i < 2; ++i) { const int c = tid + NTHREADS * i; vo[i] = (unsigned)((c >> 4) * 2048 + (c & 15) * 8) * 2u; }
#pragma unroll
        for (int i = 0; i < 4; ++i) kreg[i] = *(const h16x8*)((const char*)kg + ko[i]);
#pragma unroll
        for (int i = 0; i < 2; ++i) vreg[i] = *(const h16x8*)((const char*)vg + vo[i]);
#pragma unroll
        for (int i = 0; i < 4; ++i) { const int c = tid + NTHREADS * i; *(lh16x8*)(Kc + (c >> 5) * SKB + (c & 31) * 16) = kreg[i]; }
#pragma unroll
        for (int i = 0; i < 2; ++i) { const int c = tid + NTHREADS * i; *(lh16x8*)(Vc + (c >> 4) * SVB + (c & 15) * 16) = vreg[i]; }
        h16x8 Qn[8];
#pragma unroll
        for (int s = 0; s < 8; ++s) Qn[s] = *(const h16x8*)((const char*)(RQ + (size_t)b * L * 1024 + h * 256) + (qoff + (unsigned)(64 * s)));
        __syncthreads();
        for (int n = 0; n < L / 64; ++n) {
            const size_t row0 = (size_t)b * L + (size_t)n * 64;
            const int nn = (n + 1 < L / 64) ? n + 1 : n;
            unsigned kO[4] = {ko[0], ko[1], ko[2], ko[3]}, vO[2] = {vo[0], vo[1]}, qO = qoff, oO = ooff;
            asm volatile("" : "+v"(kO[0]), "+v"(kO[1]), "+v"(kO[2]), "+v"(kO[3]), "+v"(vO[0]), "+v"(vO[1]), "+v"(qO), "+v"(oO));
            int gO = g, cO = c16; asm volatile("" : "+v"(gO), "+v"(cO)); const int q4O = cO >> 2, p4O = cO & 3;
            float lg = lgam; asm volatile("" : "+v"(lg));
            const float xi = __builtin_amdgcn_exp2f((float)(16 * it + cO + 1) * lg);
            h16x8 Qf[8];
#pragma unroll
            for (int s = 0; s < 8; ++s) Qf[s] = Qn[s];
            unsigned long long xsv[4] = {0ull, 0ull, 0ull, 0ull};
            const int tF_ = my_tid(wv); const unsigned rowF = (unsigned)(tF_ >> 3), roF = rowF * 4096u + (unsigned)(tF_ & 7) * 32u, loF = rowF * (unsigned)OT_PITCH + (unsigned)(tF_ & 7) * 32u;
            if (fusedgn && n > 0) { P8_GATE(n - 1, roF); }
#pragma unroll
            for (int i = 0; i < 4; ++i) kreg[i] = *(const h16x8*)((const char*)(kg + (size_t)nn * 64 * 1024) + kO[i]);
#pragma unroll
            for (int i = 0; i < 2; ++i) vreg[i] = *(const h16x8*)((const char*)(vg + (size_t)nn * 64 * 2048) + vO[i]);
            h16x8 Pf[2];
#pragma unroll
            for (int ks = 0; ks < 2; ++ks)
#pragma unroll
                for (int e = 0; e < 8; ++e) Pf[ks][e] = (h16)0.f;
#pragma unroll
            for (int jt = 0; jt < 4; ++jt) {
                if (jt <= it) {
                    f32x4 S = (f32x4){0.f, 0.f, 0.f, 0.f}, Sb = S;
#pragma unroll
                    for (int s4 = 0; s4 < 8; s4 += 4) {
                        h16x8 A4[4];
#pragma unroll
                        for (int s = 0; s < 4; ++s) A4[s] = *(const lh16x8*)(Kc + (16 * jt + c16) * SKB + (32 * (s4 + s) + 8 * g) * 2);
                        __builtin_amdgcn_sched_barrier(0);
#pragma unroll
                        for (int s = 0; s < 4; s += 2) { S = __builtin_amdgcn_mfma_f32_16x16x32_f16(A4[s], Qf[s4 + s], S, 0, 0, 0); Sb = __builtin_amdgcn_mfma_f32_16x16x32_f16(A4[s + 1], Qf[s4 + s + 1], Sb, 0, 0, 0); }
                        __builtin_amdgcn_sched_barrier(0);
                    }
                    S = S + Sb;
#pragma unroll
                    for (int e = 0; e < 4; ++e) { const int d = (16 * it + cO) - (16 * jt + 4 * gO + e); const float f = (d >= 0) ? __builtin_amdgcn_exp2f((float)d * lg) : 0.f; Pf[jt >> 1][(jt & 1) * 4 + e] = (h16)(S[e] * f); }
                }
            }
            if (fusedgn && n > 0) { P8_XSLD(n - 1, rowF); }
            f32x4 acc[4];
#pragma unroll
            for (int dt = 0; dt < 4; ++dt) acc[dt] = (f32x4){0.f, 0.f, 0.f, 0.f};
#pragma unroll
            for (int s2 = 0; s2 < 8; ++s2) {
                h16x8 A4[4];
#pragma unroll
                for (int dt = 0; dt < 4; ++dt) A4[dt] = *(const lh16x8*)(St + (16 * (4 * dh + dt) + c16) * SSB + (32 * s2 + 8 * g) * 2);
                __builtin_amdgcn_sched_barrier(0);
#pragma unroll
                for (int dt = 0; dt < 4; ++dt) acc[dt] = __builtin_amdgcn_mfma_f32_16x16x32_f16(A4[dt], Qf[s2], acc[dt], 0, 0, 0);
                __builtin_amdgcn_sched_barrier(0);
            }
#pragma unroll
            for (int dt = 0; dt < 4; ++dt) acc[dt] = acc[dt] * xi;
#pragma unroll
            for (int ks = 0; ks < 2; ++ks) {
                if (2 * ks <= it) {
                    h16x8 A4[4];
#pragma unroll
                    for (int dt = 0; dt < 4; ++dt) { const lch* vp = Vc + (32 * ks + 4 * gO + q4O) * SVB + (16 * (4 * dh + dt) + 4 * p4O) * 2; A4[dt] = cat8(trrd(vp), trrd(vp + 16 * SVB)); }
                    __builtin_amdgcn_sched_barrier(0);
#pragma unroll
                    for (int dt = 0; dt < 4; ++dt) acc[dt] = __builtin_amdgcn_mfma_f32_16x16x32_f16(A4[dt], Pf[ks], acc[dt], 0, 0, 0);
                    __builtin_amdgcn_sched_barrier(0);
                }
            }
            if (!fusedgn) {
#pragma unroll
                for (int dt = 0; dt < 4; ++dt) *(h16x4*)((char*)(vg + (size_t)n * 64 * 2048) + (oO + (unsigned)(32 * dt))) = pack4(acc[dt]);
            } else {
                float s1 = 0.f, s2 = 0.f;
#pragma unroll
                for (int dt = 0; dt < 4; ++dt)
#pragma unroll
                    for (int e = 0; e < 4; ++e) { s1 += acc[dt][e]; s2 = fmaf(acc[dt][e], acc[dt][e], s2); }
                s1 = fq_sum(s1); s2 = fq_sum(s2);
                const int tk = (int)(oO >> 12);
                if ((oO & 24u) == 0u) PS[dh * 64 + tk] = (f32x2){s1, s2};
                { lch* wp_ = OT + (n & 1) * OT_BYTES + (unsigned)tk * (unsigned)OT_PITCH + (oO & 4095u);
#pragma unroll
                  for (int dt = 0; dt < 4; ++dt) *(lh16x4*)(wp_ + 32 * dt) = pack4(acc[dt]); }
            }
#pragma unroll
            for (int s = 0; s < 8; ++s) Qn[s] = *(const h16x8*)((const char*)(RQ + ((size_t)b * L + (size_t)nn * 64) * 1024 + h * 256) + (qO + (unsigned)(64 * s)));
            h16x8 Bv[2];
#pragma unroll
            for (int ks = 0; ks < 2; ++ks) { const lch* vp = Vc + (32 * ks + 8 * gO + q4O) * SVB + (16 * wid + 4 * p4O) * 2; h16x8 zf;
#pragma unroll
                for (int e = 0; e < 8; ++e) zf[e] = (h16)__builtin_amdgcn_exp2f((float)(63 - (32 * ks + 8 * gO + e)) * lg);
                Bv[ks] = cat8(trrd(vp), trrd(vp + 4 * SVB)) * zf; }
#pragma unroll
            for (int d4 = 0; d4 < 16; d4 += 2) {
                h16x8 A4[4];
#pragma unroll
                for (int j = 0; j < 2; ++j)
#pragma unroll
                    for (int ks = 0; ks < 2; ++ks) { const lch* kp = Kc + (32 * ks + 8 * gO + q4O) * SKB + (16 * (d4 + j) + 4 * p4O) * 2; A4[j * 2 + ks] = cat8(trrd(kp), trrd(kp + 4 * SKB)); }
#pragma unroll
                for (int j = 0; j < 2; ++j) state[d4 + j] = state[d4 + j] * gamma64;
                __builtin_amdgcn_sched_barrier(0);
#pragma unroll
                for (int ks = 0; ks < 2; ++ks)
#pragma unroll
                    for (int j = 0; j < 2; ++j) state[d4 + j] = __builtin_amdgcn_mfma_f32_16x16x32_f16(A4[j * 2 + ks], Bv[ks], state[d4 + j], 0, 0, 0);
                __builtin_amdgcn_sched_barrier(0);
            }
            if (fusedgn && n > 0) { P8_FINAL(n - 1, rowF, roF, loF); }
            __syncthreads();
            if (fusedgn && wid == 0) {
                int lO = lane; asm volatile("" : "+v"(lO));
                const f32x2 pa = PS[lO], pb = PS[64 + lO];
                const unsigned long long pk = (unsigned long long)__float_as_uint(pa[0] + pb[0]) | ((unsigned long long)__float_as_uint(pa[1] + pb[1]) << 32);
                __hip_atomic_store((unsigned long long*)((char*)(XS + ((size_t)(grp0 + n) * 4 + sl) * 64) + (unsigned)(lO * 8)), pk, __ATOMIC_RELAXED, __HIP_MEMORY_SCOPE_AGENT);
            }
#pragma unroll
            for (int dkt = 0; dkt < 16; ++dkt) *(lh16x4*)(St + (16 * wid + c16) * SSB + (16 * dkt + 4 * g) * 2) = pack4(state[dkt]);
#pragma unroll
            for (int i = 0; i < 4; ++i) { const int c = tid + NTHREADS * i; *(lh16x8*)(Kc + (c >> 5) * SKB + (c & 31) * 16) = kreg[i]; }
#pragma unroll
            for (int i = 0; i < 2; ++i) { const int c = tid + NTHREADS * i; *(lh16x8*)(Vc + (c >> 4) * SVB + (c & 15) * 16) = vreg[i]; }
            __syncthreads();
        }
        if (fusedgn) {
            const int tF_ = my_tid(wv); const unsigned rowF = (unsigned)(tF_ >> 3), roF = rowF * 4096u + (unsigned)(tF_ & 7) * 32u, loF = rowF * (unsigned)OT_PITCH + (unsigned)(tF_ & 7) * 32u;
            unsigned long long xsv[4]; P8_GATE(L / 64 - 1, roF); P8_XSLD(L / 64 - 1, rowF); P8_FINAL(L / 64 - 1, rowF, roF, loF);
        }
    }
#undef P8_FINAL
#undef P8_XSLD
#undef P8_GATE
#undef P8_WAIT
#undef P8_XSOK
}

__device__ __forceinline__ void p9_gnorm(const Params& P, int blk, int nblk, int wv) {
    const int tid = my_tid(wv), wid = tid >> 6, lane = tid & 63;
    unsigned char* ws = opaque_ptr(P.ws);
    h16* RO = (h16*)(ws + WS_R4); const h16* RG = (const h16*)(ws + WS_RG);
    const int gw = blk * NWAVES + wid, ngw = nblk * NWAVES;
    for (int t0 = gw; t0 < T; t0 += 2 * ngw) {
        h16x8 xv[2][4], gv[2][4];
#pragma unroll
        for (int k = 0; k < 2; ++k) { const int t = (t0 + k * ngw < T) ? t0 + k * ngw : t0;
#pragma unroll
            for (int h = 0; h < 4; ++h) { const size_t o = (size_t)t * 2048 + h * 512 + lane * 8; xv[k][h] = *(const h16x8*)(RO + o); gv[k][h] = *(const h16x8*)(RG + o); } }
#pragma unroll
        for (int k = 0; k < 2; ++k) { const int t = t0 + k * ngw;
#pragma unroll
            for (int h = 0; h < 4; ++h) {
                float v[8]; float s = 0.f;
#pragma unroll
                for (int e = 0; e < 8; ++e) { v[e] = (float)xv[k][h][e]; s += v[e]; }
                const float mu = wave_sum_dpp(s) * (1.0f / 512.0f); float q = 0.f;
#pragma unroll
                for (int e = 0; e < 8; ++e) { v[e] -= mu; q += v[e] * v[e]; }
                const float rstd = rsqrtf(wave_sum_dpp(q) * (1.0f / 512.0f) + EPS);
                h16x8 y;
#pragma unroll
                for (int e = 0; e < 8; ++e) y[e] = (h16)(v[e] * rstd * (float)gv[k][h][e]);
                if (t < T) *(h16x8*)(RO + (size_t)t * 2048 + h * 512 + lane * 8) = y;
            } }
    }
}

__device__ __forceinline__ void p12_final(const Params& P, int blk, int nblk, int wv) {
    const int tid = my_tid(wv), wid = tid >> 6, lane = tid & 63;
    unsigned char* ws = opaque_ptr(P.ws);
    const float* sq = (const float*)(ws + WS_SQH) + (size_t)3 * T * 16; const f32x4* g4 = (const f32x4*)P.in[18]; const h16* H4 = (const h16*)(ws + WS_R1);
    const int gw = blk * NWAVES + wid, ngw = nblk * NWAVES;
    for (int r0 = gw; r0 < T; r0 += 4 * ngw) {
        h16x8 hv[4][2]; f32x4 qv[4][4];
#pragma unroll
        for (int k = 0; k < 4; ++k) { const int r = r0 + k * ngw; if (r < T) {
#pragma unroll
            for (int j = 0; j < 2; ++j) hv[k][j] = *(const h16x8*)(H4 + (size_t)r * 1024 + (lane + 64 * j) * 8);
#pragma unroll
            for (int j = 0; j < 4; ++j) qv[k][j] = ((const f32x4*)(sq + (size_t)r * 16))[j]; } }
#pragma unroll
        for (int k = 0; k < 4; ++k) { const int r = r0 + k * ngw; if (r < T) {
            float s = 0.f;
#pragma unroll
            for (int j = 0; j < 4; ++j) s += (qv[k][j][0] + qv[k][j][1]) + (qv[k][j][2] + qv[k][j][3]);
            const float rstd = rsqrtf(s * (1.0f / 1024.0f) + EPS);
            f32x4* orow = (f32x4*)(P.out + (size_t)r * 1024);
#pragma unroll
            for (int j = 0; j < 2; ++j) { const int c4 = (lane + 64 * j) * 2; const f32x4 ga = g4[c4], gb = g4[c4 + 1]; f32x4 a, b2;
#pragma unroll
                for (int e = 0; e < 4; ++e) { a[e] = (float)hv[k][j][e] * rstd * ga[e]; b2[e] = (float)hv[k][j][4 + e] * rstd * gb[e]; }
                orow[c4] = a; orow[c4 + 1] = b2; } } }
    }
}

#define XB_TMO      128
#define XB_XCNT(j)  (256  + 64 * (j))
#define XB_XSUB(j)  (1280 + 64 * (j))
#define XB_XGEN(j)  (2304 + 64 * (j))
#define XB_TOP      3328
#define XB_TOPGEN   3392
#define XCD_BAR_WORDS 3456
#define XB_SPIN_CAP (1u << 18)
__device__ __forceinline__ unsigned xb_ld(unsigned* p)              { return __hip_atomic_load(p, __ATOMIC_RELAXED, __HIP_MEMORY_SCOPE_AGENT); }
__device__ __forceinline__ unsigned xb_add(unsigned* p, unsigned v) { return __hip_atomic_fetch_add(p, v, __ATOMIC_RELAXED, __HIP_MEMORY_SCOPE_AGENT); }
__device__ __forceinline__ unsigned xb_xcc_id() { return (unsigned)__builtin_amdgcn_s_getreg((3 << 11) | 20) & 0xFu; }
#define XB_SPIN(cond, bar) do { unsigned _sp = 0; while (cond) { __builtin_amdgcn_s_sleep(1); \
    if ((++_sp & 255u) == 0u) { if (xb_ld(&(bar)[XB_TMO])) break; if (_sp > XB_SPIN_CAP) { atomicAdd(&(bar)[XB_TMO], 1u); break; } } } } while (0)
typedef volatile __attribute__((address_space(3))) unsigned lvu32;
__device__ __forceinline__ void xcd_barrier_complete(unsigned* bar, unsigned x, unsigned G, unsigned& nloc, unsigned& nx) {
    unsigned sum, cnt, mine, sp = 0u;
    for (;;) {
        sum = 0u; cnt = 0u; mine = 0u;
#pragma unroll
        for (unsigned j = 0; j < 16; ++j) { const unsigned c = xb_ld(&bar[XB_XCNT(j)]); sum += c; cnt += (c > 0u) ? 1u : 0u; mine = (j == x) ? c : mine; }
        if (sum == G) break;
        __builtin_amdgcn_s_sleep(1);
        if ((++sp & 255u) == 0u) { if (xb_ld(&bar[XB_TMO])) break; if (sp > XB_SPIN_CAP) { atomicAdd(&bar[XB_TMO], 1u); break; } }
    }
    nloc = mine > 0u ? mine : 1u; nx = cnt > 0u ? cnt : 1u;
}
__device__ __forceinline__ void xcd_barrier(unsigned* bar_, unsigned x_, lvu32* st, unsigned G, int wv) {
    unsigned x = x_; asm volatile("" : "+s"(x));
    unsigned* bar = opaque_ptr(bar_);
    asm volatile("s_waitcnt vmcnt(0)" ::: "memory");
    __syncthreads();
    if (my_tid(wv) == 0) {
        __builtin_amdgcn_s_waitcnt(0);
        unsigned nloc = st[0], nx = st[1];
        if (nloc == 0u) { xcd_barrier_complete(bar, x, G, nloc, nx); st[0] = nloc; st[1] = nx; }
        const unsigned old = xb_add(&bar[XB_XSUB(x)], 1u);
        const unsigned gen = old / nloc;
        if (old + 1u == (gen + 1u) * nloc) {
            __builtin_amdgcn_fence(__ATOMIC_RELEASE, "agent");
            asm volatile("s_waitcnt vmcnt(0)" ::: "memory");
            const unsigned og = xb_add(&bar[XB_TOP], 1u);
            const unsigned tg = og / nx;
            if (og + 1u == (tg + 1u) * nx) xb_add(&bar[XB_TOPGEN], 1u);
            else XB_SPIN(xb_ld(&bar[XB_TOPGEN]) == tg, bar);
            __builtin_amdgcn_fence(__ATOMIC_ACQUIRE, "agent");
            xb_add(&bar[XB_XGEN(x)], 1u);
            asm volatile("s_waitcnt vmcnt(0)" ::: "memory");
        } else {
            XB_SPIN(xb_ld(&bar[XB_XGEN(x)]) == gen, bar);
            __builtin_amdgcn_fence(__ATOMIC_ACQUIRE, "agent");
            asm volatile("s_waitcnt vmcnt(0)" ::: "memory");
        }
    }
    __syncthreads();
}

__device__ __forceinline__ void run_gemm_job(const Params& P, unsigned char* lds, int ph, int j, int blk, int nblk, int wv) {
    unsigned char* ws = opaque_ptr(P.ws);
    float* SQKV = (float*)(ws + WS_SQKV); float* SQQ = (float*)(ws + WS_SQQ); float* SQH = (float*)(ws + WS_SQH);
    int kind = 0; Gemm g; g.M = T; g.A = nullptr; g.Bt = nullptr; g.lda = g.ldb = g.N = g.K = 0;
    h16 *h0 = nullptr, *h1 = nullptr; const h16* ch0 = nullptr; const h16* ch1 = nullptr; const float* cf0 = nullptr; float* f0 = nullptr; float* f1 = nullptr; int i0 = 0, i1 = 0, i2 = 0, i3 = 0, i4 = 0; float x0 = 0.f;
    if (ph == 1) { kind = 0; g.A = (const h16*)(ws + WS_R1); g.Bt = (const h16*)(ws + WS_WAIN); g.lda = 1024; g.ldb = 1024; g.N = 1792; g.K = 1024; }
    else if (ph == 2) {
        kind = 1;
        if (j == 0) { g.A = (const h16*)(ws + WS_CQX); g.Bt = (const h16*)(ws + WS_WQ); g.lda = 512; g.ldb = 384; g.N = 1536; g.K = 384;
                      cf0 = SQQ; i0 = 8; x0 = 1.0f / 384.0f; h0 = (h16*)(ws + WS_R1); h1 = (h16*)(ws + WS_QIDX); i1 = 1024; i2 = 512; i3 = 1; i4 = 0; }
        else if (j == 1) { g.A = (const h16*)(ws + WS_CKV); g.Bt = (const h16*)(ws + WS_WKV); g.lda = 256; g.ldb = 256; g.N = 2048; g.K = 256;
                      cf0 = SQKV; i0 = 4; x0 = 1.0f / 256.0f; h0 = (h16*)(ws + WS_R2); h1 = (h16*)(ws + WS_R3); i1 = 1024; i2 = 1024; i3 = 1; i4 = 1; }
        else { g.A = (const h16*)(ws + WS_PH0); g.Bt = (const h16*)(ws + WS_WPLE); g.lda = 256; g.ldb = 256; g.N = 1024; g.K = 256;
                      cf0 = nullptr; i0 = 0; x0 = 0.f; h0 = (h16*)(ws + WS_R5); h1 = nullptr; i1 = 1024; i2 = 1024; }
    }
    else if (ph == 5) { kind = 2; g.A = (const h16*)(ws + WS_AO); g.Bt = (const h16*)(ws + WS_WAOUT); g.lda = 1024; g.ldb = 1024; g.N = 1024; g.K = 1024;
                      cf0 = P.in[0]; ch0 = nullptr; h0 = (h16*)(ws + WS_R2); f1 = SQH; }
    else if (ph == 6) { kind = 3; g.A = (const h16*)(ws + WS_R2); g.Bt = (const h16*)(ws + WS_WPG); g.lda = 1024; g.ldb = 1024; g.N = 1024; g.K = 1024;
                      ch1 = (const h16*)(ws + WS_R2); ch0 = (const h16*)(ws + WS_R5); h0 = (h16*)(ws + WS_R3); cf0 = SQH; f1 = SQH + (size_t)T * 16; }
    else if (ph == 7) { kind = 4; g.A = (const h16*)(ws + WS_R3); g.Bt = (const h16*)(ws + WS_WRIN); g.lda = 1024; g.ldb = 1024; g.N = 6144; g.K = 1024; }
    else if (ph == 10) {
        if (j == 0) { kind = 2; g.A = (const h16*)(ws + WS_R4); g.Bt = (const h16*)(ws + WS_WROUT); g.lda = 2048; g.ldb = 2048; g.N = 1024; g.K = 2048;
                      cf0 = nullptr; ch0 = (const h16*)(ws + WS_R3); h0 = (h16*)(ws + WS_R2); f1 = SQH + (size_t)2 * T * 16; }
        else { kind = 1; g.A = (const h16*)(ws + WS_PH1); g.Bt = (const h16*)(ws + WS_WPLE) + (size_t)1024 * 256; g.lda = 256; g.ldb = 256; g.N = 1024; g.K = 256;
                      cf0 = nullptr; i0 = 0; x0 = 0.f; h0 = (h16*)(ws + WS_R1); h1 = nullptr; i1 = 1024; i2 = 1024; }
    }
    else { kind = 5; g.A = (const h16*)(ws + WS_R2); g.Bt = (const h16*)(ws + WS_WPG) + (size_t)1024 * 1024; g.lda = 1024; g.ldb = 1024; g.N = 1024; g.K = 1024;
                      ch1 = (const h16*)(ws + WS_R2); ch0 = (const h16*)(ws + WS_R1); h0 = (h16*)(ws + WS_R1); cf0 = SQH + (size_t)2 * T * 16; f1 = SQH + (size_t)3 * T * 16; }
    switch (kind) {
        case 0: { EpiInA E{(h16*)(ws + WS_CKV), (h16*)(ws + WS_CQX), (h16*)(ws + WS_R4), SQKV, SQQ, nullptr, 0, 0.f}; gemm_run(lds, g, E, blk, nblk, wv); break; }
        case 1: { EpiScale E{cf0, i0, x0, h0, h1, 4, i1, i2, i3, i4}; gemm_run(lds, g, E, blk, nblk, wv); break; }
        case 2: { EpiRes E{cf0, ch0, h0, f1, nullptr, 0, 0.f}; gemm_run(lds, g, E, blk, nblk, wv); break; }
        case 3: { EpiPle E{ch1, ch0, h0, cf0, f1, 16, 1.0f / 1024.0f}; gemm_run(lds, g, E, blk, nblk, wv); break; }
        case 5: { EpiPleFinal E{ch1, ch0, cf0, 16, 1.0f / 1024.0f, P.in[18], P.out, (unsigned*)(SQH + (size_t)3 * T * 16), (unsigned*)(ws + WS_BAR + 16384), (unsigned*)(ws + WS_BAR) + XB_TMO}; gemm_run(lds, g, E, blk, nblk, wv); break; }
        default: { EpiInR E{SQH + (size_t)T * 16, (const f32x2*)(ws + WS_SINCOS), (h16*)(ws + WS_R1), (h16*)(ws + WS_R2), (h16*)(ws + WS_R4), (h16*)(ws + WS_RG), 16, 1.0f / 1024.0f}; gemm_run(lds, g, E, blk, nblk, wv); break; }
    }
}

__global__ void __launch_bounds__(NTHREADS, 2) mk_fwd(Params P_) {
    extern __shared__ __attribute__((aligned(16))) unsigned char lds[];
    cg::grid_group grid = cg::this_grid();
    const int wv = __builtin_amdgcn_readfirstlane((int)(threadIdx.x >> 6));
    lvu32* bst = (lvu32*)(lds + LDS_BYTES - 16);
    unsigned* bar = (unsigned*)(P_.ws + WS_BAR);
    const unsigned xcc = xb_xcc_id();
    if (threadIdx.x == 0) { bst[0] = 0u; bst[1] = 0u; if (P_.ph_hi - P_.ph_lo > 1) (void)xb_add(&bar[XB_XCNT(xcc)], 1u); }
    __syncthreads();
    int dup_cnt = 0; (void)dup_cnt;
    const int blk_k = blockIdx.x, nblk_k = gridDim.x; const int ph_lo = P_.ph_lo, ph_hi = P_.ph_hi;
    for (int ph = ph_lo; ph < ph_hi; ++ph) {
        int blk = blk_k, nblk = nblk_k; asm volatile("" : "+s"(blk), "+s"(nblk));
        const Params& P = P_;
        if (ph == 0) p0_prologue(P, lds, blk, nblk, wv);
        else if (ph == 3) p3_indexer(P, lds, blk, nblk, wv);
        else if (ph == 4) p4_attn(P, lds, blk, nblk, wv);
        else if (ph == 8) p8_retention(P, lds, blk, nblk, wv);
        else if (ph == 9) { if (nblk != 256) p9_gnorm(P, blk, nblk, wv); }
        else {
            if (ph == 2) p2_kidx(P, blk, nblk, wv);
            if (ph == 5) {
                unsigned ones = ~0u; asm volatile("" : "+v"(ones)); u32x4* xs_ = (u32x4*)(opaque_ptr(P.ws) + WS_KIDXN);
                for (int i = blk * NTHREADS + my_tid(wv); i < (4 << 20) / 16; i += nblk * NTHREADS) xs_[i] = (u32x4){ones, ones, ones, ones};
            }
            const int nj = (ph == 2) ? 3 : (ph == 10) ? 2 : 1;
            for (int j = 0; j < nj; ++j) run_gemm_job(P, lds, ph, j, blk, nblk, wv);
        }
        if (ph + 1 < ph_hi && !(ph == 8 && nblk == 256)) { if (ph_hi < 0) grid.sync(); else xcd_barrier(bar, xcc, bst, (unsigned)nblk, wv); }
#if MK_DUP_MASK
        if (((MK_DUP_MASK >> ph) & 1) && dup_cnt < MK_DUP_N) { ++dup_cnt; --ph; } else dup_cnt = 0;
#endif
    }
}

#ifndef MK_FUSED
#define MK_FUSED 1
#endif
extern "C" void kernel_launch(void* const* d_in, const int* in_sizes, int n_in, void* d_out, int out_size, void* d_ws, size_t ws_size, hipStream_t stream) {
    static int grid = 0;
    if (grid == 0) {
        if (n_in != 19 || out_size != T * D || ws_size < WS_END) { fprintf(stderr, "kernel_launch: unexpected shapes (n_in %d, out %d, ws %zu)\n", n_in, out_size, ws_size); grid = -1; return; }
        int dev = 0, cus = 0, per_cu = 0;
        hipGetDevice(&dev);
        hipDeviceGetAttribute(&cus, hipDeviceAttributeMultiprocessorCount, dev);
        if (hipFuncSetAttribute((const void*)mk_fwd, hipFuncAttributeMaxDynamicSharedMemorySize, LDS_BYTES) != hipSuccess) { fprintf(stderr, "kernel_launch: hipFuncSetAttribute failed\n"); grid = -1; return; }
        hipOccupancyMaxActiveBlocksPerMultiprocessor(&per_cu, (const void*)mk_fwd, NTHREADS, LDS_BYTES);
        if (per_cu < 1) { fprintf(stderr, "kernel_launch: occupancy query says %d blocks per CU\n", per_cu); grid = -1; return; }
        grid = cus * 1;
    }
    if (grid < 0) return;
    (void)hipMemsetAsync((char*)d_ws + WS_BAR, 0, 16384 + 32768, stream);
    Params P{};
    for (int i = 0; i < 19; ++i) P.in[i] = (const float*)d_in[i];
    P.out = (float*)d_out; P.ws = (unsigned char*)d_ws;
#if MK_FUSED
    P.ph_lo = 0; P.ph_hi = NPH;
    void* args[] = {&P};
    hipError_t e = hipLaunchCooperativeKernel((const void*)mk_fwd, dim3(grid), dim3(NTHREADS), args, LDS_BYTES, stream);
    if (e != hipSuccess) fprintf(stderr, "cooperative launch failed: %s (grid %d)\n", hipGetErrorString(e), grid);
#else
    for (int ph = 0; ph < NPH; ++ph) {
        P.ph_lo = ph; P.ph_hi = ph + 1;
        hipLaunchKernelGGL(mk_fwd, dim3(grid), dim3(NTHREADS), LDS_BYTES, stream, P);
    }
#endif
}
```

```cpp
#include <hip/hip_runtime.h>
#include <hip/hip_cooperative_groups.h>
#include <cstdio>
#include <cstdint>
namespace cg = cooperative_groups;
#ifndef MK_DUP_MASK
#define MK_DUP_MASK 0
#endif
#ifndef MK_P3_REPA
#define MK_P3_REPA 0
#endif
#ifndef MK_P3_REPB
#define MK_P3_REPB 0
#endif
#ifndef MK_EPI_REP
#define MK_EPI_REP 0
#endif
#ifndef MK_DUP_N
#define MK_DUP_N 3
#endif

typedef _Float16 h16;
typedef _Float16 h16x2 __attribute__((ext_vector_type(2)));
typedef _Float16 h16x4 __attribute__((ext_vector_type(4)));
typedef _Float16 h16x8 __attribute__((ext_vector_type(8)));
typedef float f32x2 __attribute__((ext_vector_type(2)));
typedef float f32x4 __attribute__((ext_vector_type(4)));
typedef unsigned u32x4 __attribute__((ext_vector_type(4)));

constexpr int NB = 16, L = 2048, T = NB * L, D = 1024;
constexpr float EPS = 1e-6f;
constexpr int NPH = 12;
constexpr int NTHREADS = 512, NWAVES = 8;
constexpr int LDS_BYTES = 163840;

constexpr size_t MiB = (size_t)1 << 20;
constexpr size_t WS_WAIN = 0 * MiB;
constexpr size_t WS_WQ = 4 * MiB;
constexpr size_t WS_WKV = 6 * MiB;
constexpr size_t WS_WAOUT = 7 * MiB;
constexpr size_t WS_WPG = 9 * MiB;
constexpr size_t WS_WPLE = 13 * MiB;
constexpr size_t WS_WRIN = 14 * MiB;
constexpr size_t WS_WROUT = 26 * MiB;
constexpr size_t WS_SINCOS = 30 * MiB;
constexpr size_t WS_SQKV = 32 * MiB;
constexpr size_t WS_SQQ = 33 * MiB;
constexpr size_t WS_SQH = 34 * MiB;
constexpr size_t WS_KIDXN = 42 * MiB;
constexpr size_t WS_WIDX = 46 * MiB;
constexpr size_t WS_BAR = 47 * MiB;
constexpr size_t WS_PH1 = 48 * MiB;
constexpr size_t WS_R1 = 64 * MiB;
constexpr size_t WS_R2 = 128 * MiB;
constexpr size_t WS_R3 = 192 * MiB;
constexpr size_t WS_R4 = 256 * MiB;
constexpr size_t WS_R5 = 320 * MiB;
constexpr size_t WS_PH0 = 384 * MiB;
constexpr size_t WS_CQX = 400 * MiB;
constexpr size_t WS_CKV = 432 * MiB;
constexpr size_t WS_QIDX = 448 * MiB;
constexpr size_t WS_MASK = 480 * MiB;
constexpr size_t WS_AO = 400 * MiB;
constexpr size_t WS_RG = 384 * MiB;
constexpr size_t WS_END = 512 * MiB;

struct Params { const float* in[19]; float* out; unsigned char* ws; int ph_lo, ph_hi; };

__constant__ float kAngle[128] = {
    1.000000000e+00f, 9.300450087e-01f, 8.649836779e-01f, 8.044736385e-01f, 7.481966019e-01f, 6.958565116e-01f, 6.471778154e-01f, 6.019044518e-01f,
    5.597981811e-01f, 5.206375122e-01f, 4.842162728e-01f, 4.503428936e-01f, 4.188391268e-01f, 3.895392120e-01f, 3.622889817e-01f, 3.369450271e-01f,
    3.133740425e-01f, 2.914519310e-01f, 2.710633874e-01f, 2.521011233e-01f, 2.344653904e-01f, 2.180633694e-01f, 2.028087080e-01f, 1.886212230e-01f,
    1.754262149e-01f, 1.631542742e-01f, 1.517407894e-01f, 1.411257535e-01f, 1.312533021e-01f, 1.220714748e-01f, 1.135319397e-01f, 1.055898219e-01f,
    9.820328653e-02f, 9.133346379e-02f, 8.494423330e-02f, 7.900195569e-02f, 7.347535342e-02f, 6.833537668e-02f, 6.355497986e-02f, 5.910899118e-02f,
    5.497401953e-02f, 5.112830922e-02f, 4.755162448e-02f, 4.422515258e-02f, 4.113136977e-02f, 3.825402260e-02f, 3.557796404e-02f, 3.308910504e-02f,
    3.077435680e-02f, 2.862153389e-02f, 2.661931701e-02f, 2.475716174e-02f, 2.302526683e-02f, 2.141453326e-02f, 1.991648041e-02f, 1.852322184e-02f,
    1.722742990e-02f, 1.602228358e-02f, 1.490144618e-02f, 1.385901403e-02f, 1.288950257e-02f, 1.198781747e-02f, 1.114920899e-02f, 1.036926545e-02f,
    9.643883444e-03f, 8.969245479e-03f, 8.341802284e-03f, 7.758250926e-03f, 7.215522230e-03f, 6.710760761e-03f, 6.241309457e-03f, 5.804697983e-03f,
    5.398627371e-03f, 5.020966288e-03f, 4.669724498e-03f, 4.343053792e-03f, 4.039235413e-03f, 3.756670747e-03f, 3.493872471e-03f, 3.249458736e-03f,
    3.022142686e-03f, 2.810728736e-03f, 2.614103956e-03f, 2.431234345e-03f, 2.261157380e-03f, 2.102978062e-03f, 1.955864020e-03f, 1.819041790e-03f,
    1.691789716e-03f, 1.573440502e-03f, 1.463370281e-03f, 1.361000235e-03f, 1.265791478e-03f, 1.177242957e-03f, 1.094888896e-03f, 1.018295996e-03f,
    9.470609948e-04f, 8.808093844e-04f, 8.191923262e-04f, 7.618857198e-04f, 7.085879333e-04f, 6.590186385e-04f, 6.129170069e-04f, 5.700403708e-04f,
    5.301629426e-04f, 4.930753494e-04f, 4.585822753e-04f, 4.265021416e-04f, 3.966661752e-04f, 3.689173318e-04f, 3.431097430e-04f, 3.191074939e-04f,
    2.967843320e-04f, 2.760227653e-04f, 2.567135962e-04f, 2.387551940e-04f, 2.220530587e-04f, 2.065193403e-04f, 1.920722716e-04f, 1.786358480e-04f,
    1.661392889e-04f, 1.545170089e-04f, 1.437077590e-04f, 1.336546848e-04f, 1.243048755e-04f, 1.156091312e-04f, 1.075216787e-04f, 9.999999747e-05f,
};

__device__ __forceinline__ float wave_sum(float v) {
#pragma unroll
    for (int o = 1; o < 64; o <<= 1) v += __shfl_xor(v, o);
    return v;
}
__device__ __forceinline__ float wave_max(float v) {
#pragma unroll
    for (int o = 1; o < 64; o <<= 1) v = fmaxf(v, __shfl_xor(v, o));
    return v;
}
#define DPP_RED6S(v, F) do { v = F<0x111, 0xf>(v); v = F<0x112, 0xf>(v); v = F<0x114, 0xf>(v); v = F<0x118, 0xf>(v); v = F<0x142, 0xa>(v); v = F<0x143, 0xc>(v); } while (0)
template <int CTRL, int RMASK> __device__ __forceinline__ float fadd_dpp_(float a) { return a + __builtin_bit_cast(float, __builtin_amdgcn_update_dpp(0, __builtin_bit_cast(int, a), CTRL, RMASK, 0xf, false)); }
__device__ __forceinline__ float wave_sum_dpp(float v) { DPP_RED6S(v, fadd_dpp_); return __builtin_bit_cast(float, __builtin_amdgcn_readlane(__builtin_bit_cast(int, v), 63)); }
__device__ __forceinline__ float dot4(f32x4 a) { return (a[0] * a[0] + a[1] * a[1]) + (a[2] * a[2] + a[3] * a[3]); }
__device__ __forceinline__ float fq_sum(float s) {
    { auto rr = __builtin_amdgcn_permlane16_swap(__float_as_uint(s), __float_as_uint(s), false, false); s = __uint_as_float(rr[0]) + __uint_as_float(rr[1]); }
    { auto rr = __builtin_amdgcn_permlane32_swap(__float_as_uint(s), __float_as_uint(s), false, false); s = __uint_as_float(rr[0]) + __uint_as_float(rr[1]); }
    return s;
}
__device__ __forceinline__ h16x8 pack8(f32x4 a, f32x4 b) {
    h16x8 r; r[0] = (h16)a[0]; r[1] = (h16)a[1]; r[2] = (h16)a[2]; r[3] = (h16)a[3]; r[4] = (h16)b[0]; r[5] = (h16)b[1]; r[6] = (h16)b[2]; r[7] = (h16)b[3]; return r;
}
__device__ __forceinline__ h16x4 pack4(f32x4 a) { h16x4 r; r[0] = (h16)a[0]; r[1] = (h16)a[1]; r[2] = (h16)a[2]; r[3] = (h16)a[3]; return r; }
__device__ __forceinline__ float sigmoidf_(float x) { return __builtin_amdgcn_rcpf(1.0f + __builtin_amdgcn_exp2f(-1.4426950408889634f * x)); }
__device__ __forceinline__ float siluf_(float x) { return x * __builtin_amdgcn_rcpf(1.0f + __builtin_amdgcn_exp2f(-1.4426950408889634f * x)); }
#define LDS_FENCE() do { asm volatile("s_waitcnt lgkmcnt(0)" ::: "memory"); } while (0)
__device__ __forceinline__ int my_tid(int wv) { unsigned m = ~0u; asm volatile("" : "+s"(m)); int t = wv * 64 + (int)__builtin_amdgcn_mbcnt_hi(m, __builtin_amdgcn_mbcnt_lo(m, 0u)); asm volatile("" : "+v"(t)); return t; }
template <class Tp> __device__ __forceinline__ Tp* opaque_ptr(Tp* p) { size_t z = 0; asm volatile("" : "+s"(z)); return p + z; }

#define PG8_LAS __attribute__((address_space(3)))
__device__ __forceinline__ constexpr int pg8_stage_bytes() { return 131072; }
struct Unit { int pm, pn; };
struct Gemm { const h16* A; const h16* Bt; int lda, ldb, M, N, K; };
__device__ __forceinline__ int perm32(int rho) { const int n = rho >> 4, i = rho & 15; return 8 * (i >> 2) + 4 * n + (i & 3); }

template <class Epi>
__device__ __forceinline__ void gemm_simple(const Gemm g, const Epi& E, int blk, int nblk, int wv) {
    const int tid = my_tid(wv), wid = __builtin_amdgcn_readfirstlane(tid >> 6), lane = tid & 63, wr = wid >> 2, wc = wid & 3, fr = lane & 15, fq = lane >> 4;
    const int nN = g.N / 256, nU = (g.M / 256) * nN;
    for (int u = blk; u < nU; u += nblk) {
        Unit un; un.pm = u / nN; un.pn = u % nN;
        f32x4 acc[2][2][4][2];
#pragma unroll
        for (int a = 0; a < 2; ++a)
#pragma unroll
            for (int b = 0; b < 2; ++b)
#pragma unroll
                for (int m = 0; m < 4; ++m)
#pragma unroll
                    for (int n = 0; n < 2; ++n) acc[a][b][m][n] = (f32x4){0.f, 0.f, 0.f, 0.f};
        const h16* Ap = g.A + (size_t)(un.pm * 256 + wr * 64 + fr) * g.lda + fq * 8;
        const h16* Bp[2];
#pragma unroll
        for (int n = 0; n < 2; ++n) Bp[n] = g.Bt + (size_t)(un.pn * 256 + wc * 32 + (Epi::PERM ? perm32(16 * n + fr) : 16 * n + fr)) * g.ldb + fq * 8;
        for (int k0 = 0; k0 < g.K; k0 += 32) {
            h16x8 At[2][4], Bt[2][2];
#pragma unroll
            for (int ai = 0; ai < 2; ++ai)
#pragma unroll
                for (int m = 0; m < 4; ++m) At[ai][m] = *(const h16x8*)(Ap + (size_t)(ai * 128 + m * 16) * g.lda + k0);
#pragma unroll
            for (int bj = 0; bj < 2; ++bj)
#pragma unroll
                for (int n = 0; n < 2; ++n) Bt[bj][n] = *(const h16x8*)(Bp[n] + (size_t)(bj * 128) * g.ldb + k0);
#pragma unroll
            for (int ai = 0; ai < 2; ++ai)
#pragma unroll
                for (int bj = 0; bj < 2; ++bj)
#pragma unroll
                    for (int m = 0; m < 4; ++m)
#pragma unroll
                        for (int n = 0; n < 2; ++n) acc[ai][bj][m][n] = __builtin_amdgcn_mfma_f32_16x16x32_f16(Bt[bj][n], At[ai][m], acc[ai][bj][m][n], 0, 0, 0);
        }
        E(acc, un, wr, wc, fr, fq, nullptr);
    }
}

template <class E_> struct epi_fused { template <class X> static constexpr bool g(decltype(X::FUSED_FINAL)*) { return X::FUSED_FINAL; } template <class X> static constexpr bool g(...) { return false; } static constexpr bool v = g<E_>(nullptr); };
namespace pg8 {
constexpr int BM = 256, BK = 64, HALF = 128, HTB = HALF * BK * 2  , STAGE_BYTES = 8 * HTB, NXCD = 8, WGM = 8;
__host__ __device__ __forceinline__ int lds_byte(int r, int c) { const int st = (r >> 4) * 2 + (c >> 5), rr = r & 15, cc = c & 31, ob = rr * 64 + cc * 2; return st * 1024 + (ob ^ (((ob >> 9) & 1) << 5)); }
__host__ __device__ __forceinline__ void stage_rc(int b, int& R, int& C) { const int st = b / 1024, sb = b % 1024, swz = sb ^ (((sb >> 9) & 1) << 5); R = (st >> 1) * 16 + swz / 64; C = (st & 1) * 32 + (swz % 64) / 2; }
struct StaticOrder {
    int nM, nN, nwg, G, c;
    __host__ __device__ void init(int M, int N, int G_, int c_) { nM = M / BM; nN = N / BM; nwg = nM * nN; G = G_; c = c_; }
    __host__ __device__ bool next(int i, Unit& u) const {
        const long Lq = (long)i * G + c; if (Lq >= nwg) return false;
        int wgid = (int)Lq; { const int q = nwg / NXCD, r = nwg % NXCD, xcd = wgid % NXCD, off = wgid / NXCD; wgid = (xcd < r ? xcd * (q + 1) : r * (q + 1) + (xcd - r) * q) + off; }
        const int nig = WGM * nN, gid = wgid / nig, fm = gid * WGM, gsz = (nM - fm) < WGM ? (nM - fm) : WGM;
        u.pm = fm + ((wgid % nig) % gsz); u.pn = (wgid % nig) / gsz; return true;
    }
};
template <class Epi, bool ALIGN_EPI = true>
__device__ __forceinline__ void gemm_phase(PG8_LAS unsigned char* lds, const Gemm g, const StaticOrder& S, const Epi& E, int wv) {
    const int tid = my_tid(wv), wid = __builtin_amdgcn_readfirstlane(tid >> 6), lane = tid & 63, wr = wid >> 2, wc = wid & 3, fr = lane & 15, fq = lane >> 4;
    const int K = g.K, nt = K / BK;
    unsigned voffA[2], voffB[2];
#pragma unroll
    for (int i = 0; i < 2; ++i) { int R, C; stage_rc(tid * 16 + i * 8192, R, C); const int Rb = Epi::PERM ? ((R & ~31) + perm32(R & 31)) : R;
        voffA[i] = (unsigned)(R * g.lda + C) * 2u; voffB[i] = (unsigned)(Rb * g.ldb + C) * 2u; }
    const size_t kstep = (size_t)(BK * 2);
    const size_t hstepA = (size_t)HALF * g.lda * 2, hstepB = (size_t)HALF * g.ldb * 2;
    const size_t tstepA = 2 * hstepA, tstepB = 2 * hstepB;
    const unsigned ldsw = (unsigned)wid * 1024u;
    const int aoff = lds_byte(wr * 64 + fr, fq * 8), boff = lds_byte(wc * 32 + fr, fq * 8);
#define PG8_SA(b, h) (((b) * 2 + (h)) * HTB)
#define PG8_SB(b, h) ((4 + (b) * 2 + (h)) * HTB)
#define PG8_STAGE(bufoff, gbase, voff) do { _Pragma("unroll") for (int _i = 0; _i < 2; ++_i) \
        __builtin_amdgcn_global_load_lds((const unsigned*)((const char*)(gbase) + (voff)[_i]), (PG8_LAS unsigned*)(lds + (bufoff) + ldsw + _i * 8192), 16, 0, 0); } while (0)
#define PG8_LDA(dst, b, h) do { _Pragma("unroll") for (int m = 0; m < 4; ++m) _Pragma("unroll") for (int k = 0; k < 2; ++k) dst[m][k] = *(const PG8_LAS h16x8*)(lds + PG8_SA(b, h) + aoff + m * 2048 + k * 1024); } while (0)
#define PG8_LDB(dst, b, h) do { _Pragma("unroll") for (int n = 0; n < 2; ++n) _Pragma("unroll") for (int k = 0; k < 2; ++k) dst[n][k] = *(const PG8_LAS h16x8*)(lds + PG8_SB(b, h) + boff + n * 2048 + k * 1024); } while (0)
#define PG8_MMA(ai, bj, At, Bt) do { __builtin_amdgcn_s_setprio(1); _Pragma("unroll") for (int m = 0; m < 4; ++m) _Pragma("unroll") for (int n = 0; n < 2; ++n) _Pragma("unroll") for (int k = 0; k < 2; ++k) \
        acc[ai][bj][m][n] = __builtin_amdgcn_mfma_f32_16x16x32_f16(Bt[n][k], At[m][k], acc[ai][bj][m][n], 0, 0, 0); __builtin_amdgcn_s_setprio(0); } while (0)
#define PG8_WAIT_V(n) asm volatile("s_waitcnt vmcnt(" #n ")" ::: "memory")
#define PG8_WAIT_L(n) asm volatile("s_waitcnt lgkmcnt(" #n ")" ::: "memory")
#define PG8_BAR __builtin_amdgcn_s_barrier()
#define PG8_SCHED __builtin_amdgcn_sched_barrier(0)
    Unit cur, nxt; int ui = 0;
    if (!S.next(0, cur)) return;
    PG8_LAS float* rtab = (PG8_LAS float*)(lds + STAGE_BYTES);
#define PG8_FILL(U, PAR) do { const int tf_ = my_tid(wv); if (E.sqp != nullptr && tf_ < 256) { const size_t r_ = (size_t)(U).pm * 256 + tf_; float s_ = 0.f; \
        for (int j_ = 0; j_ < E.sqn; j_ += 4) { const f32x4 q_ = *(const f32x4*)(E.sqp + r_ * E.sqn + j_); s_ += (q_[0] + q_[1]) + (q_[2] + q_[3]); } \
        rtab[(PAR) * 256 + tf_] = rsqrtf(s_ * E.sqi + EPS); } } while (0)
    PG8_FILL(cur, 0);
    f32x4 acc[2][2][4][2];
#pragma unroll
    for (int a = 0; a < 2; ++a)
#pragma unroll
        for (int b = 0; b < 2; ++b)
#pragma unroll
            for (int m = 0; m < 4; ++m)
#pragma unroll
                for (int n = 0; n < 2; ++n) acc[a][b][m][n] = (f32x4){0.f, 0.f, 0.f, 0.f};
    h16x8 At[4][2], B0[2][2], B1[2][2];
    const char* cA = (const char*)g.A + (size_t)cur.pm * tstepA; const char* cB = (const char*)g.Bt + (size_t)cur.pn * tstepB;
    PG8_STAGE(PG8_SB(0, 0), cB, voffB); PG8_STAGE(PG8_SB(0, 1), cB + hstepB, voffB); PG8_STAGE(PG8_SA(0, 0), cA, voffA); PG8_STAGE(PG8_SA(0, 1), cA + hstepA, voffA);
    if (wr == 1) PG8_BAR;
    PG8_WAIT_V(2); PG8_BAR;
    PG8_STAGE(PG8_SB(1, 0), cB + kstep, voffB); PG8_STAGE(PG8_SA(1, 0), cA + kstep, voffA); PG8_STAGE(PG8_SB(1, 1), cB + hstepB + kstep, voffB);
    PG8_WAIT_V(6); PG8_BAR;
    for (;;) {
        const bool has_next = S.next(ui + 1, nxt);
        const char* nA = has_next ? (const char*)g.A + (size_t)nxt.pm * tstepA : cA; const char* nB = has_next ? (const char*)g.Bt + (size_t)nxt.pn * tstepB : cB;
        for (int t = 0; t < nt; t += 2) {
            const bool last = (t == nt - 2);
            const char* a1 = cA + (size_t)(t + 1) * kstep;
            const char* a2 = last ? nA : cA + (size_t)(t + 2) * kstep; const char* b2 = last ? nB : cB + (size_t)(t + 2) * kstep;
            const char* a3 = a2 + kstep; const char* b3 = b2 + kstep;
            PG8_LDB(B0, 0, 0); PG8_LDB(B1, 0, 1); PG8_SCHED; PG8_LDA(At, 0, 0); PG8_STAGE(PG8_SA(1, 1), a1 + hstepA, voffA);
            PG8_WAIT_V(8); PG8_WAIT_L(0); PG8_BAR; PG8_MMA(0, 0, At, B0); PG8_MMA(0, 1, At, B1); PG8_BAR; PG8_SCHED;
            PG8_LDA(At, 0, 1); PG8_STAGE(PG8_SB(0, 0), b2, voffB); PG8_STAGE(PG8_SB(0, 1), b2 + hstepB, voffB); PG8_STAGE(PG8_SA(0, 0), a2, voffA);
            PG8_WAIT_V(8); PG8_WAIT_L(0); PG8_BAR; PG8_MMA(1, 0, At, B0); PG8_MMA(1, 1, At, B1); PG8_BAR; PG8_SCHED;
            PG8_LDB(B0, 1, 0); PG8_LDB(B1, 1, 1); PG8_SCHED; PG8_LDA(At, 1, 0); PG8_STAGE(PG8_SA(0, 1), a2 + hstepA, voffA);
            PG8_WAIT_V(8); PG8_WAIT_L(0); PG8_BAR; PG8_MMA(0, 0, At, B0); PG8_MMA(0, 1, At, B1); PG8_BAR; PG8_SCHED;
            PG8_LDA(At, 1, 1); PG8_STAGE(PG8_SB(1, 0), b3, voffB); PG8_STAGE(PG8_SB(1, 1), b3 + hstepB, voffB); PG8_STAGE(PG8_SA(1, 0), a3, voffA);
            PG8_WAIT_V(8); PG8_WAIT_L(0); PG8_BAR; PG8_MMA(1, 0, At, B0); PG8_MMA(1, 1, At, B1); PG8_BAR; PG8_SCHED;
        }
        if constexpr (ALIGN_EPI) { if (wr == 0) PG8_BAR; }
        { const int te_ = my_tid(wv), le_ = te_ & 63;
          if constexpr (epi_fused<Epi>::v) E.final(acc, cur, wr, wc, le_ & 15, le_ >> 4, rtab + (ui & 1) * 256, lds, te_); else E(acc, cur, wr, wc, le_ & 15, le_ >> 4, rtab + (ui & 1) * 256); }
        if (has_next) PG8_FILL(nxt, (ui + 1) & 1);
        if (!has_next) break;
#pragma unroll
        for (int a = 0; a < 2; ++a)
#pragma unroll
            for (int b = 0; b < 2; ++b)
#pragma unroll
                for (int m = 0; m < 4; ++m)
#pragma unroll
                    for (int n = 0; n < 2; ++n) acc[a][b][m][n] = (f32x4){0.f, 0.f, 0.f, 0.f};
        cur = nxt; cA = nA; cB = nB; ++ui;
        if constexpr (ALIGN_EPI) { if (wr == 1) PG8_BAR; }
    }
    PG8_WAIT_V(0);
    if constexpr (!ALIGN_EPI) { if (wr == 0) PG8_BAR; }
    PG8_BAR;
#undef PG8_FILL
#undef PG8_SA
#undef PG8_SB
#undef PG8_STAGE
#undef PG8_LDA
#undef PG8_LDB
#undef PG8_MMA
#undef PG8_WAIT_V
#undef PG8_WAIT_L
#undef PG8_BAR
#undef PG8_SCHED
}
}
template <class Epi>
__device__ __forceinline__ void gemm_run(unsigned char* lds, const Gemm g, const Epi& E, int blk, int nblk, int wv) {
    pg8::StaticOrder S; S.init(g.M, g.N, nblk, blk);
    pg8::gemm_phase<Epi, true>((PG8_LAS unsigned char*)lds, g, S, E, wv);
}

struct EpiInA {
    static constexpr bool PERM = true;
    h16* ckv; h16* cqx; h16* sg; float* sqkv; float* sqq; const float* sqp; int sqn; float sqi;
    __device__ __forceinline__ void operator()(const f32x4 (&acc)[2][2][4][2], const Unit& u, int wr, int wc, int fr, int fq, const PG8_LAS float* rtab) const {
        asm volatile("" : "+v"(fr), "+v"(fq));
#pragma unroll
        for (int ai = 0; ai < 2; ++ai)
#pragma unroll
            for (int m = 0; m < 4; ++m) {
                const size_t r = (size_t)u.pm * 256 + ai * 128 + wr * 64 + m * 16 + fr;
                float ss = 0.f;
#pragma unroll
                for (int bj = 0; bj < 2; ++bj) {
                    const int c0 = bj * 128 + wc * 32 + 8 * fq;
                    f32x4 v0 = acc[ai][bj][m][0], v1 = acc[ai][bj][m][1];
                    if (u.pn == 0) { *(h16x8*)(ckv + r * 256 + c0) = pack8(v0, v1); ss += dot4(v0) + dot4(v1); }
                    else if (u.pn <= 2) { const int cq = (u.pn - 1) * 256 + c0; *(h16x8*)(cqx + r * 512 + cq) = pack8(v0, v1); if (cq < 384) ss += dot4(v0) + dot4(v1); }
                    else {
#pragma unroll
                        for (int e = 0; e < 4; ++e) { v0[e] = siluf_(v0[e]); v1[e] = siluf_(v1[e]); }
                        *(h16x8*)(sg + r * 1024 + (u.pn - 3) * 256 + c0) = pack8(v0, v1);
                    }
                }
                if (u.pn <= 2) {
                    ss = fq_sum(ss);
                    if (fq == 0) { if (u.pn == 0) sqkv[r * 4 + wc] = ss; else sqq[r * 8 + (u.pn - 1) * 4 + wc] = ss; }
                }
            }
    }
};
__device__ __forceinline__ unsigned cvtpk_bf16(float lo, float hi) { unsigned r; asm volatile("v_cvt_pk_bf16_f32 %0, %1, %2" : "=v"(r) : "v"(lo), "v"(hi)); return r; }
struct EpiScale {
    static constexpr bool PERM = true;
    const float* sqp; int sqn; float sqi; h16* d0; h16* d1; int split, ld0, ld1, bf0, bf1;
    __device__ __forceinline__ void operator()(const f32x4 (&acc)[2][2][4][2], const Unit& u, int wr, int wc, int fr, int fq, const PG8_LAS float* rtab) const {
        asm volatile("" : "+v"(fr), "+v"(fq));
#pragma unroll
        for (int ai = 0; ai < 2; ++ai)
#pragma unroll
            for (int m = 0; m < 4; ++m) {
                const size_t r = (size_t)u.pm * 256 + ai * 128 + wr * 64 + m * 16 + fr;
                float rs = 1.f;
                if (sqp) rs = rtab[ai * 128 + wr * 64 + m * 16 + fr];
#pragma unroll
                for (int bj = 0; bj < 2; ++bj) {
                    const int c0 = bj * 128 + wc * 32 + 8 * fq;
                    const f32x4 v0 = acc[ai][bj][m][0] * rs, v1 = acc[ai][bj][m][1] * rs;
                    const bool first = u.pn < split;
                    h16* dst = first ? d0 + r * ld0 + u.pn * 256 + c0 : d1 + r * ld1 + (u.pn - split) * 256 + c0;
                    if (first ? bf0 : bf1) { u32x4 w; w[0] = cvtpk_bf16(v0[0], v0[1]); w[1] = cvtpk_bf16(v0[2], v0[3]); w[2] = cvtpk_bf16(v1[0], v1[1]); w[3] = cvtpk_bf16(v1[2], v1[3]); *(u32x4*)dst = w; }
                    else *(h16x8*)dst = pack8(v0, v1);
                }
            }
    }
};
struct EpiRes {
    static constexpr bool PERM = true;
    const float* basef; const h16* baseh; h16* HH; float* sq; const float* sqp; int sqn; float sqi;
    __device__ __forceinline__ void operator()(const f32x4 (&acc)[2][2][4][2], const Unit& u, int wr, int wc, int fr, int fq, const PG8_LAS float* rtab) const {
        asm volatile("" : "+v"(fr), "+v"(fq));
#pragma unroll
        for (int ai = 0; ai < 2; ++ai)
#pragma unroll
            for (int m = 0; m < 4; ++m) {
                const size_t r = (size_t)u.pm * 256 + ai * 128 + wr * 64 + m * 16 + fr;
                float ss = 0.f;
#pragma unroll
                for (int bj = 0; bj < 2; ++bj) {
                    const size_t o = r * 1024 + u.pn * 256 + bj * 128 + wc * 32 + 8 * fq;
                    f32x4 h0, h1;
                    if (basef) { h0 = *(const f32x4*)(basef + o); h1 = *(const f32x4*)(basef + o + 4); }
                    else { const h16x8 b = *(const h16x8*)(baseh + o); h0 = (f32x4){(float)b[0], (float)b[1], (float)b[2], (float)b[3]}; h1 = (f32x4){(float)b[4], (float)b[5], (float)b[6], (float)b[7]}; }
                    h0 = h0 + acc[ai][bj][m][0]; h1 = h1 + acc[ai][bj][m][1];
                    *(h16x8*)(HH + o) = pack8(h0, h1); ss += dot4(h0) + dot4(h1);
                }
                ss = fq_sum(ss);
                if (fq == 0) sq[r * 16 + u.pn * 4 + wc] = ss;
            }
    }
};
struct EpiPle {
    static constexpr bool PERM = true;
    const h16* Hin; const h16* U; h16* Hout; const float* sqp; float* sqout; int sqn; float sqi;
    __device__ __forceinline__ void operator()(const f32x4 (&acc)[2][2][4][2], const Unit& u, int wr, int wc, int fr, int fq, const PG8_LAS float* rtab) const {
        asm volatile("" : "+v"(fr), "+v"(fq));
#pragma unroll
        for (int ai = 0; ai < 2; ++ai)
#pragma unroll
            for (int m = 0; m < 4; ++m) {
                const size_t r = (size_t)u.pm * 256 + ai * 128 + wr * 64 + m * 16 + fr;
                const float rs = rtab[ai * 128 + wr * 64 + m * 16 + fr];
                float ss = 0.f;
#pragma unroll
                for (int bj = 0; bj < 2; ++bj) {
                    const size_t o = r * 1024 + u.pn * 256 + bj * 128 + wc * 32 + 8 * fq;
                    const h16x8 uu = *(const h16x8*)(U + o); const h16x8 hh = *(const h16x8*)(Hin + o);
                    const f32x4 a0 = acc[ai][bj][m][0] * rs, a1 = acc[ai][bj][m][1] * rs; f32x4 h0, h1;
#pragma unroll
                    for (int e = 0; e < 4; ++e) { h0[e] = (float)hh[e] + (float)uu[e] * sigmoidf_(a0[e]); h1[e] = (float)hh[4 + e] + (float)uu[4 + e] * sigmoidf_(a1[e]); }
                    *(h16x8*)(Hout + o) = pack8(h0, h1); ss += dot4(h0) + dot4(h1);
                }
                ss = fq_sum(ss);
                if (fq == 0) sqout[r * 16 + u.pn * 4 + wc] = ss;
            }
    }
};
struct EpiPleFinal {
    static constexpr bool PERM = true, FUSED_FINAL = true;
    const h16* Hin; const h16* U; const float* sqp; int sqn; float sqi; const float* gfin; float* out; unsigned* xslot; unsigned* pcnt; unsigned* tmo;
    __device__ __forceinline__ void final(f32x4 (&acc)[2][2][4][2], const Unit& u, int wr, int wc, int fr, int fq, const PG8_LAS float* rtab, PG8_LAS unsigned char* lds, int tid) const {
        PG8_LAS float* Pt = (PG8_LAS float*)(lds + pg8_stage_bytes() + 2048);
        PG8_LAS float* St = Pt + 1024;
        const int wid = tid >> 6, lane = tid & 63;
        asm volatile("" : "+v"(fr), "+v"(fq));
#pragma unroll
        for (int ai = 0; ai < 2; ++ai)
#pragma unroll
            for (int m = 0; m < 4; ++m) {
                const int rl = ai * 128 + wr * 64 + m * 16 + fr; const size_t r = (size_t)u.pm * 256 + rl;
                const float rs = rtab[rl]; float ss = 0.f;
#pragma unroll
                for (int bj = 0; bj < 2; ++bj) {
                    const size_t o = r * 1024 + u.pn * 256 + bj * 128 + wc * 32 + 8 * fq;
                    const h16x8 uu = *(const h16x8*)(U + o); const h16x8 hh = *(const h16x8*)(Hin + o);
                    const f32x4 a0 = acc[ai][bj][m][0] * rs, a1 = acc[ai][bj][m][1] * rs; f32x4 h0, h1;
#pragma unroll
                    for (int e = 0; e < 4; ++e) { h0[e] = (float)hh[e] + (float)uu[e] * sigmoidf_(a0[e]); h1[e] = (float)hh[4 + e] + (float)uu[4 + e] * sigmoidf_(a1[e]); }
                    acc[ai][bj][m][0] = h0; acc[ai][bj][m][1] = h1; ss += dot4(h0) + dot4(h1);
                }
                ss = fq_sum(ss);
                if (fq == 0) Pt[rl * 4 + wc] = ss;
                asm volatile("" : "+v"(acc[ai][0][m][0]), "+v"(acc[ai][0][m][1]), "+v"(acc[ai][1][m][0]), "+v"(acc[ai][1][m][1]) :: "memory");
            }
        asm volatile("s_waitcnt lgkmcnt(0)" ::: "memory"); __builtin_amdgcn_s_barrier(); asm volatile("" ::: "memory");
        if (tid < 256) {
            const f32x4 p = *(const PG8_LAS f32x4*)(Pt + tid * 4);
            __hip_atomic_store(xslot + ((size_t)u.pm * 256 + tid) * 4 + u.pn, __float_as_uint((p[0] + p[1]) + (p[2] + p[3])), __ATOMIC_RELAXED, __HIP_MEMORY_SCOPE_AGENT);
            asm volatile("s_waitcnt vmcnt(0)" ::: "memory");
            if (lane == 0) __hip_atomic_fetch_add(pcnt + 64 * u.pm, 1u, __ATOMIC_RELAXED, __HIP_MEMORY_SCOPE_AGENT);
        }
        if (wid == 0) {
            unsigned sp = 0u;
            while (__hip_atomic_load(pcnt + 64 * u.pm, __ATOMIC_RELAXED, __HIP_MEMORY_SCOPE_AGENT) < 16u) {
                __builtin_amdgcn_s_sleep(2);
                if (++sp > (1u << 22)) { if (lane == 0) __hip_atomic_store(tmo, 1u, __ATOMIC_RELAXED, __HIP_MEMORY_SCOPE_AGENT); break; }
            }
            __builtin_amdgcn_fence(__ATOMIC_ACQUIRE, "agent");
        }
        asm volatile("s_waitcnt vmcnt(0) lgkmcnt(0)" ::: "memory"); __builtin_amdgcn_s_barrier(); asm volatile("" ::: "memory");
        if (tid < 256) {
            const unsigned* sl = xslot + ((size_t)u.pm * 256 + tid) * 4; float s = 0.f;
#pragma unroll
            for (int t = 0; t < 4; ++t) s += __uint_as_float(__hip_atomic_load(sl + t, __ATOMIC_RELAXED, __HIP_MEMORY_SCOPE_AGENT));
            St[tid] = rsqrtf(s * (1.0f / 1024.0f) + EPS);
        }
        asm volatile("s_waitcnt vmcnt(0) lgkmcnt(0)" ::: "memory"); __builtin_amdgcn_s_barrier(); asm volatile("" ::: "memory");
#pragma unroll
        for (int ai = 0; ai < 2; ++ai)
#pragma unroll
            for (int m = 0; m < 4; ++m) {
                const int rl = ai * 128 + wr * 64 + m * 16 + fr; const size_t r = (size_t)u.pm * 256 + rl;
                const float rr = St[rl];
#pragma unroll
                for (int bj = 0; bj < 2; ++bj) {
                    const int c = u.pn * 256 + bj * 128 + wc * 32 + 8 * fq;
                    const f32x4 g0 = *(const f32x4*)(gfin + c), g1 = *(const f32x4*)(gfin + c + 4);
                    *(f32x4*)(out + r * 1024 + c) = acc[ai][bj][m][0] * rr * g0; *(f32x4*)(out + r * 1024 + c + 4) = acc[ai][bj][m][1] * rr * g1;
                }
            }
    }
};
struct EpiInR {
    static constexpr bool PERM = true;
    const float* sqp; const f32x2* sincos; h16* rq; h16* rk; h16* rv; h16* rg; int sqn; float sqi;
    __device__ __forceinline__ void operator()(const f32x4 (&acc)[2][2][4][2], const Unit& u, int wr, int wc, int fr, int fq, const PG8_LAS float* rtab) const {
        asm volatile("" : "+v"(fr), "+v"(fq));
#pragma unroll
        for (int ai = 0; ai < 2; ++ai)
#pragma unroll
            for (int m = 0; m < 4; ++m) {
                const size_t r = (size_t)u.pm * 256 + ai * 128 + wr * 64 + m * 16 + fr;
                const float rs = rtab[ai * 128 + wr * 64 + m * 16 + fr];
                const int pos = (int)(r & (L - 1));
#pragma unroll
                for (int bj = 0; bj < 2; ++bj) {
                    const int c0 = bj * 128 + wc * 32 + 8 * fq;
                    f32x4 v0 = acc[ai][bj][m][0] * rs, v1 = acc[ai][bj][m][1] * rs;
                    if (u.pn < 8) {
                        const f32x2* sc = sincos + (size_t)pos * 128 + (c0 >> 1);
                        const f32x2 s0 = sc[0], s1 = sc[1], s2 = sc[2], s3 = sc[3];
                        f32x4 w0, w1;
                        w0[0] = v0[0] * s0[1] - v0[1] * s0[0]; w0[1] = v0[1] * s0[1] + v0[0] * s0[0];
                        w0[2] = v0[2] * s1[1] - v0[3] * s1[0]; w0[3] = v0[3] * s1[1] + v0[2] * s1[0];
                        w1[0] = v1[0] * s2[1] - v1[1] * s2[0]; w1[1] = v1[1] * s2[1] + v1[0] * s2[0];
                        w1[2] = v1[2] * s3[1] - v1[3] * s3[0]; w1[3] = v1[3] * s3[1] + v1[2] * s3[0];
                        h16* dst = (u.pn < 4) ? rq + r * 1024 + u.pn * 256 + c0 : rk + r * 1024 + (u.pn - 4) * 256 + c0;
                        *(h16x8*)dst = pack8(w0, w1);
                    } else if (u.pn < 16) {
                        *(h16x8*)(rv + r * 2048 + (u.pn - 8) * 256 + c0) = pack8(v0, v1);
                    } else {
#pragma unroll
                        for (int e = 0; e < 4; ++e) { v0[e] = siluf_(v0[e]); v1[e] = siluf_(v1[e]); }
                        *(h16x8*)(rg + r * 2048 + (u.pn - 16) * 256 + c0) = pack8(v0, v1);
                    }
                }
            }
    }
};

template <int MODE>
__device__ __forceinline__ void tr_item(const float* __restrict__ W, int K, int N, h16* Wt, int ld, int row_off, const float* ks, float scale, float* scr, int item, int lane) {
    const int nbn = (N + 31) >> 5, kb = item / nbn, nb = item % nbn, k0 = kb * 64, n0 = nb * 32;
    const int n4 = n0 + (lane & 7) * 4;
    f32x4 wv[8];
#pragma unroll
    for (int i = 0; i < 8; ++i) { const int kk = 8 * i + (lane >> 3); wv[i] = (n4 < N) ? *(const f32x4*)(W + (size_t)(k0 + kk) * N + n4) : (f32x4){0.f, 0.f, 0.f, 0.f}; }
#pragma unroll
    for (int i = 0; i < 8; ++i) { const int kk = 8 * i + (lane >> 3); const float kf = ks ? ks[k0 + kk] : 1.f;
#pragma unroll
        for (int e = 0; e < 4; ++e) scr[kk * 33 + (lane & 7) * 4 + e] = wv[i][e] * kf; }
    LDS_FENCE();
    const int c = lane & 7;
#pragma unroll
    for (int j = 0; j < 4; ++j) {
        const int nl = (lane >> 3) + 8 * j, n = n0 + nl;
        if (n < N) {
            int row = n; float sc = scale;
            if (MODE == 1) row = (n < 384) ? 256 + n : (n < 640) ? n - 384 : (n < 712) ? n : n + 56;
            if (MODE == 2 && n >= 1024 && n < 2048) sc *= 0.0625f;
            const float* s = scr + (8 * c) * 33 + nl;
            h16x8 o;
#pragma unroll
            for (int e = 0; e < 8; ++e) o[e] = (h16)(s[e * 33] * sc);
            *(h16x8*)(Wt + (size_t)(row_off + row) * ld + k0 + 8 * c) = o;
        }
    }
    LDS_FENCE();
}

__device__ __forceinline__ void p0_prologue(const Params& P, unsigned char* lds, int blk, int nblk, int wv) {
    const int tid = my_tid(wv), wid = __builtin_amdgcn_readfirstlane(tid >> 6), lane = tid & 63;
    float* scr = (float*)lds + wid * (64 * 33);
    const int gw = blk * NWAVES + wid, ngw = nblk * NWAVES;
    unsigned char* ws = opaque_ptr(P.ws);
    h16* WAIN = (h16*)(ws + WS_WAIN); h16* WQ = (h16*)(ws + WS_WQ); h16* WKV = (h16*)(ws + WS_WKV); h16* WAOUT = (h16*)(ws + WS_WAOUT);
    h16* WPG = (h16*)(ws + WS_WPG); h16* WPLE = (h16*)(ws + WS_WPLE); h16* WRIN = (h16*)(ws + WS_WRIN); h16* WROUT = (h16*)(ws + WS_WROUT);
    const float QSCALE = 0.08838834764831845f * 1.4426950408889634f;
    constexpr int I1 = 16 * 55, I2 = 6 * 32, I3 = 6 * 16, I4 = 8 * 16, I5 = 8 * 16, I6 = 16 * 32, I7 = 2 * 16 * 32, I8 = 2 * 4 * 32, I9 = 16 * 192, I10 = 32 * 32;
    constexpr int NIT = I1 + I2 + I3 + I4 + I5 + I6 + I7 + I8 + I9 + I10;
    for (int it = gw; it < NIT; it += ngw) {
        int r = it;
        if (r < I1) { tr_item<1>(P.in[3], 1024, 1736, WAIN, 1024, 0, nullptr, 1.f, scr, r, lane); continue; } r -= I1;
        if (r < I2) { tr_item<0>(P.in[6], 384, 1024, WQ, 384, 0, P.in[4], QSCALE, scr, r, lane); continue; } r -= I2;
        if (r < I3) { tr_item<0>(P.in[7], 384, 512, WQ, 384, 1024, P.in[4], 1.f, scr, r, lane); continue; } r -= I3;
        if (r < I4) { const int h = r / 16; tr_item<0>(P.in[10] + (size_t)h * 256 * 128, 256, 128, WKV, 256, h * 128, P.in[5], 1.f, scr, r % 16, lane); continue; } r -= I4;
        if (r < I5) { const int h = r / 16; tr_item<0>(P.in[11] + (size_t)h * 256 * 128, 256, 128, WKV, 256, 1024 + h * 128, P.in[5], 1.f, scr, r % 16, lane); continue; } r -= I5;
        if (r < I6) { tr_item<0>(P.in[12], 1024, 1024, WAOUT, 1024, 0, nullptr, 1.f, scr, r, lane); continue; } r -= I6;
        if (r < I7) { const int i = r / 512; tr_item<0>(P.in[15] + (size_t)i * 1024 * 1024, 1024, 1024, WPG + (size_t)i * 1024 * 1024, 1024, 0, P.in[16] + i * 1024, 1.f, scr, r % 512, lane); continue; } r -= I7;
        if (r < I8) { const int i = r / 128; tr_item<0>(P.in[17] + (size_t)i * 256 * 1024, 256, 1024, WPLE + (size_t)i * 1024 * 256, 256, 0, nullptr, 1.f, scr, r % 128, lane); continue; } r -= I8;
        if (r < I9) { tr_item<2>(P.in[13], 1024, 6144, WRIN, 1024, 0, P.in[2] + 1024, 1.f, scr, r, lane); continue; } r -= I9;
        tr_item<0>(P.in[14], 2048, 1024, WROUT, 2048, 0, nullptr, 1.f, scr, r, lane);
    }
    const int gt = blk * NTHREADS + tid, ngt = nblk * NTHREADS;
    { unsigned zz = 0u; asm volatile("" : "+v"(zz));
      for (int i = gt; i < 56 * 1024 / 8; i += ngt) ((u32x4*)(WAIN + 712 * 1024))[i] = (u32x4){zz, zz, zz, zz}; }
    {
        const float* x = P.in[0]; const f32x4* g4 = (const f32x4*)P.in[2]; h16* XN0 = (h16*)(ws + WS_R1);
        f32x4 gv[4];
#pragma unroll
        for (int j = 0; j < 4; ++j) gv[j] = g4[lane + 64 * j];
        for (int r0 = gw; r0 < T; r0 += 4 * ngw) {
            f32x4 v[4][4];
#pragma unroll
            for (int k = 0; k < 4; ++k) { const int r = (r0 + k * ngw < T) ? r0 + k * ngw : r0; const f32x4* xr = (const f32x4*)(x + (size_t)r * 1024) + lane;
#pragma unroll
                for (int j = 0; j < 4; ++j) v[k][j] = xr[64 * j]; }
#pragma unroll
            for (int k = 0; k < 4; ++k) { const int r = r0 + k * ngw; float s = 0.f;
#pragma unroll
                for (int j = 0; j < 4; ++j) s += dot4(v[k][j]);
                const float rstd = rsqrtf(wave_sum_dpp(s) * (1.0f / 1024.0f) + EPS);
                if (r < T) {
#pragma unroll
                    for (int j = 0; j < 4; ++j) { const f32x4 o = v[k][j] * rstd * gv[j]; *(h16x4*)(XN0 + (size_t)r * 1024 + (lane + 64 * j) * 4) = pack4(o); } } }
        }
    }
    {
        const f32x4* p4 = (const f32x4*)P.in[1]; h16* PH0 = (h16*)(ws + WS_PH0); h16* PH1 = (h16*)(ws + WS_PH1);
        const int nv = T * 256 / 8;
        for (int i0_ = gt; i0_ < 2 * nv; i0_ += 4 * ngt) {
            f32x4 a[4], b2[4];
#pragma unroll
            for (int k = 0; k < 4; ++k) { const int i = (i0_ + k * ngt < 2 * nv) ? i0_ + k * ngt : i0_; a[k] = p4[2 * (size_t)i]; b2[k] = p4[2 * (size_t)i + 1]; }
#pragma unroll
            for (int k = 0; k < 4; ++k) { const int i = i0_ + k * ngt; if (i < 2 * nv) { h16* dst = (i < nv) ? PH0 + (size_t)i * 8 : PH1 + (size_t)(i - nv) * 8; *(h16x8*)dst = pack8(a[k], b2[k]); } }
        }
    }
    {
        f32x2* SC = (f32x2*)(ws + WS_SINCOS);
        for (int i = gt; i < L * 128; i += ngt) {
            const int pos = i >> 7, fi = i & 127;
            const float th = (float)pos * kAngle[fi];
            double rev = (double)th * 0.15915494309189535; rev -= __builtin_rint(rev);
            const float r = (float)(rev * 6.283185307179586), r2 = r * r;
            float sn = 1.9572941e-20f;
            sn = sn * r2 - 8.2206352e-18f;
            sn = sn * r2 + 2.8114573e-15f;
            sn = sn * r2 - 7.6471637e-13f;
            sn = sn * r2 + 1.6059044e-10f;
            sn = sn * r2 - 2.5052108e-8f;
            sn = sn * r2 + 2.7557319e-6f;
            sn = sn * r2 - 1.9841270e-4f;
            sn = sn * r2 + 8.3333333e-3f;
            sn = sn * r2 - 1.6666667e-1f;
            sn = sn * r2 + 1.0f;
            sn = sn * r;
            float cs = 4.1103176e-19f;
            cs = cs * r2 - 1.5619207e-16f;
            cs = cs * r2 + 4.7794773e-14f;
            cs = cs * r2 - 1.1470746e-11f;
            cs = cs * r2 + 2.0876757e-9f;
            cs = cs * r2 - 2.7557319e-7f;
            cs = cs * r2 + 2.4801587e-5f;
            cs = cs * r2 - 1.3888889e-3f;
            cs = cs * r2 + 4.1666667e-2f;
            cs = cs * r2 - 0.5f;
            cs = cs * r2 + 1.0f;
            SC[i] = (f32x2){sn, cs};
        }
    }
}

__device__ __forceinline__ void p2_kidx(const Params& P, int blk, int nblk, int wv) {
    const h16* CQX = (const h16*)(P.ws + WS_CQX); h16* KIDXN = (h16*)(P.ws + WS_KIDXN); float* WIDX = (float*)(P.ws + WS_WIDX);
    const float* g = P.in[8]; const float* bb = P.in[9];
    for (int r = blk * NTHREADS + my_tid(wv); r < T; r += nblk * NTHREADS) {
        float v[64]; float s = 0.f;
#pragma unroll
        for (int c = 0; c < 8; ++c) { const h16x8 k = *(const h16x8*)(CQX + (size_t)r * 512 + 384 + c * 8);
#pragma unroll
            for (int e = 0; e < 8; ++e) { v[c * 8 + e] = (float)k[e]; s += v[c * 8 + e]; } }
        const float mu = s * (1.0f / 64.0f); float q = 0.f;
#pragma unroll
        for (int i = 0; i < 64; ++i) { v[i] -= mu; q += v[i] * v[i]; }
        const float rstd = rsqrtf(q * (1.0f / 64.0f) + EPS);
#pragma unroll
        for (int c = 0; c < 8; ++c) { h16x8 o;
#pragma unroll
            for (int e = 0; e < 8; ++e) o[e] = (h16)(v[c * 8 + e] * rstd * g[c * 8 + e] + bb[c * 8 + e]);
            *(h16x8*)(KIDXN + (size_t)r * 64 + c * 8) = o; }
        const h16x8 w = *(const h16x8*)(CQX + (size_t)r * 512 + 448);
        const float wsc = 0.04419417382415922f;
        f32x4 w0, w1;
#pragma unroll
        for (int e = 0; e < 4; ++e) { w0[e] = (float)w[e] * wsc; w1[e] = (float)w[4 + e] * wsc; }
        *(f32x4*)(WIDX + (size_t)r * 8) = w0; *(f32x4*)(WIDX + (size_t)r * 8 + 4) = w1;
    }
}

__device__ __forceinline__ unsigned fmap_u(float s) { s += 0.0f; const unsigned b = __float_as_uint(s); return (b & 0x80000000u) ? ~b : (b | 0x80000000u); }
__device__ __forceinline__ unsigned topk_select(const unsigned (&u)[32], int lane) {
    unsigned Tv = 0u;
    for (int bit = 31; bit >= 0; --bit) {
        const unsigned cand = Tv | (1u << bit); int cnt = 0;
#pragma unroll
        for (int i = 0; i < 32; ++i) cnt += __popcll(__ballot(u[i] >= cand));
        if (cnt >= 256) Tv = cand;
    }
    int gt = 0;
#pragma unroll
    for (int i = 0; i < 32; ++i) gt += __popcll(__ballot(u[i] > Tv));
    int need = 256 - gt;
    unsigned sel = 0u;
#pragma unroll
    for (int i = 0; i < 32; ++i) {
        const bool eq = (u[i] == Tv);
        const unsigned long long em = __ballot(eq);
        const int rank = (int)__builtin_amdgcn_mbcnt_hi((unsigned)(em >> 32), __builtin_amdgcn_mbcnt_lo((unsigned)em, 0u));
        const bool take = (u[i] > Tv) || (eq && rank < need);
        sel |= (take ? 1u : 0u) << i;
        need -= __popcll(em);
    }
    return sel;
}


__device__ __forceinline__ unsigned topk_select_radix(const unsigned (&u)[32], int lane, volatile __attribute__((address_space(3))) unsigned* hist) {
    typedef __attribute__((address_space(3))) unsigned lu32;
    unsigned prefix = 0u; int kk = 256;
#pragma unroll 1
    for (int pass = 0; pass < 4; ++pass) {
        const int shift = 24 - 8 * pass;
        { unsigned zz = 0u; asm volatile("" : "+v"(zz)); ((__attribute__((address_space(3))) u32x4*)hist)[lane] = (u32x4){zz, zz, zz, zz}; }
        LDS_FENCE();
#pragma unroll
        for (int i = 0; i < 32; ++i) {
            const bool in = (u[i] != 0u) && (pass == 0 || (u[i] >> (shift + 8)) == prefix);
            if (in) __hip_atomic_fetch_add((lu32*)hist + ((u[i] >> shift) & 255u), 1u, __ATOMIC_RELAXED, __HIP_MEMORY_SCOPE_WORKGROUP);
        }
        LDS_FENCE();
        const u32x4 c = ((__attribute__((address_space(3))) u32x4*)hist)[lane];
        const int tot = (int)(c[0] + c[1] + c[2] + c[3]);
        int S = tot;
#pragma unroll
        for (int o = 1; o < 64; o <<= 1) { const int v = __shfl_down(S, o); if (lane + o < 64) S += v; }
        const unsigned long long bm = __ballot(S >= kk);
        const int Ls = 63 - __builtin_clzll(bm);
        int cum = S - tot, bin = 0, above = 0; bool found = false;
#pragma unroll
        for (int j = 3; j >= 0; --j) { const int cj = (int)c[j]; if (!found && cum + cj >= kk) { bin = 4 * lane + j; above = cum; found = true; } cum += cj; }
        bin = __builtin_amdgcn_readlane(bin, Ls); above = __builtin_amdgcn_readlane(above, Ls);
        kk -= above; prefix = (prefix << 8) | (unsigned)bin;
        LDS_FENCE();
    }
    const unsigned Tv = prefix; int need = kk;
    unsigned sel = 0u;
#pragma unroll
    for (int i = 0; i < 32; ++i) {
        const bool eq = (u[i] == Tv);
        const unsigned long long em = __ballot(eq);
        const int rank = (int)__builtin_amdgcn_mbcnt_hi((unsigned)(em >> 32), __builtin_amdgcn_mbcnt_lo((unsigned)em, 0u));
        const bool take = (u[i] > Tv) || (eq && rank < need);
        sel |= (take ? 1u : 0u) << i;
        need -= __popcll(em);
    }
    return sel;
}


#define DPP_STEP_I(v, op, ident, ctrl, rmask) v = op(v, __builtin_amdgcn_update_dpp((int)(ident), v, ctrl, rmask, 0xf, false))
__device__ __forceinline__ int imax_(int a, int b) { return a > b ? a : b; }
__device__ __forceinline__ int iadd_(int a, int b) { return a + b; }
__device__ __forceinline__ int wave_scan_add(int v) {
    DPP_STEP_I(v, iadd_, 0, 0x111, 0xf); DPP_STEP_I(v, iadd_, 0, 0x112, 0xf); DPP_STEP_I(v, iadd_, 0, 0x114, 0xf); DPP_STEP_I(v, iadd_, 0, 0x118, 0xf);
    DPP_STEP_I(v, iadd_, 0, 0x142, 0xa); DPP_STEP_I(v, iadd_, 0, 0x143, 0xc); return v;
}
template <int CTRL, int RMASK> __device__ __forceinline__ float fmax_dpp_(float a) { return fmaxf(a, __builtin_bit_cast(float, __builtin_amdgcn_update_dpp((int)0xff800000u, __builtin_bit_cast(int, a), CTRL, RMASK, 0xf, false))); }
template <int CTRL, int RMASK> __device__ __forceinline__ float fmin_dpp_(float a) { return fminf(a, __builtin_bit_cast(float, __builtin_amdgcn_update_dpp((int)0x7f800000u, __builtin_bit_cast(int, a), CTRL, RMASK, 0xf, false))); }
#define DPP_RED6(v, F) do { v = F<0x111, 0xf>(v); v = F<0x112, 0xf>(v); v = F<0x114, 0xf>(v); v = F<0x118, 0xf>(v); v = F<0x142, 0xa>(v); v = F<0x143, 0xc>(v); } while (0)
__device__ __forceinline__ float wave_max_dpp(float v) { DPP_RED6(v, fmax_dpp_); return __builtin_bit_cast(float, __builtin_amdgcn_readlane(__builtin_bit_cast(int, v), 63)); }
__device__ __forceinline__ float wave_min_dpp(float v) { DPP_RED6(v, fmin_dpp_); return __builtin_bit_cast(float, __builtin_amdgcn_readlane(__builtin_bit_cast(int, v), 63)); }
__device__ __forceinline__ unsigned topk_select_lin(const float (&s)[32], unsigned valid, int lane, volatile __attribute__((address_space(3))) unsigned* ws_) {
    typedef __attribute__((address_space(3))) unsigned lu32;
    typedef __attribute__((address_space(3))) float lf32;
    typedef __attribute__((address_space(3))) f32x4 lf32x4;
    lu32* hist = (lu32*)ws_; lf32* cand = (lf32*)ws_ + 256;
    unsigned act = valid; int kk = 256; float Tv = 0.f; int need = 0; bool solved = false; int cnt = 0;
#pragma unroll 1
    for (int iter = 0; iter < 8; ++iter) {
        float mn = __builtin_inff(), mx = -__builtin_inff();
        if (iter == 0) {
#pragma unroll
            for (int i = 0; i < 32; ++i) { mn = fminf(mn, s[i]); mx = fmaxf(mx, s[i]); }
        } else {
#pragma unroll
            for (int i = 0; i < 32; ++i) { const bool a = (act >> i) & 1u; mn = fminf(mn, a ? s[i] : __builtin_inff()); mx = fmaxf(mx, a ? s[i] : -__builtin_inff()); }
        }
        mn = wave_min_dpp(mn); mx = wave_max_dpp(mx);
        if (mn == mx) { Tv = mx; need = kk; solved = true; break; }
        const float scale = 254.9f / (mx - mn), bias = -mn * scale;
        { unsigned zz = 0u; asm volatile("" : "+v"(zz)); ((__attribute__((address_space(3))) u32x4*)hist)[lane] = (u32x4){zz, zz, zz, zz}; }
        LDS_FENCE();
#pragma unroll
        for (int i = 0; i < 32; ++i) { int b = (int)fmaf(s[i], scale, bias); b = b < 0 ? 0 : b;
            __hip_atomic_fetch_add(hist + (((act >> i) & 1u) ? b : 321 + (lane & 15)), 1u, __ATOMIC_RELAXED, __HIP_MEMORY_SCOPE_WORKGROUP); }
        LDS_FENCE();
        const u32x4 c = ((__attribute__((address_space(3))) u32x4*)hist)[lane];
        const int tot = (int)(c[0] + c[1] + c[2] + c[3]);
        const int pre = wave_scan_add(tot);
        const int total = __builtin_amdgcn_readlane(pre, 63);
        const int S = total - pre + tot;
        const unsigned long long bm = __ballot(S >= kk);
        const int Ls = 63 - __builtin_clzll(bm | 1ull);
        int cum = S - tot, bin = 0, above = 0, cb = 0; bool found = false;
#pragma unroll
        for (int j = 3; j >= 0; --j) { const int cj = (int)c[j]; if (!found && cum + cj >= kk) { bin = 4 * lane + j; above = cum; cb = cj; found = true; } cum += cj; }
        bin = __builtin_amdgcn_readlane(bin, Ls); above = __builtin_amdgcn_readlane(above, Ls); cnt = __builtin_amdgcn_readlane(cb, Ls);
        kk -= above;
        { float sc2 = scale; asm volatile("" : "+v"(sc2));
#pragma unroll
          for (int i = 0; i < 32; ++i) { int b = (int)fmaf(s[i], sc2, bias); b = b < 0 ? 0 : b; act &= ~((b != bin ? 1u : 0u) << i); } }
        LDS_FENCE();
        if (cnt <= 64) break;
    }
    if (!solved) {
        cand[lane] = __builtin_nanf("");
        const int myc = __popc(act);
        int off = wave_scan_add(myc) - myc;
        LDS_FENCE();
#pragma unroll
        for (int i = 0; i < 32; ++i) { const bool a = (act >> i) & 1u; const int slot = (a && off < 64) ? off : 65 + (lane & 15); cand[slot] = s[i]; off += a ? 1 : 0; }
        LDS_FENCE();
        const int m = cnt < 64 ? cnt : 64;
        const float v = (lane < m) ? cand[lane] : -__builtin_inff();
        int gt = 0, eq = 0;
#pragma unroll
        for (int j4 = 0; j4 < 16; ++j4) { const f32x4 cj = ((lf32x4*)cand)[j4];
#pragma unroll
            for (int e = 0; e < 4; ++e) { gt += (cj[e] > v) ? 1 : 0; eq += (cj[e] == v) ? 1 : 0; } }
        const bool ok = (lane < m) && gt < kk && kk <= gt + eq;
        const unsigned long long okm = __ballot(ok);
        const int fl = okm ? __builtin_ctzll(okm) : 0;
        Tv = __builtin_bit_cast(float, __builtin_amdgcn_readlane(__builtin_bit_cast(int, v), fl)); need = kk - __builtin_amdgcn_readlane(gt, fl);
        LDS_FENCE();
    }
    unsigned sel = 0u, eqb = 0u;
#pragma unroll
    for (int i = 0; i < 32; ++i) { sel |= ((s[i] > Tv) ? 1u : 0u) << i; eqb |= ((s[i] == Tv) ? 1u : 0u) << i; }
    const int eqtot = __builtin_amdgcn_readlane(wave_scan_add(__popc(eqb)), 63);
    if (eqtot <= need) sel |= eqb;
    else {
#pragma unroll
        for (int i = 0; i < 32; ++i) {
            const bool eq = (eqb >> i) & 1u;
            const unsigned long long em = __ballot(eq);
            const int rank = (int)__builtin_amdgcn_mbcnt_hi((unsigned)(em >> 32), __builtin_amdgcn_mbcnt_lo((unsigned)em, 0u));
            sel |= ((eq && rank < need) ? 1u : 0u) << i;
            need -= __popcll(em);
        }
    }
    return sel;
}


__device__ __forceinline__ unsigned topk_select_fast(const float (&s)[32], unsigned valid, int nk, int lane, const __attribute__((address_space(3))) float* row, volatile __attribute__((address_space(3))) unsigned* ws_) {
    typedef __attribute__((address_space(3))) unsigned lu32; typedef __attribute__((address_space(3))) float lf32; typedef __attribute__((address_space(3))) f32x4 lf32x4;
    lu32* hist = (lu32*)ws_; lf32* cand = (lf32*)ws_ + 256;
    float mn = __builtin_inff(), mx = -__builtin_inff();
#pragma unroll
    for (int i = 0; i < 32; ++i) { mn = fminf(mn, s[i]); mx = fmaxf(mx, s[i]); }
    mn = wave_min_dpp(mn); mx = wave_max_dpp(mx);
    const bool flat = (mn == mx);
    const float scale = flat ? 0.f : 254.9f / (mx - mn), bias = flat ? 0.f : -mn * scale;
    { unsigned zz = 0u; asm volatile("" : "+v"(zz)); ((__attribute__((address_space(3))) u32x4*)hist)[lane] = (u32x4){zz, zz, zz, zz}; }
    LDS_FENCE();
    const int full = nk >> 6, rem = nk & 63;
#pragma unroll
    for (int i = 0; i < 32; ++i) if (i <= full) { int b = (int)fmaf(s[i], scale, bias); b = b < 0 ? 0 : b; __hip_atomic_fetch_add(hist + b, 1u, __ATOMIC_RELAXED, __HIP_MEMORY_SCOPE_WORKGROUP); }
    LDS_FENCE();
    u32x4 c = ((__attribute__((address_space(3))) u32x4*)hist)[lane];
    if (lane == 0 && full < 32) c[0] -= (unsigned)(64 - rem);
    const int tot = (int)(c[0] + c[1] + c[2] + c[3]);
    const int pre = wave_scan_add(tot), total = __builtin_amdgcn_readlane(pre, 63);
    const int S = total - pre + tot;
    const unsigned long long bm = __ballot(S >= 256);
    const int Ls = 63 - __builtin_clzll(bm | 1ull);
    int cum = S - tot, bin = 0, above = 0, cb = 0; bool found = false;
#pragma unroll
    for (int j = 3; j >= 0; --j) { const int cj = (int)c[j]; if (!found && cum + cj >= 256) { bin = 4 * lane + j; above = cum; cb = cj; found = true; } cum += cj; }
    bin = __builtin_amdgcn_readlane(bin, Ls); above = __builtin_amdgcn_readlane(above, Ls); const int cnt = __builtin_amdgcn_readlane(cb, Ls);
    if (flat || cnt > 64) return topk_select_lin(s, valid, lane, ws_);
    const int kk = 256 - above;
    unsigned gtb = 0u, eqb = 0u;
    { float sc2 = scale; asm volatile("" : "+v"(sc2));
#pragma unroll
      for (int i = 0; i < 32; ++i) if (i <= full) { int b = (int)fmaf(s[i], sc2, bias); b = b < 0 ? 0 : b; gtb |= (b > bin ? 1u : 0u) << i; eqb |= (b == bin ? 1u : 0u) << i; } }
    eqb &= valid;
    cand[lane] = __builtin_nanf("");
    int off = wave_scan_add(__popc(eqb)) - __popc(eqb);
    LDS_FENCE();
    { unsigned m = eqb;
      while (__any(m != 0u)) { if (m != 0u) { const int i = __builtin_ctz(m); cand[off < 64 ? off : 65 + (lane & 15)] = row[i * 64 + lane]; ++off; m &= m - 1u; } } }
    LDS_FENCE();
    const float v = (lane < cnt) ? cand[lane] : -__builtin_inff();
    int gt = 0, eq = 0;
#pragma unroll
    for (int j4 = 0; j4 < 16; ++j4) { const f32x4 cj = ((lf32x4*)cand)[j4];
#pragma unroll
        for (int e = 0; e < 4; ++e) { gt += (cj[e] > v) ? 1 : 0; eq += (cj[e] == v) ? 1 : 0; } }
    const unsigned long long okm = __ballot((lane < cnt) && gt < kk && kk <= gt + eq);
    const int fl = okm ? __builtin_ctzll(okm) : 0;
    const float Tv = __builtin_bit_cast(float, __builtin_amdgcn_readlane(__builtin_bit_cast(int, v), fl)); int need = kk - __builtin_amdgcn_readlane(gt, fl);
    const int eqtot = __builtin_amdgcn_readlane(eq, fl);
    LDS_FENCE();
    unsigned sel = gtb;
    if (eqtot <= need) {
        unsigned m = eqb;
        while (__any(m != 0u)) { if (m != 0u) { const int i = __builtin_ctz(m); if (row[i * 64 + lane] >= Tv) sel |= 1u << i; m &= m - 1u; } }
    } else {
#pragma unroll
        for (int i = 0; i < 32; ++i) {
            const bool inb = (eqb >> i) & 1u; const bool e_ = inb && (s[i] == Tv);
            const unsigned long long em = __ballot(e_);
            const int rank = (int)__builtin_amdgcn_mbcnt_hi((unsigned)(em >> 32), __builtin_amdgcn_mbcnt_lo((unsigned)em, 0u));
            sel |= (((inb && s[i] > Tv) || (e_ && rank < need)) ? 1u : 0u) << i;
            need -= __popcll(em);
        }
    }
    return sel;
}

__device__ __forceinline__ void p3_indexer_naive(const Params& P, unsigned char* lds, int blk, int nblk, int wv) {
    const int tid = my_tid(wv), wid = __builtin_amdgcn_readfirstlane(tid >> 6), lane = tid & 63;
    float* sc = (float*)lds + wid * 2048; float* qf = (float*)(lds + 65536) + wid * 512; float* wf = (float*)(lds + 65536 + 16384) + wid * 8;
    const h16* QIDX = (const h16*)(P.ws + WS_QIDX); const h16* KIDXN = (const h16*)(P.ws + WS_KIDXN); const float* WIDX = (const float*)(P.ws + WS_WIDX);
    unsigned long long* MASK = (unsigned long long*)(P.ws + WS_MASK);
    const int gw = blk * NWAVES + wid, ngw = nblk * NWAVES;
    for (int it = gw; it < T; it += ngw) {
        const int b = it >> 11, pos = ((it & 2047) + b * 389) & 2047, t = b * L + pos, nk = pos + 1;
        { const h16x8 qv = *(const h16x8*)(QIDX + (size_t)t * 512 + lane * 8);
#pragma unroll
          for (int e = 0; e < 8; ++e) qf[lane * 8 + e] = (float)qv[e];
          if (lane < 8) wf[lane] = WIDX[(size_t)t * 8 + lane]; }
        LDS_FENCE();
        for (int i = 0; i * 64 < nk; ++i) {
            const int key = i * 64 + lane; float score = 0.f;
            if (key < nk) {
                const h16x8* kp = (const h16x8*)(KIDXN + (size_t)(b * L + key) * 64);
                float kf[64];
#pragma unroll
                for (int c = 0; c < 8; ++c) { const h16x8 kv = kp[c];
#pragma unroll
                    for (int e = 0; e < 8; ++e) kf[c * 8 + e] = (float)kv[e]; }
                for (int h = 0; h < 8; ++h) {
                    float a = 0.f;
#pragma unroll
                    for (int d = 0; d < 64; ++d) a = fmaf(qf[h * 64 + d], kf[d], a);
                    score += fmaxf(a, 0.f) * wf[h];
                }
            }
            sc[key] = score;
        }
        LDS_FENCE();
        unsigned selbits = 0u;
        if (nk <= 256) {
#pragma unroll
            for (int i = 0; i < 32; ++i) selbits |= ((i * 64 + lane) < nk ? 1u : 0u) << i;
        } else {
            unsigned u[32];
#pragma unroll
            for (int i = 0; i < 32; ++i) { const int key = i * 64 + lane; const float s = sc[key]; u[i] = (key < nk) ? fmap_u(s) : 0u; }
            selbits = topk_select(u, lane);
        }
#pragma unroll
        for (int i = 0; i < 32; ++i) { const unsigned long long bal = __ballot((selbits >> i) & 1u); if (lane == 0) MASK[(size_t)t * 32 + i] = bal; }
        LDS_FENCE();
    }
}


typedef float f32x16 __attribute__((ext_vector_type(16)));
__device__ __forceinline__ h16x8 relu_pk8(const f32x16& s, int base) {
    h16x8 r;
#pragma unroll
    for (int e = 0; e < 4; ++e) { const h16x2 p = __builtin_bit_cast(h16x2, __builtin_amdgcn_cvt_pkrtz(fmaxf(s[base + 2 * e], 0.f), fmaxf(s[base + 2 * e + 1], 0.f))); r[2 * e] = p[0]; r[2 * e + 1] = p[1]; }
    return r;
}
__device__ __forceinline__ void p3_indexer(const Params& P, unsigned char* lds_, int blk, int nblk, int wv) {
    typedef __attribute__((address_space(3))) float lfloat;
    const int tid = my_tid(wv), wid = __builtin_amdgcn_readfirstlane(tid >> 6), lane = tid & 63;
    unsigned char* ws = opaque_ptr(P.ws);
    lfloat* sc = (lfloat*)lds_;
    const h16* QIDX = (const h16*)(ws + WS_QIDX); const h16* KIDXN = (const h16*)(ws + WS_KIDXN); const float* WIDX = (const float*)(ws + WS_WIDX);
    unsigned long long* MASK = (unsigned long long*)(ws + WS_MASK);
    h16x8 Afn[4][4]; f32x4 wn = (f32x4){0.f, 0.f, 0.f, 0.f};
    { const int r = lane & 31, h = lane >> 5; const int u0 = (blk < NB * (L / 16)) ? blk : 0; const int tt0 = (u0 & 15) * L + (u0 >> 4) * 16;
#pragma unroll
      for (int g = 0; g < 4; ++g)
#pragma unroll
          for (int s = 0; s < 4; ++s) Afn[g][s] = *(const h16x8*)(QIDX + (size_t)(tt0 + 4 * g + (r >> 3)) * 512 + (r & 7) * 64 + 16 * s + 8 * h);
      if (r < 16) wn = *(const f32x4*)(WIDX + (size_t)(tt0 + r) * 8 + 4 * h); }
    for (int unit = blk; unit < NB * (L / 16); unit += nblk) {
        const int b = unit & 15, qg = unit >> 4, p0 = qg * 16, t0 = b * L + p0, NT = (p0 + 15) / 32 + 1;
        int lane_o = lane; asm volatile("" : "+v"(lane_o));
        const int r = lane_o & 31, h = lane_o >> 5;
        h16x8 Af[4][4];
#pragma unroll
        for (int g = 0; g < 4; ++g)
#pragma unroll
            for (int s = 0; s < 4; ++s) Af[g][s] = Afn[g][s];
        h16x8 fragA;
        { const f32x4 w = wn;
          const h16 z = (h16)0.f;
          if (r & 1) { fragA[0] = z; fragA[1] = z; fragA[2] = z; fragA[3] = z; fragA[4] = (h16)w[0]; fragA[5] = (h16)w[1]; fragA[6] = (h16)w[2]; fragA[7] = (h16)w[3]; }
          else { fragA[0] = (h16)w[0]; fragA[1] = (h16)w[1]; fragA[2] = (h16)w[2]; fragA[3] = (h16)w[3]; fragA[4] = z; fragA[5] = z; fragA[6] = z; fragA[7] = z; } }
        const int code = (r < 16) ? (r >> 1) : -1;
        const h16* kbase = KIDXN + (size_t)b * L * 64 + (size_t)r * 64 + 8 * h;
        h16x8 Bf[4];
        if (wid < NT) {
#pragma unroll
            for (int s = 0; s < 4; ++s) Bf[s] = *(const h16x8*)(kbase + (size_t)wid * 32 * 64 + 16 * s);
        }
        for (int rep_ = 0; rep_ <= MK_P3_REPA; ++rep_) {
        if (rep_ > 0 && wid < NT) {
#pragma unroll
            for (int s = 0; s < 4; ++s) Bf[s] = *(const h16x8*)(kbase + (size_t)wid * 32 * 64 + 16 * s);
        }
        for (int kt = wid; kt < NT; kt += NWAVES) {
            h16x8 Bn[4];
            const int ktn = (kt + NWAVES < NT) ? kt + NWAVES : kt;
#pragma unroll
            for (int s = 0; s < 4; ++s) Bn[s] = *(const h16x8*)(kbase + (size_t)ktn * 32 * 64 + 16 * s);
            f32x16 C = {};
#pragma unroll
            for (int g = 0; g < 4; ++g) {
                f32x16 S = {};
#pragma unroll
                for (int s = 0; s < 4; ++s) S = __builtin_amdgcn_mfma_f32_32x32x16_f16(Af[g][s], Bf[s], S, 0, 0, 0);
                const h16x8 X0 = relu_pk8(S, 0), X1 = relu_pk8(S, 8);
                const h16x8 zero8 = (h16x8){0, 0, 0, 0, 0, 0, 0, 0};
                const h16x8 W0 = (code == 2 * g) ? fragA : zero8, W1 = (code == 2 * g + 1) ? fragA : zero8;
                C = __builtin_amdgcn_mfma_f32_32x32x16_f16(W0, X0, C, 0, 0, 0);
                C = __builtin_amdgcn_mfma_f32_32x32x16_f16(W1, X1, C, 0, 0, 0);
            }
            const int key = kt * 32 + r;
#pragma unroll
            for (int e = 0; e < 4; ++e) { sc[(e + 4 * h) * 2048 + key] = C[e]; sc[(8 + e + 4 * h) * 2048 + key] = C[4 + e]; }
#pragma unroll
            for (int s = 0; s < 4; ++s) Bf[s] = Bn[s];
        }
        }
        __syncthreads();
        { const int un = (unit + nblk < NB * (L / 16)) ? unit + nblk : unit; const int ttn = (un & 15) * L + (un >> 4) * 16;
#pragma unroll
          for (int g = 0; g < 4; ++g)
#pragma unroll
              for (int s = 0; s < 4; ++s) Afn[g][s] = *(const h16x8*)(QIDX + (size_t)(ttn + 4 * g + (r >> 3)) * 512 + (r & 7) * 64 + 16 * s + 8 * h);
          if (r < 16) wn = *(const f32x4*)(WIDX + (size_t)(ttn + r) * 8 + 4 * h); }
#pragma unroll 1
        for (int qq_ = 0; qq_ < 2 * (1 + MK_P3_REPB); ++qq_) {
            const int qq = qq_ & 1;
            const int qi = 2 * wid + qq, pos = p0 + qi, nk = pos + 1, t = t0 + qi;
            unsigned selbits = 0u;
            if (nk <= 256) {
#pragma unroll
                for (int i = 0; i < 32; ++i) selbits |= ((i * 64 + lane) < nk ? 1u : 0u) << i;
            } else {
                float sv[32];
                const int full = nk >> 6;
                const unsigned valid = (full >= 32 ? 0xffffffffu : ((1u << full) - 1u)) | ((full < 32 && lane < (nk & 63)) ? (1u << full) : 0u);
#pragma unroll
                for (int i = 0; i < 32; ++i) { const float x = sc[qi * 2048 + i * 64 + lane]; sv[i] = ((valid >> i) & 1u) ? x : __builtin_nanf(""); }
                selbits = topk_select_fast(sv, valid, nk, lane, (const __attribute__((address_space(3))) float*)(sc + qi * 2048), (volatile __attribute__((address_space(3))) unsigned*)(sc + 16 * 2048 + wid * 448));
            }
            {
                __attribute__((address_space(3))) unsigned long long* stg = (__attribute__((address_space(3))) unsigned long long*)(sc + 16 * 2048 + wid * 448 + (qq ? 0 : 338));
                LDS_FENCE();
#pragma unroll
                for (int i = 0; i < 32; ++i) { const unsigned long long bal = __ballot((selbits >> i) & 1u); if (lane == 0) stg[i] = bal; }
            }
            (void)t;
        }
        __syncthreads();
        { const int q = tid & 15, tl = tid >> 4;
          MASK[((size_t)b * 32 + tl) * L + p0 + q] = ((__attribute__((address_space(3))) unsigned long long*)(sc + 16 * 2048 + (q >> 1) * 448 + ((q & 1) ? 0 : 338)))[tl]; }
    }
}

__device__ __forceinline__ void p4_attn_naive(const Params& P, unsigned char* lds, int blk, int nblk, int wv) {
    const int tid = my_tid(wv), wid = __builtin_amdgcn_readfirstlane(tid >> 6), lane = tid & 63;
    int* keys = (int*)lds; float* qf = (float*)(lds + 1024); float* pf = (float*)(lds + 1024 + 4096) + wid * 256; int* nselp = (int*)(lds + 1024 + 4096 + 8192);
    h16* QA = (h16*)(P.ws + WS_R1); const h16* Kb = (const h16*)(P.ws + WS_R2); const h16* Vb = (const h16*)(P.ws + WS_R3); const h16* SG = (const h16*)(P.ws + WS_R4);
    const unsigned long long* MASK = (const unsigned long long*)(P.ws + WS_MASK);
    for (int t = blk; t < T; t += nblk) {
        const int b = t >> 11;
        __syncthreads();
        if (tid < 128) { const h16x8 qv = *(const h16x8*)(QA + (size_t)t * 1024 + tid * 8);
#pragma unroll
            for (int e = 0; e < 8; ++e) qf[tid * 8 + e] = (float)qv[e]; }
        if (wid == 0) {
            unsigned long long m = (lane < 32) ? MASK[(size_t)t * 32 + lane] : 0ull;
            const int cnt = __popcll(m); int inc = cnt;
#pragma unroll
            for (int o = 1; o < 64; o <<= 1) { const int v = __shfl_up(inc, o); if (lane >= o) inc += v; }
            int off = inc - cnt;
            while (m) { const int k = __builtin_ctzll(m); keys[off++] = lane * 64 + k; m &= m - 1; }
            if (lane == 63) nselp[0] = inc;
        }
        __syncthreads();
        const int nsel = nselp[0], h = wid;
        float s[4];
#pragma unroll
        for (int c = 0; c < 4; ++c) {
            const int idx = lane + 64 * c; s[c] = -INFINITY;
            if (idx < nsel) {
                const h16x8* kp = (const h16x8*)(Kb + (size_t)(b * L + keys[idx]) * 1024 + h * 128); float a = 0.f;
#pragma unroll
                for (int cc = 0; cc < 16; ++cc) { const h16x8 kv = kp[cc];
#pragma unroll
                    for (int e = 0; e < 8; ++e) a = fmaf(qf[h * 128 + cc * 8 + e], (float)kv[e], a); }
                s[c] = a;
            }
        }
        const float mx = wave_max(fmaxf(fmaxf(s[0], s[1]), fmaxf(s[2], s[3])));
        float ls = 0.f;
#pragma unroll
        for (int c = 0; c < 4; ++c) { const int idx = lane + 64 * c; const float p = (idx < nsel) ? exp2f(s[c] - mx) : 0.f; pf[idx] = p; ls += p; }
        ls = wave_sum(ls);
        LDS_FENCE();
        float o0 = 0.f, o1 = 0.f;
        for (int k = 0; k < nsel; ++k) {
            const h16x2 v = *(const h16x2*)(Vb + (size_t)(b * L + keys[k]) * 1024 + h * 128 + 2 * lane); const float pk = pf[k];
            o0 = fmaf(pk, (float)v[0], o0); o1 = fmaf(pk, (float)v[1], o1);
        }
        const float inv = 1.0f / ls;
        const h16x2 g = *(const h16x2*)(SG + (size_t)t * 1024 + h * 128 + 2 * lane);
        h16x2 o; o[0] = (h16)(o0 * inv * (float)g[0]); o[1] = (h16)(o1 * inv * (float)g[1]);
        *(h16x2*)(QA + (size_t)t * 1024 + h * 128 + 2 * lane) = o;
    }
}


namespace att {
typedef unsigned short bf16;
typedef short bf16x8 __attribute__((ext_vector_type(8)));
typedef short s16x4 __attribute__((ext_vector_type(4)));
typedef float f32x16 __attribute__((ext_vector_type(16)));
typedef __attribute__((address_space(3))) char lchar;
typedef __attribute__((address_space(3))) float lfloat;
typedef __attribute__((address_space(3))) bf16x8 lbf16x8;
constexpr int D = 128, PITCH = 1024, NW = 8, QBLK = 32, KVBLK = 64, QB = NW * QBLK;
constexpr int SHM_V = KVBLK * D * 2, SHM_K = KVBLK * D * 2;
constexpr int LDS_ATT = 2 * SHM_V + 2 * SHM_K + NW * 64 * 4;
constexpr float THR = 8.f;
#define KSWZ(row, colB) ((row) * 256 + ((colB) ^ (((row) & 7) << 4)))
#define SBAR() __builtin_amdgcn_sched_barrier(0)
__device__ __forceinline__ int v_st(int k, int c) { const int kk = (k & ~0xC) | ((k & 4) << 1) | ((k & 8) >> 1); return ((kk >> 3) * 4 + (c >> 5)) * 512 + ((kk & 7) * 32 + (c & 31)) * 2; }
__device__ __forceinline__ int v_rd_base(int lane) { return ((lane & 3) << 3) | (((lane >> 2) & 3) << 6) | (((lane >> 4) & 1) << 5) | (((lane >> 5) & 1) << 8); }
constexpr int v_rd_off(int d0, int ks, int half) { return d0 * 512 + ks * 4096 + half * 2048; }
__device__ __forceinline__ int crow(int r, int hi) { return (r & 3) + 8 * (r >> 2) + 4 * hi; }
__device__ __forceinline__ bf16x8 load8(const bf16* p) { return *reinterpret_cast<const bf16x8*>(p); }
__device__ __forceinline__ void mask_init(f32x16& p0, f32x16& p1, unsigned long long mk, int hi) {
    const unsigned lo = (unsigned)mk >> (4 * hi), hh = (unsigned)(mk >> 32) >> (4 * hi);
#pragma unroll
    for (int r = 0; r < 16; ++r) {
        const int c = (r & 3) + 8 * (r >> 2);
        const int t0 = __builtin_amdgcn_sbfe(lo, c, 1), t1 = __builtin_amdgcn_sbfe(hh, c, 1);
        p0[r] = __uint_as_float(~(unsigned)t0 & 0xff800000u); p1[r] = __uint_as_float(~(unsigned)t1 & 0xff800000u);
    }
}
__device__ __forceinline__ void partialSM(f32x16& p0, f32x16& p1, float& m_reg, float& mn, float& alpha) {
    float pmax = p0[0]; for (int r = 1; r < 16; ++r) pmax = fmaxf(pmax, p0[r]); for (int r = 0; r < 16; ++r) pmax = fmaxf(pmax, p1[r]);
    { auto rr = __builtin_amdgcn_permlane32_swap(__float_as_uint(pmax), __float_as_uint(pmax), false, false);
      pmax = fmaxf(__uint_as_float(rr[0]), __uint_as_float(rr[1])); }
    if (__builtin_expect(__all((pmax - m_reg) <= THR), 1)) { mn = m_reg; alpha = 1.f; }
    else { mn = fmaxf(m_reg, pmax); alpha = __builtin_amdgcn_exp2f(m_reg - mn); m_reg = mn; }
    for (int r = 0; r < 16; ++r) p0[r] = p0[r] - mn; for (int r = 0; r < 16; ++r) p1[r] = p1[r] - mn;
    for (int r = 0; r < 16; ++r) p0[r] = __builtin_amdgcn_exp2f(p0[r]);
}
__device__ __forceinline__ void finishSM(f32x16& p0, f32x16& p1, float alpha, float& l_reg, bf16x8& pa0, bf16x8& pa1, bf16x8& pa2, bf16x8& pa3) {
    for (int r = 0; r < 16; ++r) p1[r] = __builtin_amdgcn_exp2f(p1[r]);
    float ps = 0; for (int r = 0; r < 16; ++r) ps += p0[r]; for (int r = 0; r < 16; ++r) ps += p1[r];
    { auto rr = __builtin_amdgcn_permlane32_swap(__float_as_uint(ps), __float_as_uint(ps), false, false);
      ps = __uint_as_float(rr[0]) + __uint_as_float(rr[1]); }
    l_reg = l_reg * alpha + ps;
#define PK4(P, B_, OUT) do { unsigned a0 = cvtpk_bf16(P[B_+0], P[B_+1]), a1 = cvtpk_bf16(P[B_+2], P[B_+3]);                          \
        unsigned b0 = cvtpk_bf16(P[B_+4], P[B_+5]), b1 = cvtpk_bf16(P[B_+6], P[B_+7]);                                             \
        auto r0 = __builtin_amdgcn_permlane32_swap(a0, b0, false, false); auto r1 = __builtin_amdgcn_permlane32_swap(a1, b1, false, false); \
        u32x4 w = {r0[0], r1[0], r0[1], r1[1]}; OUT = *reinterpret_cast<bf16x8*>(&w); } while (0)
    PK4(p0, 0, pa0); PK4(p0, 8, pa1); PK4(p1, 0, pa2); PK4(p1, 8, pa3);
#undef PK4
}
template <int KB>
__device__ __forceinline__ void qkt(f32x16& p0, f32x16& p1, const lchar* K_lds, int r32, int hi, const bf16x8* qr) {
    const lchar* kb[4];
#pragma unroll
    for (int dd = 0; dd < 4; ++dd) kb[dd] = K_lds + KB * SHM_K + KSWZ(r32, (dd * 16 + hi * 8) * 2);
#pragma unroll
    for (int d0 = 0; d0 < 8; ++d0) { const lchar* a = kb[d0 & 3] + (d0 >> 2) * 128;
        bf16x8 b0 = *(const lbf16x8*)(a);
        bf16x8 b1 = *(const lbf16x8*)(a + 32 * 256);
        p0 = __builtin_amdgcn_mfma_f32_32x32x16_bf16(b0, qr[d0], p0, 0, 0, 0);
        p1 = __builtin_amdgcn_mfma_f32_32x32x16_bf16(b1, qr[d0], p1, 0, 0, 0); }
}
template <int VB>
__device__ __forceinline__ void pv_tile(f32x16* o, int vb0, bf16x8 pa0, bf16x8 pa1, bf16x8 pa2, bf16x8 pa3) {
#define TRRD(dst, off) asm volatile("ds_read_b64_tr_b16 %0, %1 offset:%2" : "=&v"(dst) : "v"(vb0), "i"(off) : "memory")
#define PV_D0(d0) do { s16x4 l0, l1, l2, l3, h0, h1, h2, h3; constexpr int b_ = VB * SHM_V + v_rd_off(d0, 0, 0); \
        TRRD(l0, b_); TRRD(h0, b_ + 2048); TRRD(l1, b_ + 4096); TRRD(h1, b_ + 6144); TRRD(l2, b_ + 8192); TRRD(h2, b_ + 10240); TRRD(l3, b_ + 12288); TRRD(h3, b_ + 14336); \
        asm volatile("s_waitcnt lgkmcnt(0)" ::: "memory"); SBAR();   \
        o[d0] = __builtin_amdgcn_mfma_f32_32x32x16_bf16(pa0, (bf16x8){l0[0], l0[1], l0[2], l0[3], h0[0], h0[1], h0[2], h0[3]}, o[d0], 0, 0, 0);   \
        o[d0] = __builtin_amdgcn_mfma_f32_32x32x16_bf16(pa1, (bf16x8){l1[0], l1[1], l1[2], l1[3], h1[0], h1[1], h1[2], h1[3]}, o[d0], 0, 0, 0);   \
        o[d0] = __builtin_amdgcn_mfma_f32_32x32x16_bf16(pa2, (bf16x8){l2[0], l2[1], l2[2], l2[3], h2[0], h2[1], h2[2], h2[3]}, o[d0], 0, 0, 0);   \
        o[d0] = __builtin_amdgcn_mfma_f32_32x32x16_bf16(pa3, (bf16x8){l3[0], l3[1], l3[2], l3[3], h3[0], h3[1], h3[2], h3[3]}, o[d0], 0, 0, 0); } while (0)
    PV_D0(0); PV_D0(1); PV_D0(2); PV_D0(3);
#undef PV_D0
#undef TRRD
}
struct BlockRef { const bf16* Q; const bf16* K; const bf16* V; h16* O; const unsigned long long* M; const h16* G; int P0; };
struct Seam { bf16x8 qr[8]; bf16x8 st_v0, st_v1, st_k0, st_k1; };
#define VMW() asm volatile("s_waitcnt vmcnt(0)" ::: "memory")
#define VMWN(n) asm volatile("s_waitcnt vmcnt(%0)" :: "i"(n) : "memory")
#define SLOAD_H(Kp, Vp, k0) do { const unsigned o0_ = ro0 + (unsigned)(k0) * PITCH, o1_ = o0_ + 32u * PITCH;     \
                         S.st_v0 = load8((Vp) + o0_); S.st_v1 = load8((Vp) + o1_); S.st_k0 = load8((Kp) + o0_); S.st_k1 = load8((Kp) + o1_); } while (0)
#define SWRITE_HK(bf) do { *(lbf16x8*)(K_lds + (bf) * SHM_K + kws) = S.st_k0; *(lbf16x8*)(K_lds + (bf) * SHM_K + kws + 32 * 256) = S.st_k1; } while (0)
#define SWRITE_HV(bf) do { *(lbf16x8*)(V_lds + (bf) * SHM_V + vst0) = S.st_v0; *(lbf16x8*)(V_lds + (bf) * SHM_V + vst1) = S.st_v1; } while (0)
#define SWRITE_H(bf) do { SWRITE_HV(bf); SWRITE_HK(bf); } while (0)
__device__ __forceinline__ void prime(const BlockRef& cur, lchar* lds, Seam& S, int wv) {
    const int tid = my_tid(wv);
    const int wid = __builtin_amdgcn_readfirstlane(tid >> 6), lane = tid & 63, r32 = lane & 31, hi = lane >> 5;
    const int sr = tid >> 4, sc = (tid & 15) * 8, kws = KSWZ(sr, sc * 2); lchar* K_lds = lds + 2 * SHM_V;
    const unsigned ro0 = (unsigned)(sr * PITCH + sc), qo = (unsigned)((wid * QBLK + r32) * PITCH + hi * 8);
    for (int d0 = 0; d0 < 8; ++d0) S.qr[d0] = load8(cur.Q + (qo + (unsigned)(d0 * 16)));
    SLOAD_H(cur.K, cur.V, 0); VMW(); SWRITE_HK(0);
    __syncthreads();
}
__device__ __forceinline__ void block(const BlockRef& cur, const BlockRef& nxt, lchar* lds, Seam& S, int wv) {
    const int tid = my_tid(wv);
    const int wid = __builtin_amdgcn_readfirstlane(tid >> 6), lane = tid & 63, r32 = lane & 31, hi = lane >> 5;
    const int NT = (cur.P0 + QB - 1) / KVBLK + 1;
    lchar* V_lds = lds; lchar* K_lds = lds + 2 * SHM_V;
    lfloat* ws = (lfloat*)(lds + 2 * SHM_V + 2 * SHM_K) + wid * 64; lfloat* li_l = ws, * al_l = ws + 32;
    float m_reg = -1e30f, l_reg = 0; f32x16 o[4] = {};
    const int sr = tid >> 4, sc = (tid & 15) * 8, vst0 = v_st(sr, sc), vst1 = v_st(32 + sr, sc), kws = KSWZ(sr, sc * 2);
    const int vb0 = (int)(unsigned)(uintptr_t)V_lds + v_rd_base(lane);
    const unsigned ro0 = (unsigned)(sr * PITCH + sc), qo = (unsigned)((wid * QBLK + r32) * PITCH + hi * 8);
    const bf16* Kh = cur.K; const bf16* Vh = cur.V;
    const unsigned mro = (unsigned)(wid * QBLK + r32) * 8u;
#define LDMASK(tile) (*(const unsigned long long*)((const char*)cur.M + (mro + (unsigned)(tile) * (unsigned)(L * 8))))
    unsigned long long mk;
#define RESC(a) do { if (__any((a) < 1.f)) { if (hi == 0) al_l[r32] = (a); asm volatile("s_waitcnt lgkmcnt(0)" ::: "memory");              \
                     for (int d_ = 0; d_ < 4; ++d_) for (int r = 0; r < 16; ++r) o[d_][r] *= al_l[crow(r, hi)]; } } while (0)
#define KBASE(t) ((t) * KVBLK)
    constexpr int NQL = 8;
#define SEAM_K0() do { VMWN(NQL); SWRITE_HK(0); SBAR(); } while (0)
    f32x16 pA0, pA1, pB0, pB1; float mnA, mnB, alA, alB; bf16x8 pa0, pa1, pa2, pa3;
    SWRITE_HV(0); SBAR();
    mk = LDMASK(0);
    if (NT > 1) { SLOAD_H(Kh, Vh, KBASE(1)); }
    mask_init(pA0, pA1, mk, hi); if (NT > 1) mk = LDMASK(1);
    SBAR(); qkt<0>(pA0, pA1, K_lds, r32, hi, S.qr);
    partialSM(pA0, pA1, m_reg, mnA, alA);
    if (NT > 1) { VMW(); SWRITE_H(1); }
    __syncthreads();
#define HALF_STEP(PX0, PX1, mnX, alX, PY0, PY1, alY, t, KB, VB, SB) do {                                                      \
        mask_init(PX0, PX1, mk, hi);                                       \
        SBAR(); qkt<KB>(PX0, PX1, K_lds, r32, hi, S.qr);                                                                      \
        if ((t) + 1 < NT) mk = LDMASK((t) + 1);                                                              \
        finishSM(PY0, PY1, alY, l_reg, pa0, pa1, pa2, pa3); SBAR();                                                           \
        if ((t) + 1 < NT) { SLOAD_H(Kh, Vh, KBASE((t) + 1)); SBAR(); }                                                        \
        pv_tile<VB>(o, vb0, pa0, pa1, pa2, pa3); partialSM(PX0, PX1, m_reg, mnX, alX);                                        \
        __syncthreads();                                                                                                      \
        if ((t) + 1 < NT) { VMW(); SWRITE_H(SB); }                                                                            \
        RESC(alX); __syncthreads(); } while (0)
    for (int t = 1; t + 1 < NT; t += 2) {
        HALF_STEP(pB0, pB1, mnB, alB, pA0, pA1, alA, t, 1, 0, 0);
        HALF_STEP(pA0, pA1, mnA, alA, pB0, pB1, alB, t + 1, 0, 1, 1);
    }
    const bool even = (NT & 1) == 0;
    if (even) { mask_init(pB0, pB1, mk, hi); SBAR(); qkt<1>(pB0, pB1, K_lds, r32, hi, S.qr); SBAR(); }
    SLOAD_H(nxt.K, nxt.V, 0); SBAR();
#pragma unroll
    for (int d0 = 0; d0 < 8; ++d0) S.qr[d0] = load8(nxt.Q + (qo + (unsigned)(d0 * 16)));
    SBAR();
    finishSM(pA0, pA1, alA, l_reg, pa0, pa1, pa2, pa3); SBAR();
    pv_tile<0>(o, vb0, pa0, pa1, pa2, pa3);
    if (even) { partialSM(pB0, pB1, m_reg, mnB, alB); __syncthreads(); RESC(alB);
        finishSM(pB0, pB1, alB, l_reg, pa0, pa1, pa2, pa3); SBAR(); pv_tile<1>(o, vb0, pa0, pa1, pa2, pa3); }
    SBAR(); SEAM_K0();
    if (hi == 0) li_l[r32] = l_reg; asm volatile("s_waitcnt lgkmcnt(0)" ::: "memory");
    float rli[16];
#pragma unroll
    for (int r = 0; r < 16; ++r) rli[r] = __builtin_amdgcn_rcpf(li_l[crow(r, hi)]);
    __syncthreads();
    {
        typedef __attribute__((address_space(3))) h16 lh16; typedef __attribute__((address_space(3))) h16x8 lh16x8_;
        lchar* ob = V_lds + wid * 4096;
#pragma unroll
        for (int half = 0; half < 2; ++half) {
#pragma unroll
            for (int r = 0; r < 16; ++r) { const int orow = crow(r, hi);
#pragma unroll
                for (int dd = 0; dd < 2; ++dd) *(lh16*)(ob + orow * 128 + (dd * 32 + r32) * 2) = (h16)(o[half * 2 + dd][r] * rli[r]); }
            asm volatile("s_waitcnt lgkmcnt(0)" ::: "memory");
#pragma unroll
            for (int i = 0; i < 4; ++i) { const int c = lane + 64 * i, row = c >> 3, c8 = c & 7;
                const h16x8 ov = *(const lh16x8_*)(ob + row * 128 + c8 * 16);
                const unsigned oo = (unsigned)((wid * QBLK + row) * PITCH + half * 64 + c8 * 8);
                const h16x8 gv = *(const h16x8*)(cur.G + oo);
                *(h16x8*)(cur.O + oo) = ov * gv; }
            asm volatile("s_waitcnt lgkmcnt(0)" ::: "memory");
        }
    }
    __syncthreads();
#undef LDMASK
#undef RESC
#undef KBASE
#undef SEAM_K0
#undef HALF_STEP
}
#undef VMW
#undef VMWN
#undef SLOAD_H
#undef SWRITE_HK
#undef SWRITE_HV
#undef SWRITE_H
#undef KSWZ
#undef SBAR
}

__device__ __forceinline__ att::BlockRef att_ref(const Params& P, unsigned char* ws, int item, int pass) {
    const int xcd = item & 7, kq = item >> 3, bh = (kq >> 2) * 8 + xcd, x = kq & 3, qb = pass ? 7 - x : x, b = bh >> 3, h = bh & 7;
    const size_t row0 = (size_t)b * L + (size_t)qb * 256;
    att::BlockRef r;
    r.Q = (const att::bf16*)(ws + WS_R1) + row0 * 1024 + h * 128; r.O = (h16*)(ws + WS_AO) + row0 * 1024 + h * 128;
    r.K = (const att::bf16*)(ws + WS_R2) + (size_t)b * L * 1024 + h * 128; r.V = (const att::bf16*)(ws + WS_R3) + (size_t)b * L * 1024 + h * 128;
    r.M = (const unsigned long long*)(ws + WS_MASK) + (size_t)b * 32 * L + (size_t)qb * 256;
    r.G = (const h16*)(ws + WS_R4) + row0 * 1024 + h * 128; r.P0 = qb * 256;
    return r;
}
__device__ __forceinline__ void p4_attn(const Params& P, unsigned char* lds, int blk, int nblk, int wv) {
    unsigned char* ws = opaque_ptr(P.ws);
    const int total = NB * 8 * 4;
    int it = blk; if (it >= total) return;
    int pass = 0;
    att::BlockRef cur = att_ref(P, ws, it, 0);
    att::Seam S;
    att::prime(cur, (att::lchar*)lds, S, wv);
    for (;;) {
        const bool more_pass = pass == 0, more_item = it + nblk < total, last = !more_pass && !more_item;
        int itn = it, passn = pass + 1;
        if (!more_pass) { passn = 0; itn = more_item ? it + nblk : it; }
        const att::BlockRef nxt = last ? cur : att_ref(P, ws, itn, passn);
        att::block(cur, nxt, (att::lchar*)lds, S, wv);
        if (last) break;
        cur = nxt; it = itn; pass = passn;
    }
}

__device__ __forceinline__ void p8_ret_naive(const Params& P, unsigned char* lds, int blk, int nblk, int wv) {
    const int tid = my_tid(wv);
    float* qk = (float*)lds;
    const h16* RQ = (const h16*)(P.ws + WS_R1); const h16* RK = (const h16*)(P.ws + WS_R2); h16* RV = (h16*)(P.ws + WS_R4);
    const int j = tid >> 2, iq = tid & 3;
    for (int it = blk; it < 256; it += nblk) {
        const int b = it >> 4, h = (it >> 2) & 3, sl = it & 3;
        const float gamma = 1.0f - exp2f(-5.0f - (float)h);
        float S[64];
#pragma unroll
        for (int i = 0; i < 64; ++i) S[i] = 0.f;
        const int col = tid & 255;
        const h16* src = (tid < 256 ? RQ : RK) + (size_t)b * L * 1024 + h * 256 + col;
        float* dst = qk + (tid >> 8) * 272 + (col >> 6) * 68 + (col & 63);
        h16* vp = RV + (size_t)b * L * 2048 + h * 512 + sl * 128 + j;
        for (int t0 = 0; t0 < L; t0 += 16) {
            __syncthreads();
            h16 vv[16];
#pragma unroll
            for (int tt = 0; tt < 16; ++tt) { dst[tt * 544] = (float)src[(size_t)(t0 + tt) * 1024]; vv[tt] = vp[(size_t)(t0 + tt) * 2048]; }
            __syncthreads();
#pragma unroll
            for (int tt = 0; tt < 16; ++tt) {
                const f32x4* qp = (const f32x4*)(qk + tt * 544 + iq * 68); const f32x4* kp = (const f32x4*)(qk + tt * 544 + 272 + iq * 68);
                const float v = (float)vv[tt]; float o = 0.f;
#pragma unroll
                for (int i4 = 0; i4 < 16; ++i4) { const f32x4 q4 = qp[i4], k4 = kp[i4];
#pragma unroll
                    for (int e = 0; e < 4; ++e) { S[i4 * 4 + e] = fmaf(gamma, S[i4 * 4 + e], k4[e] * v); o = fmaf(q4[e], S[i4 * 4 + e], o); } }
                o += __shfl_xor(o, 1); o += __shfl_xor(o, 2);
                if (iq == 0) vp[(size_t)(t0 + tt) * 2048] = (h16)o;
            }
        }
    }
}


namespace ret {
typedef __attribute__((address_space(3))) unsigned char lch;
typedef __attribute__((address_space(3))) h16x8 lh16x8;
typedef __attribute__((address_space(3))) h16x4 lh16x4;
typedef __attribute__((address_space(3))) u32x4 lu32x4;
typedef short v4i16 __attribute__((ext_vector_type(4)));
typedef __attribute__((address_space(3))) v4i16 lv4i16;
constexpr int SKB = 544, SVB = 288, SSB = 544;
constexpr int OFF_K = 0, OFF_V = 64 * SKB, OFF_S = OFF_V + 64 * SVB, LDS_RET = OFF_S + 128 * SSB;
__device__ __forceinline__ h16x4 trrd(const lch* p) { return __builtin_bit_cast(h16x4, __builtin_amdgcn_ds_read_tr16_b64_v4i16((lv4i16*)p)); }
__device__ __forceinline__ h16x8 cat8(h16x4 a, h16x4 b) { return __builtin_shufflevector(a, b, 0, 1, 2, 3, 4, 5, 6, 7); }
}
#define P8_GATE(m_, ro_) do { const char* gp_ = (const char*)(RG + ((size_t)b * L + (size_t)(m_) * 64) * 2048 + h * 512 + sl * 128) + (ro_); gt0 = *(const h16x8*)gp_; gt1 = *(const h16x8*)(gp_ + 16); } while (0)
#define P8_XSLD(m_, rw_) do { _Pragma("unroll") for (int s_ = 0; s_ < 4; ++s_) xsv[s_] = __hip_atomic_load((const unsigned long long*)((const char*)(XS + (size_t)(grp0 + (m_)) * 256) + (unsigned)(s_ * 512 + (rw_) * 8)), __ATOMIC_RELAXED, __HIP_MEMORY_SCOPE_AGENT); } while (0)
#define P8_XSOK() (((unsigned)xsv[0] != 0xffffffffu) && ((unsigned)xsv[1] != 0xffffffffu) && ((unsigned)xsv[2] != 0xffffffffu) && ((unsigned)xsv[3] != 0xffffffffu))
#define P8_WAIT(m_, rw_) do { unsigned sp_ = 0u; while (!__all(P8_XSOK())) { __builtin_amdgcn_s_sleep(1); P8_XSLD(m_, rw_); \
        if (++sp_ > (1u << 20)) { if (lane == 0) __hip_atomic_store((unsigned*)(ws + WS_BAR) + XB_TMO_W, 1u, __ATOMIC_RELAXED, __HIP_MEMORY_SCOPE_AGENT); break; } } } while (0)
#define P8_STATS(m_) do { P8_WAIT(m_, lO0); float S1_ = 0.f, S2_ = 0.f;   \
        _Pragma("unroll") for (int s_ = 0; s_ < 4; ++s_) { S1_ += __uint_as_float((unsigned)xsv[s_]); S2_ += __uint_as_float((unsigned)(xsv[s_] >> 32)); } \
        const float mu_ = S1_ * (1.0f / 512.0f); const float var_ = fmaxf(S2_ * (1.0f / 512.0f) - mu_ * mu_, 0.f); const float rs_ = rsqrtf(var_ + EPS); MR[lO0] = (f32x2){rs_, -mu_ * rs_}; } while (0)
#define P8_FINAL(m_, rw_, ro_, lo_) do { const int mm_ = (m_); const f32x2 mr_ = MR[rw_]; const float rs_ = mr_[0], nb_ = mr_[1]; \
        const lch* op_ = OT + (mm_ & 1) * OT_BYTES + (lo_); const h16x8 o0_ = *(const lh16x8*)op_, o1_ = *(const lh16x8*)(op_ + 16); h16x8 y0_, y1_; \
        _Pragma("unroll") for (int e = 0; e < 8; ++e) { y0_[e] = (h16)(fmaf((float)o0_[e], rs_, nb_) * (float)gt0[e]); y1_[e] = (h16)(fmaf((float)o1_[e], rs_, nb_) * (float)gt1[e]); } \
        char* dp_ = (char*)(vg + (size_t)mm_ * 64 * 2048) + (ro_); *(h16x8*)dp_ = y0_; *(h16x8*)(dp_ + 16) = y1_; } while (0)
#define XB_TMO_W 128
__device__ __forceinline__ void p8_retention(const Params& P, unsigned char* lds_, int blk, int nblk, int wv) {
    using namespace ret;
    const int tid = my_tid(wv), wid = __builtin_amdgcn_readfirstlane(tid >> 6), lane = tid & 63, c16 = lane & 15, g = lane >> 4, q4 = c16 >> 2, p4 = c16 & 3;
    const int it = wid & 3, dh = wid >> 2;
    unsigned char* ws = opaque_ptr(P.ws);
    lch* Kc = (lch*)lds_ + OFF_K; lch* Vc = (lch*)lds_ + OFF_V; lch* St = (lch*)lds_ + OFF_S;
    const h16* RQ = (const h16*)(ws + WS_R1); const h16* RK = (const h16*)(ws + WS_R2); h16* RV = (h16*)(ws + WS_R4);
    const bool fusedgn = (nblk == 256);
    const h16* RG = (const h16*)(ws + WS_RG);
    unsigned long long* XS = (unsigned long long*)(ws + WS_KIDXN);
    typedef __attribute__((address_space(3))) f32x2 lf32x2;
    lf32x2* PS = (lf32x2*)((lch*)lds_ + LDS_RET);
    for (int item = blk; item < 256; item += nblk) {
        const int b = item >> 4, h = (item >> 2) & 3, sl = item & 3;
        const int grp0 = (b * 4 + h) * 32;
        constexpr int OT_PITCH = 272, OT_BYTES = 64 * OT_PITCH;
        lch* OT = (lch*)lds_ + LDS_RET + 1024;
        lf32x2* MR = (lf32x2*)(OT + 2 * OT_BYTES);
        h16x8 gt0 = (h16x8){0, 0, 0, 0, 0, 0, 0, 0}, gt1 = gt0;
        const float lgam = log2f(1.0f - exp2f(-5.0f - (float)h));
        const float gamma64 = exp2f(64.0f * lgam);
        f32x4 state[16];
#pragma unroll
        for (int d = 0; d < 16; ++d) state[d] = (f32x4){0.f, 0.f, 0.f, 0.f};
        __syncthreads();
        { unsigned zz = 0u; asm volatile("" : "+v"(zz));
          for (int i = tid; i < 128 * SSB / 16; i += NTHREADS) ((lu32x4*)St)[i] = (u32x4){zz, zz, zz, zz}; }
        const h16* kg = RK + (size_t)b * L * 1024 + h * 256; const h16* vg = RV + (size_t)b * L * 2048 + h * 512 + sl * 128;
        h16x8 kreg[4], vreg[2];
        const unsigned qoff = (unsigned)((16 * it + c16) * 1024 + 8 * g) * 2u, ooff = (unsigned)((16 * it + c16) * 2048 + 64 * dh + 4 * g) * 2u;
        unsigned ko[4], vo[2];
#pragma unroll
        for (int i = 0; i < 4; ++i) { const int c = tid + NTHREADS * i; ko[i] = (unsigned)((c >> 5) * 1024 + (c & 31) * 8) * 2u; }
#pragma unroll
        for (int i = 0; i < 2; ++i) { const int c = tid + NTHREADS * i; vo[i] = (unsigned)((c >> 4) * 2048 + (c & 15) * 8) * 2u; }
#pragma unroll
        for (int i = 0; i < 4; ++i) kreg[i] = *(const h16x8*)((const char*)kg + ko[i]);
#pragma unroll
        for (int i = 0; i < 2; ++i) vreg[i] = *(const h16x8*)((const char*)vg + vo[i]);
#pragma unroll
        for (int i = 0; i < 4; ++i) { const int c = tid + NTHREADS * i; *(lh16x8*)(Kc + (c >> 5) * SKB + (c & 31) * 16) = kreg[i]; }
#pragma unroll
        for (int i = 0; i < 2; ++i) { const int c = tid + NTHREADS * i; *(lh16x8*)(Vc + (c >> 4) * SVB + (c & 15) * 16) = vreg[i]; }
        h16x8 Qn[8];
#pragma unroll
        for (int s = 0; s < 8; ++s) Qn[s] = *(const h16x8*)((const char*)(RQ + (size_t)b * L * 1024 + h * 256) + (qoff + (unsigned)(64 * s)));
        __syncthreads();
        for (int n = 0; n < L / 64; ++n) {
            const size_t row0 = (size_t)b * L + (size_t)n * 64;
            const int nn = (n + 1 < L / 64) ? n + 1 : n;
            unsigned kO[4] = {ko[0], ko[1], ko[2], ko[3]}, vO[2] = {vo[0], vo[1]}, qO = qoff, oO = ooff;
            asm volatile("" : "+v"(kO[0]), "+v"(kO[1]), "+v"(kO[2]), "+v"(kO[3]), "+v"(vO[0]), "+v"(vO[1]), "+v"(qO), "+v"(oO));
            int gO = g, cO = c16; asm volatile("" : "+v"(gO), "+v"(cO)); const int q4O = cO >> 2, p4O = cO & 3;
            float lg = lgam; asm volatile("" : "+v"(lg));
            const float xi = __builtin_amdgcn_exp2f((float)(16 * it + cO + 1) * lg);
            h16x8 Qf[8];
#pragma unroll
            for (int s = 0; s < 8; ++s) Qf[s] = Qn[s];
            unsigned long long xsv[4] = {0ull, 0ull, 0ull, 0ull};
            const int tF_ = my_tid(wv); const unsigned rowF = (unsigned)(tF_ >> 3), roF = rowF * 4096u + (unsigned)(tF_ & 7) * 32u, loF = rowF * (unsigned)OT_PITCH + (unsigned)(tF_ & 7) * 32u;
            if (fusedgn && n > 0) { P8_GATE(n - 1, roF); }
#pragma unroll
            for (int i = 0; i < 4; ++i) kreg[i] = *(const h16x8*)((const char*)(kg + (size_t)nn * 64 * 1024) + kO[i]);
#pragma unroll
            for (int i = 0; i < 2; ++i) vreg[i] = *(const h16x8*)((const char*)(vg + (size_t)nn * 64 * 2048) + vO[i]);
            h16x8 Pf[2];
#pragma unroll
            for (int ks = 0; ks < 2; ++ks)
#pragma unroll
                for (int e = 0; e < 8; ++e) Pf[ks][e] = (h16)0.f;
#pragma unroll
            for (int jt = 0; jt < 4; ++jt) {
                if (jt <= it) {
                    f32x4 S = (f32x4){0.f, 0.f, 0.f, 0.f}, Sb = S;
#pragma unroll
                    for (int s4 = 0; s4 < 8; s4 += 4) {
                        h16x8 A4[4];
#pragma unroll
                        for (int s = 0; s < 4; ++s) A4[s] = *(const lh16x8*)(Kc + (16 * jt + c16) * SKB + (32 * (s4 + s) + 8 * g) * 2);
                        __builtin_amdgcn_sched_barrier(0);
#pragma unroll
                        for (int s = 0; s < 4; s += 2) { S = __builtin_amdgcn_mfma_f32_16x16x32_f16(A4[s], Qf[s4 + s], S, 0, 0, 0); Sb = __builtin_amdgcn_mfma_f32_16x16x32_f16(A4[s + 1], Qf[s4 + s + 1], Sb, 0, 0, 0); }
                        __builtin_amdgcn_sched_barrier(0);
                    }
                    S = S + Sb;
#pragma unroll
                    for (int e = 0; e < 4; ++e) { const int d = (16 * it + cO) - (16 * jt + 4 * gO + e); const float f = (d >= 0) ? __builtin_amdgcn_exp2f((float)d * lg) : 0.f; Pf[jt >> 1][(jt & 1) * 4 + e] = (h16)(S[e] * f); }
                }
            }
            int lO0 = lane; asm volatile("" : "+v"(lO0));
            if (fusedgn && n > 0 && wid == 0) { P8_XSLD(n - 1, lO0); }
            f32x4 acc[4];
#pragma unroll
            for (int dt = 0; dt < 4; ++dt) acc[dt] = (f32x4){0.f, 0.f, 0.f, 0.f};
#pragma unroll
            for (int s2 = 0; s2 < 8; ++s2) {
                h16x8 A4[4];
#pragma unroll
                for (int dt = 0; dt < 4; ++dt) A4[dt] = *(const lh16x8*)(St + (16 * (4 * dh + dt) + c16) * SSB + (32 * s2 + 8 * g) * 2);
                __builtin_amdgcn_sched_barrier(0);
#pragma unroll
                for (int dt = 0; dt < 4; ++dt) acc[dt] = __builtin_amdgcn_mfma_f32_16x16x32_f16(A4[dt], Qf[s2], acc[dt], 0, 0, 0);
                __builtin_amdgcn_sched_barrier(0);
            }
#pragma unroll
            for (int dt = 0; dt < 4; ++dt) acc[dt] = acc[dt] * xi;
#pragma unroll
            for (int ks = 0; ks < 2; ++ks) {
                if (2 * ks <= it) {
                    h16x8 A4[4];
#pragma unroll
                    for (int dt = 0; dt < 4; ++dt) { const lch* vp = Vc + (32 * ks + 4 * gO + q4O) * SVB + (16 * (4 * dh + dt) + 4 * p4O) * 2; A4[dt] = cat8(trrd(vp), trrd(vp + 16 * SVB)); }
                    __builtin_amdgcn_sched_barrier(0);
#pragma unroll
                    for (int dt = 0; dt < 4; ++dt) acc[dt] = __builtin_amdgcn_mfma_f32_16x16x32_f16(A4[dt], Pf[ks], acc[dt], 0, 0, 0);
                    __builtin_amdgcn_sched_barrier(0);
                }
            }
            if (!fusedgn) {
#pragma unroll
                for (int dt = 0; dt < 4; ++dt) *(h16x4*)((char*)(vg + (size_t)n * 64 * 2048) + (oO + (unsigned)(32 * dt))) = pack4(acc[dt]);
            } else {
                float s1 = 0.f, s2 = 0.f;
#pragma unroll
                for (int dt = 0; dt < 4; ++dt)
#pragma unroll
                    for (int e = 0; e < 4; ++e) { s1 += acc[dt][e]; s2 = fmaf(acc[dt][e], acc[dt][e], s2); }
                s1 = fq_sum(s1); s2 = fq_sum(s2);
                const int tk = (int)(oO >> 12);
                if ((oO & 24u) == 0u) PS[dh * 64 + tk] = (f32x2){s1, s2};
                { lch* wp_ = OT + (n & 1) * OT_BYTES + (unsigned)tk * (unsigned)OT_PITCH + (oO & 4095u);
#pragma unroll
                  for (int dt = 0; dt < 4; ++dt) *(lh16x4*)(wp_ + 32 * dt) = pack4(acc[dt]); }
            }
#pragma unroll
            for (int s = 0; s < 8; ++s) Qn[s] = *(const h16x8*)((const char*)(RQ + ((size_t)b * L + (size_t)nn * 64) * 1024 + h * 256) + (qO + (unsigned)(64 * s)));
            h16x8 Bv[2];
#pragma unroll
            for (int ks = 0; ks < 2; ++ks) { const lch* vp = Vc + (32 * ks + 8 * gO + q4O) * SVB + (16 * wid + 4 * p4O) * 2; h16x8 zf;
#pragma unroll
                for (int e = 0; e < 8; ++e) zf[e] = (h16)__builtin_amdgcn_exp2f((float)(63 - (32 * ks + 8 * gO + e)) * lg);
                Bv[ks] = cat8(trrd(vp), trrd(vp + 4 * SVB)) * zf; }
#pragma unroll
            for (int d4 = 0; d4 < 16; d4 += 2) {
                h16x8 A4[4];
#pragma unroll
                for (int j = 0; j < 2; ++j)
#pragma unroll
                    for (int ks = 0; ks < 2; ++ks) { const lch* kp = Kc + (32 * ks + 8 * gO + q4O) * SKB + (16 * (d4 + j) + 4 * p4O) * 2; A4[j * 2 + ks] = cat8(trrd(kp), trrd(kp + 4 * SKB)); }
#pragma unroll
                for (int j = 0; j < 2; ++j) state[d4 + j] = state[d4 + j] * gamma64;
                __builtin_amdgcn_sched_barrier(0);
#pragma unroll
                for (int ks = 0; ks < 2; ++ks)
#pragma unroll
                    for (int j = 0; j < 2; ++j) state[d4 + j] = __builtin_amdgcn_mfma_f32_16x16x32_f16(A4[j * 2 + ks], Bv[ks], state[d4 + j], 0, 0, 0);
                __builtin_amdgcn_sched_barrier(0);
            }
            if (fusedgn && n > 0 && wid == 0) { P8_STATS(n - 1); }
            __syncthreads();
            if (fusedgn && n > 0) { P8_FINAL(n - 1, rowF, roF, loF); }
            if (fusedgn && wid == 0) {
                int lO = lane; asm volatile("" : "+v"(lO));
                const f32x2 pa = PS[lO], pb = PS[64 + lO];
                const unsigned long long pk = (unsigned long long)__float_as_uint(pa[0] + pb[0]) | ((unsigned long long)__float_as_uint(pa[1] + pb[1]) << 32);
                __hip_atomic_store((unsigned long long*)((char*)(XS + ((size_t)(grp0 + n) * 4 + sl) * 64) + (unsigned)(lO * 8)), pk, __ATOMIC_RELAXED, __HIP_MEMORY_SCOPE_AGENT);
            }
#pragma unroll
            for (int dkt = 0; dkt < 16; ++dkt) *(lh16x4*)(St + (16 * wid + c16) * SSB + (16 * dkt + 4 * g) * 2) = pack4(state[dkt]);
#pragma unroll
            for (int i = 0; i < 4; ++i) { const int c = tid + NTHREADS * i; *(lh16x8*)(Kc + (c >> 5) * SKB + (c & 31) * 16) = kreg[i]; }
#pragma unroll
            for (int i = 0; i < 2; ++i) { const int c = tid + NTHREADS * i; *(lh16x8*)(Vc + (c >> 4) * SVB + (c & 15) * 16) = vreg[i]; }
            __syncthreads();
        }
        if (fusedgn) {
            const int tF_ = my_tid(wv); const unsigned rowF = (unsigned)(tF_ >> 3), roF = rowF * 4096u + (unsigned)(tF_ & 7) * 32u, loF = rowF * (unsigned)OT_PITCH + (unsigned)(tF_ & 7) * 32u;
            unsigned long long xsv[4] = {0ull, 0ull, 0ull, 0ull}; int lO0 = lane; asm volatile("" : "+v"(lO0)); P8_GATE(L / 64 - 1, roF);
            if (wid == 0) { P8_XSLD(L / 64 - 1, lO0); P8_STATS(L / 64 - 1); }
            __syncthreads();
            P8_FINAL(L / 64 - 1, rowF, roF, loF);
        }
    }
#undef P8_FINAL
#undef P8_STATS
#undef P8_XSLD
#undef P8_GATE
#undef P8_WAIT
#undef P8_XSOK
}

__device__ __forceinline__ void p9_gnorm(const Params& P, int blk, int nblk, int wv) {
    const int tid = my_tid(wv), wid = tid >> 6, lane = tid & 63;
    unsigned char* ws = opaque_ptr(P.ws);
    h16* RO = (h16*)(ws + WS_R4); const h16* RG = (const h16*)(ws + WS_RG);
    const int gw = blk * NWAVES + wid, ngw = nblk * NWAVES;
    for (int t0 = gw; t0 < T; t0 += 2 * ngw) {
        h16x8 xv[2][4], gv[2][4];
#pragma unroll
        for (int k = 0; k < 2; ++k) { const int t = (t0 + k * ngw < T) ? t0 + k * ngw : t0;
#pragma unroll
            for (int h = 0; h < 4; ++h) { const size_t o = (size_t)t * 2048 + h * 512 + lane * 8; xv[k][h] = *(const h16x8*)(RO + o); gv[k][h] = *(const h16x8*)(RG + o); } }
#pragma unroll
        for (int k = 0; k < 2; ++k) { const int t = t0 + k * ngw;
#pragma unroll
            for (int h = 0; h < 4; ++h) {
                float v[8]; float s = 0.f;
#pragma unroll
                for (int e = 0; e < 8; ++e) { v[e] = (float)xv[k][h][e]; s += v[e]; }
                const float mu = wave_sum_dpp(s) * (1.0f / 512.0f); float q = 0.f;
#pragma unroll
                for (int e = 0; e < 8; ++e) { v[e] -= mu; q += v[e] * v[e]; }
                const float rstd = rsqrtf(wave_sum_dpp(q) * (1.0f / 512.0f) + EPS);
                h16x8 y;
#pragma unroll
                for (int e = 0; e < 8; ++e) y[e] = (h16)(v[e] * rstd * (float)gv[k][h][e]);
                if (t < T) *(h16x8*)(RO + (size_t)t * 2048 + h * 512 + lane * 8) = y;
            } }
    }
}

__device__ __forceinline__ void p12_final(const Params& P, int blk, int nblk, int wv) {
    const int tid = my_tid(wv), wid = tid >> 6, lane = tid & 63;
    unsigned char* ws = opaque_ptr(P.ws);
    const float* sq = (const float*)(ws + WS_SQH) + (size_t)3 * T * 16; const f32x4* g4 = (const f32x4*)P.in[18]; const h16* H4 = (const h16*)(ws + WS_R1);
    const int gw = blk * NWAVES + wid, ngw = nblk * NWAVES;
    for (int r0 = gw; r0 < T; r0 += 4 * ngw) {
        h16x8 hv[4][2]; f32x4 qv[4][4];
#pragma unroll
        for (int k = 0; k < 4; ++k) { const int r = r0 + k * ngw; if (r < T) {
#pragma unroll
            for (int j = 0; j < 2; ++j) hv[k][j] = *(const h16x8*)(H4 + (size_t)r * 1024 + (lane + 64 * j) * 8);
#pragma unroll
            for (int j = 0; j < 4; ++j) qv[k][j] = ((const f32x4*)(sq + (size_t)r * 16))[j]; } }
#pragma unroll
        for (int k = 0; k < 4; ++k) { const int r = r0 + k * ngw; if (r < T) {
            float s = 0.f;
#pragma unroll
            for (int j = 0; j < 4; ++j) s += (qv[k][j][0] + qv[k][j][1]) + (qv[k][j][2] + qv[k][j][3]);
            const float rstd = rsqrtf(s * (1.0f / 1024.0f) + EPS);
            f32x4* orow = (f32x4*)(P.out + (size_t)r * 1024);
#pragma unroll
            for (int j = 0; j < 2; ++j) { const int c4 = (lane + 64 * j) * 2; const f32x4 ga = g4[c4], gb = g4[c4 + 1]; f32x4 a, b2;
#pragma unroll
                for (int e = 0; e < 4; ++e) { a[e] = (float)hv[k][j][e] * rstd * ga[e]; b2[e] = (float)hv[k][j][4 + e] * rstd * gb[e]; }
                orow[c4] = a; orow[c4 + 1] = b2; } } }
    }
}

#define XB_TMO      128
#define XB_XCNT(j)  (256  + 64 * (j))
#define XB_XSUB(j)  (1280 + 64 * (j))
#define XB_XGEN(j)  (2304 + 64 * (j))
#define XB_TOP      3328
#define XB_TOPGEN   3392
#define XCD_BAR_WORDS 3456
#define XB_SPIN_CAP (1u << 18)
__device__ __forceinline__ unsigned xb_ld(unsigned* p)              { return __hip_atomic_load(p, __ATOMIC_RELAXED, __HIP_MEMORY_SCOPE_AGENT); }
__device__ __forceinline__ unsigned xb_add(unsigned* p, unsigned v) { return __hip_atomic_fetch_add(p, v, __ATOMIC_RELAXED, __HIP_MEMORY_SCOPE_AGENT); }
__device__ __forceinline__ unsigned xb_xcc_id() { return (unsigned)__builtin_amdgcn_s_getreg((3 << 11) | 20) & 0xFu; }
#define XB_SPIN(cond, bar) do { unsigned _sp = 0; while (cond) { __builtin_amdgcn_s_sleep(1); \
    if ((++_sp & 255u) == 0u) { if (xb_ld(&(bar)[XB_TMO])) break; if (_sp > XB_SPIN_CAP) { atomicAdd(&(bar)[XB_TMO], 1u); break; } } } } while (0)
typedef volatile __attribute__((address_space(3))) unsigned lvu32;
__device__ __forceinline__ void xcd_barrier_complete(unsigned* bar, unsigned x, unsigned G, unsigned& nloc, unsigned& nx) {
    unsigned sum, cnt, mine, sp = 0u;
    for (;;) {
        sum = 0u; cnt = 0u; mine = 0u;
#pragma unroll
        for (unsigned j = 0; j < 16; ++j) { const unsigned c = xb_ld(&bar[XB_XCNT(j)]); sum += c; cnt += (c > 0u) ? 1u : 0u; mine = (j == x) ? c : mine; }
        if (sum == G) break;
        __builtin_amdgcn_s_sleep(1);
        if ((++sp & 255u) == 0u) { if (xb_ld(&bar[XB_TMO])) break; if (sp > XB_SPIN_CAP) { atomicAdd(&bar[XB_TMO], 1u); break; } }
    }
    nloc = mine > 0u ? mine : 1u; nx = cnt > 0u ? cnt : 1u;
}
__device__ __forceinline__ void xcd_barrier(unsigned* bar_, unsigned x_, lvu32* st, unsigned G, int wv) {
    unsigned x = x_; asm volatile("" : "+s"(x));
    unsigned* bar = opaque_ptr(bar_);
    asm volatile("s_waitcnt vmcnt(0)" ::: "memory");
    __syncthreads();
    if (my_tid(wv) == 0) {
        __builtin_amdgcn_s_waitcnt(0);
        unsigned nloc = st[0], nx = st[1];
        if (nloc == 0u) { xcd_barrier_complete(bar, x, G, nloc, nx); st[0] = nloc; st[1] = nx; }
        const unsigned old = xb_add(&bar[XB_XSUB(x)], 1u);
        const unsigned gen = old / nloc;
        if (old + 1u == (gen + 1u) * nloc) {
            __builtin_amdgcn_fence(__ATOMIC_RELEASE, "agent");
            asm volatile("s_waitcnt vmcnt(0)" ::: "memory");
            const unsigned og = xb_add(&bar[XB_TOP], 1u);
            const unsigned tg = og / nx;
            if (og + 1u == (tg + 1u) * nx) xb_add(&bar[XB_TOPGEN], 1u);
            else XB_SPIN(xb_ld(&bar[XB_TOPGEN]) == tg, bar);
            __builtin_amdgcn_fence(__ATOMIC_ACQUIRE, "agent");
            xb_add(&bar[XB_XGEN(x)], 1u);
            asm volatile("s_waitcnt vmcnt(0)" ::: "memory");
        } else {
            XB_SPIN(xb_ld(&bar[XB_XGEN(x)]) == gen, bar);
            __builtin_amdgcn_fence(__ATOMIC_ACQUIRE, "agent");
            asm volatile("s_waitcnt vmcnt(0)" ::: "memory");
        }
    }
    __syncthreads();
}

__device__ __forceinline__ void run_gemm_job(const Params& P, unsigned char* lds, int ph, int j, int blk, int nblk, int wv) {
    unsigned char* ws = opaque_ptr(P.ws);
    float* SQKV = (float*)(ws + WS_SQKV); float* SQQ = (float*)(ws + WS_SQQ); float* SQH = (float*)(ws + WS_SQH);
    int kind = 0; Gemm g; g.M = T; g.A = nullptr; g.Bt = nullptr; g.lda = g.ldb = g.N = g.K = 0;
    h16 *h0 = nullptr, *h1 = nullptr; const h16* ch0 = nullptr; const h16* ch1 = nullptr; const float* cf0 = nullptr; float* f0 = nullptr; float* f1 = nullptr; int i0 = 0, i1 = 0, i2 = 0, i3 = 0, i4 = 0; float x0 = 0.f;
    if (ph == 1) { kind = 0; g.A = (const h16*)(ws + WS_R1); g.Bt = (const h16*)(ws + WS_WAIN); g.lda = 1024; g.ldb = 1024; g.N = 1792; g.K = 1024; }
    else if (ph == 2) {
        kind = 1;
        if (j == 0) { g.A = (const h16*)(ws + WS_CQX); g.Bt = (const h16*)(ws + WS_WQ); g.lda = 512; g.ldb = 384; g.N = 1536; g.K = 384;
                      cf0 = SQQ; i0 = 8; x0 = 1.0f / 384.0f; h0 = (h16*)(ws + WS_R1); h1 = (h16*)(ws + WS_QIDX); i1 = 1024; i2 = 512; i3 = 1; i4 = 0; }
        else if (j == 1) { g.A = (const h16*)(ws + WS_CKV); g.Bt = (const h16*)(ws + WS_WKV); g.lda = 256; g.ldb = 256; g.N = 2048; g.K = 256;
                      cf0 = SQKV; i0 = 4; x0 = 1.0f / 256.0f; h0 = (h16*)(ws + WS_R2); h1 = (h16*)(ws + WS_R3); i1 = 1024; i2 = 1024; i3 = 1; i4 = 1; }
        else { g.A = (const h16*)(ws + WS_PH0); g.Bt = (const h16*)(ws + WS_WPLE); g.lda = 256; g.ldb = 256; g.N = 1024; g.K = 256;
                      cf0 = nullptr; i0 = 0; x0 = 0.f; h0 = (h16*)(ws + WS_R5); h1 = nullptr; i1 = 1024; i2 = 1024; }
    }
    else if (ph == 5) { kind = 2; g.A = (const h16*)(ws + WS_AO); g.Bt = (const h16*)(ws + WS_WAOUT); g.lda = 1024; g.ldb = 1024; g.N = 1024; g.K = 1024;
                      cf0 = P.in[0]; ch0 = nullptr; h0 = (h16*)(ws + WS_R2); f1 = SQH; }
    else if (ph == 6) { kind = 3; g.A = (const h16*)(ws + WS_R2); g.Bt = (const h16*)(ws + WS_WPG); g.lda = 1024; g.ldb = 1024; g.N = 1024; g.K = 1024;
                      ch1 = (const h16*)(ws + WS_R2); ch0 = (const h16*)(ws + WS_R5); h0 = (h16*)(ws + WS_R3); cf0 = SQH; f1 = SQH + (size_t)T * 16; }
    else if (ph == 7) { kind = 4; g.A = (const h16*)(ws + WS_R3); g.Bt = (const h16*)(ws + WS_WRIN); g.lda = 1024; g.ldb = 1024; g.N = 6144; g.K = 1024; }
    else if (ph == 10) {
        if (j == 0) { kind = 2; g.A = (const h16*)(ws + WS_R4); g.Bt = (const h16*)(ws + WS_WROUT); g.lda = 2048; g.ldb = 2048; g.N = 1024; g.K = 2048;
                      cf0 = nullptr; ch0 = (const h16*)(ws + WS_R3); h0 = (h16*)(ws + WS_R2); f1 = SQH + (size_t)2 * T * 16; }
        else { kind = 1; g.A = (const h16*)(ws + WS_PH1); g.Bt = (const h16*)(ws + WS_WPLE) + (size_t)1024 * 256; g.lda = 256; g.ldb = 256; g.N = 1024; g.K = 256;
                      cf0 = nullptr; i0 = 0; x0 = 0.f; h0 = (h16*)(ws + WS_R1); h1 = nullptr; i1 = 1024; i2 = 1024; }
    }
    else { kind = 5; g.A = (const h16*)(ws + WS_R2); g.Bt = (const h16*)(ws + WS_WPG) + (size_t)1024 * 1024; g.lda = 1024; g.ldb = 1024; g.N = 1024; g.K = 1024;
                      ch1 = (const h16*)(ws + WS_R2); ch0 = (const h16*)(ws + WS_R1); h0 = (h16*)(ws + WS_R1); cf0 = SQH + (size_t)2 * T * 16; f1 = SQH + (size_t)3 * T * 16; }
    switch (kind) {
        case 0: { EpiInA E{(h16*)(ws + WS_CKV), (h16*)(ws + WS_CQX), (h16*)(ws + WS_R4), SQKV, SQQ, nullptr, 0, 0.f}; gemm_run(lds, g, E, blk, nblk, wv); break; }
        case 1: { EpiScale E{cf0, i0, x0, h0, h1, 4, i1, i2, i3, i4}; gemm_run(lds, g, E, blk, nblk, wv); break; }
        case 2: { EpiRes E{cf0, ch0, h0, f1, nullptr, 0, 0.f}; gemm_run(lds, g, E, blk, nblk, wv); break; }
        case 3: { EpiPle E{ch1, ch0, h0, cf0, f1, 16, 1.0f / 1024.0f}; gemm_run(lds, g, E, blk, nblk, wv); break; }
        case 5: { EpiPleFinal E{ch1, ch0, cf0, 16, 1.0f / 1024.0f, P.in[18], P.out, (unsigned*)(SQH + (size_t)3 * T * 16), (unsigned*)(ws + WS_BAR + 16384), (unsigned*)(ws + WS_BAR) + XB_TMO}; gemm_run(lds, g, E, blk, nblk, wv); break; }
        default: { EpiInR E{SQH + (size_t)T * 16, (const f32x2*)(ws + WS_SINCOS), (h16*)(ws + WS_R1), (h16*)(ws + WS_R2), (h16*)(ws + WS_R4), (h16*)(ws + WS_RG), 16, 1.0f / 1024.0f}; gemm_run(lds, g, E, blk, nblk, wv); break; }
    }
}

__global__ void __launch_bounds__(NTHREADS, 2) mk_fwd(Params P_) {
    extern __shared__ __attribute__((aligned(16))) unsigned char lds[];
    cg::grid_group grid = cg::this_grid();
    const int wv = __builtin_amdgcn_readfirstlane((int)(threadIdx.x >> 6));
    lvu32* bst = (lvu32*)(lds + LDS_BYTES - 16);
    unsigned* bar = (unsigned*)(P_.ws + WS_BAR);
    const unsigned xcc = xb_xcc_id();
    if (threadIdx.x == 0) { bst[0] = 0u; bst[1] = 0u; if (P_.ph_hi - P_.ph_lo > 1) (void)xb_add(&bar[XB_XCNT(xcc)], 1u); }
    __syncthreads();
    int dup_cnt = 0; (void)dup_cnt;
    const int blk_k = blockIdx.x, nblk_k = gridDim.x; const int ph_lo = P_.ph_lo, ph_hi = P_.ph_hi;
    for (int ph = ph_lo; ph < ph_hi; ++ph) {
        int blk = blk_k, nblk = nblk_k; asm volatile("" : "+s"(blk), "+s"(nblk));
        const Params& P = P_;
        if (ph == 0) p0_prologue(P, lds, blk, nblk, wv);
        else if (ph == 3) p3_indexer(P, lds, blk, nblk, wv);
        else if (ph == 4) p4_attn(P, lds, blk, nblk, wv);
        else if (ph == 8) p8_retention(P, lds, blk, nblk, wv);
        else if (ph == 9) { if (nblk != 256) p9_gnorm(P, blk, nblk, wv); }
        else {
            if (ph == 2) p2_kidx(P, blk, nblk, wv);
            if (ph == 5) {
                unsigned ones = ~0u; asm volatile("" : "+v"(ones)); u32x4* xs_ = (u32x4*)(opaque_ptr(P.ws) + WS_KIDXN);
                for (int i = blk * NTHREADS + my_tid(wv); i < (4 << 20) / 16; i += nblk * NTHREADS) xs_[i] = (u32x4){ones, ones, ones, ones};
            }
            const int nj = (ph == 2) ? 3 : (ph == 10) ? 2 : 1;
            for (int j = 0; j < nj; ++j) run_gemm_job(P, lds, ph, j, blk, nblk, wv);
        }
        if (ph + 1 < ph_hi && !(ph == 8 && nblk == 256)) { if (ph_hi < 0) grid.sync(); else xcd_barrier(bar, xcc, bst, (unsigned)nblk, wv); }
#if MK_DUP_MASK
        if (((MK_DUP_MASK >> ph) & 1) && dup_cnt < MK_DUP_N) { ++dup_cnt; --ph; } else dup_cnt = 0;
#endif
    }
}

#ifndef MK_FUSED
#define MK_FUSED 1
#endif
extern "C" void kernel_launch(void* const* d_in, const int* in_sizes, int n_in, void* d_out, int out_size, void* d_ws, size_t ws_size, hipStream_t stream) {
    static int grid = 0;
    if (grid == 0) {
        if (n_in != 19 || out_size != T * D || ws_size < WS_END) { fprintf(stderr, "kernel_launch: unexpected shapes (n_in %d, out %d, ws %zu)\n", n_in, out_size, ws_size); grid = -1; return; }
        int dev = 0, cus = 0, per_cu = 0;
        hipGetDevice(&dev);
        hipDeviceGetAttribute(&cus, hipDeviceAttributeMultiprocessorCount, dev);
        if (hipFuncSetAttribute((const void*)mk_fwd, hipFuncAttributeMaxDynamicSharedMemorySize, LDS_BYTES) != hipSuccess) { fprintf(stderr, "kernel_launch: hipFuncSetAttribute failed\n"); grid = -1; return; }
        hipOccupancyMaxActiveBlocksPerMultiprocessor(&per_cu, (const void*)mk_fwd, NTHREADS, LDS_BYTES);
        if (per_cu < 1) { fprintf(stderr, "kernel_launch: occupancy query says %d blocks per CU\n", per_cu); grid = -1; return; }
        grid = cus * 1;
    }
    if (grid < 0) return;
    (void)hipMemsetAsync((char*)d_ws + WS_BAR, 0, 16384 + 32768, stream);
    Params P{};
    for (int i = 0; i < 19; ++i) P.in[i] = (const float*)d_in[i];
    P.out = (float*)d_out; P.ws = (unsigned char*)d_ws;
#if MK_FUSED
    P.ph_lo = 0; P.ph_hi = NPH;
    void* args[] = {&P};
    hipError_t e = hipLaunchCooperativeKernel((const void*)mk_fwd, dim3(grid), dim3(NTHREADS), args, LDS_BYTES, stream);
    if (e != hipSuccess) fprintf(stderr, "cooperative launch failed: %s (grid %d)\n", hipGetErrorString(e), grid);
#else
    for (int ph = 0; ph < NPH; ++ph) {
        P.ph_lo = ph; P.ph_hi = ph + 1;
        hipLaunchKernelGGL(mk_fwd, dim3(grid), dim3(NTHREADS), LDS_BYTES, stream, P);
    }
#endif
}
```

```cpp
#include <hip/hip_runtime.h>
#include <hip/hip_cooperative_groups.h>
#include <cstdio>
#include <cstdint>
namespace cg = cooperative_groups;
#ifndef MK_DUP_MASK
#define MK_DUP_MASK 0
#endif
#ifndef MK_P3_REPA
#define MK_P3_REPA 0
#endif
#ifndef MK_P3_REPB
#define MK_P3_REPB 0
#endif
#ifndef MK_EPI_REP
#define MK_EPI_REP 0
#endif
#ifndef MK_DUP_N
#define MK_DUP_N 3
#endif

typedef _Float16 h16;
typedef _Float16 h16x2 __attribute__((ext_vector_type(2)));
typedef _Float16 h16x4 __attribute__((ext_vector_type(4)));
typedef _Float16 h16x8 __attribute__((ext_vector_type(8)));
typedef float f32x2 __attribute__((ext_vector_type(2)));
typedef float f32x4 __attribute__((ext_vector_type(4)));
typedef unsigned u32x4 __attribute__((ext_vector_type(4)));

constexpr int NB = 16, L = 2048, T = NB * L, D = 1024;
constexpr float EPS = 1e-6f;
constexpr int NPH = 12;
constexpr int NTHREADS = 512, NWAVES = 8;
constexpr int LDS_BYTES = 163840;

constexpr size_t MiB = (size_t)1 << 20;
constexpr size_t WS_WAIN = 0 * MiB;
constexpr size_t WS_WQ = 4 * MiB;
constexpr size_t WS_WKV = 6 * MiB;
constexpr size_t WS_WAOUT = 7 * MiB;
constexpr size_t WS_WPG = 9 * MiB;
constexpr size_t WS_WPLE = 13 * MiB;
constexpr size_t WS_WRIN = 14 * MiB;
constexpr size_t WS_WROUT = 26 * MiB;
constexpr size_t WS_SINCOS = 30 * MiB;
constexpr size_t WS_SQKV = 32 * MiB;
constexpr size_t WS_SQQ = 33 * MiB;
constexpr size_t WS_SQH = 34 * MiB;
constexpr size_t WS_KIDXN = 42 * MiB;
constexpr size_t WS_WIDX = 46 * MiB;
constexpr size_t WS_BAR = 47 * MiB;
constexpr size_t WS_PH1 = 48 * MiB;
constexpr size_t WS_R1 = 64 * MiB;
constexpr size_t WS_R2 = 128 * MiB;
constexpr size_t WS_R3 = 192 * MiB;
constexpr size_t WS_R4 = 256 * MiB;
constexpr size_t WS_R5 = 320 * MiB;
constexpr size_t WS_PH0 = 384 * MiB;
constexpr size_t WS_CQX = 400 * MiB;
constexpr size_t WS_CKV = 432 * MiB;
constexpr size_t WS_QIDX = 448 * MiB;
constexpr size_t WS_MASK = 480 * MiB;
constexpr size_t WS_AO = 400 * MiB;
constexpr size_t WS_RG = 384 * MiB;
constexpr size_t WS_END = 512 * MiB;

struct Params { const float* in[19]; float* out; unsigned char* ws; int ph_lo, ph_hi; };

__constant__ float kAngle[128] = {
    1.000000000e+00f, 9.300450087e-01f, 8.649836779e-01f, 8.044736385e-01f, 7.481966019e-01f, 6.958565116e-01f, 6.471778154e-01f, 6.019044518e-01f,
    5.597981811e-01f, 5.206375122e-01f, 4.842162728e-01f, 4.503428936e-01f, 4.188391268e-01f, 3.895392120e-01f, 3.622889817e-01f, 3.369450271e-01f,
    3.133740425e-01f, 2.914519310e-01f, 2.710633874e-01f, 2.521011233e-01f, 2.344653904e-01f, 2.180633694e-01f, 2.028087080e-01f, 1.886212230e-01f,
    1.754262149e-01f, 1.631542742e-01f, 1.517407894e-01f, 1.411257535e-01f, 1.312533021e-01f, 1.220714748e-01f, 1.135319397e-01f, 1.055898219e-01f,
    9.820328653e-02f, 9.133346379e-02f, 8.494423330e-02f, 7.900195569e-02f, 7.347535342e-02f, 6.833537668e-02f, 6.355497986e-02f, 5.910899118e-02f,
    5.497401953e-02f, 5.112830922e-02f, 4.755162448e-02f, 4.422515258e-02f, 4.113136977e-02f, 3.825402260e-02f, 3.557796404e-02f, 3.308910504e-02f,
    3.077435680e-02f, 2.862153389e-02f, 2.661931701e-02f, 2.475716174e-02f, 2.302526683e-02f, 2.141453326e-02f, 1.991648041e-02f, 1.852322184e-02f,
    1.722742990e-02f, 1.602228358e-02f, 1.490144618e-02f, 1.385901403e-02f, 1.288950257e-02f, 1.198781747e-02f, 1.114920899e-02f, 1.036926545e-02f,
    9.643883444e-03f, 8.969245479e-03f, 8.341802284e-03f, 7.758250926e-03f, 7.215522230e-03f, 6.710760761e-03f, 6.241309457e-03f, 5.804697983e-03f,
    5.398627371e-03f, 5.020966288e-03f, 4.669724498e-03f, 4.343053792e-03f, 4.039235413e-03f, 3.756670747e-03f, 3.493872471e-03f, 3.249458736e-03f,
    3.022142686e-03f, 2.810728736e-03f, 2.614103956e-03f, 2.431234345e-03f, 2.261157380e-03f, 2.102978062e-03f, 1.955864020e-03f, 1.819041790e-03f,
    1.691789716e-03f, 1.573440502e-03f, 1.463370281e-03f, 1.361000235e-03f, 1.265791478e-03f, 1.177242957e-03f, 1.094888896e-03f, 1.018295996e-03f,
    9.470609948e-04f, 8.808093844e-04f, 8.191923262e-04f, 7.618857198e-04f, 7.085879333e-04f, 6.590186385e-04f, 6.129170069e-04f, 5.700403708e-04f,
    5.301629426e-04f, 4.930753494e-04f, 4.585822753e-04f, 4.265021416e-04f, 3.966661752e-04f, 3.689173318e-04f, 3.431097430e-04f, 3.191074939e-04f,
    2.967843320e-04f, 2.760227653e-04f, 2.567135962e-04f, 2.387551940e-04f, 2.220530587e-04f, 2.065193403e-04f, 1.920722716e-04f, 1.786358480e-04f,
    1.661392889e-04f, 1.545170089e-04f, 1.437077590e-04f, 1.336546848e-04f, 1.243048755e-04f, 1.156091312e-04f, 1.075216787e-04f, 9.999999747e-05f,
};

__device__ __forceinline__ float wave_sum(float v) {
#pragma unroll
    for (int o = 1; o < 64; o <<= 1) v += __shfl_xor(v, o);
    return v;
}
__device__ __forceinline__ float wave_max(float v) {
#pragma unroll
    for (int o = 1; o < 64; o <<= 1) v = fmaxf(v, __shfl_xor(v, o));
    return v;
}
#define DPP_RED6S(v, F) do { v = F<0x111, 0xf>(v); v = F<0x112, 0xf>(v); v = F<0x114, 0xf>(v); v = F<0x118, 0xf>(v); v = F<0x142, 0xa>(v); v = F<0x143, 0xc>(v); } while (0)
template <int CTRL, int RMASK> __device__ __forceinline__ float fadd_dpp_(float a) { return a + __builtin_bit_cast(float, __builtin_amdgcn_update_dpp(0, __builtin_bit_cast(int, a), CTRL, RMASK, 0xf, false)); }
__device__ __forceinline__ float wave_sum_dpp(float v) { DPP_RED6S(v, fadd_dpp_); return __builtin_bit_cast(float, __builtin_amdgcn_readlane(__builtin_bit_cast(int, v), 63)); }
__device__ __forceinline__ float dot4(f32x4 a) { return (a[0] * a[0] + a[1] * a[1]) + (a[2] * a[2] + a[3] * a[3]); }
__device__ __forceinline__ float fq_sum(float s) {
    { auto rr = __builtin_amdgcn_permlane16_swap(__float_as_uint(s), __float_as_uint(s), false, false); s = __uint_as_float(rr[0]) + __uint_as_float(rr[1]); }
    { auto rr = __builtin_amdgcn_permlane32_swap(__float_as_uint(s), __float_as_uint(s), false, false); s = __uint_as_float(rr[0]) + __uint_as_float(rr[1]); }
    return s;
}
__device__ __forceinline__ h16x8 pack8(f32x4 a, f32x4 b) {
    h16x8 r; r[0] = (h16)a[0]; r[1] = (h16)a[1]; r[2] = (h16)a[2]; r[3] = (h16)a[3]; r[4] = (h16)b[0]; r[5] = (h16)b[1]; r[6] = (h16)b[2]; r[7] = (h16)b[3]; return r;
}
__device__ __forceinline__ h16x4 pack4(f32x4 a) { h16x4 r; r[0] = (h16)a[0]; r[1] = (h16)a[1]; r[2] = (h16)a[2]; r[3] = (h16)a[3]; return r; }
__device__ __forceinline__ float sigmoidf_(float x) { return __builtin_amdgcn_rcpf(1.0f + __builtin_amdgcn_exp2f(-1.4426950408889634f * x)); }
__device__ __forceinline__ float siluf_(float x) { return x * __builtin_amdgcn_rcpf(1.0f + __builtin_amdgcn_exp2f(-1.4426950408889634f * x)); }
#define LDS_FENCE() do { asm volatile("s_waitcnt lgkmcnt(0)" ::: "memory"); } while (0)
__device__ __forceinline__ int my_tid(int wv) { unsigned m = ~0u; asm volatile("" : "+s"(m)); int t = wv * 64 + (int)__builtin_amdgcn_mbcnt_hi(m, __builtin_amdgcn_mbcnt_lo(m, 0u)); asm volatile("" : "+v"(t)); return t; }
template <class Tp> __device__ __forceinline__ Tp* opaque_ptr(Tp* p) { size_t z = 0; asm volatile("" : "+s"(z)); return p + z; }

#define PG8_LAS __attribute__((address_space(3)))
__device__ __forceinline__ constexpr int pg8_stage_bytes() { return 131072; }
struct Unit { int pm, pn; };
struct Gemm { const h16* A; const h16* Bt; int lda, ldb, M, N, K; };
__device__ __forceinline__ int perm32(int rho) { const int n = rho >> 4, i = rho & 15; return 8 * (i >> 2) + 4 * n + (i & 3); }

template <class Epi>
__device__ __forceinline__ void gemm_simple(const Gemm g, const Epi& E, int blk, int nblk, int wv) {
    const int tid = my_tid(wv), wid = __builtin_amdgcn_readfirstlane(tid >> 6), lane = tid & 63, wr = wid >> 2, wc = wid & 3, fr = lane & 15, fq = lane >> 4;
    const int nN = g.N / 256, nU = (g.M / 256) * nN;
    for (int u = blk; u < nU; u += nblk) {
        Unit un; un.pm = u / nN; un.pn = u % nN;
        f32x4 acc[2][2][4][2];
#pragma unroll
        for (int a = 0; a < 2; ++a)
#pragma unroll
            for (int b = 0; b < 2; ++b)
#pragma unroll
                for (int m = 0; m < 4; ++m)
#pragma unroll
                    for (int n = 0; n < 2; ++n) acc[a][b][m][n] = (f32x4){0.f, 0.f, 0.f, 0.f};
        const h16* Ap = g.A + (size_t)(un.pm * 256 + wr * 64 + fr) * g.lda + fq * 8;
        const h16* Bp[2];
#pragma unroll
        for (int n = 0; n < 2; ++n) Bp[n] = g.Bt + (size_t)(un.pn * 256 + wc * 32 + (Epi::PERM ? perm32(16 * n + fr) : 16 * n + fr)) * g.ldb + fq * 8;
        for (int k0 = 0; k0 < g.K; k0 += 32) {
            h16x8 At[2][4], Bt[2][2];
#pragma unroll
            for (int ai = 0; ai < 2; ++ai)
#pragma unroll
                for (int m = 0; m < 4; ++m) At[ai][m] = *(const h16x8*)(Ap + (size_t)(ai * 128 + m * 16) * g.lda + k0);
#pragma unroll
            for (int bj = 0; bj < 2; ++bj)
#pragma unroll
                for (int n = 0; n < 2; ++n) Bt[bj][n] = *(const h16x8*)(Bp[n] + (size_t)(bj * 128) * g.ldb + k0);
#pragma unroll
            for (int ai = 0; ai < 2; ++ai)
#pragma unroll
                for (int bj = 0; bj < 2; ++bj)
#pragma unroll
                    for (int m = 0; m < 4; ++m)
#pragma unroll
                        for (int n = 0; n < 2; ++n) acc[ai][bj][m][n] = __builtin_amdgcn_mfma_f32_16x16x32_f16(Bt[bj][n], At[ai][m], acc[ai][bj][m][n], 0, 0, 0);
        }
        E(acc, un, wr, wc, fr, fq, nullptr);
    }
}

template <class E_> struct epi_fused { template <class X> static constexpr bool g(decltype(X::FUSED_FINAL)*) { return X::FUSED_FINAL; } template <class X> static constexpr bool g(...) { return false; } static constexpr bool v = g<E_>(nullptr); };
namespace pg8 {
constexpr int BM = 256, BK = 64, HALF = 128, HTB = HALF * BK * 2  , STAGE_BYTES = 8 * HTB, NXCD = 8, WGM = 8;
__host__ __device__ __forceinline__ int lds_byte(int r, int c) { const int st = (r >> 4) * 2 + (c >> 5), rr = r & 15, cc = c & 31, ob = rr * 64 + cc * 2; return st * 1024 + (ob ^ (((ob >> 9) & 1) << 5)); }
__host__ __device__ __forceinline__ void stage_rc(int b, int& R, int& C) { const int st = b / 1024, sb = b % 1024, swz = sb ^ (((sb >> 9) & 1) << 5); R = (st >> 1) * 16 + swz / 64; C = (st & 1) * 32 + (swz % 64) / 2; }
struct StaticOrder {
    int nM, nN, nwg, G, c;
    __host__ __device__ void init(int M, int N, int G_, int c_) { nM = M / BM; nN = N / BM; nwg = nM * nN; G = G_; c = c_; }
    __host__ __device__ bool next(int i, Unit& u) const {
        const long Lq = (long)i * G + c; if (Lq >= nwg) return false;
        int wgid = (int)Lq; { const int q = nwg / NXCD, r = nwg % NXCD, xcd = wgid % NXCD, off = wgid / NXCD; wgid = (xcd < r ? xcd * (q + 1) : r * (q + 1) + (xcd - r) * q) + off; }
        const int nig = WGM * nN, gid = wgid / nig, fm = gid * WGM, gsz = (nM - fm) < WGM ? (nM - fm) : WGM;
        u.pm = fm + ((wgid % nig) % gsz); u.pn = (wgid % nig) / gsz; return true;
    }
};
template <class Epi, bool ALIGN_EPI = true>
__device__ __forceinline__ void gemm_phase(PG8_LAS unsigned char* lds, const Gemm g, const StaticOrder& S, const Epi& E, int wv) {
    const int tid = my_tid(wv), wid = __builtin_amdgcn_readfirstlane(tid >> 6), lane = tid & 63, wr = wid >> 2, wc = wid & 3, fr = lane & 15, fq = lane >> 4;
    const int K = g.K, nt = K / BK;
    unsigned voffA[2], voffB[2];
#pragma unroll
    for (int i = 0; i < 2; ++i) { int R, C; stage_rc(tid * 16 + i * 8192, R, C); const int Rb = Epi::PERM ? ((R & ~31) + perm32(R & 31)) : R;
        voffA[i] = (unsigned)(R * g.lda + C) * 2u; voffB[i] = (unsigned)(Rb * g.ldb + C) * 2u; }
    const size_t kstep = (size_t)(BK * 2);
    const size_t hstepA = (size_t)HALF * g.lda * 2, hstepB = (size_t)HALF * g.ldb * 2;
    const size_t tstepA = 2 * hstepA, tstepB = 2 * hstepB;
    const unsigned ldsw = (unsigned)wid * 1024u;
    const int aoff = lds_byte(wr * 64 + fr, fq * 8), boff = lds_byte(wc * 32 + fr, fq * 8);
#define PG8_SA(b, h) (((b) * 2 + (h)) * HTB)
#define PG8_SB(b, h) ((4 + (b) * 2 + (h)) * HTB)
#define PG8_STAGE(bufoff, gbase, voff) do { _Pragma("unroll") for (int _i = 0; _i < 2; ++_i) \
        __builtin_amdgcn_global_load_lds((const unsigned*)((const char*)(gbase) + (voff)[_i]), (PG8_LAS unsigned*)(lds + (bufoff) + ldsw + _i * 8192), 16, 0, 0); } while (0)
#define PG8_LDA(dst, b, h) do { _Pragma("unroll") for (int m = 0; m < 4; ++m) _Pragma("unroll") for (int k = 0; k < 2; ++k) dst[m][k] = *(const PG8_LAS h16x8*)(lds + PG8_SA(b, h) + aoff + m * 2048 + k * 1024); } while (0)
#define PG8_LDB(dst, b, h) do { _Pragma("unroll") for (int n = 0; n < 2; ++n) _Pragma("unroll") for (int k = 0; k < 2; ++k) dst[n][k] = *(const PG8_LAS h16x8*)(lds + PG8_SB(b, h) + boff + n * 2048 + k * 1024); } while (0)
#define PG8_MMA(ai, bj, At, Bt) do { __builtin_amdgcn_s_setprio(1); _Pragma("unroll") for (int m = 0; m < 4; ++m) _Pragma("unroll") for (int n = 0; n < 2; ++n) _Pragma("unroll") for (int k = 0; k < 2; ++k) \
        acc[ai][bj][m][n] = __builtin_amdgcn_mfma_f32_16x16x32_f16(Bt[n][k], At[m][k], acc[ai][bj][m][n], 0, 0, 0); __builtin_amdgcn_s_setprio(0); } while (0)
#define PG8_WAIT_V(n) asm volatile("s_waitcnt vmcnt(" #n ")" ::: "memory")
#define PG8_WAIT_L(n) asm volatile("s_waitcnt lgkmcnt(" #n ")" ::: "memory")
#define PG8_BAR __builtin_amdgcn_s_barrier()
#define PG8_SCHED __builtin_amdgcn_sched_barrier(0)
    Unit cur, nxt; int ui = 0;
    if (!S.next(0, cur)) return;
    PG8_LAS float* rtab = (PG8_LAS float*)(lds + STAGE_BYTES);
#define PG8_FILL(U, PAR) do { const int tf_ = my_tid(wv); if (E.sqp != nullptr && tf_ < 256) { const size_t r_ = (size_t)(U).pm * 256 + tf_; float s_ = 0.f; \
        for (int j_ = 0; j_ < E.sqn; j_ += 4) { const f32x4 q_ = *(const f32x4*)(E.sqp + r_ * E.sqn + j_); s_ += (q_[0] + q_[1]) + (q_[2] + q_[3]); } \
        rtab[(PAR) * 256 + tf_] = rsqrtf(s_ * E.sqi + EPS); } } while (0)
    PG8_FILL(cur, 0);
    f32x4 acc[2][2][4][2];
#pragma unroll
    for (int a = 0; a < 2; ++a)
#pragma unroll
        for (int b = 0; b < 2; ++b)
#pragma unroll
            for (int m = 0; m < 4; ++m)
#pragma unroll
                for (int n = 0; n < 2; ++n) acc[a][b][m][n] = (f32x4){0.f, 0.f, 0.f, 0.f};
    h16x8 At[4][2], B0[2][2], B1[2][2];
    const char* cA = (const char*)g.A + (size_t)cur.pm * tstepA; const char* cB = (const char*)g.Bt + (size_t)cur.pn * tstepB;
    PG8_STAGE(PG8_SB(0, 0), cB, voffB); PG8_STAGE(PG8_SB(0, 1), cB + hstepB, voffB); PG8_STAGE(PG8_SA(0, 0), cA, voffA); PG8_STAGE(PG8_SA(0, 1), cA + hstepA, voffA);
    if (wr == 1) PG8_BAR;
    PG8_WAIT_V(2); PG8_BAR;
    PG8_STAGE(PG8_SB(1, 0), cB + kstep, voffB); PG8_STAGE(PG8_SA(1, 0), cA + kstep, voffA); PG8_STAGE(PG8_SB(1, 1), cB + hstepB + kstep, voffB);
    PG8_WAIT_V(6); PG8_BAR;
    for (;;) {
        const bool has_next = S.next(ui + 1, nxt);
        const char* nA = has_next ? (const char*)g.A + (size_t)nxt.pm * tstepA : cA; const char* nB = has_next ? (const char*)g.Bt + (size_t)nxt.pn * tstepB : cB;
        for (int t = 0; t < nt; t += 2) {
            const bool last = (t == nt - 2);
            const char* a1 = cA + (size_t)(t + 1) * kstep;
            const char* a2 = last ? nA : cA + (size_t)(t + 2) * kstep; const char* b2 = last ? nB : cB + (size_t)(t + 2) * kstep;
            const char* a3 = a2 + kstep; const char* b3 = b2 + kstep;
            PG8_LDB(B0, 0, 0); PG8_LDB(B1, 0, 1); PG8_SCHED; PG8_LDA(At, 0, 0); PG8_STAGE(PG8_SA(1, 1), a1 + hstepA, voffA);
            PG8_WAIT_V(8); PG8_WAIT_L(0); PG8_BAR; PG8_MMA(0, 0, At, B0); PG8_MMA(0, 1, At, B1); PG8_BAR; PG8_SCHED;
            PG8_LDA(At, 0, 1); PG8_STAGE(PG8_SB(0, 0), b2, voffB); PG8_STAGE(PG8_SB(0, 1), b2 + hstepB, voffB); PG8_STAGE(PG8_SA(0, 0), a2, voffA);
            PG8_WAIT_V(8); PG8_WAIT_L(0); PG8_BAR; PG8_MMA(1, 0, At, B0); PG8_MMA(1, 1, At, B1); PG8_BAR; PG8_SCHED;
            PG8_LDB(B0, 1, 0); PG8_LDB(B1, 1, 1); PG8_SCHED; PG8_LDA(At, 1, 0); PG8_STAGE(PG8_SA(0, 1), a2 + hstepA, voffA);
            PG8_WAIT_V(8); PG8_WAIT_L(0); PG8_BAR; PG8_MMA(0, 0, At, B0); PG8_MMA(0, 1, At, B1); PG8_BAR; PG8_SCHED;
            PG8_LDA(At, 1, 1); PG8_STAGE(PG8_SB(1, 0), b3, voffB); PG8_STAGE(PG8_SB(1, 1), b3 + hstepB, voffB); PG8_STAGE(PG8_SA(1, 0), a3, voffA);
            PG8_WAIT_V(8); PG8_WAIT_L(0); PG8_BAR; PG8_MMA(1, 0, At, B0); PG8_MMA(1, 1, At, B1); PG8_BAR; PG8_SCHED;
        }
        if constexpr (ALIGN_EPI) { if (wr == 0) PG8_BAR; }
        { const int te_ = my_tid(wv), le_ = te_ & 63;
          if constexpr (epi_fused<Epi>::v) E.final(acc, cur, wr, wc, le_ & 15, le_ >> 4, rtab + (ui & 1) * 256, lds, te_); else E(acc, cur, wr, wc, le_ & 15, le_ >> 4, rtab + (ui & 1) * 256); }
        if (has_next) PG8_FILL(nxt, (ui + 1) & 1);
        if (!has_next) break;
#pragma unroll
        for (int a = 0; a < 2; ++a)
#pragma unroll
            for (int b = 0; b < 2; ++b)
#pragma unroll
                for (int m = 0; m < 4; ++m)
#pragma unroll
                    for (int n = 0; n < 2; ++n) acc[a][b][m][n] = (f32x4){0.f, 0.f, 0.f, 0.f};
        cur = nxt; cA = nA; cB = nB; ++ui;
        if constexpr (ALIGN_EPI) { if (wr == 1) PG8_BAR; }
    }
    PG8_WAIT_V(0);
    if constexpr (!ALIGN_EPI) { if (wr == 0) PG8_BAR; }
    PG8_BAR;
#undef PG8_FILL
#undef PG8_SA
#undef PG8_SB
#undef PG8_STAGE
#undef PG8_LDA
#undef PG8_LDB
#undef PG8_MMA
#undef PG8_WAIT_V
#undef PG8_WAIT_L
#undef PG8_BAR
#undef PG8_SCHED
}
}
template <class Epi>
__device__ __forceinline__ void gemm_run(unsigned char* lds, const Gemm g, const Epi& E, int blk, int nblk, int wv) {
    pg8::StaticOrder S; S.init(g.M, g.N, nblk, blk);
    pg8::gemm_phase<Epi, true>((PG8_LAS unsigned char*)lds, g, S, E, wv);
}

struct EpiInA {
    static constexpr bool PERM = true;
    h16* ckv; h16* cqx; h16* sg; float* sqkv; float* sqq; const float* sqp; int sqn; float sqi;
    __device__ __forceinline__ void operator()(const f32x4 (&acc)[2][2][4][2], const Unit& u, int wr, int wc, int fr, int fq, const PG8_LAS float* rtab) const {
        asm volatile("" : "+v"(fr), "+v"(fq));
#pragma unroll
        for (int ai = 0; ai < 2; ++ai)
#pragma unroll
            for (int m = 0; m < 4; ++m) {
                const size_t r = (size_t)u.pm * 256 + ai * 128 + wr * 64 + m * 16 + fr;
                float ss = 0.f;
#pragma unroll
                for (int bj = 0; bj < 2; ++bj) {
                    const int c0 = bj * 128 + wc * 32 + 8 * fq;
                    f32x4 v0 = acc[ai][bj][m][0], v1 = acc[ai][bj][m][1];
                    if (u.pn == 0) { *(h16x8*)(ckv + r * 256 + c0) = pack8(v0, v1); ss += dot4(v0) + dot4(v1); }
                    else if (u.pn <= 2) { const int cq = (u.pn - 1) * 256 + c0; *(h16x8*)(cqx + r * 512 + cq) = pack8(v0, v1); if (cq < 384) ss += dot4(v0) + dot4(v1); }
                    else {
#pragma unroll
                        for (int e = 0; e < 4; ++e) { v0[e] = siluf_(v0[e]); v1[e] = siluf_(v1[e]); }
                        *(h16x8*)(sg + r * 1024 + (u.pn - 3) * 256 + c0) = pack8(v0, v1);
                    }
                }
                if (u.pn <= 2) {
                    ss = fq_sum(ss);
                    if (fq == 0) { if (u.pn == 0) sqkv[r * 4 + wc] = ss; else sqq[r * 8 + (u.pn - 1) * 4 + wc] = ss; }
                }
            }
    }
};
__device__ __forceinline__ unsigned cvtpk_bf16(float lo, float hi) { unsigned r; asm volatile("v_cvt_pk_bf16_f32 %0, %1, %2" : "=v"(r) : "v"(lo), "v"(hi)); return r; }
struct EpiScale {
    static constexpr bool PERM = true;
    const float* sqp; int sqn; float sqi; h16* d0; h16* d1; int split, ld0, ld1, bf0, bf1;
    __device__ __forceinline__ void operator()(const f32x4 (&acc)[2][2][4][2], const Unit& u, int wr, int wc, int fr, int fq, const PG8_LAS float* rtab) const {
        asm volatile("" : "+v"(fr), "+v"(fq));
#pragma unroll
        for (int ai = 0; ai < 2; ++ai)
#pragma unroll
            for (int m = 0; m < 4; ++m) {
                const size_t r = (size_t)u.pm * 256 + ai * 128 + wr * 64 + m * 16 + fr;
                float rs = 1.f;
                if (sqp) rs = rtab[ai * 128 + wr * 64 + m * 16 + fr];
#pragma unroll
                for (int bj = 0; bj < 2; ++bj) {
                    const int c0 = bj * 128 + wc * 32 + 8 * fq;
                    const f32x4 v0 = acc[ai][bj][m][0] * rs, v1 = acc[ai][bj][m][1] * rs;
                    const bool first = u.pn < split;
                    h16* dst = first ? d0 + r * ld0 + u.pn * 256 + c0 : d1 + r * ld1 + (u.pn - split) * 256 + c0;
                    if (first ? bf0 : bf1) { u32x4 w; w[0] = cvtpk_bf16(v0[0], v0[1]); w[1] = cvtpk_bf16(v0[2], v0[3]); w[2] = cvtpk_bf16(v1[0], v1[1]); w[3] = cvtpk_bf16(v1[2], v1[3]); *(u32x4*)dst = w; }
                    else *(h16x8*)dst = pack8(v0, v1);
                }
            }
    }
};
struct EpiRes {
    static constexpr bool PERM = true;
    const float* basef; const h16* baseh; h16* HH; float* sq; const float* sqp; int sqn; float sqi;
    __device__ __forceinline__ void operator()(const f32x4 (&acc)[2][2][4][2], const Unit& u, int wr, int wc, int fr, int fq, const PG8_LAS float* rtab) const {
        asm volatile("" : "+v"(fr), "+v"(fq));
#pragma unroll
        for (int ai = 0; ai < 2; ++ai)
#pragma unroll
            for (int m = 0; m < 4; ++m) {
                const size_t r = (size_t)u.pm * 256 + ai * 128 + wr * 64 + m * 16 + fr;
                float ss = 0.f;
#pragma unroll
                for (int bj = 0; bj < 2; ++bj) {
                    const size_t o = r * 1024 + u.pn * 256 + bj * 128 + wc * 32 + 8 * fq;
                    f32x4 h0, h1;
                    if (basef) { h0 = *(const f32x4*)(basef + o); h1 = *(const f32x4*)(basef + o + 4); }
                    else { const h16x8 b = *(const h16x8*)(baseh + o); h0 = (f32x4){(float)b[0], (float)b[1], (float)b[2], (float)b[3]}; h1 = (f32x4){(float)b[4], (float)b[5], (float)b[6], (float)b[7]}; }
                    h0 = h0 + acc[ai][bj][m][0]; h1 = h1 + acc[ai][bj][m][1];
                    *(h16x8*)(HH + o) = pack8(h0, h1); ss += dot4(h0) + dot4(h1);
                }
                ss = fq_sum(ss);
                if (fq == 0) sq[r * 16 + u.pn * 4 + wc] = ss;
            }
    }
};
struct EpiPle {
    static constexpr bool PERM = true;
    const h16* Hin; const h16* U; h16* Hout; const float* sqp; float* sqout; int sqn; float sqi;
    __device__ __forceinline__ void operator()(const f32x4 (&acc)[2][2][4][2], const Unit& u, int wr, int wc, int fr, int fq, const PG8_LAS float* rtab) const {
        asm volatile("" : "+v"(fr), "+v"(fq));
#pragma unroll
        for (int ai = 0; ai < 2; ++ai)
#pragma unroll
            for (int m = 0; m < 4; ++m) {
                const size_t r = (size_t)u.pm * 256 + ai * 128 + wr * 64 + m * 16 + fr;
                const float rs = rtab[ai * 128 + wr * 64 + m * 16 + fr];
                float ss = 0.f;
#pragma unroll
                for (int bj = 0; bj < 2; ++bj) {
                    const size_t o = r * 1024 + u.pn * 256 + bj * 128 + wc * 32 + 8 * fq;
                    const h16x8 uu = *(const h16x8*)(U + o); const h16x8 hh = *(const h16x8*)(Hin + o);
                    const f32x4 a0 = acc[ai][bj][m][0] * rs, a1 = acc[ai][bj][m][1] * rs; f32x4 h0, h1;
#pragma unroll
                    for (int e = 0; e < 4; ++e) { h0[e] = (float)hh[e] + (float)uu[e] * sigmoidf_(a0[e]); h1[e] = (float)hh[4 + e] + (float)uu[4 + e] * sigmoidf_(a1[e]); }
                    *(h16x8*)(Hout + o) = pack8(h0, h1); ss += dot4(h0) + dot4(h1);
                }
                ss = fq_sum(ss);
                if (fq == 0) sqout[r * 16 + u.pn * 4 + wc] = ss;
            }
    }
};
struct EpiPleFinal {
    static constexpr bool PERM = true, FUSED_FINAL = true;
    const h16* Hin; const h16* U; const float* sqp; int sqn; float sqi; const float* gfin; float* out; unsigned* xslot; unsigned* pcnt; unsigned* tmo;
    __device__ __forceinline__ void final(f32x4 (&acc)[2][2][4][2], const Unit& u, int wr, int wc, int fr, int fq, const PG8_LAS float* rtab, PG8_LAS unsigned char* lds, int tid) const {
        PG8_LAS float* Pt = (PG8_LAS float*)(lds + pg8_stage_bytes() + 2048);
        PG8_LAS float* St = Pt + 1024;
        const int wid = tid >> 6, lane = tid & 63;
        asm volatile("" : "+v"(fr), "+v"(fq));
#pragma unroll
        for (int ai = 0; ai < 2; ++ai)
#pragma unroll
            for (int m = 0; m < 4; ++m) {
                const int rl = ai * 128 + wr * 64 + m * 16 + fr; const size_t r = (size_t)u.pm * 256 + rl;
                const float rs = rtab[rl]; float ss = 0.f;
#pragma unroll
                for (int bj = 0; bj < 2; ++bj) {
                    const size_t o = r * 1024 + u.pn * 256 + bj * 128 + wc * 32 + 8 * fq;
                    const h16x8 uu = *(const h16x8*)(U + o); const h16x8 hh = *(const h16x8*)(Hin + o);
                    const f32x4 a0 = acc[ai][bj][m][0] * rs, a1 = acc[ai][bj][m][1] * rs; f32x4 h0, h1;
#pragma unroll
                    for (int e = 0; e < 4; ++e) { h0[e] = (float)hh[e] + (float)uu[e] * sigmoidf_(a0[e]); h1[e] = (float)hh[4 + e] + (float)uu[4 + e] * sigmoidf_(a1[e]); }
                    acc[ai][bj][m][0] = h0; acc[ai][bj][m][1] = h1; ss += dot4(h0) + dot4(h1);
                }
                ss = fq_sum(ss);
                if (fq == 0) Pt[rl * 4 + wc] = ss;
                asm volatile("" : "+v"(acc[ai][0][m][0]), "+v"(acc[ai][0][m][1]), "+v"(acc[ai][1][m][0]), "+v"(acc[ai][1][m][1]) :: "memory");
            }
        asm volatile("s_waitcnt lgkmcnt(0)" ::: "memory"); __builtin_amdgcn_s_barrier(); asm volatile("" ::: "memory");
        if (tid < 256) {
            const f32x4 p = *(const PG8_LAS f32x4*)(Pt + tid * 4);
            __hip_atomic_store(xslot + ((size_t)u.pm * 256 + tid) * 4 + u.pn, __float_as_uint((p[0] + p[1]) + (p[2] + p[3])), __ATOMIC_RELAXED, __HIP_MEMORY_SCOPE_AGENT);
            asm volatile("s_waitcnt vmcnt(0)" ::: "memory");
            if (lane == 0) __hip_atomic_fetch_add(pcnt + 64 * u.pm, 1u, __ATOMIC_RELAXED, __HIP_MEMORY_SCOPE_AGENT);
        }
        if (wid == 0) {
            unsigned sp = 0u;
            while (__hip_atomic_load(pcnt + 64 * u.pm, __ATOMIC_RELAXED, __HIP_MEMORY_SCOPE_AGENT) < 16u) {
                __builtin_amdgcn_s_sleep(2);
                if (++sp > (1u << 22)) { if (lane == 0) __hip_atomic_store(tmo, 1u, __ATOMIC_RELAXED, __HIP_MEMORY_SCOPE_AGENT); break; }
            }
            __builtin_amdgcn_fence(__ATOMIC_ACQUIRE, "agent");
        }
        asm volatile("s_waitcnt vmcnt(0) lgkmcnt(0)" ::: "memory"); __builtin_amdgcn_s_barrier(); asm volatile("" ::: "memory");
        if (tid < 256) {
            const unsigned* sl = xslot + ((size_t)u.pm * 256 + tid) * 4; float s = 0.f;
#pragma unroll
            for (int t = 0; t < 4; ++t) s += __uint_as_float(__hip_atomic_load(sl + t, __ATOMIC_RELAXED, __HIP_MEMORY_SCOPE_AGENT));
            St[tid] = rsqrtf(s * (1.0f / 1024.0f) + EPS);
        }
        asm volatile("s_waitcnt vmcnt(0) lgkmcnt(0)" ::: "memory"); __builtin_amdgcn_s_barrier(); asm volatile("" ::: "memory");
#pragma unroll
        for (int ai = 0; ai < 2; ++ai)
#pragma unroll
            for (int m = 0; m < 4; ++m) {
                const int rl = ai * 128 + wr * 64 + m * 16 + fr; const size_t r = (size_t)u.pm * 256 + rl;
                const float rr = St[rl];
#pragma unroll
                for (int bj = 0; bj < 2; ++bj) {
                    const int c = u.pn * 256 + bj * 128 + wc * 32 + 8 * fq;
                    const f32x4 g0 = *(const f32x4*)(gfin + c), g1 = *(const f32x4*)(gfin + c + 4);
                    *(f32x4*)(out + r * 1024 + c) = acc[ai][bj][m][0] * rr * g0; *(f32x4*)(out + r * 1024 + c + 4) = acc[ai][bj][m][1] * rr * g1;
                }
            }
    }
};
struct EpiInR {
    static constexpr bool PERM = true;
    const float* sqp; const f32x2* sincos; h16* rq; h16* rk; h16* rv; h16* rg; int sqn; float sqi;
    __device__ __forceinline__ void operator()(const f32x4 (&acc)[2][2][4][2], const Unit& u, int wr, int wc, int fr, int fq, const PG8_LAS float* rtab) const {
        asm volatile("" : "+v"(fr), "+v"(fq));
#pragma unroll
        for (int ai = 0; ai < 2; ++ai)
#pragma unroll
            for (int m = 0; m < 4; ++m) {
                const size_t r = (size_t)u.pm * 256 + ai * 128 + wr * 64 + m * 16 + fr;
                const float rs = rtab[ai * 128 + wr * 64 + m * 16 + fr];
                const int pos = (int)(r & (L - 1));
#pragma unroll
                for (int bj = 0; bj < 2; ++bj) {
                    const int c0 = bj * 128 + wc * 32 + 8 * fq;
                    f32x4 v0 = acc[ai][bj][m][0] * rs, v1 = acc[ai][bj][m][1] * rs;
                    if (u.pn < 8) {
                        const f32x2* sc = sincos + (size_t)pos * 128 + (c0 >> 1);
                        const f32x2 s0 = sc[0], s1 = sc[1], s2 = sc[2], s3 = sc[3];
                        f32x4 w0, w1;
                        w0[0] = v0[0] * s0[1] - v0[1] * s0[0]; w0[1] = v0[1] * s0[1] + v0[0] * s0[0];
                        w0[2] = v0[2] * s1[1] - v0[3] * s1[0]; w0[3] = v0[3] * s1[1] + v0[2] * s1[0];
                        w1[0] = v1[0] * s2[1] - v1[1] * s2[0]; w1[1] = v1[1] * s2[1] + v1[0] * s2[0];
                        w1[2] = v1[2] * s3[1] - v1[3] * s3[0]; w1[3] = v1[3] * s3[1] + v1[2] * s3[0];
                        h16* dst = (u.pn < 4) ? rq + r * 1024 + u.pn * 256 + c0 : rk + r * 1024 + (u.pn - 4) * 256 + c0;
                        *(h16x8*)dst = pack8(w0, w1);
                    } else if (u.pn < 16) {
                        *(h16x8*)(rv + r * 2048 + (u.pn - 8) * 256 + c0) = pack8(v0, v1);
                    } else {
#pragma unroll
                        for (int e = 0; e < 4; ++e) { v0[e] = siluf_(v0[e]); v1[e] = siluf_(v1[e]); }
                        *(h16x8*)(rg + r * 2048 + (u.pn - 16) * 256 + c0) = pack8(v0, v1);
                    }
                }
            }
    }
};

template <int MODE>
__device__ __forceinline__ void tr_item(const float* __restrict__ W, int K, int N, h16* Wt, int ld, int row_off, const float* ks, float scale, float* scr, int item, int lane) {
    const int nbn = (N + 31) >> 5, kb = item / nbn, nb = item % nbn, k0 = kb * 64, n0 = nb * 32;
    const int n4 = n0 + (lane & 7) * 4;
    f32x4 wv[8];
#pragma unroll
    for (int i = 0; i < 8; ++i) { const int kk = 8 * i + (lane >> 3); wv[i] = (n4 < N) ? *(const f32x4*)(W + (size_t)(k0 + kk) * N + n4) : (f32x4){0.f, 0.f, 0.f, 0.f}; }
#pragma unroll
    for (int i = 0; i < 8; ++i) { const int kk = 8 * i + (lane >> 3); const float kf = ks ? ks[k0 + kk] : 1.f;
#pragma unroll
        for (int e = 0; e < 4; ++e) scr[kk * 33 + (lane & 7) * 4 + e] = wv[i][e] * kf; }
    LDS_FENCE();
    const int c = lane & 7;
#pragma unroll
    for (int j = 0; j < 4; ++j) {
        const int nl = (lane >> 3) + 8 * j, n = n0 + nl;
        if (n < N) {
            int row = n; float sc = scale;
            if (MODE == 1) row = (n < 384) ? 256 + n : (n < 640) ? n - 384 : (n < 712) ? n : n + 56;
            if (MODE == 2 && n >= 1024 && n < 2048) sc *= 0.0625f;
            const float* s = scr + (8 * c) * 33 + nl;
            h16x8 o;
#pragma unroll
            for (int e = 0; e < 8; ++e) o[e] = (h16)(s[e * 33] * sc);
            *(h16x8*)(Wt + (size_t)(row_off + row) * ld + k0 + 8 * c) = o;
        }
    }
    LDS_FENCE();
}

__device__ __forceinline__ void p0_prologue(const Params& P, unsigned char* lds, int blk, int nblk, int wv, int mode) {
    const int tid = my_tid(wv), wid = __builtin_amdgcn_readfirstlane(tid >> 6), lane = tid & 63;
    float* scr = (float*)lds + wid * (64 * 33);
    unsigned char* ws = opaque_ptr(P.ws);
    h16* WAIN = (h16*)(ws + WS_WAIN); h16* WQ = (h16*)(ws + WS_WQ); h16* WKV = (h16*)(ws + WS_WKV); h16* WAOUT = (h16*)(ws + WS_WAOUT);
    h16* WPG = (h16*)(ws + WS_WPG); h16* WPLE = (h16*)(ws + WS_WPLE); h16* WRIN = (h16*)(ws + WS_WRIN); h16* WROUT = (h16*)(ws + WS_WROUT);
    const float QSCALE = 0.08838834764831845f * 1.4426950408889634f;
    constexpr int I1 = 16 * 55, I2 = 6 * 32, I3 = 6 * 16, I4 = 8 * 16, I5 = 8 * 16, I6 = 16 * 32, I7 = 2 * 16 * 32, I8 = 2 * 4 * 32, I9 = 16 * 192, I10 = 32 * 32;
    constexpr int NIT = I1 + I2 + I3 + I4 + I5 + I6 + I7 + I8 + I9 + I10;
    const bool wgt = (nblk == 256);
    const int nslot = wgt ? 1152 : nblk, s_lo = (mode == 0) ? blk : wgt ? (blk < 128 ? 2 * blk : 256 + 7 * (blk - 128)) : blk, s_n = (mode == 0) ? 1 : wgt ? (blk < 128 ? 2 : 7) : 1, s_tot = (mode == 0) ? nblk : nslot;
    for (int sl_ = s_lo; sl_ < s_lo + s_n; ++sl_) {
    const int gw = sl_ * NWAVES + wid, ngw = s_tot * NWAVES;
    for (int it = (mode == 0 ? 0 : I1) + gw; it < (mode == 0 ? I1 : NIT); it += ngw) {
        int r = it;
        if (r < I1) { tr_item<1>(P.in[3], 1024, 1736, WAIN, 1024, 0, nullptr, 1.f, scr, r, lane); continue; } r -= I1;
        if (r < I2) { tr_item<0>(P.in[6], 384, 1024, WQ, 384, 0, P.in[4], QSCALE, scr, r, lane); continue; } r -= I2;
        if (r < I3) { tr_item<0>(P.in[7], 384, 512, WQ, 384, 1024, P.in[4], 1.f, scr, r, lane); continue; } r -= I3;
        if (r < I4) { const int h = r / 16; tr_item<0>(P.in[10] + (size_t)h * 256 * 128, 256, 128, WKV, 256, h * 128, P.in[5], 1.f, scr, r % 16, lane); continue; } r -= I4;
        if (r < I5) { const int h = r / 16; tr_item<0>(P.in[11] + (size_t)h * 256 * 128, 256, 128, WKV, 256, 1024 + h * 128, P.in[5], 1.f, scr, r % 16, lane); continue; } r -= I5;
        if (r < I6) { tr_item<0>(P.in[12], 1024, 1024, WAOUT, 1024, 0, nullptr, 1.f, scr, r, lane); continue; } r -= I6;
        if (r < I7) { const int i = r / 512; tr_item<0>(P.in[15] + (size_t)i * 1024 * 1024, 1024, 1024, WPG + (size_t)i * 1024 * 1024, 1024, 0, P.in[16] + i * 1024, 1.f, scr, r % 512, lane); continue; } r -= I7;
        if (r < I8) { const int i = r / 128; tr_item<0>(P.in[17] + (size_t)i * 256 * 1024, 256, 1024, WPLE + (size_t)i * 1024 * 256, 256, 0, nullptr, 1.f, scr, r % 128, lane); continue; } r -= I8;
        if (r < I9) { tr_item<2>(P.in[13], 1024, 6144, WRIN, 1024, 0, P.in[2] + 1024, 1.f, scr, r, lane); continue; } r -= I9;
        tr_item<0>(P.in[14], 2048, 1024, WROUT, 2048, 0, nullptr, 1.f, scr, r, lane);
    }
    }
    if (mode == 0) {
    const int gw = blk * NWAVES + wid, ngw = nblk * NWAVES;
    const int gt = blk * NTHREADS + tid, ngt = nblk * NTHREADS;
    { unsigned zz = 0u; asm volatile("" : "+v"(zz));
      for (int i = gt; i < 56 * 1024 / 8; i += ngt) ((u32x4*)(WAIN + 712 * 1024))[i] = (u32x4){zz, zz, zz, zz}; }
    {
        const float* x = P.in[0]; const f32x4* g4 = (const f32x4*)P.in[2]; h16* XN0 = (h16*)(ws + WS_R1);
        f32x4 gv[4];
#pragma unroll
        for (int j = 0; j < 4; ++j) gv[j] = g4[lane + 64 * j];
        for (int r0 = gw; r0 < T; r0 += 4 * ngw) {
            f32x4 v[4][4];
#pragma unroll
            for (int k = 0; k < 4; ++k) { const int r = (r0 + k * ngw < T) ? r0 + k * ngw : r0; const f32x4* xr = (const f32x4*)(x + (size_t)r * 1024) + lane;
#pragma unroll
                for (int j = 0; j < 4; ++j) v[k][j] = xr[64 * j]; }
#pragma unroll
            for (int k = 0; k < 4; ++k) { const int r = r0 + k * ngw; float s = 0.f;
#pragma unroll
                for (int j = 0; j < 4; ++j) s += dot4(v[k][j]);
                const float rstd = rsqrtf(wave_sum_dpp(s) * (1.0f / 1024.0f) + EPS);
                if (r < T) {
#pragma unroll
                    for (int j = 0; j < 4; ++j) { const f32x4 o = v[k][j] * rstd * gv[j]; *(h16x4*)(XN0 + (size_t)r * 1024 + (lane + 64 * j) * 4) = pack4(o); } } }
        }
    }
    }
    if (mode == 1)
    for (int sl_ = s_lo; sl_ < s_lo + s_n; ++sl_) {
    const int gt = sl_ * NTHREADS + tid, ngt = s_tot * NTHREADS;
    {
        const f32x4* p4 = (const f32x4*)P.in[1]; h16* PH0 = (h16*)(ws + WS_PH0); h16* PH1 = (h16*)(ws + WS_PH1);
        const int nv = T * 256 / 8;
        for (int i0_ = gt; i0_ < 2 * nv; i0_ += 4 * ngt) {
            f32x4 a[4], b2[4];
#pragma unroll
            for (int k = 0; k < 4; ++k) { const int i = (i0_ + k * ngt < 2 * nv) ? i0_ + k * ngt : i0_; a[k] = p4[2 * (size_t)i]; b2[k] = p4[2 * (size_t)i + 1]; }
#pragma unroll
            for (int k = 0; k < 4; ++k) { const int i = i0_ + k * ngt; if (i < 2 * nv) { h16* dst = (i < nv) ? PH0 + (size_t)i * 8 : PH1 + (size_t)(i - nv) * 8; *(h16x8*)dst = pack8(a[k], b2[k]); } }
        }
    }
    {
        f32x2* SC = (f32x2*)(ws + WS_SINCOS);
        for (int i = gt; i < L * 128; i += ngt) {
            const int pos = i >> 7, fi = i & 127;
            const float th = (float)pos * kAngle[fi];
            double rev = (double)th * 0.15915494309189535; rev -= __builtin_rint(rev);
            const float r = (float)(rev * 6.283185307179586), r2 = r * r;
            float sn = 1.9572941e-20f;
            sn = sn * r2 - 8.2206352e-18f;
            sn = sn * r2 + 2.8114573e-15f;
            sn = sn * r2 - 7.6471637e-13f;
            sn = sn * r2 + 1.6059044e-10f;
            sn = sn * r2 - 2.5052108e-8f;
            sn = sn * r2 + 2.7557319e-6f;
            sn = sn * r2 - 1.9841270e-4f;
            sn = sn * r2 + 8.3333333e-3f;
            sn = sn * r2 - 1.6666667e-1f;
            sn = sn * r2 + 1.0f;
            sn = sn * r;
            float cs = 4.1103176e-19f;
            cs = cs * r2 - 1.5619207e-16f;
            cs = cs * r2 + 4.7794773e-14f;
            cs = cs * r2 - 1.1470746e-11f;
            cs = cs * r2 + 2.0876757e-9f;
            cs = cs * r2 - 2.7557319e-7f;
            cs = cs * r2 + 2.4801587e-5f;
            cs = cs * r2 - 1.3888889e-3f;
            cs = cs * r2 + 4.1666667e-2f;
            cs = cs * r2 - 0.5f;
            cs = cs * r2 + 1.0f;
            SC[i] = (f32x2){sn, cs};
        }
    }
    }
}

__device__ __forceinline__ void p2_kidx(const Params& P, int blk, int nblk, int wv) {
    const h16* CQX = (const h16*)(P.ws + WS_CQX); h16* KIDXN = (h16*)(P.ws + WS_KIDXN); float* WIDX = (float*)(P.ws + WS_WIDX);
    const float* g = P.in[8]; const float* bb = P.in[9];
    for (int r = blk * NTHREADS + my_tid(wv); r < T; r += nblk * NTHREADS) {
        float v[64]; float s = 0.f;
#pragma unroll
        for (int c = 0; c < 8; ++c) { const h16x8 k = *(const h16x8*)(CQX + (size_t)r * 512 + 384 + c * 8);
#pragma unroll
            for (int e = 0; e < 8; ++e) { v[c * 8 + e] = (float)k[e]; s += v[c * 8 + e]; } }
        const float mu = s * (1.0f / 64.0f); float q = 0.f;
#pragma unroll
        for (int i = 0; i < 64; ++i) { v[i] -= mu; q += v[i] * v[i]; }
        const float rstd = rsqrtf(q * (1.0f / 64.0f) + EPS);
#pragma unroll
        for (int c = 0; c < 8; ++c) { h16x8 o;
#pragma unroll
            for (int e = 0; e < 8; ++e) o[e] = (h16)(v[c * 8 + e] * rstd * g[c * 8 + e] + bb[c * 8 + e]);
            *(h16x8*)(KIDXN + (size_t)r * 64 + c * 8) = o; }
        const h16x8 w = *(const h16x8*)(CQX + (size_t)r * 512 + 448);
        const float wsc = 0.04419417382415922f;
        f32x4 w0, w1;
#pragma unroll
        for (int e = 0; e < 4; ++e) { w0[e] = (float)w[e] * wsc; w1[e] = (float)w[4 + e] * wsc; }
        *(f32x4*)(WIDX + (size_t)r * 8) = w0; *(f32x4*)(WIDX + (size_t)r * 8 + 4) = w1;
    }
}

__device__ __forceinline__ unsigned fmap_u(float s) { s += 0.0f; const unsigned b = __float_as_uint(s); return (b & 0x80000000u) ? ~b : (b | 0x80000000u); }
__device__ __forceinline__ unsigned topk_select(const unsigned (&u)[32], int lane) {
    unsigned Tv = 0u;
    for (int bit = 31; bit >= 0; --bit) {
        const unsigned cand = Tv | (1u << bit); int cnt = 0;
#pragma unroll
        for (int i = 0; i < 32; ++i) cnt += __popcll(__ballot(u[i] >= cand));
        if (cnt >= 256) Tv = cand;
    }
    int gt = 0;
#pragma unroll
    for (int i = 0; i < 32; ++i) gt += __popcll(__ballot(u[i] > Tv));
    int need = 256 - gt;
    unsigned sel = 0u;
#pragma unroll
    for (int i = 0; i < 32; ++i) {
        const bool eq = (u[i] == Tv);
        const unsigned long long em = __ballot(eq);
        const int rank = (int)__builtin_amdgcn_mbcnt_hi((unsigned)(em >> 32), __builtin_amdgcn_mbcnt_lo((unsigned)em, 0u));
        const bool take = (u[i] > Tv) || (eq && rank < need);
        sel |= (take ? 1u : 0u) << i;
        need -= __popcll(em);
    }
    return sel;
}


__device__ __forceinline__ unsigned topk_select_radix(const unsigned (&u)[32], int lane, volatile __attribute__((address_space(3))) unsigned* hist) {
    typedef __attribute__((address_space(3))) unsigned lu32;
    unsigned prefix = 0u; int kk = 256;
#pragma unroll 1
    for (int pass = 0; pass < 4; ++pass) {
        const int shift = 24 - 8 * pass;
        { unsigned zz = 0u; asm volatile("" : "+v"(zz)); ((__attribute__((address_space(3))) u32x4*)hist)[lane] = (u32x4){zz, zz, zz, zz}; }
        LDS_FENCE();
#pragma unroll
        for (int i = 0; i < 32; ++i) {
            const bool in = (u[i] != 0u) && (pass == 0 || (u[i] >> (shift + 8)) == prefix);
            if (in) __hip_atomic_fetch_add((lu32*)hist + ((u[i] >> shift) & 255u), 1u, __ATOMIC_RELAXED, __HIP_MEMORY_SCOPE_WORKGROUP);
        }
        LDS_FENCE();
        const u32x4 c = ((__attribute__((address_space(3))) u32x4*)hist)[lane];
        const int tot = (int)(c[0] + c[1] + c[2] + c[3]);
        int S = tot;
#pragma unroll
        for (int o = 1; o < 64; o <<= 1) { const int v = __shfl_down(S, o); if (lane + o < 64) S += v; }
        const unsigned long long bm = __ballot(S >= kk);
        const int Ls = 63 - __builtin_clzll(bm);
        int cum = S - tot, bin = 0, above = 0; bool found = false;
#pragma unroll
        for (int j = 3; j >= 0; --j) { const int cj = (int)c[j]; if (!found && cum + cj >= kk) { bin = 4 * lane + j; above = cum; found = true; } cum += cj; }
        bin = __builtin_amdgcn_readlane(bin, Ls); above = __builtin_amdgcn_readlane(above, Ls);
        kk -= above; prefix = (prefix << 8) | (unsigned)bin;
        LDS_FENCE();
    }
    const unsigned Tv = prefix; int need = kk;
    unsigned sel = 0u;
#pragma unroll
    for (int i = 0; i < 32; ++i) {
        const bool eq = (u[i] == Tv);
        const unsigned long long em = __ballot(eq);
        const int rank = (int)__builtin_amdgcn_mbcnt_hi((unsigned)(em >> 32), __builtin_amdgcn_mbcnt_lo((unsigned)em, 0u));
        const bool take = (u[i] > Tv) || (eq && rank < need);
        sel |= (take ? 1u : 0u) << i;
        need -= __popcll(em);
    }
    return sel;
}


#define DPP_STEP_I(v, op, ident, ctrl, rmask) v = op(v, __builtin_amdgcn_update_dpp((int)(ident), v, ctrl, rmask, 0xf, false))
__device__ __forceinline__ int imax_(int a, int b) { return a > b ? a : b; }
__device__ __forceinline__ int iadd_(int a, int b) { return a + b; }
__device__ __forceinline__ int wave_scan_add(int v) {
    DPP_STEP_I(v, iadd_, 0, 0x111, 0xf); DPP_STEP_I(v, iadd_, 0, 0x112, 0xf); DPP_STEP_I(v, iadd_, 0, 0x114, 0xf); DPP_STEP_I(v, iadd_, 0, 0x118, 0xf);
    DPP_STEP_I(v, iadd_, 0, 0x142, 0xa); DPP_STEP_I(v, iadd_, 0, 0x143, 0xc); return v;
}
template <int CTRL, int RMASK> __device__ __forceinline__ float fmax_dpp_(float a) { return fmaxf(a, __builtin_bit_cast(float, __builtin_amdgcn_update_dpp((int)0xff800000u, __builtin_bit_cast(int, a), CTRL, RMASK, 0xf, false))); }
template <int CTRL, int RMASK> __device__ __forceinline__ float fmin_dpp_(float a) { return fminf(a, __builtin_bit_cast(float, __builtin_amdgcn_update_dpp((int)0x7f800000u, __builtin_bit_cast(int, a), CTRL, RMASK, 0xf, false))); }
#define DPP_RED6(v, F) do { v = F<0x111, 0xf>(v); v = F<0x112, 0xf>(v); v = F<0x114, 0xf>(v); v = F<0x118, 0xf>(v); v = F<0x142, 0xa>(v); v = F<0x143, 0xc>(v); } while (0)
__device__ __forceinline__ float wave_max_dpp(float v) { DPP_RED6(v, fmax_dpp_); return __builtin_bit_cast(float, __builtin_amdgcn_readlane(__builtin_bit_cast(int, v), 63)); }
__device__ __forceinline__ float wave_min_dpp(float v) { DPP_RED6(v, fmin_dpp_); return __builtin_bit_cast(float, __builtin_amdgcn_readlane(__builtin_bit_cast(int, v), 63)); }
__device__ __forceinline__ unsigned topk_select_lin(const float (&s)[32], unsigned valid, int lane, volatile __attribute__((address_space(3))) unsigned* ws_) {
    typedef __attribute__((address_space(3))) unsigned lu32;
    typedef __attribute__((address_space(3))) float lf32;
    typedef __attribute__((address_space(3))) f32x4 lf32x4;
    lu32* hist = (lu32*)ws_; lf32* cand = (lf32*)ws_ + 256;
    unsigned act = valid; int kk = 256; float Tv = 0.f; int need = 0; bool solved = false; int cnt = 0;
#pragma unroll 1
    for (int iter = 0; iter < 8; ++iter) {
        float mn = __builtin_inff(), mx = -__builtin_inff();
        if (iter == 0) {
#pragma unroll
            for (int i = 0; i < 32; ++i) { mn = fminf(mn, s[i]); mx = fmaxf(mx, s[i]); }
        } else {
#pragma unroll
            for (int i = 0; i < 32; ++i) { const bool a = (act >> i) & 1u; mn = fminf(mn, a ? s[i] : __builtin_inff()); mx = fmaxf(mx, a ? s[i] : -__builtin_inff()); }
        }
        mn = wave_min_dpp(mn); mx = wave_max_dpp(mx);
        if (mn == mx) { Tv = mx; need = kk; solved = true; break; }
        const float scale = 254.9f / (mx - mn), bias = -mn * scale;
        { unsigned zz = 0u; asm volatile("" : "+v"(zz)); ((__attribute__((address_space(3))) u32x4*)hist)[lane] = (u32x4){zz, zz, zz, zz}; }
        LDS_FENCE();
#pragma unroll
        for (int i = 0; i < 32; ++i) { int b = (int)fmaf(s[i], scale, bias); b = b < 0 ? 0 : b;
            __hip_atomic_fetch_add(hist + (((act >> i) & 1u) ? b : 321 + (lane & 15)), 1u, __ATOMIC_RELAXED, __HIP_MEMORY_SCOPE_WORKGROUP); }
        LDS_FENCE();
        const u32x4 c = ((__attribute__((address_space(3))) u32x4*)hist)[lane];
        const int tot = (int)(c[0] + c[1] + c[2] + c[3]);
        const int pre = wave_scan_add(tot);
        const int total = __builtin_amdgcn_readlane(pre, 63);
        const int S = total - pre + tot;
        const unsigned long long bm = __ballot(S >= kk);
        const int Ls = 63 - __builtin_clzll(bm | 1ull);
        int cum = S - tot, bin = 0, above = 0, cb = 0; bool found = false;
#pragma unroll
        for (int j = 3; j >= 0; --j) { const int cj = (int)c[j]; if (!found && cum + cj >= kk) { bin = 4 * lane + j; above = cum; cb = cj; found = true; } cum += cj; }
        bin = __builtin_amdgcn_readlane(bin, Ls); above = __builtin_amdgcn_readlane(above, Ls); cnt = __builtin_amdgcn_readlane(cb, Ls);
        kk -= above;
        { float sc2 = scale; asm volatile("" : "+v"(sc2));
#pragma unroll
          for (int i = 0; i < 32; ++i) { int b = (int)fmaf(s[i], sc2, bias); b = b < 0 ? 0 : b; act &= ~((b != bin ? 1u : 0u) << i); } }
        LDS_FENCE();
        if (cnt <= 64) break;
    }
    if (!solved) {
        cand[lane] = __builtin_nanf("");
        const int myc = __popc(act);
        int off = wave_scan_add(myc) - myc;
        LDS_FENCE();
#pragma unroll
        for (int i = 0; i < 32; ++i) { const bool a = (act >> i) & 1u; const int slot = (a && off < 64) ? off : 65 + (lane & 15); cand[slot] = s[i]; off += a ? 1 : 0; }
        LDS_FENCE();
        const int m = cnt < 64 ? cnt : 64;
        const float v = (lane < m) ? cand[lane] : -__builtin_inff();
        int gt = 0, eq = 0;
#pragma unroll
        for (int j4 = 0; j4 < 16; ++j4) { const f32x4 cj = ((lf32x4*)cand)[j4];
#pragma unroll
            for (int e = 0; e < 4; ++e) { gt += (cj[e] > v) ? 1 : 0; eq += (cj[e] == v) ? 1 : 0; } }
        const bool ok = (lane < m) && gt < kk && kk <= gt + eq;
        const unsigned long long okm = __ballot(ok);
        const int fl = okm ? __builtin_ctzll(okm) : 0;
        Tv = __builtin_bit_cast(float, __builtin_amdgcn_readlane(__builtin_bit_cast(int, v), fl)); need = kk - __builtin_amdgcn_readlane(gt, fl);
        LDS_FENCE();
    }
    unsigned sel = 0u, eqb = 0u;
#pragma unroll
    for (int i = 0; i < 32; ++i) { sel |= ((s[i] > Tv) ? 1u : 0u) << i; eqb |= ((s[i] == Tv) ? 1u : 0u) << i; }
    const int eqtot = __builtin_amdgcn_readlane(wave_scan_add(__popc(eqb)), 63);
    if (eqtot <= need) sel |= eqb;
    else {
#pragma unroll
        for (int i = 0; i < 32; ++i) {
            const bool eq = (eqb >> i) & 1u;
            const unsigned long long em = __ballot(eq);
            const int rank = (int)__builtin_amdgcn_mbcnt_hi((unsigned)(em >> 32), __builtin_amdgcn_mbcnt_lo((unsigned)em, 0u));
            sel |= ((eq && rank < need) ? 1u : 0u) << i;
            need -= __popcll(em);
        }
    }
    return sel;
}


__device__ __forceinline__ unsigned topk_select_fast(const float (&s)[32], unsigned valid, int nk, int lane, const __attribute__((address_space(3))) float* row, volatile __attribute__((address_space(3))) unsigned* ws_) {
    typedef __attribute__((address_space(3))) unsigned lu32; typedef __attribute__((address_space(3))) float lf32; typedef __attribute__((address_space(3))) f32x4 lf32x4;
    lu32* hist = (lu32*)ws_; lf32* cand = (lf32*)ws_ + 256;
    float mn = __builtin_inff(), mx = -__builtin_inff();
#pragma unroll
    for (int i = 0; i < 32; ++i) { mn = fminf(mn, s[i]); mx = fmaxf(mx, s[i]); }
    mn = wave_min_dpp(mn); mx = wave_max_dpp(mx);
    const bool flat = (mn == mx);
    const float scale = flat ? 0.f : 254.9f / (mx - mn), bias = flat ? 0.f : -mn * scale;
    { unsigned zz = 0u; asm volatile("" : "+v"(zz)); ((__attribute__((address_space(3))) u32x4*)hist)[lane] = (u32x4){zz, zz, zz, zz}; }
    LDS_FENCE();
    const int full = nk >> 6, rem = nk & 63;
#pragma unroll
    for (int i = 0; i < 32; ++i) if (i <= full) { int b = (int)fmaf(s[i], scale, bias); b = b < 0 ? 0 : b; __hip_atomic_fetch_add(hist + b, 1u, __ATOMIC_RELAXED, __HIP_MEMORY_SCOPE_WORKGROUP); }
    LDS_FENCE();
    u32x4 c = ((__attribute__((address_space(3))) u32x4*)hist)[lane];
    if (lane == 0 && full < 32) c[0] -= (unsigned)(64 - rem);
    const int tot = (int)(c[0] + c[1] + c[2] + c[3]);
    const int pre = wave_scan_add(tot), total = __builtin_amdgcn_readlane(pre, 63);
    const int S = total - pre + tot;
    const unsigned long long bm = __ballot(S >= 256);
    const int Ls = 63 - __builtin_clzll(bm | 1ull);
    int cum = S - tot, bin = 0, above = 0, cb = 0; bool found = false;
#pragma unroll
    for (int j = 3; j >= 0; --j) { const int cj = (int)c[j]; if (!found && cum + cj >= 256) { bin = 4 * lane + j; above = cum; cb = cj; found = true; } cum += cj; }
    bin = __builtin_amdgcn_readlane(bin, Ls); above = __builtin_amdgcn_readlane(above, Ls); const int cnt = __builtin_amdgcn_readlane(cb, Ls);
    if (flat || cnt > 64) return topk_select_lin(s, valid, lane, ws_);
    const int kk = 256 - above;
    unsigned gtb = 0u, eqb = 0u;
    { float sc2 = scale; asm volatile("" : "+v"(sc2));
#pragma unroll
      for (int i = 0; i < 32; ++i) if (i <= full) { int b = (int)fmaf(s[i], sc2, bias); b = b < 0 ? 0 : b; gtb |= (b > bin ? 1u : 0u) << i; eqb |= (b == bin ? 1u : 0u) << i; } }
    eqb &= valid;
    cand[lane] = __builtin_nanf("");
    int off = wave_scan_add(__popc(eqb)) - __popc(eqb);
    LDS_FENCE();
    { unsigned m = eqb;
      while (__any(m != 0u)) { if (m != 0u) { const int i = __builtin_ctz(m); cand[off < 64 ? off : 65 + (lane & 15)] = row[i * 64 + lane]; ++off; m &= m - 1u; } } }
    LDS_FENCE();
    const float v = (lane < cnt) ? cand[lane] : -__builtin_inff();
    int gt = 0, eq = 0;
#pragma unroll
    for (int j4 = 0; j4 < 16; ++j4) { const f32x4 cj = ((lf32x4*)cand)[j4];
#pragma unroll
        for (int e = 0; e < 4; ++e) { gt += (cj[e] > v) ? 1 : 0; eq += (cj[e] == v) ? 1 : 0; } }
    const unsigned long long okm = __ballot((lane < cnt) && gt < kk && kk <= gt + eq);
    const int fl = okm ? __builtin_ctzll(okm) : 0;
    const float Tv = __builtin_bit_cast(float, __builtin_amdgcn_readlane(__builtin_bit_cast(int, v), fl)); int need = kk - __builtin_amdgcn_readlane(gt, fl);
    const int eqtot = __builtin_amdgcn_readlane(eq, fl);
    LDS_FENCE();
    unsigned sel = gtb;
    if (eqtot <= need) {
        unsigned m = eqb;
        while (__any(m != 0u)) { if (m != 0u) { const int i = __builtin_ctz(m); if (row[i * 64 + lane] >= Tv) sel |= 1u << i; m &= m - 1u; } }
    } else {
#pragma unroll
        for (int i = 0; i < 32; ++i) {
            const bool inb = (eqb >> i) & 1u; const bool e_ = inb && (s[i] == Tv);
            const unsigned long long em = __ballot(e_);
            const int rank = (int)__builtin_amdgcn_mbcnt_hi((unsigned)(em >> 32), __builtin_amdgcn_mbcnt_lo((unsigned)em, 0u));
            sel |= (((inb && s[i] > Tv) || (e_ && rank < need)) ? 1u : 0u) << i;
            need -= __popcll(em);
        }
    }
    return sel;
}

__device__ __forceinline__ void p3_indexer_naive(const Params& P, unsigned char* lds, int blk, int nblk, int wv) {
    const int tid = my_tid(wv), wid = __builtin_amdgcn_readfirstlane(tid >> 6), lane = tid & 63;
    float* sc = (float*)lds + wid * 2048; float* qf = (float*)(lds + 65536) + wid * 512; float* wf = (float*)(lds + 65536 + 16384) + wid * 8;
    const h16* QIDX = (const h16*)(P.ws + WS_QIDX); const h16* KIDXN = (const h16*)(P.ws + WS_KIDXN); const float* WIDX = (const float*)(P.ws + WS_WIDX);
    unsigned long long* MASK = (unsigned long long*)(P.ws + WS_MASK);
    const int gw = blk * NWAVES + wid, ngw = nblk * NWAVES;
    for (int it = gw; it < T; it += ngw) {
        const int b = it >> 11, pos = ((it & 2047) + b * 389) & 2047, t = b * L + pos, nk = pos + 1;
        { const h16x8 qv = *(const h16x8*)(QIDX + (size_t)t * 512 + lane * 8);
#pragma unroll
          for (int e = 0; e < 8; ++e) qf[lane * 8 + e] = (float)qv[e];
          if (lane < 8) wf[lane] = WIDX[(size_t)t * 8 + lane]; }
        LDS_FENCE();
        for (int i = 0; i * 64 < nk; ++i) {
            const int key = i * 64 + lane; float score = 0.f;
            if (key < nk) {
                const h16x8* kp = (const h16x8*)(KIDXN + (size_t)(b * L + key) * 64);
                float kf[64];
#pragma unroll
                for (int c = 0; c < 8; ++c) { const h16x8 kv = kp[c];
#pragma unroll
                    for (int e = 0; e < 8; ++e) kf[c * 8 + e] = (float)kv[e]; }
                for (int h = 0; h < 8; ++h) {
                    float a = 0.f;
#pragma unroll
                    for (int d = 0; d < 64; ++d) a = fmaf(qf[h * 64 + d], kf[d], a);
                    score += fmaxf(a, 0.f) * wf[h];
                }
            }
            sc[key] = score;
        }
        LDS_FENCE();
        unsigned selbits = 0u;
        if (nk <= 256) {
#pragma unroll
            for (int i = 0; i < 32; ++i) selbits |= ((i * 64 + lane) < nk ? 1u : 0u) << i;
        } else {
            unsigned u[32];
#pragma unroll
            for (int i = 0; i < 32; ++i) { const int key = i * 64 + lane; const float s = sc[key]; u[i] = (key < nk) ? fmap_u(s) : 0u; }
            selbits = topk_select(u, lane);
        }
#pragma unroll
        for (int i = 0; i < 32; ++i) { const unsigned long long bal = __ballot((selbits >> i) & 1u); if (lane == 0) MASK[(size_t)t * 32 + i] = bal; }
        LDS_FENCE();
    }
}


typedef float f32x16 __attribute__((ext_vector_type(16)));
__device__ __forceinline__ h16x8 relu_pk8(const f32x16& s, int base) {
    h16x8 r;
#pragma unroll
    for (int e = 0; e < 4; ++e) { const h16x2 p = __builtin_bit_cast(h16x2, __builtin_amdgcn_cvt_pkrtz(fmaxf(s[base + 2 * e], 0.f), fmaxf(s[base + 2 * e + 1], 0.f))); r[2 * e] = p[0]; r[2 * e + 1] = p[1]; }
    return r;
}
__device__ __forceinline__ void p3_indexer(const Params& P, unsigned char* lds_, int blk, int nblk, int wv) {
    typedef __attribute__((address_space(3))) float lfloat;
    const int tid = my_tid(wv), wid = __builtin_amdgcn_readfirstlane(tid >> 6), lane = tid & 63;
    unsigned char* ws = opaque_ptr(P.ws);
    lfloat* sc = (lfloat*)lds_;
    const h16* QIDX = (const h16*)(ws + WS_QIDX); const h16* KIDXN = (const h16*)(ws + WS_KIDXN); const float* WIDX = (const float*)(ws + WS_WIDX);
    unsigned long long* MASK = (unsigned long long*)(ws + WS_MASK);
    h16x8 Afn[4][4]; f32x4 wn = (f32x4){0.f, 0.f, 0.f, 0.f};
    { const int r = lane & 31, h = lane >> 5; const int u0 = (blk < NB * (L / 16)) ? blk : 0; const int tt0 = (u0 & 15) * L + (u0 >> 4) * 16;
#pragma unroll
      for (int g = 0; g < 4; ++g)
#pragma unroll
          for (int s = 0; s < 4; ++s) Afn[g][s] = *(const h16x8*)(QIDX + (size_t)(tt0 + 4 * g + (r >> 3)) * 512 + (r & 7) * 64 + 16 * s + 8 * h);
      if (r < 16) wn = *(const f32x4*)(WIDX + (size_t)(tt0 + r) * 8 + 4 * h); }
    for (int unit = blk; unit < NB * (L / 16); unit += nblk) {
        const int b = unit & 15, qg = unit >> 4, p0 = qg * 16, t0 = b * L + p0, NT = (p0 + 15) / 32 + 1;
        int lane_o = lane; asm volatile("" : "+v"(lane_o));
        const int r = lane_o & 31, h = lane_o >> 5;
        h16x8 Af[4][4];
#pragma unroll
        for (int g = 0; g < 4; ++g)
#pragma unroll
            for (int s = 0; s < 4; ++s) Af[g][s] = Afn[g][s];
        h16x8 fragA;
        { const f32x4 w = wn;
          const h16 z = (h16)0.f;
          if (r & 1) { fragA[0] = z; fragA[1] = z; fragA[2] = z; fragA[3] = z; fragA[4] = (h16)w[0]; fragA[5] = (h16)w[1]; fragA[6] = (h16)w[2]; fragA[7] = (h16)w[3]; }
          else { fragA[0] = (h16)w[0]; fragA[1] = (h16)w[1]; fragA[2] = (h16)w[2]; fragA[3] = (h16)w[3]; fragA[4] = z; fragA[5] = z; fragA[6] = z; fragA[7] = z; } }
        const int code = (r < 16) ? (r >> 1) : -1;
        const h16* kbase = KIDXN + (size_t)b * L * 64 + (size_t)r * 64 + 8 * h;
        h16x8 Bf[4];
        if (wid < NT) {
#pragma unroll
            for (int s = 0; s < 4; ++s) Bf[s] = *(const h16x8*)(kbase + (size_t)wid * 32 * 64 + 16 * s);
        }
        for (int rep_ = 0; rep_ <= MK_P3_REPA; ++rep_) {
        if (rep_ > 0 && wid < NT) {
#pragma unroll
            for (int s = 0; s < 4; ++s) Bf[s] = *(const h16x8*)(kbase + (size_t)wid * 32 * 64 + 16 * s);
        }
        for (int kt = wid; kt < NT; kt += NWAVES) {
            h16x8 Bn[4];
            const int ktn = (kt + NWAVES < NT) ? kt + NWAVES : kt;
#pragma unroll
            for (int s = 0; s < 4; ++s) Bn[s] = *(const h16x8*)(kbase + (size_t)ktn * 32 * 64 + 16 * s);
            f32x16 C = {};
#pragma unroll
            for (int g = 0; g < 4; ++g) {
                f32x16 S = {};
#pragma unroll
                for (int s = 0; s < 4; ++s) S = __builtin_amdgcn_mfma_f32_32x32x16_f16(Af[g][s], Bf[s], S, 0, 0, 0);
                const h16x8 X0 = relu_pk8(S, 0), X1 = relu_pk8(S, 8);
                const h16x8 zero8 = (h16x8){0, 0, 0, 0, 0, 0, 0, 0};
                const h16x8 W0 = (code == 2 * g) ? fragA : zero8, W1 = (code == 2 * g + 1) ? fragA : zero8;
                C = __builtin_amdgcn_mfma_f32_32x32x16_f16(W0, X0, C, 0, 0, 0);
                C = __builtin_amdgcn_mfma_f32_32x32x16_f16(W1, X1, C, 0, 0, 0);
            }
            const int key = kt * 32 + r;
#pragma unroll
            for (int e = 0; e < 4; ++e) { sc[(e + 4 * h) * 2048 + key] = C[e]; sc[(8 + e + 4 * h) * 2048 + key] = C[4 + e]; }
#pragma unroll
            for (int s = 0; s < 4; ++s) Bf[s] = Bn[s];
        }
        }
        __syncthreads();
        { const int un = (unit + nblk < NB * (L / 16)) ? unit + nblk : unit; const int ttn = (un & 15) * L + (un >> 4) * 16;
#pragma unroll
          for (int g = 0; g < 4; ++g)
#pragma unroll
              for (int s = 0; s < 4; ++s) Afn[g][s] = *(const h16x8*)(QIDX + (size_t)(ttn + 4 * g + (r >> 3)) * 512 + (r & 7) * 64 + 16 * s + 8 * h);
          if (r < 16) wn = *(const f32x4*)(WIDX + (size_t)(ttn + r) * 8 + 4 * h); }
#pragma unroll 1
        for (int qq_ = 0; qq_ < 2 * (1 + MK_P3_REPB); ++qq_) {
            const int qq = qq_ & 1;
            const int qi = 2 * wid + qq, pos = p0 + qi, nk = pos + 1, t = t0 + qi;
            unsigned selbits = 0u;
            if (nk <= 256) {
#pragma unroll
                for (int i = 0; i < 32; ++i) selbits |= ((i * 64 + lane) < nk ? 1u : 0u) << i;
            } else {
                float sv[32];
                const int full = nk >> 6;
                const unsigned valid = (full >= 32 ? 0xffffffffu : ((1u << full) - 1u)) | ((full < 32 && lane < (nk & 63)) ? (1u << full) : 0u);
#pragma unroll
                for (int i = 0; i < 32; ++i) { const float x = sc[qi * 2048 + i * 64 + lane]; sv[i] = ((valid >> i) & 1u) ? x : __builtin_nanf(""); }
                selbits = topk_select_fast(sv, valid, nk, lane, (const __attribute__((address_space(3))) float*)(sc + qi * 2048), (volatile __attribute__((address_space(3))) unsigned*)(sc + 16 * 2048 + wid * 448));
            }
            {
                __attribute__((address_space(3))) unsigned long long* stg = (__attribute__((address_space(3))) unsigned long long*)(sc + 16 * 2048 + wid * 448 + (qq ? 0 : 338));
                LDS_FENCE();
#pragma unroll
                for (int i = 0; i < 32; ++i) { const unsigned long long bal = __ballot((selbits >> i) & 1u); if (lane == 0) stg[i] = bal; }
            }
            (void)t;
        }
        __syncthreads();
        { const int q = tid & 15, tl = tid >> 4;
          MASK[((size_t)b * 32 + tl) * L + p0 + q] = ((__attribute__((address_space(3))) unsigned long long*)(sc + 16 * 2048 + (q >> 1) * 448 + ((q & 1) ? 0 : 338)))[tl]; }
    }
}

__device__ __forceinline__ void p4_attn_naive(const Params& P, unsigned char* lds, int blk, int nblk, int wv) {
    const int tid = my_tid(wv), wid = __builtin_amdgcn_readfirstlane(tid >> 6), lane = tid & 63;
    int* keys = (int*)lds; float* qf = (float*)(lds + 1024); float* pf = (float*)(lds + 1024 + 4096) + wid * 256; int* nselp = (int*)(lds + 1024 + 4096 + 8192);
    h16* QA = (h16*)(P.ws + WS_R1); const h16* Kb = (const h16*)(P.ws + WS_R2); const h16* Vb = (const h16*)(P.ws + WS_R3); const h16* SG = (const h16*)(P.ws + WS_R4);
    const unsigned long long* MASK = (const unsigned long long*)(P.ws + WS_MASK);
    for (int t = blk; t < T; t += nblk) {
        const int b = t >> 11;
        __syncthreads();
        if (tid < 128) { const h16x8 qv = *(const h16x8*)(QA + (size_t)t * 1024 + tid * 8);
#pragma unroll
            for (int e = 0; e < 8; ++e) qf[tid * 8 + e] = (float)qv[e]; }
        if (wid == 0) {
            unsigned long long m = (lane < 32) ? MASK[(size_t)t * 32 + lane] : 0ull;
            const int cnt = __popcll(m); int inc = cnt;
#pragma unroll
            for (int o = 1; o < 64; o <<= 1) { const int v = __shfl_up(inc, o); if (lane >= o) inc += v; }
            int off = inc - cnt;
            while (m) { const int k = __builtin_ctzll(m); keys[off++] = lane * 64 + k; m &= m - 1; }
            if (lane == 63) nselp[0] = inc;
        }
        __syncthreads();
        const int nsel = nselp[0], h = wid;
        float s[4];
#pragma unroll
        for (int c = 0; c < 4; ++c) {
            const int idx = lane + 64 * c; s[c] = -INFINITY;
            if (idx < nsel) {
                const h16x8* kp = (const h16x8*)(Kb + (size_t)(b * L + keys[idx]) * 1024 + h * 128); float a = 0.f;
#pragma unroll
                for (int cc = 0; cc < 16; ++cc) { const h16x8 kv = kp[cc];
#pragma unroll
                    for (int e = 0; e < 8; ++e) a = fmaf(qf[h * 128 + cc * 8 + e], (float)kv[e], a); }
                s[c] = a;
            }
        }
        const float mx = wave_max(fmaxf(fmaxf(s[0], s[1]), fmaxf(s[2], s[3])));
        float ls = 0.f;
#pragma unroll
        for (int c = 0; c < 4; ++c) { const int idx = lane + 64 * c; const float p = (idx < nsel) ? exp2f(s[c] - mx) : 0.f; pf[idx] = p; ls += p; }
        ls = wave_sum(ls);
        LDS_FENCE();
        float o0 = 0.f, o1 = 0.f;
        for (int k = 0; k < nsel; ++k) {
            const h16x2 v = *(const h16x2*)(Vb + (size_t)(b * L + keys[k]) * 1024 + h * 128 + 2 * lane); const float pk = pf[k];
            o0 = fmaf(pk, (float)v[0], o0); o1 = fmaf(pk, (float)v[1], o1);
        }
        const float inv = 1.0f / ls;
        const h16x2 g = *(const h16x2*)(SG + (size_t)t * 1024 + h * 128 + 2 * lane);
        h16x2 o; o[0] = (h16)(o0 * inv * (float)g[0]); o[1] = (h16)(o1 * inv * (float)g[1]);
        *(h16x2*)(QA + (size_t)t * 1024 + h * 128 + 2 * lane) = o;
    }
}


namespace att {
typedef unsigned short bf16;
typedef short bf16x8 __attribute__((ext_vector_type(8)));
typedef short s16x4 __attribute__((ext_vector_type(4)));
typedef float f32x16 __attribute__((ext_vector_type(16)));
typedef __attribute__((address_space(3))) char lchar;
typedef __attribute__((address_space(3))) float lfloat;
typedef __attribute__((address_space(3))) bf16x8 lbf16x8;
constexpr int D = 128, PITCH = 1024, NW = 8, QBLK = 32, KVBLK = 64, QB = NW * QBLK;
constexpr int SHM_V = KVBLK * D * 2, SHM_K = KVBLK * D * 2;
constexpr int LDS_ATT = 2 * SHM_V + 2 * SHM_K + NW * 64 * 4;
constexpr float THR = 8.f;
#define KSWZ(row, colB) ((row) * 256 + ((colB) ^ (((row) & 7) << 4)))
#define SBAR() __builtin_amdgcn_sched_barrier(0)
__device__ __forceinline__ int v_st(int k, int c) { const int kk = (k & ~0xC) | ((k & 4) << 1) | ((k & 8) >> 1); return ((kk >> 3) * 4 + (c >> 5)) * 512 + ((kk & 7) * 32 + (c & 31)) * 2; }
__device__ __forceinline__ int v_rd_base(int lane) { return ((lane & 3) << 3) | (((lane >> 2) & 3) << 6) | (((lane >> 4) & 1) << 5) | (((lane >> 5) & 1) << 8); }
constexpr int v_rd_off(int d0, int ks, int half) { return d0 * 512 + ks * 4096 + half * 2048; }
__device__ __forceinline__ int crow(int r, int hi) { return (r & 3) + 8 * (r >> 2) + 4 * hi; }
__device__ __forceinline__ bf16x8 load8(const bf16* p) { return *reinterpret_cast<const bf16x8*>(p); }
__device__ __forceinline__ void mask_init(f32x16& p0, f32x16& p1, unsigned long long mk, int hi) {
    const unsigned lo = (unsigned)mk >> (4 * hi), hh = (unsigned)(mk >> 32) >> (4 * hi);
#pragma unroll
    for (int r = 0; r < 16; ++r) {
        const int c = (r & 3) + 8 * (r >> 2);
        const int t0 = __builtin_amdgcn_sbfe(lo, c, 1), t1 = __builtin_amdgcn_sbfe(hh, c, 1);
        p0[r] = __uint_as_float(~(unsigned)t0 & 0xff800000u); p1[r] = __uint_as_float(~(unsigned)t1 & 0xff800000u);
    }
}
__device__ __forceinline__ void partialSM(f32x16& p0, f32x16& p1, float& m_reg, float& mn, float& alpha) {
    float pmax = p0[0]; for (int r = 1; r < 16; ++r) pmax = fmaxf(pmax, p0[r]); for (int r = 0; r < 16; ++r) pmax = fmaxf(pmax, p1[r]);
    { auto rr = __builtin_amdgcn_permlane32_swap(__float_as_uint(pmax), __float_as_uint(pmax), false, false);
      pmax = fmaxf(__uint_as_float(rr[0]), __uint_as_float(rr[1])); }
    if (__builtin_expect(__all((pmax - m_reg) <= THR), 1)) { mn = m_reg; alpha = 1.f; }
    else { mn = fmaxf(m_reg, pmax); alpha = __builtin_amdgcn_exp2f(m_reg - mn); m_reg = mn; }
    for (int r = 0; r < 16; ++r) p0[r] = p0[r] - mn; for (int r = 0; r < 16; ++r) p1[r] = p1[r] - mn;
    for (int r = 0; r < 16; ++r) p0[r] = __builtin_amdgcn_exp2f(p0[r]);
}
__device__ __forceinline__ void finishSM(f32x16& p0, f32x16& p1, float alpha, float& l_reg, bf16x8& pa0, bf16x8& pa1, bf16x8& pa2, bf16x8& pa3) {
    for (int r = 0; r < 16; ++r) p1[r] = __builtin_amdgcn_exp2f(p1[r]);
    float ps = 0; for (int r = 0; r < 16; ++r) ps += p0[r]; for (int r = 0; r < 16; ++r) ps += p1[r];
    { auto rr = __builtin_amdgcn_permlane32_swap(__float_as_uint(ps), __float_as_uint(ps), false, false);
      ps = __uint_as_float(rr[0]) + __uint_as_float(rr[1]); }
    l_reg = l_reg * alpha + ps;
#define PK4(P, B_, OUT) do { unsigned a0 = cvtpk_bf16(P[B_+0], P[B_+1]), a1 = cvtpk_bf16(P[B_+2], P[B_+3]);                          \
        unsigned b0 = cvtpk_bf16(P[B_+4], P[B_+5]), b1 = cvtpk_bf16(P[B_+6], P[B_+7]);                                             \
        auto r0 = __builtin_amdgcn_permlane32_swap(a0, b0, false, false); auto r1 = __builtin_amdgcn_permlane32_swap(a1, b1, false, false); \
        u32x4 w = {r0[0], r1[0], r0[1], r1[1]}; OUT = *reinterpret_cast<bf16x8*>(&w); } while (0)
    PK4(p0, 0, pa0); PK4(p0, 8, pa1); PK4(p1, 0, pa2); PK4(p1, 8, pa3);
#undef PK4
}
template <int KB>
__device__ __forceinline__ void qkt(f32x16& p0, f32x16& p1, const lchar* K_lds, int r32, int hi, const bf16x8* qr) {
    const lchar* kb[4];
#pragma unroll
    for (int dd = 0; dd < 4; ++dd) kb[dd] = K_lds + KB * SHM_K + KSWZ(r32, (dd * 16 + hi * 8) * 2);
#pragma unroll
    for (int d0 = 0; d0 < 8; ++d0) { const lchar* a = kb[d0 & 3] + (d0 >> 2) * 128;
        bf16x8 b0 = *(const lbf16x8*)(a);
        bf16x8 b1 = *(const lbf16x8*)(a + 32 * 256);
        p0 = __builtin_amdgcn_mfma_f32_32x32x16_bf16(b0, qr[d0], p0, 0, 0, 0);
        p1 = __builtin_amdgcn_mfma_f32_32x32x16_bf16(b1, qr[d0], p1, 0, 0, 0); }
}
template <int VB>
__device__ __forceinline__ void pv_tile(f32x16* o, int vb0, bf16x8 pa0, bf16x8 pa1, bf16x8 pa2, bf16x8 pa3) {
#define TRRD(dst, off) asm volatile("ds_read_b64_tr_b16 %0, %1 offset:%2" : "=&v"(dst) : "v"(vb0), "i"(off) : "memory")
#define PV_D0(d0) do { s16x4 l0, l1, l2, l3, h0, h1, h2, h3; constexpr int b_ = VB * SHM_V + v_rd_off(d0, 0, 0); \
        TRRD(l0, b_); TRRD(h0, b_ + 2048); TRRD(l1, b_ + 4096); TRRD(h1, b_ + 6144); TRRD(l2, b_ + 8192); TRRD(h2, b_ + 10240); TRRD(l3, b_ + 12288); TRRD(h3, b_ + 14336); \
        asm volatile("s_waitcnt lgkmcnt(0)" ::: "memory"); SBAR();   \
        o[d0] = __builtin_amdgcn_mfma_f32_32x32x16_bf16(pa0, (bf16x8){l0[0], l0[1], l0[2], l0[3], h0[0], h0[1], h0[2], h0[3]}, o[d0], 0, 0, 0);   \
        o[d0] = __builtin_amdgcn_mfma_f32_32x32x16_bf16(pa1, (bf16x8){l1[0], l1[1], l1[2], l1[3], h1[0], h1[1], h1[2], h1[3]}, o[d0], 0, 0, 0);   \
        o[d0] = __builtin_amdgcn_mfma_f32_32x32x16_bf16(pa2, (bf16x8){l2[0], l2[1], l2[2], l2[3], h2[0], h2[1], h2[2], h2[3]}, o[d0], 0, 0, 0);   \
        o[d0] = __builtin_amdgcn_mfma_f32_32x32x16_bf16(pa3, (bf16x8){l3[0], l3[1], l3[2], l3[3], h3[0], h3[1], h3[2], h3[3]}, o[d0], 0, 0, 0); } while (0)
    PV_D0(0); PV_D0(1); PV_D0(2); PV_D0(3);
#undef PV_D0
#undef TRRD
}
struct BlockRef { const bf16* Q; const bf16* K; const bf16* V; h16* O; const unsigned long long* M; const h16* G; int P0; };
struct Seam { bf16x8 qr[8]; bf16x8 st_v0, st_v1, st_k0, st_k1; };
#define VMW() asm volatile("s_waitcnt vmcnt(0)" ::: "memory")
#define VMWN(n) asm volatile("s_waitcnt vmcnt(%0)" :: "i"(n) : "memory")
#define SLOAD_H(Kp, Vp, k0) do { const unsigned o0_ = ro0 + (unsigned)(k0) * PITCH, o1_ = o0_ + 32u * PITCH;     \
                         S.st_v0 = load8((Vp) + o0_); S.st_v1 = load8((Vp) + o1_); S.st_k0 = load8((Kp) + o0_); S.st_k1 = load8((Kp) + o1_); } while (0)
#define SWRITE_HK(bf) do { *(lbf16x8*)(K_lds + (bf) * SHM_K + kws) = S.st_k0; *(lbf16x8*)(K_lds + (bf) * SHM_K + kws + 32 * 256) = S.st_k1; } while (0)
#define SWRITE_HV(bf) do { *(lbf16x8*)(V_lds + (bf) * SHM_V + vst0) = S.st_v0; *(lbf16x8*)(V_lds + (bf) * SHM_V + vst1) = S.st_v1; } while (0)
#define SWRITE_H(bf) do { SWRITE_HV(bf); SWRITE_HK(bf); } while (0)
__device__ __forceinline__ void prime(const BlockRef& cur, lchar* lds, Seam& S, int wv) {
    const int tid = my_tid(wv);
    const int wid = __builtin_amdgcn_readfirstlane(tid >> 6), lane = tid & 63, r32 = lane & 31, hi = lane >> 5;
    const int sr = tid >> 4, sc = (tid & 15) * 8, kws = KSWZ(sr, sc * 2); lchar* K_lds = lds + 2 * SHM_V;
    const unsigned ro0 = (unsigned)(sr * PITCH + sc), qo = (unsigned)((wid * QBLK + r32) * PITCH + hi * 8);
    for (int d0 = 0; d0 < 8; ++d0) S.qr[d0] = load8(cur.Q + (qo + (unsigned)(d0 * 16)));
    SLOAD_H(cur.K, cur.V, 0); VMW(); SWRITE_HK(0);
    __syncthreads();
}
__device__ __forceinline__ void block(const BlockRef& cur, const BlockRef& nxt, lchar* lds, Seam& S, int wv) {
    const int tid = my_tid(wv);
    const int wid = __builtin_amdgcn_readfirstlane(tid >> 6), lane = tid & 63, r32 = lane & 31, hi = lane >> 5;
    const int NT = (cur.P0 + QB - 1) / KVBLK + 1;
    lchar* V_lds = lds; lchar* K_lds = lds + 2 * SHM_V;
    lfloat* ws = (lfloat*)(lds + 2 * SHM_V + 2 * SHM_K) + wid * 64; lfloat* li_l = ws, * al_l = ws + 32;
    float m_reg = -1e30f, l_reg = 0; f32x16 o[4] = {};
    const int sr = tid >> 4, sc = (tid & 15) * 8, vst0 = v_st(sr, sc), vst1 = v_st(32 + sr, sc), kws = KSWZ(sr, sc * 2);
    const int vb0 = (int)(unsigned)(uintptr_t)V_lds + v_rd_base(lane);
    const unsigned ro0 = (unsigned)(sr * PITCH + sc), qo = (unsigned)((wid * QBLK + r32) * PITCH + hi * 8);
    const bf16* Kh = cur.K; const bf16* Vh = cur.V;
    const unsigned mro = (unsigned)(wid * QBLK + r32) * 8u;
#define LDMASK(tile) (*(const unsigned long long*)((const char*)cur.M + (mro + (unsigned)(tile) * (unsigned)(L * 8))))
    unsigned long long mk;
#define RESC(a) do { if (__any((a) < 1.f)) { if (hi == 0) al_l[r32] = (a); asm volatile("s_waitcnt lgkmcnt(0)" ::: "memory");              \
                     for (int d_ = 0; d_ < 4; ++d_) for (int r = 0; r < 16; ++r) o[d_][r] *= al_l[crow(r, hi)]; } } while (0)
#define KBASE(t) ((t) * KVBLK)
    constexpr int NQL = 8;
#define SEAM_K0() do { VMWN(NQL); SWRITE_HK(0); SBAR(); } while (0)
    f32x16 pA0, pA1, pB0, pB1; float mnA, mnB, alA, alB; bf16x8 pa0, pa1, pa2, pa3;
    SWRITE_HV(0); SBAR();
    mk = LDMASK(0);
    if (NT > 1) { SLOAD_H(Kh, Vh, KBASE(1)); }
    mask_init(pA0, pA1, mk, hi); if (NT > 1) mk = LDMASK(1);
    SBAR(); qkt<0>(pA0, pA1, K_lds, r32, hi, S.qr);
    partialSM(pA0, pA1, m_reg, mnA, alA);
    if (NT > 1) { VMW(); SWRITE_H(1); }
    __syncthreads();
#define HALF_STEP(PX0, PX1, mnX, alX, PY0, PY1, alY, t, KB, VB, SB) do {                                                      \
        mask_init(PX0, PX1, mk, hi);                                       \
        SBAR(); qkt<KB>(PX0, PX1, K_lds, r32, hi, S.qr);                                                                      \
        if ((t) + 1 < NT) mk = LDMASK((t) + 1);                                                              \
        finishSM(PY0, PY1, alY, l_reg, pa0, pa1, pa2, pa3); SBAR();                                                           \
        if ((t) + 1 < NT) { SLOAD_H(Kh, Vh, KBASE((t) + 1)); SBAR(); }                                                        \
        pv_tile<VB>(o, vb0, pa0, pa1, pa2, pa3); partialSM(PX0, PX1, m_reg, mnX, alX);                                        \
        __syncthreads();                                                                                                      \
        if ((t) + 1 < NT) { VMW(); SWRITE_H(SB); }                                                                            \
        RESC(alX); __syncthreads(); } while (0)
    for (int t = 1; t + 1 < NT; t += 2) {
        HALF_STEP(pB0, pB1, mnB, alB, pA0, pA1, alA, t, 1, 0, 0);
        HALF_STEP(pA0, pA1, mnA, alA, pB0, pB1, alB, t + 1, 0, 1, 1);
    }
    const bool even = (NT & 1) == 0;
    if (even) { mask_init(pB0, pB1, mk, hi); SBAR(); qkt<1>(pB0, pB1, K_lds, r32, hi, S.qr); SBAR(); }
    SLOAD_H(nxt.K, nxt.V, 0); SBAR();
#pragma unroll
    for (int d0 = 0; d0 < 8; ++d0) S.qr[d0] = load8(nxt.Q + (qo + (unsigned)(d0 * 16)));
    SBAR();
    finishSM(pA0, pA1, alA, l_reg, pa0, pa1, pa2, pa3); SBAR();
    pv_tile<0>(o, vb0, pa0, pa1, pa2, pa3);
    if (even) { partialSM(pB0, pB1, m_reg, mnB, alB); __syncthreads(); RESC(alB);
        finishSM(pB0, pB1, alB, l_reg, pa0, pa1, pa2, pa3); SBAR(); pv_tile<1>(o, vb0, pa0, pa1, pa2, pa3); }
    SBAR(); SEAM_K0();
    if (hi == 0) li_l[r32] = l_reg; asm volatile("s_waitcnt lgkmcnt(0)" ::: "memory");
    float rli[16];
#pragma unroll
    for (int r = 0; r < 16; ++r) rli[r] = __builtin_amdgcn_rcpf(li_l[crow(r, hi)]);
    __syncthreads();
    {
        typedef __attribute__((address_space(3))) h16 lh16; typedef __attribute__((address_space(3))) h16x8 lh16x8_;
        lchar* ob = V_lds + wid * 4096;
#pragma unroll
        for (int half = 0; half < 2; ++half) {
#pragma unroll
            for (int r = 0; r < 16; ++r) { const int orow = crow(r, hi);
#pragma unroll
                for (int dd = 0; dd < 2; ++dd) *(lh16*)(ob + orow * 128 + (dd * 32 + r32) * 2) = (h16)(o[half * 2 + dd][r] * rli[r]); }
            asm volatile("s_waitcnt lgkmcnt(0)" ::: "memory");
#pragma unroll
            for (int i = 0; i < 4; ++i) { const int c = lane + 64 * i, row = c >> 3, c8 = c & 7;
                const h16x8 ov = *(const lh16x8_*)(ob + row * 128 + c8 * 16);
                const unsigned oo = (unsigned)((wid * QBLK + row) * PITCH + half * 64 + c8 * 8);
                const h16x8 gv = *(const h16x8*)(cur.G + oo);
                *(h16x8*)(cur.O + oo) = ov * gv; }
            asm volatile("s_waitcnt lgkmcnt(0)" ::: "memory");
        }
    }
    __syncthreads();
#undef LDMASK
#undef RESC
#undef KBASE
#undef SEAM_K0
#undef HALF_STEP
}
#undef VMW
#undef VMWN
#undef SLOAD_H
#undef SWRITE_HK
#undef SWRITE_HV
#undef SWRITE_H
#undef KSWZ
#undef SBAR
}

__device__ __forceinline__ att::BlockRef att_ref(const Params& P, unsigned char* ws, int item, int pass) {
    const int xcd = item & 7, kq = item >> 3, bh = (kq >> 2) * 8 + xcd, x = kq & 3, qb = pass ? 7 - x : x, b = bh >> 3, h = bh & 7;
    const size_t row0 = (size_t)b * L + (size_t)qb * 256;
    att::BlockRef r;
    r.Q = (const att::bf16*)(ws + WS_R1) + row0 * 1024 + h * 128; r.O = (h16*)(ws + WS_AO) + row0 * 1024 + h * 128;
    r.K = (const att::bf16*)(ws + WS_R2) + (size_t)b * L * 1024 + h * 128; r.V = (const att::bf16*)(ws + WS_R3) + (size_t)b * L * 1024 + h * 128;
    r.M = (const unsigned long long*)(ws + WS_MASK) + (size_t)b * 32 * L + (size_t)qb * 256;
    r.G = (const h16*)(ws + WS_R4) + row0 * 1024 + h * 128; r.P0 = qb * 256;
    return r;
}
__device__ __forceinline__ void p4_attn(const Params& P, unsigned char* lds, int blk, int nblk, int wv) {
    unsigned char* ws = opaque_ptr(P.ws);
    const int total = NB * 8 * 4;
    int it = blk; if (it >= total) return;
    int pass = 0;
    att::BlockRef cur = att_ref(P, ws, it, 0);
    att::Seam S;
    att::prime(cur, (att::lchar*)lds, S, wv);
    for (;;) {
        const bool more_pass = pass == 0, more_item = it + nblk < total, last = !more_pass && !more_item;
        int itn = it, passn = pass + 1;
        if (!more_pass) { passn = 0; itn = more_item ? it + nblk : it; }
        const att::BlockRef nxt = last ? cur : att_ref(P, ws, itn, passn);
        att::block(cur, nxt, (att::lchar*)lds, S, wv);
        if (last) break;
        cur = nxt; it = itn; pass = passn;
    }
}

__device__ __forceinline__ void p8_ret_naive(const Params& P, unsigned char* lds, int blk, int nblk, int wv) {
    const int tid = my_tid(wv);
    float* qk = (float*)lds;
    const h16* RQ = (const h16*)(P.ws + WS_R1); const h16* RK = (const h16*)(P.ws + WS_R2); h16* RV = (h16*)(P.ws + WS_R4);
    const int j = tid >> 2, iq = tid & 3;
    for (int it = blk; it < 256; it += nblk) {
        const int b = it >> 4, h = (it >> 2) & 3, sl = it & 3;
        const float gamma = 1.0f - exp2f(-5.0f - (float)h);
        float S[64];
#pragma unroll
        for (int i = 0; i < 64; ++i) S[i] = 0.f;
        const int col = tid & 255;
        const h16* src = (tid < 256 ? RQ : RK) + (size_t)b * L * 1024 + h * 256 + col;
        float* dst = qk + (tid >> 8) * 272 + (col >> 6) * 68 + (col & 63);
        h16* vp = RV + (size_t)b * L * 2048 + h * 512 + sl * 128 + j;
        for (int t0 = 0; t0 < L; t0 += 16) {
            __syncthreads();
            h16 vv[16];
#pragma unroll
            for (int tt = 0; tt < 16; ++tt) { dst[tt * 544] = (float)src[(size_t)(t0 + tt) * 1024]; vv[tt] = vp[(size_t)(t0 + tt) * 2048]; }
            __syncthreads();
#pragma unroll
            for (int tt = 0; tt < 16; ++tt) {
                const f32x4* qp = (const f32x4*)(qk + tt * 544 + iq * 68); const f32x4* kp = (const f32x4*)(qk + tt * 544 + 272 + iq * 68);
                const float v = (float)vv[tt]; float o = 0.f;
#pragma unroll
                for (int i4 = 0; i4 < 16; ++i4) { const f32x4 q4 = qp[i4], k4 = kp[i4];
#pragma unroll
                    for (int e = 0; e < 4; ++e) { S[i4 * 4 + e] = fmaf(gamma, S[i4 * 4 + e], k4[e] * v); o = fmaf(q4[e], S[i4 * 4 + e], o); } }
                o += __shfl_xor(o, 1); o += __shfl_xor(o, 2);
                if (iq == 0) vp[(size_t)(t0 + tt) * 2048] = (h16)o;
            }
        }
    }
}


namespace ret {
typedef __attribute__((address_space(3))) unsigned char lch;
typedef __attribute__((address_space(3))) h16x8 lh16x8;
typedef __attribute__((address_space(3))) h16x4 lh16x4;
typedef __attribute__((address_space(3))) u32x4 lu32x4;
typedef short v4i16 __attribute__((ext_vector_type(4)));
typedef __attribute__((address_space(3))) v4i16 lv4i16;
constexpr int SKB = 544, SVB = 288, SSB = 544;
constexpr int OFF_K = 0, OFF_V = 64 * SKB, OFF_S = OFF_V + 64 * SVB, LDS_RET = OFF_S + 128 * SSB;
__device__ __forceinline__ h16x4 trrd(const lch* p) { return __builtin_bit_cast(h16x4, __builtin_amdgcn_ds_read_tr16_b64_v4i16((lv4i16*)p)); }
__device__ __forceinline__ h16x8 cat8(h16x4 a, h16x4 b) { return __builtin_shufflevector(a, b, 0, 1, 2, 3, 4, 5, 6, 7); }
}
#define P8_GATE(m_, ro_) do { const char* gp_ = (const char*)(RG + ((size_t)b * L + (size_t)(m_) * 64) * 2048 + h * 512 + sl * 128) + (ro_); gt0 = *(const h16x8*)gp_; gt1 = *(const h16x8*)(gp_ + 16); } while (0)
#define P8_XSLD(m_, rw_) do { _Pragma("unroll") for (int s_ = 0; s_ < 4; ++s_) xsv[s_] = __hip_atomic_load((const unsigned long long*)((const char*)(XS + (size_t)(grp0 + (m_)) * 256) + (unsigned)(s_ * 512 + (rw_) * 8)), __ATOMIC_RELAXED, __HIP_MEMORY_SCOPE_AGENT); } while (0)
#define P8_XSOK() (((unsigned)xsv[0] != 0xffffffffu) && ((unsigned)xsv[1] != 0xffffffffu) && ((unsigned)xsv[2] != 0xffffffffu) && ((unsigned)xsv[3] != 0xffffffffu))
#define P8_WAIT(m_, rw_) do { unsigned sp_ = 0u; while (!__all(P8_XSOK())) { __builtin_amdgcn_s_sleep(1); P8_XSLD(m_, rw_); \
        if (++sp_ > (1u << 20)) { if (lane == 0) __hip_atomic_store((unsigned*)(ws + WS_BAR) + XB_TMO_W, 1u, __ATOMIC_RELAXED, __HIP_MEMORY_SCOPE_AGENT); break; } } } while (0)
#define P8_STATS(m_) do { P8_WAIT(m_, lO0); float S1_ = 0.f, S2_ = 0.f;   \
        _Pragma("unroll") for (int s_ = 0; s_ < 4; ++s_) { S1_ += __uint_as_float((unsigned)xsv[s_]); S2_ += __uint_as_float((unsigned)(xsv[s_] >> 32)); } \
        const float mu_ = S1_ * (1.0f / 512.0f); const float var_ = fmaxf(S2_ * (1.0f / 512.0f) - mu_ * mu_, 0.f); const float rs_ = rsqrtf(var_ + EPS); MR[lO0] = (f32x2){rs_, -mu_ * rs_}; } while (0)
#define P8_FINAL(m_, rw_, ro_, lo_) do { const int mm_ = (m_); const f32x2 mr_ = MR[rw_]; const float rs_ = mr_[0], nb_ = mr_[1]; \
        const lch* op_ = OT + (mm_ & 1) * OT_BYTES + (lo_); const h16x8 o0_ = *(const lh16x8*)op_, o1_ = *(const lh16x8*)(op_ + 16); h16x8 y0_, y1_; \
        _Pragma("unroll") for (int e = 0; e < 8; ++e) { y0_[e] = (h16)(fmaf((float)o0_[e], rs_, nb_) * (float)gt0[e]); y1_[e] = (h16)(fmaf((float)o1_[e], rs_, nb_) * (float)gt1[e]); } \
        char* dp_ = (char*)(vg + (size_t)mm_ * 64 * 2048) + (ro_); *(h16x8*)dp_ = y0_; *(h16x8*)(dp_ + 16) = y1_; } while (0)
#define XB_TMO_W 128
__device__ __forceinline__ void p8_retention(const Params& P, unsigned char* lds_, int blk, int nblk, int wv) {
    using namespace ret;
    const int tid = my_tid(wv), wid = __builtin_amdgcn_readfirstlane(tid >> 6), lane = tid & 63, c16 = lane & 15, g = lane >> 4, q4 = c16 >> 2, p4 = c16 & 3;
    const int it = wid & 3, dh = wid >> 2;
    unsigned char* ws = opaque_ptr(P.ws);
    lch* Kc = (lch*)lds_ + OFF_K; lch* Vc = (lch*)lds_ + OFF_V; lch* St = (lch*)lds_ + OFF_S;
    const h16* RQ = (const h16*)(ws + WS_R1); const h16* RK = (const h16*)(ws + WS_R2); h16* RV = (h16*)(ws + WS_R4);
    const bool fusedgn = (nblk == 256);
    const h16* RG = (const h16*)(ws + WS_RG);
    unsigned long long* XS = (unsigned long long*)(ws + WS_KIDXN);
    typedef __attribute__((address_space(3))) f32x2 lf32x2;
    lf32x2* PS = (lf32x2*)((lch*)lds_ + LDS_RET);
    for (int item = blk; item < 256; item += nblk) {
        const int b = item >> 4, h = (item >> 2) & 3, sl = item & 3;
        const int grp0 = (b * 4 + h) * 32;
        constexpr int OT_PITCH = 272, OT_BYTES = 64 * OT_PITCH;
        lch* OT = (lch*)lds_ + LDS_RET + 1024;
        lf32x2* MR = (lf32x2*)(OT + 2 * OT_BYTES);
        h16x8 gt0 = (h16x8){0, 0, 0, 0, 0, 0, 0, 0}, gt1 = gt0;
        const float lgam = log2f(1.0f - exp2f(-5.0f - (float)h));
        const float gamma64 = exp2f(64.0f * lgam);
        f32x4 state[16];
#pragma unroll
        for (int d = 0; d < 16; ++d) state[d] = (f32x4){0.f, 0.f, 0.f, 0.f};
        __syncthreads();
        { unsigned zz = 0u; asm volatile("" : "+v"(zz));
          for (int i = tid; i < 128 * SSB / 16; i += NTHREADS) ((lu32x4*)St)[i] = (u32x4){zz, zz, zz, zz}; }
        const h16* kg = RK + (size_t)b * L * 1024 + h * 256; const h16* vg = RV + (size_t)b * L * 2048 + h * 512 + sl * 128;
        h16x8 kreg[4], vreg[2];
        const unsigned qoff = (unsigned)((16 * it + c16) * 1024 + 8 * g) * 2u, ooff = (unsigned)((16 * it + c16) * 2048 + 64 * dh + 4 * g) * 2u;
        unsigned ko[4], vo[2];
#pragma unroll
        for (int i = 0; i < 4; ++i) { const int c = tid + NTHREADS * i; ko[i] = (unsigned)((c >> 5) * 1024 + (c & 31) * 8) * 2u; }
#pragma unroll
        for (int i = 0; i < 2; ++i) { const int c = tid + NTHREADS * i; vo[i] = (unsigned)((c >> 4) * 2048 + (c & 15) * 8) * 2u; }
#pragma unroll
        for (int i = 0; i < 4; ++i) kreg[i] = *(const h16x8*)((const char*)kg + ko[i]);
#pragma unroll
        for (int i = 0; i < 2; ++i) vreg[i] = *(const h16x8*)((const char*)vg + vo[i]);
#pragma unroll
        for (int i = 0; i < 4; ++i) { const int c = tid + NTHREADS * i; *(lh16x8*)(Kc + (c >> 5) * SKB + (c & 31) * 16) = kreg[i]; }
#pragma unroll
        for (int i = 0; i < 2; ++i) { const int c = tid + NTHREADS * i; *(lh16x8*)(Vc + (c >> 4) * SVB + (c & 15) * 16) = vreg[i]; }
        h16x8 Qn[8];
#pragma unroll
        for (int s = 0; s < 8; ++s) Qn[s] = *(const h16x8*)((const char*)(RQ + (size_t)b * L * 1024 + h * 256) + (qoff + (unsigned)(64 * s)));
        __syncthreads();
        for (int n = 0; n < L / 64; ++n) {
            const size_t row0 = (size_t)b * L + (size_t)n * 64;
            const int nn = (n + 1 < L / 64) ? n + 1 : n;
            unsigned kO[4] = {ko[0], ko[1], ko[2], ko[3]}, vO[2] = {vo[0], vo[1]}, qO = qoff, oO = ooff;
            asm volatile("" : "+v"(kO[0]), "+v"(kO[1]), "+v"(kO[2]), "+v"(kO[3]), "+v"(vO[0]), "+v"(vO[1]), "+v"(qO), "+v"(oO));
            int gO = g, cO = c16; asm volatile("" : "+v"(gO), "+v"(cO)); const int q4O = cO >> 2, p4O = cO & 3;
            float lg = lgam; asm volatile("" : "+v"(lg));
            const float xi = __builtin_amdgcn_exp2f((float)(16 * it + cO + 1) * lg);
            h16x8 Qf[8];
#pragma unroll
            for (int s = 0; s < 8; ++s) Qf[s] = Qn[s];
            unsigned long long xsv[4] = {0ull, 0ull, 0ull, 0ull};
            const int tF_ = my_tid(wv); const unsigned rowF = (unsigned)(tF_ >> 3), roF = rowF * 4096u + (unsigned)(tF_ & 7) * 32u, loF = rowF * (unsigned)OT_PITCH + (unsigned)(tF_ & 7) * 32u;
            if (fusedgn && n > 0) { P8_GATE(n - 1, roF); }
#pragma unroll
            for (int i = 0; i < 4; ++i) kreg[i] = *(const h16x8*)((const char*)(kg + (size_t)nn * 64 * 1024) + kO[i]);
#pragma unroll
            for (int i = 0; i < 2; ++i) vreg[i] = *(const h16x8*)((const char*)(vg + (size_t)nn * 64 * 2048) + vO[i]);
            h16x8 Pf[2];
#pragma unroll
            for (int ks = 0; ks < 2; ++ks)
#pragma unroll
                for (int e = 0; e < 8; ++e) Pf[ks][e] = (h16)0.f;
#pragma unroll
            for (int jt = 0; jt < 4; ++jt) {
                if (jt <= it) {
                    f32x4 S = (f32x4){0.f, 0.f, 0.f, 0.f}, Sb = S;
#pragma unroll
                    for (int s4 = 0; s4 < 8; s4 += 4) {
                        h16x8 A4[4];
#pragma unroll
                        for (int s = 0; s < 4; ++s) A4[s] = *(const lh16x8*)(Kc + (16 * jt + c16) * SKB + (32 * (s4 + s) + 8 * g) * 2);
                        __builtin_amdgcn_sched_barrier(0);
#pragma unroll
                        for (int s = 0; s < 4; s += 2) { S = __builtin_amdgcn_mfma_f32_16x16x32_f16(A4[s], Qf[s4 + s], S, 0, 0, 0); Sb = __builtin_amdgcn_mfma_f32_16x16x32_f16(A4[s + 1], Qf[s4 + s + 1], Sb, 0, 0, 0); }
                        __builtin_amdgcn_sched_barrier(0);
                    }
                    S = S + Sb;
#pragma unroll
                    for (int e = 0; e < 4; ++e) { const int d = (16 * it + cO) - (16 * jt + 4 * gO + e); const float f = (d >= 0) ? __builtin_amdgcn_exp2f((float)d * lg) : 0.f; Pf[jt >> 1][(jt & 1) * 4 + e] = (h16)(S[e] * f); }
                }
            }
            int lO0 = lane; asm volatile("" : "+v"(lO0));
            if (fusedgn && n > 0 && wid == 0) { P8_XSLD(n - 1, lO0); }
            f32x4 acc[4];
#pragma unroll
            for (int dt = 0; dt < 4; ++dt) acc[dt] = (f32x4){0.f, 0.f, 0.f, 0.f};
#pragma unroll
            for (int s2 = 0; s2 < 8; ++s2) {
                h16x8 A4[4];
#pragma unroll
                for (int dt = 0; dt < 4; ++dt) A4[dt] = *(const lh16x8*)(St + (16 * (4 * dh + dt) + c16) * SSB + (32 * s2 + 8 * g) * 2);
                __builtin_amdgcn_sched_barrier(0);
#pragma unroll
                for (int dt = 0; dt < 4; ++dt) acc[dt] = __builtin_amdgcn_mfma_f32_16x16x32_f16(A4[dt], Qf[s2], acc[dt], 0, 0, 0);
                __builtin_amdgcn_sched_barrier(0);
            }
#pragma unroll
            for (int dt = 0; dt < 4; ++dt) acc[dt] = acc[dt] * xi;
#pragma unroll
            for (int ks = 0; ks < 2; ++ks) {
                if (2 * ks <= it) {
                    h16x8 A4[4];
#pragma unroll
                    for (int dt = 0; dt < 4; ++dt) { const lch* vp = Vc + (32 * ks + 4 * gO + q4O) * SVB + (16 * (4 * dh + dt) + 4 * p4O) * 2; A4[dt] = cat8(trrd(vp), trrd(vp + 16 * SVB)); }
                    __builtin_amdgcn_sched_barrier(0);
#pragma unroll
                    for (int dt = 0; dt < 4; ++dt) acc[dt] = __builtin_amdgcn_mfma_f32_16x16x32_f16(A4[dt], Pf[ks], acc[dt], 0, 0, 0);
                    __builtin_amdgcn_sched_barrier(0);
                }
            }
            if (!fusedgn) {
#pragma unroll
                for (int dt = 0; dt < 4; ++dt) *(h16x4*)((char*)(vg + (size_t)n * 64 * 2048) + (oO + (unsigned)(32 * dt))) = pack4(acc[dt]);
            } else {
                float s1 = 0.f, s2 = 0.f;
#pragma unroll
                for (int dt = 0; dt < 4; ++dt)
#pragma unroll
                    for (int e = 0; e < 4; ++e) { s1 += acc[dt][e]; s2 = fmaf(acc[dt][e], acc[dt][e], s2); }
                s1 = fq_sum(s1); s2 = fq_sum(s2);
                const int tk = (int)(oO >> 12);
                if ((oO & 24u) == 0u) PS[dh * 64 + tk] = (f32x2){s1, s2};
                { lch* wp_ = OT + (n & 1) * OT_BYTES + (unsigned)tk * (unsigned)OT_PITCH + (oO & 4095u);
#pragma unroll
                  for (int dt = 0; dt < 4; ++dt) *(lh16x4*)(wp_ + 32 * dt) = pack4(acc[dt]); }
            }
#pragma unroll
            for (int s = 0; s < 8; ++s) Qn[s] = *(const h16x8*)((const char*)(RQ + ((size_t)b * L + (size_t)nn * 64) * 1024 + h * 256) + (qO + (unsigned)(64 * s)));
            h16x8 Bv[2];
#pragma unroll
            for (int ks = 0; ks < 2; ++ks) { const lch* vp = Vc + (32 * ks + 8 * gO + q4O) * SVB + (16 * wid + 4 * p4O) * 2; h16x8 zf;
#pragma unroll
                for (int e = 0; e < 8; ++e) zf[e] = (h16)__builtin_amdgcn_exp2f((float)(63 - (32 * ks + 8 * gO + e)) * lg);
                Bv[ks] = cat8(trrd(vp), trrd(vp + 4 * SVB)) * zf; }
#pragma unroll
            for (int d4 = 0; d4 < 16; d4 += 2) {
                h16x8 A4[4];
#pragma unroll
                for (int j = 0; j < 2; ++j)
#pragma unroll
                    for (int ks = 0; ks < 2; ++ks) { const lch* kp = Kc + (32 * ks + 8 * gO + q4O) * SKB + (16 * (d4 + j) + 4 * p4O) * 2; A4[j * 2 + ks] = cat8(trrd(kp), trrd(kp + 4 * SKB)); }
#pragma unroll
                for (int j = 0; j < 2; ++j) state[d4 + j] = state[d4 + j] * gamma64;
                __builtin_amdgcn_sched_barrier(0);
#pragma unroll
                for (int ks = 0; ks < 2; ++ks)
#pragma unroll
                    for (int j = 0; j < 2; ++j) state[d4 + j] = __builtin_amdgcn_mfma_f32_16x16x32_f16(A4[j * 2 + ks], Bv[ks], state[d4 + j], 0, 0, 0);
                __builtin_amdgcn_sched_barrier(0);
            }
            if (fusedgn && n > 0 && wid == 0) { P8_STATS(n - 1); }
            __syncthreads();
            if (fusedgn && n > 0) { P8_FINAL(n - 1, rowF, roF, loF); }
            if (fusedgn && wid == 0) {
                int lO = lane; asm volatile("" : "+v"(lO));
                const f32x2 pa = PS[lO], pb = PS[64 + lO];
                const unsigned long long pk = (unsigned long long)__float_as_uint(pa[0] + pb[0]) | ((unsigned long long)__float_as_uint(pa[1] + pb[1]) << 32);
                __hip_atomic_store((unsigned long long*)((char*)(XS + ((size_t)(grp0 + n) * 4 + sl) * 64) + (unsigned)(lO * 8)), pk, __ATOMIC_RELAXED, __HIP_MEMORY_SCOPE_AGENT);
            }
#pragma unroll
            for (int dkt = 0; dkt < 16; ++dkt) *(lh16x4*)(St + (16 * wid + c16) * SSB + (16 * dkt + 4 * g) * 2) = pack4(state[dkt]);
#pragma unroll
            for (int i = 0; i < 4; ++i) { const int c = tid + NTHREADS * i; *(lh16x8*)(Kc + (c >> 5) * SKB + (c & 31) * 16) = kreg[i]; }
#pragma unroll
            for (int i = 0; i < 2; ++i) { const int c = tid + NTHREADS * i; *(lh16x8*)(Vc + (c >> 4) * SVB + (c & 15) * 16) = vreg[i]; }
            __syncthreads();
        }
        if (fusedgn) {
            const int tF_ = my_tid(wv); const unsigned rowF = (unsigned)(tF_ >> 3), roF = rowF * 4096u + (unsigned)(tF_ & 7) * 32u, loF = rowF * (unsigned)OT_PITCH + (unsigned)(tF_ & 7) * 32u;
            unsigned long long xsv[4] = {0ull, 0ull, 0ull, 0ull}; int lO0 = lane; asm volatile("" : "+v"(lO0)); P8_GATE(L / 64 - 1, roF);
            if (wid == 0) { P8_XSLD(L / 64 - 1, lO0); P8_STATS(L / 64 - 1); }
            __syncthreads();
            P8_FINAL(L / 64 - 1, rowF, roF, loF);
        }
    }
#undef P8_FINAL
#undef P8_STATS
#undef P8_XSLD
#undef P8_GATE
#undef P8_WAIT
#undef P8_XSOK
}

__device__ __forceinline__ void p9_gnorm(const Params& P, int blk, int nblk, int wv) {
    const int tid = my_tid(wv), wid = tid >> 6, lane = tid & 63;
    unsigned char* ws = opaque_ptr(P.ws);
    h16* RO = (h16*)(ws + WS_R4); const h16* RG = (const h16*)(ws + WS_RG);
    const int gw = blk * NWAVES + wid, ngw = nblk * NWAVES;
    for (int t0 = gw; t0 < T; t0 += 2 * ngw) {
        h16x8 xv[2][4], gv[2][4];
#pragma unroll
        for (int k = 0; k < 2; ++k) { const int t = (t0 + k * ngw < T) ? t0 + k * ngw : t0;
#pragma unroll
            for (int h = 0; h < 4; ++h) { const size_t o = (size_t)t * 2048 + h * 512 + lane * 8; xv[k][h] = *(const h16x8*)(RO + o); gv[k][h] = *(const h16x8*)(RG + o); } }
#pragma unroll
        for (int k = 0; k < 2; ++k) { const int t = t0 + k * ngw;
#pragma unroll
            for (int h = 0; h < 4; ++h) {
                float v[8]; float s = 0.f;
#pragma unroll
                for (int e = 0; e < 8; ++e) { v[e] = (float)xv[k][h][e]; s += v[e]; }
                const float mu = wave_sum_dpp(s) * (1.0f / 512.0f); float q = 0.f;
#pragma unroll
                for (int e = 0; e < 8; ++e) { v[e] -= mu; q += v[e] * v[e]; }
                const float rstd = rsqrtf(wave_sum_dpp(q) * (1.0f / 512.0f) + EPS);
                h16x8 y;
#pragma unroll
                for (int e = 0; e < 8; ++e) y[e] = (h16)(v[e] * rstd * (float)gv[k][h][e]);
                if (t < T) *(h16x8*)(RO + (size_t)t * 2048 + h * 512 + lane * 8) = y;
            } }
    }
}

__device__ __forceinline__ void p12_final(const Params& P, int blk, int nblk, int wv) {
    const int tid = my_tid(wv), wid = tid >> 6, lane = tid & 63;
    unsigned char* ws = opaque_ptr(P.ws);
    const float* sq = (const float*)(ws + WS_SQH) + (size_t)3 * T * 16; const f32x4* g4 = (const f32x4*)P.in[18]; const h16* H4 = (const h16*)(ws + WS_R1);
    const int gw = blk * NWAVES + wid, ngw = nblk * NWAVES;
    for (int r0 = gw; r0 < T; r0 += 4 * ngw) {
        h16x8 hv[4][2]; f32x4 qv[4][4];
#pragma unroll
        for (int k = 0; k < 4; ++k) { const int r = r0 + k * ngw; if (r < T) {
#pragma unroll
            for (int j = 0; j < 2; ++j) hv[k][j] = *(const h16x8*)(H4 + (size_t)r * 1024 + (lane + 64 * j) * 8);
#pragma unroll
            for (int j = 0; j < 4; ++j) qv[k][j] = ((const f32x4*)(sq + (size_t)r * 16))[j]; } }
#pragma unroll
        for (int k = 0; k < 4; ++k) { const int r = r0 + k * ngw; if (r < T) {
            float s = 0.f;
#pragma unroll
            for (int j = 0; j < 4; ++j) s += (qv[k][j][0] + qv[k][j][1]) + (qv[k][j][2] + qv[k][j][3]);
            const float rstd = rsqrtf(s * (1.0f / 1024.0f) + EPS);
            f32x4* orow = (f32x4*)(P.out + (size_t)r * 1024);
#pragma unroll
            for (int j = 0; j < 2; ++j) { const int c4 = (lane + 64 * j) * 2; const f32x4 ga = g4[c4], gb = g4[c4 + 1]; f32x4 a, b2;
#pragma unroll
                for (int e = 0; e < 4; ++e) { a[e] = (float)hv[k][j][e] * rstd * ga[e]; b2[e] = (float)hv[k][j][4 + e] * rstd * gb[e]; }
                orow[c4] = a; orow[c4 + 1] = b2; } } }
    }
}

#define XB_TMO      128
#define XB_XCNT(j)  (256  + 64 * (j))
#define XB_XSUB(j)  (1280 + 64 * (j))
#define XB_XGEN(j)  (2304 + 64 * (j))
#define XB_TOP      3328
#define XB_TOPGEN   3392
#define XCD_BAR_WORDS 3456
#define XB_SPIN_CAP (1u << 18)
__device__ __forceinline__ unsigned xb_ld(unsigned* p)              { return __hip_atomic_load(p, __ATOMIC_RELAXED, __HIP_MEMORY_SCOPE_AGENT); }
__device__ __forceinline__ unsigned xb_add(unsigned* p, unsigned v) { return __hip_atomic_fetch_add(p, v, __ATOMIC_RELAXED, __HIP_MEMORY_SCOPE_AGENT); }
__device__ __forceinline__ unsigned xb_xcc_id() { return (unsigned)__builtin_amdgcn_s_getreg((3 << 11) | 20) & 0xFu; }
#define XB_SPIN(cond, bar) do { unsigned _sp = 0; while (cond) { __builtin_amdgcn_s_sleep(1); \
    if ((++_sp & 255u) == 0u) { if (xb_ld(&(bar)[XB_TMO])) break; if (_sp > XB_SPIN_CAP) { atomicAdd(&(bar)[XB_TMO], 1u); break; } } } } while (0)
typedef volatile __attribute__((address_space(3))) unsigned lvu32;
__device__ __forceinline__ void xcd_barrier_complete(unsigned* bar, unsigned x, unsigned G, unsigned& nloc, unsigned& nx) {
    unsigned sum, cnt, mine, sp = 0u;
    for (;;) {
        sum = 0u; cnt = 0u; mine = 0u;
#pragma unroll
        for (unsigned j = 0; j < 16; ++j) { const unsigned c = xb_ld(&bar[XB_XCNT(j)]); sum += c; cnt += (c > 0u) ? 1u : 0u; mine = (j == x) ? c : mine; }
        if (sum == G) break;
        __builtin_amdgcn_s_sleep(1);
        if ((++sp & 255u) == 0u) { if (xb_ld(&bar[XB_TMO])) break; if (sp > XB_SPIN_CAP) { atomicAdd(&bar[XB_TMO], 1u); break; } }
    }
    nloc = mine > 0u ? mine : 1u; nx = cnt > 0u ? cnt : 1u;
}
__device__ __forceinline__ void xcd_barrier(unsigned* bar_, unsigned x_, lvu32* st, unsigned G, int wv) {
    unsigned x = x_; asm volatile("" : "+s"(x));
    unsigned* bar = opaque_ptr(bar_);
    asm volatile("s_waitcnt vmcnt(0)" ::: "memory");
    __syncthreads();
    if (my_tid(wv) == 0) {
        __builtin_amdgcn_s_waitcnt(0);
        unsigned nloc = st[0], nx = st[1];
        if (nloc == 0u) { xcd_barrier_complete(bar, x, G, nloc, nx); st[0] = nloc; st[1] = nx; }
        const unsigned old = xb_add(&bar[XB_XSUB(x)], 1u);
        const unsigned gen = old / nloc;
        if (old + 1u == (gen + 1u) * nloc) {
            __builtin_amdgcn_fence(__ATOMIC_RELEASE, "agent");
            asm volatile("s_waitcnt vmcnt(0)" ::: "memory");
            const unsigned og = xb_add(&bar[XB_TOP], 1u);
            const unsigned tg = og / nx;
            if (og + 1u == (tg + 1u) * nx) xb_add(&bar[XB_TOPGEN], 1u);
            else XB_SPIN(xb_ld(&bar[XB_TOPGEN]) == tg, bar);
            __builtin_amdgcn_fence(__ATOMIC_ACQUIRE, "agent");
            xb_add(&bar[XB_XGEN(x)], 1u);
            asm volatile("s_waitcnt vmcnt(0)" ::: "memory");
        } else {
            XB_SPIN(xb_ld(&bar[XB_XGEN(x)]) == gen, bar);
            __builtin_amdgcn_fence(__ATOMIC_ACQUIRE, "agent");
            asm volatile("s_waitcnt vmcnt(0)" ::: "memory");
        }
    }
    __syncthreads();
}

__device__ __forceinline__ void run_gemm_job(const Params& P, unsigned char* lds, int ph, int j, int blk, int nblk, int wv) {
    unsigned char* ws = opaque_ptr(P.ws);
    float* SQKV = (float*)(ws + WS_SQKV); float* SQQ = (float*)(ws + WS_SQQ); float* SQH = (float*)(ws + WS_SQH);
    int kind = 0; Gemm g; g.M = T; g.A = nullptr; g.Bt = nullptr; g.lda = g.ldb = g.N = g.K = 0;
    h16 *h0 = nullptr, *h1 = nullptr; const h16* ch0 = nullptr; const h16* ch1 = nullptr; const float* cf0 = nullptr; float* f0 = nullptr; float* f1 = nullptr; int i0 = 0, i1 = 0, i2 = 0, i3 = 0, i4 = 0; float x0 = 0.f;
    if (ph == 1) { kind = 0; g.A = (const h16*)(ws + WS_R1); g.Bt = (const h16*)(ws + WS_WAIN); g.lda = 1024; g.ldb = 1024; g.N = 1792; g.K = 1024; }
    else if (ph == 2) {
        kind = 1;
        if (j == 0) { g.A = (const h16*)(ws + WS_CQX); g.Bt = (const h16*)(ws + WS_WQ); g.lda = 512; g.ldb = 384; g.N = 1536; g.K = 384;
                      cf0 = SQQ; i0 = 8; x0 = 1.0f / 384.0f; h0 = (h16*)(ws + WS_R1); h1 = (h16*)(ws + WS_QIDX); i1 = 1024; i2 = 512; i3 = 1; i4 = 0; }
        else if (j == 1) { g.A = (const h16*)(ws + WS_CKV); g.Bt = (const h16*)(ws + WS_WKV); g.lda = 256; g.ldb = 256; g.N = 2048; g.K = 256;
                      cf0 = SQKV; i0 = 4; x0 = 1.0f / 256.0f; h0 = (h16*)(ws + WS_R2); h1 = (h16*)(ws + WS_R3); i1 = 1024; i2 = 1024; i3 = 1; i4 = 1; }
        else { g.A = (const h16*)(ws + WS_PH0); g.Bt = (const h16*)(ws + WS_WPLE); g.lda = 256; g.ldb = 256; g.N = 1024; g.K = 256;
                      cf0 = nullptr; i0 = 0; x0 = 0.f; h0 = (h16*)(ws + WS_R5); h1 = nullptr; i1 = 1024; i2 = 1024; }
    }
    else if (ph == 5) { kind = 2; g.A = (const h16*)(ws + WS_AO); g.Bt = (const h16*)(ws + WS_WAOUT); g.lda = 1024; g.ldb = 1024; g.N = 1024; g.K = 1024;
                      cf0 = P.in[0]; ch0 = nullptr; h0 = (h16*)(ws + WS_R2); f1 = SQH; }
    else if (ph == 6) { kind = 3; g.A = (const h16*)(ws + WS_R2); g.Bt = (const h16*)(ws + WS_WPG); g.lda = 1024; g.ldb = 1024; g.N = 1024; g.K = 1024;
                      ch1 = (const h16*)(ws + WS_R2); ch0 = (const h16*)(ws + WS_R5); h0 = (h16*)(ws + WS_R3); cf0 = SQH; f1 = SQH + (size_t)T * 16; }
    else if (ph == 7) { kind = 4; g.A = (const h16*)(ws + WS_R3); g.Bt = (const h16*)(ws + WS_WRIN); g.lda = 1024; g.ldb = 1024; g.N = 6144; g.K = 1024; }
    else if (ph == 10) {
        if (j == 0) { kind = 2; g.A = (const h16*)(ws + WS_R4); g.Bt = (const h16*)(ws + WS_WROUT); g.lda = 2048; g.ldb = 2048; g.N = 1024; g.K = 2048;
                      cf0 = nullptr; ch0 = (const h16*)(ws + WS_R3); h0 = (h16*)(ws + WS_R2); f1 = SQH + (size_t)2 * T * 16; }
        else { kind = 1; g.A = (const h16*)(ws + WS_PH1); g.Bt = (const h16*)(ws + WS_WPLE) + (size_t)1024 * 256; g.lda = 256; g.ldb = 256; g.N = 1024; g.K = 256;
                      cf0 = nullptr; i0 = 0; x0 = 0.f; h0 = (h16*)(ws + WS_R1); h1 = nullptr; i1 = 1024; i2 = 1024; }
    }
    else { kind = 5; g.A = (const h16*)(ws + WS_R2); g.Bt = (const h16*)(ws + WS_WPG) + (size_t)1024 * 1024; g.lda = 1024; g.ldb = 1024; g.N = 1024; g.K = 1024;
                      ch1 = (const h16*)(ws + WS_R2); ch0 = (const h16*)(ws + WS_R1); h0 = (h16*)(ws + WS_R1); cf0 = SQH + (size_t)2 * T * 16; f1 = SQH + (size_t)3 * T * 16; }
    switch (kind) {
        case 0: { EpiInA E{(h16*)(ws + WS_CKV), (h16*)(ws + WS_CQX), (h16*)(ws + WS_R4), SQKV, SQQ, nullptr, 0, 0.f}; gemm_run(lds, g, E, blk, nblk, wv); break; }
        case 1: { EpiScale E{cf0, i0, x0, h0, h1, 4, i1, i2, i3, i4}; gemm_run(lds, g, E, blk, nblk, wv); break; }
        case 2: { EpiRes E{cf0, ch0, h0, f1, nullptr, 0, 0.f}; gemm_run(lds, g, E, blk, nblk, wv); break; }
        case 3: { EpiPle E{ch1, ch0, h0, cf0, f1, 16, 1.0f / 1024.0f}; gemm_run(lds, g, E, blk, nblk, wv); break; }
        case 5: { EpiPleFinal E{ch1, ch0, cf0, 16, 1.0f / 1024.0f, P.in[18], P.out, (unsigned*)(SQH + (size_t)3 * T * 16), (unsigned*)(ws + WS_BAR + 16384), (unsigned*)(ws + WS_BAR) + XB_TMO}; gemm_run(lds, g, E, blk, nblk, wv); break; }
        default: { EpiInR E{SQH + (size_t)T * 16, (const f32x2*)(ws + WS_SINCOS), (h16*)(ws + WS_R1), (h16*)(ws + WS_R2), (h16*)(ws + WS_R4), (h16*)(ws + WS_RG), 16, 1.0f / 1024.0f}; gemm_run(lds, g, E, blk, nblk, wv); break; }
    }
}

__global__ void __launch_bounds__(NTHREADS, 2) mk_fwd(Params P_) {
    extern __shared__ __attribute__((aligned(16))) unsigned char lds[];
    cg::grid_group grid = cg::this_grid();
    const int wv = __builtin_amdgcn_readfirstlane((int)(threadIdx.x >> 6));
    lvu32* bst = (lvu32*)(lds + LDS_BYTES - 16);
    unsigned* bar = (unsigned*)(P_.ws + WS_BAR);
    const unsigned xcc = xb_xcc_id();
    if (threadIdx.x == 0) { bst[0] = 0u; bst[1] = 0u; if (P_.ph_hi - P_.ph_lo > 1) (void)xb_add(&bar[XB_XCNT(xcc)], 1u); }
    __syncthreads();
    int dup_cnt = 0; (void)dup_cnt;
    const int blk_k = blockIdx.x, nblk_k = gridDim.x; const int ph_lo = P_.ph_lo, ph_hi = P_.ph_hi;
    for (int ph = ph_lo; ph < ph_hi; ++ph) {
        int blk = blk_k, nblk = nblk_k; asm volatile("" : "+s"(blk), "+s"(nblk));
        const Params& P = P_;
        if (ph == 0) p0_prologue(P, lds, blk, nblk, wv, 0);
        else if (ph == 3) p3_indexer(P, lds, blk, nblk, wv);
        else if (ph == 4) p4_attn(P, lds, blk, nblk, wv);
        else if (ph == 8) p8_retention(P, lds, blk, nblk, wv);
        else if (ph == 9) { if (nblk != 256) p9_gnorm(P, blk, nblk, wv); }
        else {
            if (ph == 2) p2_kidx(P, blk, nblk, wv);
            if (ph == 5) {
                unsigned ones = ~0u; asm volatile("" : "+v"(ones)); u32x4* xs_ = (u32x4*)(opaque_ptr(P.ws) + WS_KIDXN);
                for (int i = blk * NTHREADS + my_tid(wv); i < (4 << 20) / 16; i += nblk * NTHREADS) xs_[i] = (u32x4){ones, ones, ones, ones};
            }
            const int nj = (ph == 2) ? 3 : (ph == 10) ? 2 : 1;
            for (int j = 0; j < nj; ++j) run_gemm_job(P, lds, ph, j, blk, nblk, wv);
            if (ph == 1) p0_prologue(P, lds, blk, nblk, wv, 1);
        }
        if (ph + 1 < ph_hi && !(ph == 8 && nblk == 256)) { if (ph_hi < 0) grid.sync(); else xcd_barrier(bar, xcc, bst, (unsigned)nblk, wv); }
#if MK_DUP_MASK
        if (((MK_DUP_MASK >> ph) & 1) && dup_cnt < MK_DUP_N) { ++dup_cnt; --ph; } else dup_cnt = 0;
#endif
    }
}

#ifndef MK_FUSED
#define MK_FUSED 1
#endif
extern "C" void kernel_launch(void* const* d_in, const int* in_sizes, int n_in, void* d_out, int out_size, void* d_ws, size_t ws_size, hipStream_t stream) {
    static int grid = 0;
    if (grid == 0) {
        if (n_in != 19 || out_size != T * D || ws_size < WS_END) { fprintf(stderr, "kernel_launch: unexpected shapes (n_in %d, out %d, ws %zu)\n", n_in, out_size, ws_size); grid = -1; return; }
        int dev = 0, cus = 0, per_cu = 0;
        hipGetDevice(&dev);
        hipDeviceGetAttribute(&cus, hipDeviceAttributeMultiprocessorCount, dev);
        if (hipFuncSetAttribute((const void*)mk_fwd, hipFuncAttributeMaxDynamicSharedMemorySize, LDS_BYTES) != hipSuccess) { fprintf(stderr, "kernel_launch: hipFuncSetAttribute failed\n"); grid = -1; return; }
        hipOccupancyMaxActiveBlocksPerMultiprocessor(&per_cu, (const void*)mk_fwd, NTHREADS, LDS_BYTES);
        if (per_cu < 1) { fprintf(stderr, "kernel_launch: occupancy query says %d blocks per CU\n", per_cu); grid = -1; return; }
        grid = cus * 1;
    }
    if (grid < 0) return;
    (void)hipMemsetAsync((char*)d_ws + WS_BAR, 0, 16384 + 32768, stream);
    Params P{};
    for (int i = 0; i < 19; ++i) P.in[i] = (const float*)d_in[i];
    P.out = (float*)d_out; P.ws = (unsigned char*)d_ws;
#if MK_FUSED
    P.ph_lo = 0; P.ph_hi = NPH;
    void* args[] = {&P};
    hipError_t e = hipLaunchCooperativeKernel((const void*)mk_fwd, dim3(grid), dim3(NTHREADS), args, LDS_BYTES, stream);
    if (e != hipSuccess) fprintf(stderr, "cooperative launch failed: %s (grid %d)\n", hipGetErrorString(e), grid);
#else
    for (int ph = 0; ph < NPH; ++ph) {
        P.ph_lo = ph; P.ph_hi = ph + 1;
        hipLaunchKernelGGL(mk_fwd, dim3(grid), dim3(NTHREADS), LDS_BYTES, stream, P);
    }
#endif
}
```

```cpp
#include <hip/hip_runtime.h>
#include <hip/hip_cooperative_groups.h>
#include <cstdio>
#include <cstdint>
namespace cg = cooperative_groups;
#ifndef MK_DUP_MASK
#define MK_DUP_MASK 0
#endif
#ifndef MK_P3_REPA
#define MK_P3_REPA 0
#endif
#ifndef MK_P3_REPB
#define MK_P3_REPB 0
#endif
#ifndef MK_EPI_REP
#define MK_EPI_REP 0
#endif
#ifndef MK_DUP_N
#define MK_DUP_N 3
#endif

typedef _Float16 h16;
typedef _Float16 h16x2 __attribute__((ext_vector_type(2)));
typedef _Float16 h16x4 __attribute__((ext_vector_type(4)));
typedef _Float16 h16x8 __attribute__((ext_vector_type(8)));
typedef float f32x2 __attribute__((ext_vector_type(2)));
typedef float f32x4 __attribute__((ext_vector_type(4)));
typedef unsigned u32x4 __attribute__((ext_vector_type(4)));

constexpr int NB = 16, L = 2048, T = NB * L, D = 1024;
constexpr float EPS = 1e-6f;
constexpr int NPH = 12;
constexpr int NTHREADS = 512, NWAVES = 8;
constexpr int LDS_BYTES = 163840;

constexpr size_t MiB = (size_t)1 << 20;
constexpr size_t WS_WAIN = 0 * MiB;
constexpr size_t WS_WQ = 4 * MiB;
constexpr size_t WS_WKV = 6 * MiB;
constexpr size_t WS_WAOUT = 7 * MiB;
constexpr size_t WS_WPG = 9 * MiB;
constexpr size_t WS_WPLE = 13 * MiB;
constexpr size_t WS_WRIN = 14 * MiB;
constexpr size_t WS_WROUT = 26 * MiB;
constexpr size_t WS_SINCOS = 30 * MiB;
constexpr size_t WS_SQKV = 32 * MiB;
constexpr size_t WS_SQQ = 33 * MiB;
constexpr size_t WS_SQH = 34 * MiB;
constexpr size_t WS_KIDXN = 42 * MiB;
constexpr size_t WS_WIDX = 46 * MiB;
constexpr size_t WS_BAR = 47 * MiB;
constexpr size_t WS_PH1 = 48 * MiB;
constexpr size_t WS_R1 = 64 * MiB;
constexpr size_t WS_R2 = 128 * MiB;
constexpr size_t WS_R3 = 192 * MiB;
constexpr size_t WS_R4 = 256 * MiB;
constexpr size_t WS_R5 = 320 * MiB;
constexpr size_t WS_PH0 = 384 * MiB;
constexpr size_t WS_CQX = 400 * MiB;
constexpr size_t WS_CKV = 432 * MiB;
constexpr size_t WS_QIDX = 448 * MiB;
constexpr size_t WS_MASK = 480 * MiB;
constexpr size_t WS_AO = 400 * MiB;
constexpr size_t WS_RG = 384 * MiB;
constexpr size_t WS_END = 512 * MiB;

struct Params { const float* in[19]; float* out; unsigned char* ws; int ph_lo, ph_hi; };

__constant__ float kAngle[128] = {
    1.000000000e+00f, 9.300450087e-01f, 8.649836779e-01f, 8.044736385e-01f, 7.481966019e-01f, 6.958565116e-01f, 6.471778154e-01f, 6.019044518e-01f,
    5.597981811e-01f, 5.206375122e-01f, 4.842162728e-01f, 4.503428936e-01f, 4.188391268e-01f, 3.895392120e-01f, 3.622889817e-01f, 3.369450271e-01f,
    3.133740425e-01f, 2.914519310e-01f, 2.710633874e-01f, 2.521011233e-01f, 2.344653904e-01f, 2.180633694e-01f, 2.028087080e-01f, 1.886212230e-01f,
    1.754262149e-01f, 1.631542742e-01f, 1.517407894e-01f, 1.411257535e-01f, 1.312533021e-01f, 1.220714748e-01f, 1.135319397e-01f, 1.055898219e-01f,
    9.820328653e-02f, 9.133346379e-02f, 8.494423330e-02f, 7.900195569e-02f, 7.347535342e-02f, 6.833537668e-02f, 6.355497986e-02f, 5.910899118e-02f,
    5.497401953e-02f, 5.112830922e-02f, 4.755162448e-02f, 4.422515258e-02f, 4.113136977e-02f, 3.825402260e-02f, 3.557796404e-02f, 3.308910504e-02f,
    3.077435680e-02f, 2.862153389e-02f, 2.661931701e-02f, 2.475716174e-02f, 2.302526683e-02f, 2.141453326e-02f, 1.991648041e-02f, 1.852322184e-02f,
    1.722742990e-02f, 1.602228358e-02f, 1.490144618e-02f, 1.385901403e-02f, 1.288950257e-02f, 1.198781747e-02f, 1.114920899e-02f, 1.036926545e-02f,
    9.643883444e-03f, 8.969245479e-03f, 8.341802284e-03f, 7.758250926e-03f, 7.215522230e-03f, 6.710760761e-03f, 6.241309457e-03f, 5.804697983e-03f,
    5.398627371e-03f, 5.020966288e-03f, 4.669724498e-03f, 4.343053792e-03f, 4.039235413e-03f, 3.756670747e-03f, 3.493872471e-03f, 3.249458736e-03f,
    3.022142686e-03f, 2.810728736e-03f, 2.614103956e-03f, 2.431234345e-03f, 2.261157380e-03f, 2.102978062e-03f, 1.955864020e-03f, 1.819041790e-03f,
    1.691789716e-03f, 1.573440502e-03f, 1.463370281e-03f, 1.361000235e-03f, 1.265791478e-03f, 1.177242957e-03f, 1.094888896e-03f, 1.018295996e-03f,
    9.470609948e-04f, 8.808093844e-04f, 8.191923262e-04f, 7.618857198e-04f, 7.085879333e-04f, 6.590186385e-04f, 6.129170069e-04f, 5.700403708e-04f,
    5.301629426e-04f, 4.930753494e-04f, 4.585822753e-04f, 4.265021416e-04f, 3.966661752e-04f, 3.689173318e-04f, 3.431097430e-04f, 3.191074939e-04f,
    2.967843320e-04f, 2.760227653e-04f, 2.567135962e-04f, 2.387551940e-04f, 2.220530587e-04f, 2.065193403e-04f, 1.920722716e-04f, 1.786358480e-04f,
    1.661392889e-04f, 1.545170089e-04f, 1.437077590e-04f, 1.336546848e-04f, 1.243048755e-04f, 1.156091312e-04f, 1.075216787e-04f, 9.999999747e-05f,
};

__device__ __forceinline__ float wave_sum(float v) {
#pragma unroll
    for (int o = 1; o < 64; o <<= 1) v += __shfl_xor(v, o);
    return v;
}
__device__ __forceinline__ float wave_max(float v) {
#pragma unroll
    for (int o = 1; o < 64; o <<= 1) v = fmaxf(v, __shfl_xor(v, o));
    return v;
}
#define DPP_RED6S(v, F) do { v = F<0x111, 0xf>(v); v = F<0x112, 0xf>(v); v = F<0x114, 0xf>(v); v = F<0x118, 0xf>(v); v = F<0x142, 0xa>(v); v = F<0x143, 0xc>(v); } while (0)
template <int CTRL, int RMASK> __device__ __forceinline__ float fadd_dpp_(float a) { return a + __builtin_bit_cast(float, __builtin_amdgcn_update_dpp(0, __builtin_bit_cast(int, a), CTRL, RMASK, 0xf, false)); }
__device__ __forceinline__ float wave_sum_dpp(float v) { DPP_RED6S(v, fadd_dpp_); return __builtin_bit_cast(float, __builtin_amdgcn_readlane(__builtin_bit_cast(int, v), 63)); }
__device__ __forceinline__ float dot4(f32x4 a) { return (a[0] * a[0] + a[1] * a[1]) + (a[2] * a[2] + a[3] * a[3]); }
__device__ __forceinline__ float fq_sum(float s) {
    { auto rr = __builtin_amdgcn_permlane16_swap(__float_as_uint(s), __float_as_uint(s), false, false); s = __uint_as_float(rr[0]) + __uint_as_float(rr[1]); }
    { auto rr = __builtin_amdgcn_permlane32_swap(__float_as_uint(s), __float_as_uint(s), false, false); s = __uint_as_float(rr[0]) + __uint_as_float(rr[1]); }
    return s;
}
__device__ __forceinline__ h16x8 pack8(f32x4 a, f32x4 b) {
    h16x8 r; r[0] = (h16)a[0]; r[1] = (h16)a[1]; r[2] = (h16)a[2]; r[3] = (h16)a[3]; r[4] = (h16)b[0]; r[5] = (h16)b[1]; r[6] = (h16)b[2]; r[7] = (h16)b[3]; return r;
}
__device__ __forceinline__ h16x4 pack4(f32x4 a) { h16x4 r; r[0] = (h16)a[0]; r[1] = (h16)a[1]; r[2] = (h16)a[2]; r[3] = (h16)a[3]; return r; }
__device__ __forceinline__ float sigmoidf_(float x) { return __builtin_amdgcn_rcpf(1.0f + __builtin_amdgcn_exp2f(-1.4426950408889634f * x)); }
__device__ __forceinline__ float siluf_(float x) { return x * __builtin_amdgcn_rcpf(1.0f + __builtin_amdgcn_exp2f(-1.4426950408889634f * x)); }
#define LDS_FENCE() do { asm volatile("s_waitcnt lgkmcnt(0)" ::: "memory"); } while (0)
__device__ __forceinline__ int my_tid(int wv) { unsigned m = ~0u; asm volatile("" : "+s"(m)); int t = wv * 64 + (int)__builtin_amdgcn_mbcnt_hi(m, __builtin_amdgcn_mbcnt_lo(m, 0u)); asm volatile("" : "+v"(t)); return t; }
template <class Tp> __device__ __forceinline__ Tp* opaque_ptr(Tp* p) { size_t z = 0; asm volatile("" : "+s"(z)); return p + z; }

#define PG8_LAS __attribute__((address_space(3)))
__device__ __forceinline__ constexpr int pg8_stage_bytes() { return 131072; }
struct Unit { int pm, pn; };
struct Gemm { const h16* A; const h16* Bt; int lda, ldb, M, N, K; };
__device__ __forceinline__ int perm32(int rho) { const int n = rho >> 4, i = rho & 15; return 8 * (i >> 2) + 4 * n + (i & 3); }

template <class Epi>
__device__ __forceinline__ void gemm_simple(const Gemm g, const Epi& E, int blk, int nblk, int wv) {
    const int tid = my_tid(wv), wid = __builtin_amdgcn_readfirstlane(tid >> 6), lane = tid & 63, wr = wid >> 2, wc = wid & 3, fr = lane & 15, fq = lane >> 4;
    const int nN = g.N / 256, nU = (g.M / 256) * nN;
    for (int u = blk; u < nU; u += nblk) {
        Unit un; un.pm = u / nN; un.pn = u % nN;
        f32x4 acc[2][2][4][2];
#pragma unroll
        for (int a = 0; a < 2; ++a)
#pragma unroll
            for (int b = 0; b < 2; ++b)
#pragma unroll
                for (int m = 0; m < 4; ++m)
#pragma unroll
                    for (int n = 0; n < 2; ++n) acc[a][b][m][n] = (f32x4){0.f, 0.f, 0.f, 0.f};
        const h16* Ap = g.A + (size_t)(un.pm * 256 + wr * 64 + fr) * g.lda + fq * 8;
        const h16* Bp[2];
#pragma unroll
        for (int n = 0; n < 2; ++n) Bp[n] = g.Bt + (size_t)(un.pn * 256 + wc * 32 + (Epi::PERM ? perm32(16 * n + fr) : 16 * n + fr)) * g.ldb + fq * 8;
        for (int k0 = 0; k0 < g.K; k0 += 32) {
            h16x8 At[2][4], Bt[2][2];
#pragma unroll
            for (int ai = 0; ai < 2; ++ai)
#pragma unroll
                for (int m = 0; m < 4; ++m) At[ai][m] = *(const h16x8*)(Ap + (size_t)(ai * 128 + m * 16) * g.lda + k0);
#pragma unroll
            for (int bj = 0; bj < 2; ++bj)
#pragma unroll
                for (int n = 0; n < 2; ++n) Bt[bj][n] = *(const h16x8*)(Bp[n] + (size_t)(bj * 128) * g.ldb + k0);
#pragma unroll
            for (int ai = 0; ai < 2; ++ai)
#pragma unroll
                for (int bj = 0; bj < 2; ++bj)
#pragma unroll
                    for (int m = 0; m < 4; ++m)
#pragma unroll
                        for (int n = 0; n < 2; ++n) acc[ai][bj][m][n] = __builtin_amdgcn_mfma_f32_16x16x32_f16(Bt[bj][n], At[ai][m], acc[ai][bj][m][n], 0, 0, 0);
        }
        E(acc, un, wr, wc, fr, fq, nullptr);
    }
}

template <class E_> struct epi_fused { template <class X> static constexpr bool g(decltype(X::FUSED_FINAL)*) { return X::FUSED_FINAL; } template <class X> static constexpr bool g(...) { return false; } static constexpr bool v = g<E_>(nullptr); };
namespace pg8 {
constexpr int BM = 256, BK = 64, HALF = 128, HTB = HALF * BK * 2  , STAGE_BYTES = 8 * HTB, NXCD = 8, WGM = 8;
__host__ __device__ __forceinline__ int lds_byte(int r, int c) { const int st = (r >> 4) * 2 + (c >> 5), rr = r & 15, cc = c & 31, ob = rr * 64 + cc * 2; return st * 1024 + (ob ^ (((ob >> 9) & 1) << 5)); }
__host__ __device__ __forceinline__ void stage_rc(int b, int& R, int& C) { const int st = b / 1024, sb = b % 1024, swz = sb ^ (((sb >> 9) & 1) << 5); R = (st >> 1) * 16 + swz / 64; C = (st & 1) * 32 + (swz % 64) / 2; }
struct StaticOrder {
    int nM, nN, nwg, G, c;
    __host__ __device__ void init(int M, int N, int G_, int c_) { nM = M / BM; nN = N / BM; nwg = nM * nN; G = G_; c = c_; }
    __host__ __device__ bool next(int i, Unit& u) const {
        const long Lq = (long)i * G + c; if (Lq >= nwg) return false;
        int wgid = (int)Lq; { const int q = nwg / NXCD, r = nwg % NXCD, xcd = wgid % NXCD, off = wgid / NXCD; wgid = (xcd < r ? xcd * (q + 1) : r * (q + 1) + (xcd - r) * q) + off; }
        const int nig = WGM * nN, gid = wgid / nig, fm = gid * WGM, gsz = (nM - fm) < WGM ? (nM - fm) : WGM;
        u.pm = fm + ((wgid % nig) % gsz); u.pn = (wgid % nig) / gsz; return true;
    }
};
template <class Epi, bool ALIGN_EPI = true>
__device__ __forceinline__ void gemm_phase(PG8_LAS unsigned char* lds, const Gemm g, const StaticOrder& S, const Epi& E, int wv) {
    const int tid = my_tid(wv), wid = __builtin_amdgcn_readfirstlane(tid >> 6), lane = tid & 63, wr = wid >> 2, wc = wid & 3, fr = lane & 15, fq = lane >> 4;
    const int K = g.K, nt = K / BK;
    unsigned voffA[2], voffB[2];
#pragma unroll
    for (int i = 0; i < 2; ++i) { int R, C; stage_rc(tid * 16 + i * 8192, R, C); const int Rb = Epi::PERM ? ((R & ~31) + perm32(R & 31)) : R;
        voffA[i] = (unsigned)(R * g.lda + C) * 2u; voffB[i] = (unsigned)(Rb * g.ldb + C) * 2u; }
    const size_t kstep = (size_t)(BK * 2);
    const size_t hstepA = (size_t)HALF * g.lda * 2, hstepB = (size_t)HALF * g.ldb * 2;
    const size_t tstepA = 2 * hstepA, tstepB = 2 * hstepB;
    const unsigned ldsw = (unsigned)wid * 1024u;
    const int aoff = lds_byte(wr * 64 + fr, fq * 8), boff = lds_byte(wc * 32 + fr, fq * 8);
#define PG8_SA(b, h) (((b) * 2 + (h)) * HTB)
#define PG8_SB(b, h) ((4 + (b) * 2 + (h)) * HTB)
#define PG8_STAGE(bufoff, gbase, voff) do { _Pragma("unroll") for (int _i = 0; _i < 2; ++_i) \
        __builtin_amdgcn_global_load_lds((const unsigned*)((const char*)(gbase) + (voff)[_i]), (PG8_LAS unsigned*)(lds + (bufoff) + ldsw + _i * 8192), 16, 0, 0); } while (0)
#define PG8_LDA(dst, b, h) do { _Pragma("unroll") for (int m = 0; m < 4; ++m) _Pragma("unroll") for (int k = 0; k < 2; ++k) dst[m][k] = *(const PG8_LAS h16x8*)(lds + PG8_SA(b, h) + aoff + m * 2048 + k * 1024); } while (0)
#define PG8_LDB(dst, b, h) do { _Pragma("unroll") for (int n = 0; n < 2; ++n) _Pragma("unroll") for (int k = 0; k < 2; ++k) dst[n][k] = *(const PG8_LAS h16x8*)(lds + PG8_SB(b, h) + boff + n * 2048 + k * 1024); } while (0)
#define PG8_MMA(ai, bj, At, Bt) do { __builtin_amdgcn_s_setprio(1); _Pragma("unroll") for (int m = 0; m < 4; ++m) _Pragma("unroll") for (int n = 0; n < 2; ++n) _Pragma("unroll") for (int k = 0; k < 2; ++k) \
        acc[ai][bj][m][n] = __builtin_amdgcn_mfma_f32_16x16x32_f16(Bt[n][k], At[m][k], acc[ai][bj][m][n], 0, 0, 0); __builtin_amdgcn_s_setprio(0); } while (0)
#define PG8_WAIT_V(n) asm volatile("s_waitcnt vmcnt(" #n ")" ::: "memory")
#define PG8_WAIT_L(n) asm volatile("s_waitcnt lgkmcnt(" #n ")" ::: "memory")
#define PG8_BAR __builtin_amdgcn_s_barrier()
#define PG8_SCHED __builtin_amdgcn_sched_barrier(0)
    Unit cur, nxt; int ui = 0;
    if (!S.next(0, cur)) return;
    PG8_LAS float* rtab = (PG8_LAS float*)(lds + STAGE_BYTES);
#define PG8_FILL(U, PAR) do { const int tf_ = my_tid(wv); if (E.sqp != nullptr && tf_ < 256) { const size_t r_ = (size_t)(U).pm * 256 + tf_; float s_ = 0.f; \
        for (int j_ = 0; j_ < E.sqn; j_ += 4) { const f32x4 q_ = *(const f32x4*)(E.sqp + r_ * E.sqn + j_); s_ += (q_[0] + q_[1]) + (q_[2] + q_[3]); } \
        rtab[(PAR) * 256 + tf_] = rsqrtf(s_ * E.sqi + EPS); } } while (0)
    PG8_FILL(cur, 0);
    f32x4 acc[2][2][4][2];
#pragma unroll
    for (int a = 0; a < 2; ++a)
#pragma unroll
        for (int b = 0; b < 2; ++b)
#pragma unroll
            for (int m = 0; m < 4; ++m)
#pragma unroll
                for (int n = 0; n < 2; ++n) acc[a][b][m][n] = (f32x4){0.f, 0.f, 0.f, 0.f};
    h16x8 At[4][2], B0[2][2], B1[2][2];
    const char* cA = (const char*)g.A + (size_t)cur.pm * tstepA; const char* cB = (const char*)g.Bt + (size_t)cur.pn * tstepB;
    PG8_STAGE(PG8_SB(0, 0), cB, voffB); PG8_STAGE(PG8_SB(0, 1), cB + hstepB, voffB); PG8_STAGE(PG8_SA(0, 0), cA, voffA); PG8_STAGE(PG8_SA(0, 1), cA + hstepA, voffA);
    if (wr == 1) PG8_BAR;
    PG8_WAIT_V(2); PG8_BAR;
    PG8_STAGE(PG8_SB(1, 0), cB + kstep, voffB); PG8_STAGE(PG8_SA(1, 0), cA + kstep, voffA); PG8_STAGE(PG8_SB(1, 1), cB + hstepB + kstep, voffB);
    PG8_WAIT_V(6); PG8_BAR;
    for (;;) {
        const bool has_next = S.next(ui + 1, nxt);
        const char* nA = has_next ? (const char*)g.A + (size_t)nxt.pm * tstepA : cA; const char* nB = has_next ? (const char*)g.Bt + (size_t)nxt.pn * tstepB : cB;
        for (int t = 0; t < nt; t += 2) {
            const bool last = (t == nt - 2);
            const char* a1 = cA + (size_t)(t + 1) * kstep;
            const char* a2 = last ? nA : cA + (size_t)(t + 2) * kstep; const char* b2 = last ? nB : cB + (size_t)(t + 2) * kstep;
            const char* a3 = a2 + kstep; const char* b3 = b2 + kstep;
            PG8_LDB(B0, 0, 0); PG8_LDB(B1, 0, 1); PG8_SCHED; PG8_LDA(At, 0, 0); PG8_STAGE(PG8_SA(1, 1), a1 + hstepA, voffA);
            PG8_WAIT_V(8); PG8_WAIT_L(0); PG8_BAR; PG8_MMA(0, 0, At, B0); PG8_MMA(0, 1, At, B1); PG8_BAR; PG8_SCHED;
            PG8_LDA(At, 0, 1); PG8_STAGE(PG8_SB(0, 0), b2, voffB); PG8_STAGE(PG8_SB(0, 1), b2 + hstepB, voffB); PG8_STAGE(PG8_SA(0, 0), a2, voffA);
            PG8_WAIT_V(8); PG8_WAIT_L(0); PG8_BAR; PG8_MMA(1, 0, At, B0); PG8_MMA(1, 1, At, B1); PG8_BAR; PG8_SCHED;
            PG8_LDB(B0, 1, 0); PG8_LDB(B1, 1, 1); PG8_SCHED; PG8_LDA(At, 1, 0); PG8_STAGE(PG8_SA(0, 1), a2 + hstepA, voffA);
            PG8_WAIT_V(8); PG8_WAIT_L(0); PG8_BAR; PG8_MMA(0, 0, At, B0); PG8_MMA(0, 1, At, B1); PG8_BAR; PG8_SCHED;
            PG8_LDA(At, 1, 1); PG8_STAGE(PG8_SB(1, 0), b3, voffB); PG8_STAGE(PG8_SB(1, 1), b3 + hstepB, voffB); PG8_STAGE(PG8_SA(1, 0), a3, voffA);
            PG8_WAIT_V(8); PG8_WAIT_L(0); PG8_BAR; PG8_MMA(1, 0, At, B0); PG8_MMA(1, 1, At, B1); PG8_BAR; PG8_SCHED;
        }
        if constexpr (ALIGN_EPI) { if (wr == 0) PG8_BAR; }
        { const int te_ = my_tid(wv), le_ = te_ & 63;
          if constexpr (epi_fused<Epi>::v) E.final(acc, cur, wr, wc, le_ & 15, le_ >> 4, rtab + (ui & 1) * 256, lds, te_); else E(acc, cur, wr, wc, le_ & 15, le_ >> 4, rtab + (ui & 1) * 256); }
        if (has_next) PG8_FILL(nxt, (ui + 1) & 1);
        if (!has_next) break;
#pragma unroll
        for (int a = 0; a < 2; ++a)
#pragma unroll
            for (int b = 0; b < 2; ++b)
#pragma unroll
                for (int m = 0; m < 4; ++m)
#pragma unroll
                    for (int n = 0; n < 2; ++n) acc[a][b][m][n] = (f32x4){0.f, 0.f, 0.f, 0.f};
        cur = nxt; cA = nA; cB = nB; ++ui;
        if constexpr (ALIGN_EPI) { if (wr == 1) PG8_BAR; }
    }
    PG8_WAIT_V(0);
    if constexpr (!ALIGN_EPI) { if (wr == 0) PG8_BAR; }
    PG8_BAR;
#undef PG8_FILL
#undef PG8_SA
#undef PG8_SB
#undef PG8_STAGE
#undef PG8_LDA
#undef PG8_LDB
#undef PG8_MMA
#undef PG8_WAIT_V
#undef PG8_WAIT_L
#undef PG8_BAR
#undef PG8_SCHED
}
}
template <class Epi>
__device__ __forceinline__ void gemm_run(unsigned char* lds, const Gemm g, const Epi& E, int blk, int nblk, int wv) {
    pg8::StaticOrder S; S.init(g.M, g.N, nblk, blk);
    pg8::gemm_phase<Epi, true>((PG8_LAS unsigned char*)lds, g, S, E, wv);
}

struct EpiInA {
    static constexpr bool PERM = true;
    h16* ckv; h16* cqx; h16* sg; float* sqkv; float* sqq; const float* sqp; int sqn; float sqi;
    __device__ __forceinline__ void operator()(const f32x4 (&acc)[2][2][4][2], const Unit& u, int wr, int wc, int fr, int fq, const PG8_LAS float* rtab) const {
        asm volatile("" : "+v"(fr), "+v"(fq));
#pragma unroll
        for (int ai = 0; ai < 2; ++ai)
#pragma unroll
            for (int m = 0; m < 4; ++m) {
                const size_t r = (size_t)u.pm * 256 + ai * 128 + wr * 64 + m * 16 + fr;
                float ss = 0.f;
#pragma unroll
                for (int bj = 0; bj < 2; ++bj) {
                    const int c0 = bj * 128 + wc * 32 + 8 * fq;
                    f32x4 v0 = acc[ai][bj][m][0], v1 = acc[ai][bj][m][1];
                    if (u.pn == 0) { *(h16x8*)(ckv + r * 256 + c0) = pack8(v0, v1); ss += dot4(v0) + dot4(v1); }
                    else if (u.pn <= 2) { const int cq = (u.pn - 1) * 256 + c0; *(h16x8*)(cqx + r * 512 + cq) = pack8(v0, v1); if (cq < 384) ss += dot4(v0) + dot4(v1); }
                    else {
#pragma unroll
                        for (int e = 0; e < 4; ++e) { v0[e] = siluf_(v0[e]); v1[e] = siluf_(v1[e]); }
                        *(h16x8*)(sg + r * 1024 + (u.pn - 3) * 256 + c0) = pack8(v0, v1);
                    }
                }
                if (u.pn <= 2) {
                    ss = fq_sum(ss);
                    if (fq == 0) { if (u.pn == 0) sqkv[r * 4 + wc] = ss; else sqq[r * 8 + (u.pn - 1) * 4 + wc] = ss; }
                }
            }
    }
};
__device__ __forceinline__ unsigned cvtpk_bf16(float lo, float hi) { unsigned r; asm volatile("v_cvt_pk_bf16_f32 %0, %1, %2" : "=v"(r) : "v"(lo), "v"(hi)); return r; }
struct EpiScale {
    static constexpr bool PERM = true;
    const float* sqp; int sqn; float sqi; h16* d0; h16* d1; int split, ld0, ld1, bf0, bf1;
    __device__ __forceinline__ void operator()(const f32x4 (&acc)[2][2][4][2], const Unit& u, int wr, int wc, int fr, int fq, const PG8_LAS float* rtab) const {
        asm volatile("" : "+v"(fr), "+v"(fq));
#pragma unroll
        for (int ai = 0; ai < 2; ++ai)
#pragma unroll
            for (int m = 0; m < 4; ++m) {
                const size_t r = (size_t)u.pm * 256 + ai * 128 + wr * 64 + m * 16 + fr;
                float rs = 1.f;
                if (sqp) rs = rtab[ai * 128 + wr * 64 + m * 16 + fr];
#pragma unroll
                for (int bj = 0; bj < 2; ++bj) {
                    const int c0 = bj * 128 + wc * 32 + 8 * fq;
                    const f32x4 v0 = acc[ai][bj][m][0] * rs, v1 = acc[ai][bj][m][1] * rs;
                    const bool first = u.pn < split;
                    h16* dst = first ? d0 + r * ld0 + u.pn * 256 + c0 : d1 + r * ld1 + (u.pn - split) * 256 + c0;
                    if (first ? bf0 : bf1) { u32x4 w; w[0] = cvtpk_bf16(v0[0], v0[1]); w[1] = cvtpk_bf16(v0[2], v0[3]); w[2] = cvtpk_bf16(v1[0], v1[1]); w[3] = cvtpk_bf16(v1[2], v1[3]); *(u32x4*)dst = w; }
                    else *(h16x8*)dst = pack8(v0, v1);
                }
            }
    }
};
struct EpiRes {
    static constexpr bool PERM = true;
    const float* basef; const h16* baseh; h16* HH; float* sq; const float* sqp; int sqn; float sqi;
    __device__ __forceinline__ void operator()(const f32x4 (&acc)[2][2][4][2], const Unit& u, int wr, int wc, int fr, int fq, const PG8_LAS float* rtab) const {
        asm volatile("" : "+v"(fr), "+v"(fq));
#pragma unroll
        for (int ai = 0; ai < 2; ++ai)
#pragma unroll
            for (int m = 0; m < 4; ++m) {
                const size_t r = (size_t)u.pm * 256 + ai * 128 + wr * 64 + m * 16 + fr;
                float ss = 0.f;
#pragma unroll
                for (int bj = 0; bj < 2; ++bj) {
                    const size_t o = r * 1024 + u.pn * 256 + bj * 128 + wc * 32 + 8 * fq;
                    f32x4 h0, h1;
                    if (basef) { h0 = *(const f32x4*)(basef + o); h1 = *(const f32x4*)(basef + o + 4); }
                    else { const h16x8 b = *(const h16x8*)(baseh + o); h0 = (f32x4){(float)b[0], (float)b[1], (float)b[2], (float)b[3]}; h1 = (f32x4){(float)b[4], (float)b[5], (float)b[6], (float)b[7]}; }
                    h0 = h0 + acc[ai][bj][m][0]; h1 = h1 + acc[ai][bj][m][1];
                    *(h16x8*)(HH + o) = pack8(h0, h1); ss += dot4(h0) + dot4(h1);
                }
                ss = fq_sum(ss);
                if (fq == 0) sq[r * 16 + u.pn * 4 + wc] = ss;
            }
    }
};
struct EpiPle {
    static constexpr bool PERM = true;
    const h16* Hin; const h16* U; h16* Hout; const float* sqp; float* sqout; int sqn; float sqi;
    __device__ __forceinline__ void operator()(const f32x4 (&acc)[2][2][4][2], const Unit& u, int wr, int wc, int fr, int fq, const PG8_LAS float* rtab) const {
        asm volatile("" : "+v"(fr), "+v"(fq));
#pragma unroll
        for (int ai = 0; ai < 2; ++ai)
#pragma unroll
            for (int m = 0; m < 4; ++m) {
                const size_t r = (size_t)u.pm * 256 + ai * 128 + wr * 64 + m * 16 + fr;
                const float rs = rtab[ai * 128 + wr * 64 + m * 16 + fr];
                float ss = 0.f;
#pragma unroll
                for (int bj = 0; bj < 2; ++bj) {
                    const size_t o = r * 1024 + u.pn * 256 + bj * 128 + wc * 32 + 8 * fq;
                    const h16x8 uu = *(const h16x8*)(U + o); const h16x8 hh = *(const h16x8*)(Hin + o);
                    const f32x4 a0 = acc[ai][bj][m][0] * rs, a1 = acc[ai][bj][m][1] * rs; f32x4 h0, h1;
#pragma unroll
                    for (int e = 0; e < 4; ++e) { h0[e] = (float)hh[e] + (float)uu[e] * sigmoidf_(a0[e]); h1[e] = (float)hh[4 + e] + (float)uu[4 + e] * sigmoidf_(a1[e]); }
                    *(h16x8*)(Hout + o) = pack8(h0, h1); ss += dot4(h0) + dot4(h1);
                }
                ss = fq_sum(ss);
                if (fq == 0) sqout[r * 16 + u.pn * 4 + wc] = ss;
            }
    }
};
struct EpiPleFinal {
    static constexpr bool PERM = true, FUSED_FINAL = true;
    const h16* Hin; const h16* U; const float* sqp; int sqn; float sqi; const float* gfin; float* out; unsigned* xslot; unsigned* pcnt; unsigned* tmo;
    __device__ __forceinline__ void final(f32x4 (&acc)[2][2][4][2], const Unit& u, int wr, int wc, int fr, int fq, const PG8_LAS float* rtab, PG8_LAS unsigned char* lds, int tid) const {
        PG8_LAS float* Pt = (PG8_LAS float*)(lds + pg8_stage_bytes() + 2048);
        PG8_LAS float* St = Pt + 1024;
        const int wid = tid >> 6, lane = tid & 63;
        asm volatile("" : "+v"(fr), "+v"(fq));
#pragma unroll
        for (int ai = 0; ai < 2; ++ai)
#pragma unroll
            for (int m = 0; m < 4; ++m) {
                const int rl = ai * 128 + wr * 64 + m * 16 + fr; const size_t r = (size_t)u.pm * 256 + rl;
                const float rs = rtab[rl]; float ss = 0.f;
#pragma unroll
                for (int bj = 0; bj < 2; ++bj) {
                    const size_t o = r * 1024 + u.pn * 256 + bj * 128 + wc * 32 + 8 * fq;
                    const h16x8 uu = *(const h16x8*)(U + o); const h16x8 hh = *(const h16x8*)(Hin + o);
                    const f32x4 a0 = acc[ai][bj][m][0] * rs, a1 = acc[ai][bj][m][1] * rs; f32x4 h0, h1;
#pragma unroll
                    for (int e = 0; e < 4; ++e) { h0[e] = (float)hh[e] + (float)uu[e] * sigmoidf_(a0[e]); h1[e] = (float)hh[4 + e] + (float)uu[4 + e] * sigmoidf_(a1[e]); }
                    acc[ai][bj][m][0] = h0; acc[ai][bj][m][1] = h1; ss += dot4(h0) + dot4(h1);
                }
                ss = fq_sum(ss);
                if (fq == 0) Pt[rl * 4 + wc] = ss;
                asm volatile("" : "+v"(acc[ai][0][m][0]), "+v"(acc[ai][0][m][1]), "+v"(acc[ai][1][m][0]), "+v"(acc[ai][1][m][1]) :: "memory");
            }
        asm volatile("s_waitcnt lgkmcnt(0)" ::: "memory"); __builtin_amdgcn_s_barrier(); asm volatile("" ::: "memory");
        if (tid < 256) {
            const f32x4 p = *(const PG8_LAS f32x4*)(Pt + tid * 4);
            __hip_atomic_store(xslot + ((size_t)u.pm * 256 + tid) * 4 + u.pn, __float_as_uint((p[0] + p[1]) + (p[2] + p[3])), __ATOMIC_RELAXED, __HIP_MEMORY_SCOPE_AGENT);
            asm volatile("s_waitcnt vmcnt(0)" ::: "memory");
            if (lane == 0) __hip_atomic_fetch_add(pcnt + 64 * u.pm, 1u, __ATOMIC_RELAXED, __HIP_MEMORY_SCOPE_AGENT);
        }
        if (wid == 0) {
            unsigned sp = 0u;
            while (__hip_atomic_load(pcnt + 64 * u.pm, __ATOMIC_RELAXED, __HIP_MEMORY_SCOPE_AGENT) < 16u) {
                __builtin_amdgcn_s_sleep(2);
                if (++sp > (1u << 22)) { if (lane == 0) __hip_atomic_store(tmo, 1u, __ATOMIC_RELAXED, __HIP_MEMORY_SCOPE_AGENT); break; }
            }
            __builtin_amdgcn_fence(__ATOMIC_ACQUIRE, "agent");
        }
        asm volatile("s_waitcnt vmcnt(0) lgkmcnt(0)" ::: "memory"); __builtin_amdgcn_s_barrier(); asm volatile("" ::: "memory");
        if (tid < 256) {
            const unsigned* sl = xslot + ((size_t)u.pm * 256 + tid) * 4; float s = 0.f;
#pragma unroll
            for (int t = 0; t < 4; ++t) s += __uint_as_float(__hip_atomic_load(sl + t, __ATOMIC_RELAXED, __HIP_MEMORY_SCOPE_AGENT));
            St[tid] = rsqrtf(s * (1.0f / 1024.0f) + EPS);
        }
        asm volatile("s_waitcnt vmcnt(0) lgkmcnt(0)" ::: "memory"); __builtin_amdgcn_s_barrier(); asm volatile("" ::: "memory");
#pragma unroll
        for (int ai = 0; ai < 2; ++ai)
#pragma unroll
            for (int m = 0; m < 4; ++m) {
                const int rl = ai * 128 + wr * 64 + m * 16 + fr; const size_t r = (size_t)u.pm * 256 + rl;
                const float rr = St[rl];
#pragma unroll
                for (int bj = 0; bj < 2; ++bj) {
                    const int c = u.pn * 256 + bj * 128 + wc * 32 + 8 * fq;
                    const f32x4 g0 = *(const f32x4*)(gfin + c), g1 = *(const f32x4*)(gfin + c + 4);
                    *(f32x4*)(out + r * 1024 + c) = acc[ai][bj][m][0] * rr * g0; *(f32x4*)(out + r * 1024 + c + 4) = acc[ai][bj][m][1] * rr * g1;
                }
            }
    }
};
struct EpiInR {
    static constexpr bool PERM = true;
    const float* sqp; const f32x2* sincos; h16* rq; h16* rk; h16* rv; h16* rg; int sqn; float sqi;
    __device__ __forceinline__ void operator()(const f32x4 (&acc)[2][2][4][2], const Unit& u, int wr, int wc, int fr, int fq, const PG8_LAS float* rtab) const {
        asm volatile("" : "+v"(fr), "+v"(fq));
#pragma unroll
        for (int ai = 0; ai < 2; ++ai)
#pragma unroll
            for (int m = 0; m < 4; ++m) {
                const size_t r = (size_t)u.pm * 256 + ai * 128 + wr * 64 + m * 16 + fr;
                const float rs = rtab[ai * 128 + wr * 64 + m * 16 + fr];
                const int pos = (int)(r & (L - 1));
#pragma unroll
                for (int bj = 0; bj < 2; ++bj) {
                    const int c0 = bj * 128 + wc * 32 + 8 * fq;
                    f32x4 v0 = acc[ai][bj][m][0] * rs, v1 = acc[ai][bj][m][1] * rs;
                    if (u.pn < 8) {
                        const f32x2* sc = sincos + (size_t)pos * 128 + (c0 >> 1);
                        const f32x2 s0 = sc[0], s1 = sc[1], s2 = sc[2], s3 = sc[3];
                        f32x4 w0, w1;
                        w0[0] = v0[0] * s0[1] - v0[1] * s0[0]; w0[1] = v0[1] * s0[1] + v0[0] * s0[0];
                        w0[2] = v0[2] * s1[1] - v0[3] * s1[0]; w0[3] = v0[3] * s1[1] + v0[2] * s1[0];
                        w1[0] = v1[0] * s2[1] - v1[1] * s2[0]; w1[1] = v1[1] * s2[1] + v1[0] * s2[0];
                        w1[2] = v1[2] * s3[1] - v1[3] * s3[0]; w1[3] = v1[3] * s3[1] + v1[2] * s3[0];
                        h16* dst = (u.pn < 4) ? rq + r * 1024 + u.pn * 256 + c0 : rk + r * 1024 + (u.pn - 4) * 256 + c0;
                        *(h16x8*)dst = pack8(w0, w1);
                    } else if (u.pn < 16) {
                        *(h16x8*)(rv + r * 2048 + (u.pn - 8) * 256 + c0) = pack8(v0, v1);
                    } else {
#pragma unroll
                        for (int e = 0; e < 4; ++e) { v0[e] = siluf_(v0[e]); v1[e] = siluf_(v1[e]); }
                        *(h16x8*)(rg + r * 2048 + (u.pn - 16) * 256 + c0) = pack8(v0, v1);
                    }
                }
            }
    }
};

template <int MODE>
__device__ __forceinline__ void tr_item(const float* __restrict__ W, int K, int N, h16* Wt, int ld, int row_off, const float* ks, float scale, float* scr, int item, int lane) {
    const int nbn = (N + 31) >> 5, kb = item / nbn, nb = item % nbn, k0 = kb * 64, n0 = nb * 32;
    const int n4 = n0 + (lane & 7) * 4;
    f32x4 wv[8];
#pragma unroll
    for (int i = 0; i < 8; ++i) { const int kk = 8 * i + (lane >> 3); wv[i] = (n4 < N) ? *(const f32x4*)(W + (size_t)(k0 + kk) * N + n4) : (f32x4){0.f, 0.f, 0.f, 0.f}; }
#pragma unroll
    for (int i = 0; i < 8; ++i) { const int kk = 8 * i + (lane >> 3); const float kf = ks ? ks[k0 + kk] : 1.f;
#pragma unroll
        for (int e = 0; e < 4; ++e) scr[kk * 33 + (lane & 7) * 4 + e] = wv[i][e] * kf; }
    LDS_FENCE();
    const int c = lane & 7;
#pragma unroll
    for (int j = 0; j < 4; ++j) {
        const int nl = (lane >> 3) + 8 * j, n = n0 + nl;
        if (n < N) {
            int row = n; float sc = scale;
            if (MODE == 1) row = (n < 384) ? 256 + n : (n < 640) ? n - 384 : (n < 712) ? n : n + 56;
            if (MODE == 2 && n >= 1024 && n < 2048) sc *= 0.0625f;
            const float* s = scr + (8 * c) * 33 + nl;
            h16x8 o;
#pragma unroll
            for (int e = 0; e < 8; ++e) o[e] = (h16)(s[e * 33] * sc);
            *(h16x8*)(Wt + (size_t)(row_off + row) * ld + k0 + 8 * c) = o;
        }
    }
    LDS_FENCE();
}

__device__ __forceinline__ void p0_prologue(const Params& P, unsigned char* lds, int blk, int nblk, int wv, int mode) {
    const int tid = my_tid(wv), wid = __builtin_amdgcn_readfirstlane(tid >> 6), lane = tid & 63;
    float* scr = (float*)lds + wid * (64 * 33);
    unsigned char* ws = opaque_ptr(P.ws);
    h16* WAIN = (h16*)(ws + WS_WAIN); h16* WQ = (h16*)(ws + WS_WQ); h16* WKV = (h16*)(ws + WS_WKV); h16* WAOUT = (h16*)(ws + WS_WAOUT);
    h16* WPG = (h16*)(ws + WS_WPG); h16* WPLE = (h16*)(ws + WS_WPLE); h16* WRIN = (h16*)(ws + WS_WRIN); h16* WROUT = (h16*)(ws + WS_WROUT);
    const float QSCALE = 0.08838834764831845f * 1.4426950408889634f;
    constexpr int I1 = 16 * 55, I2 = 6 * 32, I3 = 6 * 16, I4 = 8 * 16, I5 = 8 * 16, I6 = 16 * 32, I7 = 2 * 16 * 32, I8 = 2 * 4 * 32, I9 = 16 * 192, I10 = 32 * 32;
    constexpr int NIT = I1 + I2 + I3 + I4 + I5 + I6 + I7 + I8 + I9 + I10;
    const bool wgt = (nblk == 256);
    const int nslot = wgt ? 1152 : nblk, s_lo = (mode == 0) ? blk : wgt ? (blk < 128 ? 2 * blk : 256 + 7 * (blk - 128)) : blk, s_n = (mode == 0) ? 1 : wgt ? (blk < 128 ? 2 : 7) : 1, s_tot = (mode == 0) ? nblk : nslot;
    for (int sl_ = s_lo; sl_ < s_lo + s_n; ++sl_) {
    const int gw = sl_ * NWAVES + wid, ngw = s_tot * NWAVES;
    for (int it = (mode == 0 ? 0 : I1) + gw; it < (mode == 0 ? I1 : NIT); it += ngw) {
        int r = it;
        if (r < I1) { tr_item<1>(P.in[3], 1024, 1736, WAIN, 1024, 0, nullptr, 1.f, scr, r, lane); continue; } r -= I1;
        if (r < I2) { tr_item<0>(P.in[6], 384, 1024, WQ, 384, 0, P.in[4], QSCALE, scr, r, lane); continue; } r -= I2;
        if (r < I3) { tr_item<0>(P.in[7], 384, 512, WQ, 384, 1024, P.in[4], 1.f, scr, r, lane); continue; } r -= I3;
        if (r < I4) { const int h = r / 16; tr_item<0>(P.in[10] + (size_t)h * 256 * 128, 256, 128, WKV, 256, h * 128, P.in[5], 1.f, scr, r % 16, lane); continue; } r -= I4;
        if (r < I5) { const int h = r / 16; tr_item<0>(P.in[11] + (size_t)h * 256 * 128, 256, 128, WKV, 256, 1024 + h * 128, P.in[5], 1.f, scr, r % 16, lane); continue; } r -= I5;
        if (r < I6) { tr_item<0>(P.in[12], 1024, 1024, WAOUT, 1024, 0, nullptr, 1.f, scr, r, lane); continue; } r -= I6;
        if (r < I7) { const int i = r / 512; tr_item<0>(P.in[15] + (size_t)i * 1024 * 1024, 1024, 1024, WPG + (size_t)i * 1024 * 1024, 1024, 0, P.in[16] + i * 1024, 1.f, scr, r % 512, lane); continue; } r -= I7;
        if (r < I8) { const int i = r / 128; tr_item<0>(P.in[17] + (size_t)i * 256 * 1024, 256, 1024, WPLE + (size_t)i * 1024 * 256, 256, 0, nullptr, 1.f, scr, r % 128, lane); continue; } r -= I8;
        if (r < I9) { tr_item<2>(P.in[13], 1024, 6144, WRIN, 1024, 0, P.in[2] + 1024, 1.f, scr, r, lane); continue; } r -= I9;
        tr_item<0>(P.in[14], 2048, 1024, WROUT, 2048, 0, nullptr, 1.f, scr, r, lane);
    }
    }
    if (mode == 0) {
    const int gw = blk * NWAVES + wid, ngw = nblk * NWAVES;
    const int gt = blk * NTHREADS + tid, ngt = nblk * NTHREADS;
    { unsigned zz = 0u; asm volatile("" : "+v"(zz));
      for (int i = gt; i < 56 * 1024 / 8; i += ngt) ((u32x4*)(WAIN + 712 * 1024))[i] = (u32x4){zz, zz, zz, zz}; }
    {
        const float* x = P.in[0]; const f32x4* g4 = (const f32x4*)P.in[2]; h16* XN0 = (h16*)(ws + WS_R1);
        f32x4 gv[4];
#pragma unroll
        for (int j = 0; j < 4; ++j) gv[j] = g4[lane + 64 * j];
        for (int r0 = gw; r0 < T; r0 += 4 * ngw) {
            f32x4 v[4][4];
#pragma unroll
            for (int k = 0; k < 4; ++k) { const int r = (r0 + k * ngw < T) ? r0 + k * ngw : r0; const f32x4* xr = (const f32x4*)(x + (size_t)r * 1024) + lane;
#pragma unroll
                for (int j = 0; j < 4; ++j) v[k][j] = xr[64 * j]; }
#pragma unroll
            for (int k = 0; k < 4; ++k) { const int r = r0 + k * ngw; float s = 0.f;
#pragma unroll
                for (int j = 0; j < 4; ++j) s += dot4(v[k][j]);
                const float rstd = rsqrtf(wave_sum_dpp(s) * (1.0f / 1024.0f) + EPS);
                if (r < T) {
#pragma unroll
                    for (int j = 0; j < 4; ++j) { const f32x4 o = v[k][j] * rstd * gv[j]; *(h16x4*)(XN0 + (size_t)r * 1024 + (lane + 64 * j) * 4) = pack4(o); } } }
        }
    }
    }
    if (mode == 1)
    for (int sl_ = s_lo; sl_ < s_lo + s_n; ++sl_) {
    const int gt = sl_ * NTHREADS + tid, ngt = s_tot * NTHREADS;
    {
        const f32x4* p4 = (const f32x4*)P.in[1]; h16* PH0 = (h16*)(ws + WS_PH0); h16* PH1 = (h16*)(ws + WS_PH1);
        const int nv = T * 256 / 8;
        for (int i0_ = gt; i0_ < 2 * nv; i0_ += 4 * ngt) {
            f32x4 a[4], b2[4];
#pragma unroll
            for (int k = 0; k < 4; ++k) { const int i = (i0_ + k * ngt < 2 * nv) ? i0_ + k * ngt : i0_; a[k] = p4[2 * (size_t)i]; b2[k] = p4[2 * (size_t)i + 1]; }
#pragma unroll
            for (int k = 0; k < 4; ++k) { const int i = i0_ + k * ngt; if (i < 2 * nv) { h16* dst = (i < nv) ? PH0 + (size_t)i * 8 : PH1 + (size_t)(i - nv) * 8; *(h16x8*)dst = pack8(a[k], b2[k]); } }
        }
    }
    {
        f32x2* SC = (f32x2*)(ws + WS_SINCOS);
        for (int i = gt; i < L * 128; i += ngt) {
            const int pos = i >> 7, fi = i & 127;
            const float th = (float)pos * kAngle[fi];
            double rev = (double)th * 0.15915494309189535; rev -= __builtin_rint(rev);
            const float r = (float)(rev * 6.283185307179586), r2 = r * r;
            float sn = 1.9572941e-20f;
            sn = sn * r2 - 8.2206352e-18f;
            sn = sn * r2 + 2.8114573e-15f;
            sn = sn * r2 - 7.6471637e-13f;
            sn = sn * r2 + 1.6059044e-10f;
            sn = sn * r2 - 2.5052108e-8f;
            sn = sn * r2 + 2.7557319e-6f;
            sn = sn * r2 - 1.9841270e-4f;
            sn = sn * r2 + 8.3333333e-3f;
            sn = sn * r2 - 1.6666667e-1f;
            sn = sn * r2 + 1.0f;
            sn = sn * r;
            float cs = 4.1103176e-19f;
            cs = cs * r2 - 1.5619207e-16f;
            cs = cs * r2 + 4.7794773e-14f;
            cs = cs * r2 - 1.1470746e-11f;
            cs = cs * r2 + 2.0876757e-9f;
            cs = cs * r2 - 2.7557319e-7f;
            cs = cs * r2 + 2.4801587e-5f;
            cs = cs * r2 - 1.3888889e-3f;
            cs = cs * r2 + 4.1666667e-2f;
            cs = cs * r2 - 0.5f;
            cs = cs * r2 + 1.0f;
            SC[i] = (f32x2){sn, cs};
        }
    }
    }
}

__device__ __forceinline__ void p2_kidx(const Params& P, int blk, int nblk, int wv) {
    const h16* CQX = (const h16*)(P.ws + WS_CQX); h16* KIDXN = (h16*)(P.ws + WS_KIDXN); float* WIDX = (float*)(P.ws + WS_WIDX);
    const float* g = P.in[8]; const float* bb = P.in[9];
    for (int r = blk * NTHREADS + my_tid(wv); r < T; r += nblk * NTHREADS) {
        float v[64]; float s = 0.f;
#pragma unroll
        for (int c = 0; c < 8; ++c) { const h16x8 k = *(const h16x8*)(CQX + (size_t)r * 512 + 384 + c * 8);
#pragma unroll
            for (int e = 0; e < 8; ++e) { v[c * 8 + e] = (float)k[e]; s += v[c * 8 + e]; } }
        const float mu = s * (1.0f / 64.0f); float q = 0.f;
#pragma unroll
        for (int i = 0; i < 64; ++i) { v[i] -= mu; q += v[i] * v[i]; }
        const float rstd = rsqrtf(q * (1.0f / 64.0f) + EPS);
#pragma unroll
        for (int c = 0; c < 8; ++c) { h16x8 o;
#pragma unroll
            for (int e = 0; e < 8; ++e) o[e] = (h16)(v[c * 8 + e] * rstd * g[c * 8 + e] + bb[c * 8 + e]);
            *(h16x8*)(KIDXN + (size_t)r * 64 + c * 8) = o; }
        const h16x8 w = *(const h16x8*)(CQX + (size_t)r * 512 + 448);
        const float wsc = 0.04419417382415922f;
        f32x4 w0, w1;
#pragma unroll
        for (int e = 0; e < 4; ++e) { w0[e] = (float)w[e] * wsc; w1[e] = (float)w[4 + e] * wsc; }
        *(f32x4*)(WIDX + (size_t)r * 8) = w0; *(f32x4*)(WIDX + (size_t)r * 8 + 4) = w1;
    }
}

__device__ __forceinline__ unsigned fmap_u(float s) { s += 0.0f; const unsigned b = __float_as_uint(s); return (b & 0x80000000u) ? ~b : (b | 0x80000000u); }
__device__ __forceinline__ unsigned topk_select(const unsigned (&u)[32], int lane) {
    unsigned Tv = 0u;
    for (int bit = 31; bit >= 0; --bit) {
        const unsigned cand = Tv | (1u << bit); int cnt = 0;
#pragma unroll
        for (int i = 0; i < 32; ++i) cnt += __popcll(__ballot(u[i] >= cand));
        if (cnt >= 256) Tv = cand;
    }
    int gt = 0;
#pragma unroll
    for (int i = 0; i < 32; ++i) gt += __popcll(__ballot(u[i] > Tv));
    int need = 256 - gt;
    unsigned sel = 0u;
#pragma unroll
    for (int i = 0; i < 32; ++i) {
        const bool eq = (u[i] == Tv);
        const unsigned long long em = __ballot(eq);
        const int rank = (int)__builtin_amdgcn_mbcnt_hi((unsigned)(em >> 32), __builtin_amdgcn_mbcnt_lo((unsigned)em, 0u));
        const bool take = (u[i] > Tv) || (eq && rank < need);
        sel |= (take ? 1u : 0u) << i;
        need -= __popcll(em);
    }
    return sel;
}


__device__ __forceinline__ unsigned topk_select_radix(const unsigned (&u)[32], int lane, volatile __attribute__((address_space(3))) unsigned* hist) {
    typedef __attribute__((address_space(3))) unsigned lu32;
    unsigned prefix = 0u; int kk = 256;
#pragma unroll 1
    for (int pass = 0; pass < 4; ++pass) {
        const int shift = 24 - 8 * pass;
        { unsigned zz = 0u; asm volatile("" : "+v"(zz)); ((__attribute__((address_space(3))) u32x4*)hist)[lane] = (u32x4){zz, zz, zz, zz}; }
        LDS_FENCE();
#pragma unroll
        for (int i = 0; i < 32; ++i) {
            const bool in = (u[i] != 0u) && (pass == 0 || (u[i] >> (shift + 8)) == prefix);
            if (in) __hip_atomic_fetch_add((lu32*)hist + ((u[i] >> shift) & 255u), 1u, __ATOMIC_RELAXED, __HIP_MEMORY_SCOPE_WORKGROUP);
        }
        LDS_FENCE();
        const u32x4 c = ((__attribute__((address_space(3))) u32x4*)hist)[lane];
        const int tot = (int)(c[0] + c[1] + c[2] + c[3]);
        int S = tot;
#pragma unroll
        for (int o = 1; o < 64; o <<= 1) { const int v = __shfl_down(S, o); if (lane + o < 64) S += v; }
        const unsigned long long bm = __ballot(S >= kk);
        const int Ls = 63 - __builtin_clzll(bm);
        int cum = S - tot, bin = 0, above = 0; bool found = false;
#pragma unroll
        for (int j = 3; j >= 0; --j) { const int cj = (int)c[j]; if (!found && cum + cj >= kk) { bin = 4 * lane + j; above = cum; found = true; } cum += cj; }
        bin = __builtin_amdgcn_readlane(bin, Ls); above = __builtin_amdgcn_readlane(above, Ls);
        kk -= above; prefix = (prefix << 8) | (unsigned)bin;
        LDS_FENCE();
    }
    const unsigned Tv = prefix; int need = kk;
    unsigned sel = 0u;
#pragma unroll
    for (int i = 0; i < 32; ++i) {
        const bool eq = (u[i] == Tv);
        const unsigned long long em = __ballot(eq);
        const int rank = (int)__builtin_amdgcn_mbcnt_hi((unsigned)(em >> 32), __builtin_amdgcn_mbcnt_lo((unsigned)em, 0u));
        const bool take = (u[i] > Tv) || (eq && rank < need);
        sel |= (take ? 1u : 0u) << i;
        need -= __popcll(em);
    }
    return sel;
}


#define DPP_STEP_I(v, op, ident, ctrl, rmask) v = op(v, __builtin_amdgcn_update_dpp((int)(ident), v, ctrl, rmask, 0xf, false))
__device__ __forceinline__ int imax_(int a, int b) { return a > b ? a : b; }
__device__ __forceinline__ int iadd_(int a, int b) { return a + b; }
__device__ __forceinline__ int wave_scan_add(int v) {
    DPP_STEP_I(v, iadd_, 0, 0x111, 0xf); DPP_STEP_I(v, iadd_, 0, 0x112, 0xf); DPP_STEP_I(v, iadd_, 0, 0x114, 0xf); DPP_STEP_I(v, iadd_, 0, 0x118, 0xf);
    DPP_STEP_I(v, iadd_, 0, 0x142, 0xa); DPP_STEP_I(v, iadd_, 0, 0x143, 0xc); return v;
}
template <int CTRL, int RMASK> __device__ __forceinline__ float fmax_dpp_(float a) { return fmaxf(a, __builtin_bit_cast(float, __builtin_amdgcn_update_dpp((int)0xff800000u, __builtin_bit_cast(int, a), CTRL, RMASK, 0xf, false))); }
template <int CTRL, int RMASK> __device__ __forceinline__ float fmin_dpp_(float a) { return fminf(a, __builtin_bit_cast(float, __builtin_amdgcn_update_dpp((int)0x7f800000u, __builtin_bit_cast(int, a), CTRL, RMASK, 0xf, false))); }
#define DPP_RED6(v, F) do { v = F<0x111, 0xf>(v); v = F<0x112, 0xf>(v); v = F<0x114, 0xf>(v); v = F<0x118, 0xf>(v); v = F<0x142, 0xa>(v); v = F<0x143, 0xc>(v); } while (0)
__device__ __forceinline__ float wave_max_dpp(float v) { DPP_RED6(v, fmax_dpp_); return __builtin_bit_cast(float, __builtin_amdgcn_readlane(__builtin_bit_cast(int, v), 63)); }
__device__ __forceinline__ float wave_min_dpp(float v) { DPP_RED6(v, fmin_dpp_); return __builtin_bit_cast(float, __builtin_amdgcn_readlane(__builtin_bit_cast(int, v), 63)); }
__device__ __forceinline__ unsigned topk_select_lin(const float (&s)[32], unsigned valid, int lane, volatile __attribute__((address_space(3))) unsigned* ws_) {
    typedef __attribute__((address_space(3))) unsigned lu32;
    typedef __attribute__((address_space(3))) float lf32;
    typedef __attribute__((address_space(3))) f32x4 lf32x4;
    lu32* hist = (lu32*)ws_; lf32* cand = (lf32*)ws_ + 256;
    unsigned act = valid; int kk = 256; float Tv = 0.f; int need = 0; bool solved = false; int cnt = 0;
#pragma unroll 1
    for (int iter = 0; iter < 8; ++iter) {
        float mn = __builtin_inff(), mx = -__builtin_inff();
        if (iter == 0) {
#pragma unroll
            for (int i = 0; i < 32; ++i) { mn = fminf(mn, s[i]); mx = fmaxf(mx, s[i]); }
        } else {
#pragma unroll
            for (int i = 0; i < 32; ++i) { const bool a = (act >> i) & 1u; mn = fminf(mn, a ? s[i] : __builtin_inff()); mx = fmaxf(mx, a ? s[i] : -__builtin_inff()); }
        }
        mn = wave_min_dpp(mn); mx = wave_max_dpp(mx);
        if (mn == mx) { Tv = mx; need = kk; solved = true; break; }
        const float scale = 254.9f / (mx - mn), bias = -mn * scale;
        { unsigned zz = 0u; asm volatile("" : "+v"(zz)); ((__attribute__((address_space(3))) u32x4*)hist)[lane] = (u32x4){zz, zz, zz, zz}; }
        LDS_FENCE();
#pragma unroll
        for (int i = 0; i < 32; ++i) { int b = (int)fmaf(s[i], scale, bias); b = b < 0 ? 0 : b;
            __hip_atomic_fetch_add(hist + (((act >> i) & 1u) ? b : 321 + (lane & 15)), 1u, __ATOMIC_RELAXED, __HIP_MEMORY_SCOPE_WORKGROUP); }
        LDS_FENCE();
        const u32x4 c = ((__attribute__((address_space(3))) u32x4*)hist)[lane];
        const int tot = (int)(c[0] + c[1] + c[2] + c[3]);
        const int pre = wave_scan_add(tot);
        const int total = __builtin_amdgcn_readlane(pre, 63);
        const int S = total - pre + tot;
        const unsigned long long bm = __ballot(S >= kk);
        const int Ls = 63 - __builtin_clzll(bm | 1ull);
        int cum = S - tot, bin = 0, above = 0, cb = 0; bool found = false;
#pragma unroll
        for (int j = 3; j >= 0; --j) { const int cj = (int)c[j]; if (!found && cum + cj >= kk) { bin = 4 * lane + j; above = cum; cb = cj; found = true; } cum += cj; }
        bin = __builtin_amdgcn_readlane(bin, Ls); above = __builtin_amdgcn_readlane(above, Ls); cnt = __builtin_amdgcn_readlane(cb, Ls);
        kk -= above;
        { float sc2 = scale; asm volatile("" : "+v"(sc2));
#pragma unroll
          for (int i = 0; i < 32; ++i) { int b = (int)fmaf(s[i], sc2, bias); b = b < 0 ? 0 : b; act &= ~((b != bin ? 1u : 0u) << i); } }
        LDS_FENCE();
        if (cnt <= 64) break;
    }
    if (!solved) {
        cand[lane] = __builtin_nanf("");
        const int myc = __popc(act);
        int off = wave_scan_add(myc) - myc;
        LDS_FENCE();
#pragma unroll
        for (int i = 0; i < 32; ++i) { const bool a = (act >> i) & 1u; const int slot = (a && off < 64) ? off : 65 + (lane & 15); cand[slot] = s[i]; off += a ? 1 : 0; }
        LDS_FENCE();
        const int m = cnt < 64 ? cnt : 64;
        const float v = (lane < m) ? cand[lane] : -__builtin_inff();
        int gt = 0, eq = 0;
#pragma unroll
        for (int j4 = 0; j4 < 16; ++j4) { const f32x4 cj = ((lf32x4*)cand)[j4];
#pragma unroll
            for (int e = 0; e < 4; ++e) { gt += (cj[e] > v) ? 1 : 0; eq += (cj[e] == v) ? 1 : 0; } }
        const bool ok = (lane < m) && gt < kk && kk <= gt + eq;
        const unsigned long long okm = __ballot(ok);
        const int fl = okm ? __builtin_ctzll(okm) : 0;
        Tv = __builtin_bit_cast(float, __builtin_amdgcn_readlane(__builtin_bit_cast(int, v), fl)); need = kk - __builtin_amdgcn_readlane(gt, fl);
        LDS_FENCE();
    }
    unsigned sel = 0u, eqb = 0u;
#pragma unroll
    for (int i = 0; i < 32; ++i) { sel |= ((s[i] > Tv) ? 1u : 0u) << i; eqb |= ((s[i] == Tv) ? 1u : 0u) << i; }
    const int eqtot = __builtin_amdgcn_readlane(wave_scan_add(__popc(eqb)), 63);
    if (eqtot <= need) sel |= eqb;
    else {
#pragma unroll
        for (int i = 0; i < 32; ++i) {
            const bool eq = (eqb >> i) & 1u;
            const unsigned long long em = __ballot(eq);
            const int rank = (int)__builtin_amdgcn_mbcnt_hi((unsigned)(em >> 32), __builtin_amdgcn_mbcnt_lo((unsigned)em, 0u));
            sel |= ((eq && rank < need) ? 1u : 0u) << i;
            need -= __popcll(em);
        }
    }
    return sel;
}


__device__ __forceinline__ unsigned topk_select_fast(const float (&s)[32], unsigned valid, int nk, int lane, const __attribute__((address_space(3))) float* row, volatile __attribute__((address_space(3))) unsigned* ws_) {
    typedef __attribute__((address_space(3))) unsigned lu32; typedef __attribute__((address_space(3))) float lf32; typedef __attribute__((address_space(3))) f32x4 lf32x4;
    lu32* hist = (lu32*)ws_; lf32* cand = (lf32*)ws_ + 256;
    float mn = __builtin_inff(), mx = -__builtin_inff();
#pragma unroll
    for (int i = 0; i < 32; ++i) { mn = fminf(mn, s[i]); mx = fmaxf(mx, s[i]); }
    mn = wave_min_dpp(mn); mx = wave_max_dpp(mx);
    const bool flat = (mn == mx);
    const float scale = flat ? 0.f : 254.9f / (mx - mn), bias = flat ? 0.f : -mn * scale;
    { unsigned zz = 0u; asm volatile("" : "+v"(zz)); ((__attribute__((address_space(3))) u32x4*)hist)[lane] = (u32x4){zz, zz, zz, zz}; }
    LDS_FENCE();
    const int full = nk >> 6, rem = nk & 63;
#pragma unroll
    for (int i = 0; i < 32; ++i) if (i <= full) { int b = (int)fmaf(s[i], scale, bias); b = b < 0 ? 0 : b; __hip_atomic_fetch_add(hist + b, 1u, __ATOMIC_RELAXED, __HIP_MEMORY_SCOPE_WORKGROUP); }
    LDS_FENCE();
    u32x4 c = ((__attribute__((address_space(3))) u32x4*)hist)[lane];
    if (lane == 0 && full < 32) c[0] -= (unsigned)(64 - rem);
    const int tot = (int)(c[0] + c[1] + c[2] + c[3]);
    const int pre = wave_scan_add(tot), total = __builtin_amdgcn_readlane(pre, 63);
    const int S = total - pre + tot;
    const unsigned long long bm = __ballot(S >= 256);
    const int Ls = 63 - __builtin_clzll(bm | 1ull);
    int cum = S - tot, bin = 0, above = 0, cb = 0; bool found = false;
#pragma unroll
    for (int j = 3; j >= 0; --j) { const int cj = (int)c[j]; if (!found && cum + cj >= 256) { bin = 4 * lane + j; above = cum; cb = cj; found = true; } cum += cj; }
    bin = __builtin_amdgcn_readlane(bin, Ls); above = __builtin_amdgcn_readlane(above, Ls); const int cnt = __builtin_amdgcn_readlane(cb, Ls);
    if (flat || cnt > 64) return topk_select_lin(s, valid, lane, ws_);
    const int kk = 256 - above;
    unsigned gtb = 0u, eqb = 0u;
    { float sc2 = scale; asm volatile("" : "+v"(sc2));
#pragma unroll
      for (int i = 0; i < 32; ++i) if (i <= full) { int b = (int)fmaf(s[i], sc2, bias); b = b < 0 ? 0 : b; gtb |= (b > bin ? 1u : 0u) << i; eqb |= (b == bin ? 1u : 0u) << i; } }
    eqb &= valid;
    cand[lane] = __builtin_nanf("");
    int off = wave_scan_add(__popc(eqb)) - __popc(eqb);
    LDS_FENCE();
    { unsigned m = eqb;
      while (__any(m != 0u)) { if (m != 0u) { const int i = __builtin_ctz(m); cand[off < 64 ? off : 65 + (lane & 15)] = row[i * 64 + lane]; ++off; m &= m - 1u; } } }
    LDS_FENCE();
    const float v = (lane < cnt) ? cand[lane] : -__builtin_inff();
    int gt = 0, eq = 0;
#pragma unroll
    for (int j4 = 0; j4 < 16; ++j4) { const f32x4 cj = ((lf32x4*)cand)[j4];
#pragma unroll
        for (int e = 0; e < 4; ++e) { gt += (cj[e] > v) ? 1 : 0; eq += (cj[e] == v) ? 1 : 0; } }
    const unsigned long long okm = __ballot((lane < cnt) && gt < kk && kk <= gt + eq);
    const int fl = okm ? __builtin_ctzll(okm) : 0;
    const float Tv = __builtin_bit_cast(float, __builtin_amdgcn_readlane(__builtin_bit_cast(int, v), fl)); int need = kk - __builtin_amdgcn_readlane(gt, fl);
    const int eqtot = __builtin_amdgcn_readlane(eq, fl);
    LDS_FENCE();
    unsigned sel = gtb;
    if (eqtot <= need) {
        unsigned m = eqb;
        while (__any(m != 0u)) { if (m != 0u) { const int i = __builtin_ctz(m); if (row[i * 64 + lane] >= Tv) sel |= 1u << i; m &= m - 1u; } }
    } else {
#pragma unroll
        for (int i = 0; i < 32; ++i) {
            const bool inb = (eqb >> i) & 1u; const bool e_ = inb && (s[i] == Tv);
            const unsigned long long em = __ballot(e_);
            const int rank = (int)__builtin_amdgcn_mbcnt_hi((unsigned)(em >> 32), __builtin_amdgcn_mbcnt_lo((unsigned)em, 0u));
            sel |= (((inb && s[i] > Tv) || (e_ && rank < need)) ? 1u : 0u) << i;
            need -= __popcll(em);
        }
    }
    return sel;
}

__device__ __forceinline__ void p3_indexer_naive(const Params& P, unsigned char* lds, int blk, int nblk, int wv) {
    const int tid = my_tid(wv), wid = __builtin_amdgcn_readfirstlane(tid >> 6), lane = tid & 63;
    float* sc = (float*)lds + wid * 2048; float* qf = (float*)(lds + 65536) + wid * 512; float* wf = (float*)(lds + 65536 + 16384) + wid * 8;
    const h16* QIDX = (const h16*)(P.ws + WS_QIDX); const h16* KIDXN = (const h16*)(P.ws + WS_KIDXN); const float* WIDX = (const float*)(P.ws + WS_WIDX);
    unsigned long long* MASK = (unsigned long long*)(P.ws + WS_MASK);
    const int gw = blk * NWAVES + wid, ngw = nblk * NWAVES;
    for (int it = gw; it < T; it += ngw) {
        const int b = it >> 11, pos = ((it & 2047) + b * 389) & 2047, t = b * L + pos, nk = pos + 1;
        { const h16x8 qv = *(const h16x8*)(QIDX + (size_t)t * 512 + lane * 8);
#pragma unroll
          for (int e = 0; e < 8; ++e) qf[lane * 8 + e] = (float)qv[e];
          if (lane < 8) wf[lane] = WIDX[(size_t)t * 8 + lane]; }
        LDS_FENCE();
        for (int i = 0; i * 64 < nk; ++i) {
            const int key = i * 64 + lane; float score = 0.f;
            if (key < nk) {
                const h16x8* kp = (const h16x8*)(KIDXN + (size_t)(b * L + key) * 64);
                float kf[64];
#pragma unroll
                for (int c = 0; c < 8; ++c) { const h16x8 kv = kp[c];
#pragma unroll
                    for (int e = 0; e < 8; ++e) kf[c * 8 + e] = (float)kv[e]; }
                for (int h = 0; h < 8; ++h) {
                    float a = 0.f;
#pragma unroll
                    for (int d = 0; d < 64; ++d) a = fmaf(qf[h * 64 + d], kf[d], a);
                    score += fmaxf(a, 0.f) * wf[h];
                }
            }
            sc[key] = score;
        }
        LDS_FENCE();
        unsigned selbits = 0u;
        if (nk <= 256) {
#pragma unroll
            for (int i = 0; i < 32; ++i) selbits |= ((i * 64 + lane) < nk ? 1u : 0u) << i;
        } else {
            unsigned u[32];
#pragma unroll
            for (int i = 0; i < 32; ++i) { const int key = i * 64 + lane; const float s = sc[key]; u[i] = (key < nk) ? fmap_u(s) : 0u; }
            selbits = topk_select(u, lane);
        }
#pragma unroll
        for (int i = 0; i < 32; ++i) { const unsigned long long bal = __ballot((selbits >> i) & 1u); if (lane == 0) MASK[(size_t)t * 32 + i] = bal; }
        LDS_FENCE();
    }
}


typedef float f32x16 __attribute__((ext_vector_type(16)));
__device__ __forceinline__ h16x8 relu_pk8(const f32x16& s, int base) {
    h16x8 r;
#pragma unroll
    for (int e = 0; e < 4; ++e) { const h16x2 p = __builtin_bit_cast(h16x2, __builtin_amdgcn_cvt_pkrtz(fmaxf(s[base + 2 * e], 0.f), fmaxf(s[base + 2 * e + 1], 0.f))); r[2 * e] = p[0]; r[2 * e + 1] = p[1]; }
    return r;
}
#define P3_QG(u_) ((((u_) >> 4) & 16) ? (((u_) >> 4) ^ 15) : ((u_) >> 4))
__device__ __forceinline__ void p3_indexer(const Params& P, unsigned char* lds_, int blk, int nblk, int wv) {
    typedef __attribute__((address_space(3))) float lfloat;
    const int tid = my_tid(wv), wid = __builtin_amdgcn_readfirstlane(tid >> 6), lane = tid & 63;
    unsigned char* ws = opaque_ptr(P.ws);
    lfloat* sc = (lfloat*)lds_;
    const h16* QIDX = (const h16*)(ws + WS_QIDX); const h16* KIDXN = (const h16*)(ws + WS_KIDXN); const float* WIDX = (const float*)(ws + WS_WIDX);
    unsigned long long* MASK = (unsigned long long*)(ws + WS_MASK);
    h16x8 Afn[4][4]; f32x4 wn = (f32x4){0.f, 0.f, 0.f, 0.f};
    { const int r = lane & 31, h = lane >> 5; const int u0 = (blk < NB * (L / 16)) ? blk : 0; const int tt0 = (u0 & 15) * L + P3_QG(u0) * 16;
#pragma unroll
      for (int g = 0; g < 4; ++g)
#pragma unroll
          for (int s = 0; s < 4; ++s) Afn[g][s] = *(const h16x8*)(QIDX + (size_t)(tt0 + 4 * g + (r >> 3)) * 512 + (r & 7) * 64 + 16 * s + 8 * h);
      if (r < 16) wn = *(const f32x4*)(WIDX + (size_t)(tt0 + r) * 8 + 4 * h); }
    for (int unit = blk; unit < NB * (L / 16); unit += nblk) {
        const int b = unit & 15, qg = P3_QG(unit), p0 = qg * 16, t0 = b * L + p0, NT = (p0 + 15) / 32 + 1;
        int lane_o = lane; asm volatile("" : "+v"(lane_o));
        const int r = lane_o & 31, h = lane_o >> 5;
        h16x8 Af[4][4];
#pragma unroll
        for (int g = 0; g < 4; ++g)
#pragma unroll
            for (int s = 0; s < 4; ++s) Af[g][s] = Afn[g][s];
        h16x8 fragA;
        { const f32x4 w = wn;
          const h16 z = (h16)0.f;
          if (r & 1) { fragA[0] = z; fragA[1] = z; fragA[2] = z; fragA[3] = z; fragA[4] = (h16)w[0]; fragA[5] = (h16)w[1]; fragA[6] = (h16)w[2]; fragA[7] = (h16)w[3]; }
          else { fragA[0] = (h16)w[0]; fragA[1] = (h16)w[1]; fragA[2] = (h16)w[2]; fragA[3] = (h16)w[3]; fragA[4] = z; fragA[5] = z; fragA[6] = z; fragA[7] = z; } }
        const int code = (r < 16) ? (r >> 1) : -1;
        const h16* kbase = KIDXN + (size_t)b * L * 64 + (size_t)r * 64 + 8 * h;
        h16x8 Bf[4];
        if (wid < NT) {
#pragma unroll
            for (int s = 0; s < 4; ++s) Bf[s] = *(const h16x8*)(kbase + (size_t)wid * 32 * 64 + 16 * s);
        }
        for (int rep_ = 0; rep_ <= MK_P3_REPA; ++rep_) {
        if (rep_ > 0 && wid < NT) {
#pragma unroll
            for (int s = 0; s < 4; ++s) Bf[s] = *(const h16x8*)(kbase + (size_t)wid * 32 * 64 + 16 * s);
        }
        for (int kt = wid; kt < NT; kt += NWAVES) {
            h16x8 Bn[4];
            const int ktn = (kt + NWAVES < NT) ? kt + NWAVES : kt;
#pragma unroll
            for (int s = 0; s < 4; ++s) Bn[s] = *(const h16x8*)(kbase + (size_t)ktn * 32 * 64 + 16 * s);
            f32x16 C = {};
#pragma unroll
            for (int g = 0; g < 4; ++g) {
                f32x16 S = {};
#pragma unroll
                for (int s = 0; s < 4; ++s) S = __builtin_amdgcn_mfma_f32_32x32x16_f16(Af[g][s], Bf[s], S, 0, 0, 0);
                const h16x8 X0 = relu_pk8(S, 0), X1 = relu_pk8(S, 8);
                const h16x8 zero8 = (h16x8){0, 0, 0, 0, 0, 0, 0, 0};
                const h16x8 W0 = (code == 2 * g) ? fragA : zero8, W1 = (code == 2 * g + 1) ? fragA : zero8;
                C = __builtin_amdgcn_mfma_f32_32x32x16_f16(W0, X0, C, 0, 0, 0);
                C = __builtin_amdgcn_mfma_f32_32x32x16_f16(W1, X1, C, 0, 0, 0);
            }
            const int key = kt * 32 + r;
#pragma unroll
            for (int e = 0; e < 4; ++e) { sc[(e + 4 * h) * 2048 + key] = C[e]; sc[(8 + e + 4 * h) * 2048 + key] = C[4 + e]; }
#pragma unroll
            for (int s = 0; s < 4; ++s) Bf[s] = Bn[s];
        }
        }
        __syncthreads();
        { const int un = (unit + nblk < NB * (L / 16)) ? unit + nblk : unit; const int ttn = (un & 15) * L + P3_QG(un) * 16;
#pragma unroll
          for (int g = 0; g < 4; ++g)
#pragma unroll
              for (int s = 0; s < 4; ++s) Afn[g][s] = *(const h16x8*)(QIDX + (size_t)(ttn + 4 * g + (r >> 3)) * 512 + (r & 7) * 64 + 16 * s + 8 * h);
          if (r < 16) wn = *(const f32x4*)(WIDX + (size_t)(ttn + r) * 8 + 4 * h); }
#pragma unroll 1
        for (int qq_ = 0; qq_ < 2 * (1 + MK_P3_REPB); ++qq_) {
            const int qq = qq_ & 1;
            const int qi = 2 * wid + qq, pos = p0 + qi, nk = pos + 1, t = t0 + qi;
            unsigned selbits = 0u;
            if (nk <= 256) {
#pragma unroll
                for (int i = 0; i < 32; ++i) selbits |= ((i * 64 + lane) < nk ? 1u : 0u) << i;
            } else {
                float sv[32];
                const int full = nk >> 6;
                const unsigned valid = (full >= 32 ? 0xffffffffu : ((1u << full) - 1u)) | ((full < 32 && lane < (nk & 63)) ? (1u << full) : 0u);
#pragma unroll
                for (int i = 0; i < 32; ++i) { const float x = sc[qi * 2048 + i * 64 + lane]; sv[i] = ((valid >> i) & 1u) ? x : __builtin_nanf(""); }
                selbits = topk_select_fast(sv, valid, nk, lane, (const __attribute__((address_space(3))) float*)(sc + qi * 2048), (volatile __attribute__((address_space(3))) unsigned*)(sc + 16 * 2048 + wid * 448));
            }
            {
                __attribute__((address_space(3))) unsigned long long* stg = (__attribute__((address_space(3))) unsigned long long*)(sc + 16 * 2048 + wid * 448 + (qq ? 0 : 338));
                LDS_FENCE();
#pragma unroll
                for (int i = 0; i < 32; ++i) { const unsigned long long bal = __ballot((selbits >> i) & 1u); if (lane == 0) stg[i] = bal; }
            }
            (void)t;
        }
        __syncthreads();
        { const int q = tid & 15, tl = tid >> 4;
          MASK[((size_t)b * 32 + tl) * L + p0 + q] = ((__attribute__((address_space(3))) unsigned long long*)(sc + 16 * 2048 + (q >> 1) * 448 + ((q & 1) ? 0 : 338)))[tl]; }
    }
}

__device__ __forceinline__ void p4_attn_naive(const Params& P, unsigned char* lds, int blk, int nblk, int wv) {
    const int tid = my_tid(wv), wid = __builtin_amdgcn_readfirstlane(tid >> 6), lane = tid & 63;
    int* keys = (int*)lds; float* qf = (float*)(lds + 1024); float* pf = (float*)(lds + 1024 + 4096) + wid * 256; int* nselp = (int*)(lds + 1024 + 4096 + 8192);
    h16* QA = (h16*)(P.ws + WS_R1); const h16* Kb = (const h16*)(P.ws + WS_R2); const h16* Vb = (const h16*)(P.ws + WS_R3); const h16* SG = (const h16*)(P.ws + WS_R4);
    const unsigned long long* MASK = (const unsigned long long*)(P.ws + WS_MASK);
    for (int t = blk; t < T; t += nblk) {
        const int b = t >> 11;
        __syncthreads();
        if (tid < 128) { const h16x8 qv = *(const h16x8*)(QA + (size_t)t * 1024 + tid * 8);
#pragma unroll
            for (int e = 0; e < 8; ++e) qf[tid * 8 + e] = (float)qv[e]; }
        if (wid == 0) {
            unsigned long long m = (lane < 32) ? MASK[(size_t)t * 32 + lane] : 0ull;
            const int cnt = __popcll(m); int inc = cnt;
#pragma unroll
            for (int o = 1; o < 64; o <<= 1) { const int v = __shfl_up(inc, o); if (lane >= o) inc += v; }
            int off = inc - cnt;
            while (m) { const int k = __builtin_ctzll(m); keys[off++] = lane * 64 + k; m &= m - 1; }
            if (lane == 63) nselp[0] = inc;
        }
        __syncthreads();
        const int nsel = nselp[0], h = wid;
        float s[4];
#pragma unroll
        for (int c = 0; c < 4; ++c) {
            const int idx = lane + 64 * c; s[c] = -INFINITY;
            if (idx < nsel) {
                const h16x8* kp = (const h16x8*)(Kb + (size_t)(b * L + keys[idx]) * 1024 + h * 128); float a = 0.f;
#pragma unroll
                for (int cc = 0; cc < 16; ++cc) { const h16x8 kv = kp[cc];
#pragma unroll
                    for (int e = 0; e < 8; ++e) a = fmaf(qf[h * 128 + cc * 8 + e], (float)kv[e], a); }
                s[c] = a;
            }
        }
        const float mx = wave_max(fmaxf(fmaxf(s[0], s[1]), fmaxf(s[2], s[3])));
        float ls = 0.f;
#pragma unroll
        for (int c = 0; c < 4; ++c) { const int idx = lane + 64 * c; const float p = (idx < nsel) ? exp2f(s[c] - mx) : 0.f; pf[idx] = p; ls += p; }
        ls = wave_sum(ls);
        LDS_FENCE();
        float o0 = 0.f, o1 = 0.f;
        for (int k = 0; k < nsel; ++k) {
            const h16x2 v = *(const h16x2*)(Vb + (size_t)(b * L + keys[k]) * 1024 + h * 128 + 2 * lane); const float pk = pf[k];
            o0 = fmaf(pk, (float)v[0], o0); o1 = fmaf(pk, (float)v[1], o1);
        }
        const float inv = 1.0f / ls;
        const h16x2 g = *(const h16x2*)(SG + (size_t)t * 1024 + h * 128 + 2 * lane);
        h16x2 o; o[0] = (h16)(o0 * inv * (float)g[0]); o[1] = (h16)(o1 * inv * (float)g[1]);
        *(h16x2*)(QA + (size_t)t * 1024 + h * 128 + 2 * lane) = o;
    }
}


namespace att {
typedef unsigned short bf16;
typedef short bf16x8 __attribute__((ext_vector_type(8)));
typedef short s16x4 __attribute__((ext_vector_type(4)));
typedef float f32x16 __attribute__((ext_vector_type(16)));
typedef __attribute__((address_space(3))) char lchar;
typedef __attribute__((address_space(3))) float lfloat;
typedef __attribute__((address_space(3))) bf16x8 lbf16x8;
constexpr int D = 128, PITCH = 1024, NW = 8, QBLK = 32, KVBLK = 64, QB = NW * QBLK;
constexpr int SHM_V = KVBLK * D * 2, SHM_K = KVBLK * D * 2;
constexpr int LDS_ATT = 2 * SHM_V + 2 * SHM_K + NW * 64 * 4;
constexpr float THR = 8.f;
#define KSWZ(row, colB) ((row) * 256 + ((colB) ^ (((row) & 7) << 4)))
#define SBAR() __builtin_amdgcn_sched_barrier(0)
__device__ __forceinline__ int v_st(int k, int c) { const int kk = (k & ~0xC) | ((k & 4) << 1) | ((k & 8) >> 1); return ((kk >> 3) * 4 + (c >> 5)) * 512 + ((kk & 7) * 32 + (c & 31)) * 2; }
__device__ __forceinline__ int v_rd_base(int lane) { return ((lane & 3) << 3) | (((lane >> 2) & 3) << 6) | (((lane >> 4) & 1) << 5) | (((lane >> 5) & 1) << 8); }
constexpr int v_rd_off(int d0, int ks, int half) { return d0 * 512 + ks * 4096 + half * 2048; }
__device__ __forceinline__ int crow(int r, int hi) { return (r & 3) + 8 * (r >> 2) + 4 * hi; }
__device__ __forceinline__ bf16x8 load8(const bf16* p) { return *reinterpret_cast<const bf16x8*>(p); }
__device__ __forceinline__ void mask_init(f32x16& p0, f32x16& p1, unsigned long long mk, int hi) {
    const unsigned lo = (unsigned)mk >> (4 * hi), hh = (unsigned)(mk >> 32) >> (4 * hi);
#pragma unroll
    for (int r = 0; r < 16; ++r) {
        const int c = (r & 3) + 8 * (r >> 2);
        const int t0 = __builtin_amdgcn_sbfe(lo, c, 1), t1 = __builtin_amdgcn_sbfe(hh, c, 1);
        p0[r] = __uint_as_float(~(unsigned)t0 & 0xff800000u); p1[r] = __uint_as_float(~(unsigned)t1 & 0xff800000u);
    }
}
__device__ __forceinline__ void partialSM(f32x16& p0, f32x16& p1, float& m_reg, float& mn, float& alpha) {
    float pmax = p0[0]; for (int r = 1; r < 16; ++r) pmax = fmaxf(pmax, p0[r]); for (int r = 0; r < 16; ++r) pmax = fmaxf(pmax, p1[r]);
    { auto rr = __builtin_amdgcn_permlane32_swap(__float_as_uint(pmax), __float_as_uint(pmax), false, false);
      pmax = fmaxf(__uint_as_float(rr[0]), __uint_as_float(rr[1])); }
    if (__builtin_expect(__all((pmax - m_reg) <= THR), 1)) { mn = m_reg; alpha = 1.f; }
    else { mn = fmaxf(m_reg, pmax); alpha = __builtin_amdgcn_exp2f(m_reg - mn); m_reg = mn; }
    for (int r = 0; r < 16; ++r) p0[r] = p0[r] - mn; for (int r = 0; r < 16; ++r) p1[r] = p1[r] - mn;
    for (int r = 0; r < 16; ++r) p0[r] = __builtin_amdgcn_exp2f(p0[r]);
}
__device__ __forceinline__ void finishSM(f32x16& p0, f32x16& p1, float alpha, float& l_reg, bf16x8& pa0, bf16x8& pa1, bf16x8& pa2, bf16x8& pa3) {
    for (int r = 0; r < 16; ++r) p1[r] = __builtin_amdgcn_exp2f(p1[r]);
    float ps = 0; for (int r = 0; r < 16; ++r) ps += p0[r]; for (int r = 0; r < 16; ++r) ps += p1[r];
    { auto rr = __builtin_amdgcn_permlane32_swap(__float_as_uint(ps), __float_as_uint(ps), false, false);
      ps = __uint_as_float(rr[0]) + __uint_as_float(rr[1]); }
    l_reg = l_reg * alpha + ps;
#define PK4(P, B_, OUT) do { unsigned a0 = cvtpk_bf16(P[B_+0], P[B_+1]), a1 = cvtpk_bf16(P[B_+2], P[B_+3]);                          \
        unsigned b0 = cvtpk_bf16(P[B_+4], P[B_+5]), b1 = cvtpk_bf16(P[B_+6], P[B_+7]);                                             \
        auto r0 = __builtin_amdgcn_permlane32_swap(a0, b0, false, false); auto r1 = __builtin_amdgcn_permlane32_swap(a1, b1, false, false); \
        u32x4 w = {r0[0], r1[0], r0[1], r1[1]}; OUT = *reinterpret_cast<bf16x8*>(&w); } while (0)
    PK4(p0, 0, pa0); PK4(p0, 8, pa1); PK4(p1, 0, pa2); PK4(p1, 8, pa3);
#undef PK4
}
template <int KB>
__device__ __forceinline__ void qkt(f32x16& p0, f32x16& p1, const lchar* K_lds, int r32, int hi, const bf16x8* qr) {
    const lchar* kb[4];
#pragma unroll
    for (int dd = 0; dd < 4; ++dd) kb[dd] = K_lds + KB * SHM_K + KSWZ(r32, (dd * 16 + hi * 8) * 2);
#pragma unroll
    for (int d0 = 0; d0 < 8; ++d0) { const lchar* a = kb[d0 & 3] + (d0 >> 2) * 128;
        bf16x8 b0 = *(const lbf16x8*)(a);
        bf16x8 b1 = *(const lbf16x8*)(a + 32 * 256);
        p0 = __builtin_amdgcn_mfma_f32_32x32x16_bf16(b0, qr[d0], p0, 0, 0, 0);
        p1 = __builtin_amdgcn_mfma_f32_32x32x16_bf16(b1, qr[d0], p1, 0, 0, 0); }
}
template <int VB>
__device__ __forceinline__ void pv_tile(f32x16* o, int vb0, bf16x8 pa0, bf16x8 pa1, bf16x8 pa2, bf16x8 pa3) {
#define TRRD(dst, off) asm volatile("ds_read_b64_tr_b16 %0, %1 offset:%2" : "=&v"(dst) : "v"(vb0), "i"(off) : "memory")
#define PV_D0(d0) do { s16x4 l0, l1, l2, l3, h0, h1, h2, h3; constexpr int b_ = VB * SHM_V + v_rd_off(d0, 0, 0); \
        TRRD(l0, b_); TRRD(h0, b_ + 2048); TRRD(l1, b_ + 4096); TRRD(h1, b_ + 6144); TRRD(l2, b_ + 8192); TRRD(h2, b_ + 10240); TRRD(l3, b_ + 12288); TRRD(h3, b_ + 14336); \
        asm volatile("s_waitcnt lgkmcnt(0)" ::: "memory"); SBAR();   \
        o[d0] = __builtin_amdgcn_mfma_f32_32x32x16_bf16(pa0, (bf16x8){l0[0], l0[1], l0[2], l0[3], h0[0], h0[1], h0[2], h0[3]}, o[d0], 0, 0, 0);   \
        o[d0] = __builtin_amdgcn_mfma_f32_32x32x16_bf16(pa1, (bf16x8){l1[0], l1[1], l1[2], l1[3], h1[0], h1[1], h1[2], h1[3]}, o[d0], 0, 0, 0);   \
        o[d0] = __builtin_amdgcn_mfma_f32_32x32x16_bf16(pa2, (bf16x8){l2[0], l2[1], l2[2], l2[3], h2[0], h2[1], h2[2], h2[3]}, o[d0], 0, 0, 0);   \
        o[d0] = __builtin_amdgcn_mfma_f32_32x32x16_bf16(pa3, (bf16x8){l3[0], l3[1], l3[2], l3[3], h3[0], h3[1], h3[2], h3[3]}, o[d0], 0, 0, 0); } while (0)
    PV_D0(0); PV_D0(1); PV_D0(2); PV_D0(3);
#undef PV_D0
#undef TRRD
}
struct BlockRef { const bf16* Q; const bf16* K; const bf16* V; h16* O; const unsigned long long* M; const h16* G; int P0; };
struct Seam { bf16x8 qr[8]; bf16x8 st_v0, st_v1, st_k0, st_k1; };
#define VMW() asm volatile("s_waitcnt vmcnt(0)" ::: "memory")
#define VMWN(n) asm volatile("s_waitcnt vmcnt(%0)" :: "i"(n) : "memory")
#define SLOAD_H(Kp, Vp, k0) do { const unsigned o0_ = ro0 + (unsigned)(k0) * PITCH, o1_ = o0_ + 32u * PITCH;     \
                         S.st_v0 = load8((Vp) + o0_); S.st_v1 = load8((Vp) + o1_); S.st_k0 = load8((Kp) + o0_); S.st_k1 = load8((Kp) + o1_); } while (0)
#define SWRITE_HK(bf) do { *(lbf16x8*)(K_lds + (bf) * SHM_K + kws) = S.st_k0; *(lbf16x8*)(K_lds + (bf) * SHM_K + kws + 32 * 256) = S.st_k1; } while (0)
#define SWRITE_HV(bf) do { *(lbf16x8*)(V_lds + (bf) * SHM_V + vst0) = S.st_v0; *(lbf16x8*)(V_lds + (bf) * SHM_V + vst1) = S.st_v1; } while (0)
#define SWRITE_H(bf) do { SWRITE_HV(bf); SWRITE_HK(bf); } while (0)
__device__ __forceinline__ void prime(const BlockRef& cur, lchar* lds, Seam& S, int wv) {
    const int tid = my_tid(wv);
    const int wid = __builtin_amdgcn_readfirstlane(tid >> 6), lane = tid & 63, r32 = lane & 31, hi = lane >> 5;
    const int sr = tid >> 4, sc = (tid & 15) * 8, kws = KSWZ(sr, sc * 2); lchar* K_lds = lds + 2 * SHM_V;
    const unsigned ro0 = (unsigned)(sr * PITCH + sc), qo = (unsigned)((wid * QBLK + r32) * PITCH + hi * 8);
    for (int d0 = 0; d0 < 8; ++d0) S.qr[d0] = load8(cur.Q + (qo + (unsigned)(d0 * 16)));
    SLOAD_H(cur.K, cur.V, 0); VMW(); SWRITE_HK(0);
    __syncthreads();
}
__device__ __forceinline__ void block(const BlockRef& cur, const BlockRef& nxt, lchar* lds, Seam& S, int wv) {
    const int tid = my_tid(wv);
    const int wid = __builtin_amdgcn_readfirstlane(tid >> 6), lane = tid & 63, r32 = lane & 31, hi = lane >> 5;
    const int NT = (cur.P0 + QB - 1) / KVBLK + 1;
    lchar* V_lds = lds; lchar* K_lds = lds + 2 * SHM_V;
    lfloat* ws = (lfloat*)(lds + 2 * SHM_V + 2 * SHM_K) + wid * 64; lfloat* li_l = ws, * al_l = ws + 32;
    float m_reg = -1e30f, l_reg = 0; f32x16 o[4] = {};
    const int sr = tid >> 4, sc = (tid & 15) * 8, vst0 = v_st(sr, sc), vst1 = v_st(32 + sr, sc), kws = KSWZ(sr, sc * 2);
    const int vb0 = (int)(unsigned)(uintptr_t)V_lds + v_rd_base(lane);
    const unsigned ro0 = (unsigned)(sr * PITCH + sc), qo = (unsigned)((wid * QBLK + r32) * PITCH + hi * 8);
    const bf16* Kh = cur.K; const bf16* Vh = cur.V;
    const unsigned mro = (unsigned)(wid * QBLK + r32) * 8u;
#define LDMASK(tile) (*(const unsigned long long*)((const char*)cur.M + (mro + (unsigned)(tile) * (unsigned)(L * 8))))
    unsigned long long mk;
#define RESC(a) do { if (__any((a) < 1.f)) { if (hi == 0) al_l[r32] = (a); asm volatile("s_waitcnt lgkmcnt(0)" ::: "memory");              \
                     for (int d_ = 0; d_ < 4; ++d_) for (int r = 0; r < 16; ++r) o[d_][r] *= al_l[crow(r, hi)]; } } while (0)
#define KBASE(t) ((t) * KVBLK)
    constexpr int NQL = 8;
#define SEAM_K0() do { VMWN(NQL); SWRITE_HK(0); SBAR(); } while (0)
    f32x16 pA0, pA1, pB0, pB1; float mnA, mnB, alA, alB; bf16x8 pa0, pa1, pa2, pa3;
    SWRITE_HV(0); SBAR();
    mk = LDMASK(0);
    if (NT > 1) { SLOAD_H(Kh, Vh, KBASE(1)); }
    mask_init(pA0, pA1, mk, hi); if (NT > 1) mk = LDMASK(1);
    SBAR(); qkt<0>(pA0, pA1, K_lds, r32, hi, S.qr);
    partialSM(pA0, pA1, m_reg, mnA, alA);
    if (NT > 1) { VMW(); SWRITE_H(1); }
    __syncthreads();
#define HALF_STEP(PX0, PX1, mnX, alX, PY0, PY1, alY, t, KB, VB, SB) do {                                                      \
        mask_init(PX0, PX1, mk, hi);                                       \
        SBAR(); qkt<KB>(PX0, PX1, K_lds, r32, hi, S.qr);                                                                      \
        if ((t) + 1 < NT) mk = LDMASK((t) + 1);                                                              \
        finishSM(PY0, PY1, alY, l_reg, pa0, pa1, pa2, pa3); SBAR();                                                           \
        if ((t) + 1 < NT) { SLOAD_H(Kh, Vh, KBASE((t) + 1)); SBAR(); }                                                        \
        pv_tile<VB>(o, vb0, pa0, pa1, pa2, pa3); partialSM(PX0, PX1, m_reg, mnX, alX);                                        \
        __syncthreads();                                                                                                      \
        if ((t) + 1 < NT) { VMW(); SWRITE_H(SB); }                                                                            \
        RESC(alX); __syncthreads(); } while (0)
    for (int t = 1; t + 1 < NT; t += 2) {
        HALF_STEP(pB0, pB1, mnB, alB, pA0, pA1, alA, t, 1, 0, 0);
        HALF_STEP(pA0, pA1, mnA, alA, pB0, pB1, alB, t + 1, 0, 1, 1);
    }
    const bool even = (NT & 1) == 0;
    if (even) { mask_init(pB0, pB1, mk, hi); SBAR(); qkt<1>(pB0, pB1, K_lds, r32, hi, S.qr); SBAR(); }
    SLOAD_H(nxt.K, nxt.V, 0); SBAR();
#pragma unroll
    for (int d0 = 0; d0 < 8; ++d0) S.qr[d0] = load8(nxt.Q + (qo + (unsigned)(d0 * 16)));
    SBAR();
    finishSM(pA0, pA1, alA, l_reg, pa0, pa1, pa2, pa3); SBAR();
    pv_tile<0>(o, vb0, pa0, pa1, pa2, pa3);
    if (even) { partialSM(pB0, pB1, m_reg, mnB, alB); __syncthreads(); RESC(alB);
        finishSM(pB0, pB1, alB, l_reg, pa0, pa1, pa2, pa3); SBAR(); pv_tile<1>(o, vb0, pa0, pa1, pa2, pa3); }
    SBAR(); SEAM_K0();
    if (hi == 0) li_l[r32] = l_reg; asm volatile("s_waitcnt lgkmcnt(0)" ::: "memory");
    float rli[16];
#pragma unroll
    for (int r = 0; r < 16; ++r) rli[r] = __builtin_amdgcn_rcpf(li_l[crow(r, hi)]);
    __syncthreads();
    {
        typedef __attribute__((address_space(3))) h16 lh16; typedef __attribute__((address_space(3))) h16x8 lh16x8_;
        lchar* ob = V_lds + wid * 4096;
#pragma unroll
        for (int half = 0; half < 2; ++half) {
#pragma unroll
            for (int r = 0; r < 16; ++r) { const int orow = crow(r, hi);
#pragma unroll
                for (int dd = 0; dd < 2; ++dd) *(lh16*)(ob + orow * 128 + (dd * 32 + r32) * 2) = (h16)(o[half * 2 + dd][r] * rli[r]); }
            asm volatile("s_waitcnt lgkmcnt(0)" ::: "memory");
#pragma unroll
            for (int i = 0; i < 4; ++i) { const int c = lane + 64 * i, row = c >> 3, c8 = c & 7;
                const h16x8 ov = *(const lh16x8_*)(ob + row * 128 + c8 * 16);
                const unsigned oo = (unsigned)((wid * QBLK + row) * PITCH + half * 64 + c8 * 8);
                const h16x8 gv = *(const h16x8*)(cur.G + oo);
                *(h16x8*)(cur.O + oo) = ov * gv; }
            asm volatile("s_waitcnt lgkmcnt(0)" ::: "memory");
        }
    }
    __syncthreads();
#undef LDMASK
#undef RESC
#undef KBASE
#undef SEAM_K0
#undef HALF_STEP
}
#undef VMW
#undef VMWN
#undef SLOAD_H
#undef SWRITE_HK
#undef SWRITE_HV
#undef SWRITE_H
#undef KSWZ
#undef SBAR
}

__device__ __forceinline__ att::BlockRef att_ref(const Params& P, unsigned char* ws, int item, int pass) {
    const int xcd = item & 7, kq = item >> 3, bh = (kq >> 2) * 8 + xcd, x = kq & 3, qb = pass ? 7 - x : x, b = bh >> 3, h = bh & 7;
    const size_t row0 = (size_t)b * L + (size_t)qb * 256;
    att::BlockRef r;
    r.Q = (const att::bf16*)(ws + WS_R1) + row0 * 1024 + h * 128; r.O = (h16*)(ws + WS_AO) + row0 * 1024 + h * 128;
    r.K = (const att::bf16*)(ws + WS_R2) + (size_t)b * L * 1024 + h * 128; r.V = (const att::bf16*)(ws + WS_R3) + (size_t)b * L * 1024 + h * 128;
    r.M = (const unsigned long long*)(ws + WS_MASK) + (size_t)b * 32 * L + (size_t)qb * 256;
    r.G = (const h16*)(ws + WS_R4) + row0 * 1024 + h * 128; r.P0 = qb * 256;
    return r;
}
__device__ __forceinline__ void p4_attn(const Params& P, unsigned char* lds, int blk, int nblk, int wv) {
    unsigned char* ws = opaque_ptr(P.ws);
    const int total = NB * 8 * 4;
    int it = blk; if (it >= total) return;
    int pass = 0;
    att::BlockRef cur = att_ref(P, ws, it, 0);
    att::Seam S;
    att::prime(cur, (att::lchar*)lds, S, wv);
    for (;;) {
        const bool more_pass = pass == 0, more_item = it + nblk < total, last = !more_pass && !more_item;
        int itn = it, passn = pass + 1;
        if (!more_pass) { passn = 0; itn = more_item ? it + nblk : it; }
        const att::BlockRef nxt = last ? cur : att_ref(P, ws, itn, passn);
        att::block(cur, nxt, (att::lchar*)lds, S, wv);
        if (last) break;
        cur = nxt; it = itn; pass = passn;
    }
}

__device__ __forceinline__ void p8_ret_naive(const Params& P, unsigned char* lds, int blk, int nblk, int wv) {
    const int tid = my_tid(wv);
    float* qk = (float*)lds;
    const h16* RQ = (const h16*)(P.ws + WS_R1); const h16* RK = (const h16*)(P.ws + WS_R2); h16* RV = (h16*)(P.ws + WS_R4);
    const int j = tid >> 2, iq = tid & 3;
    for (int it = blk; it < 256; it += nblk) {
        const int b = it >> 4, h = (it >> 2) & 3, sl = it & 3;
        const float gamma = 1.0f - exp2f(-5.0f - (float)h);
        float S[64];
#pragma unroll
        for (int i = 0; i < 64; ++i) S[i] = 0.f;
        const int col = tid & 255;
        const h16* src = (tid < 256 ? RQ : RK) + (size_t)b * L * 1024 + h * 256 + col;
        float* dst = qk + (tid >> 8) * 272 + (col >> 6) * 68 + (col & 63);
        h16* vp = RV + (size_t)b * L * 2048 + h * 512 + sl * 128 + j;
        for (int t0 = 0; t0 < L; t0 += 16) {
            __syncthreads();
            h16 vv[16];
#pragma unroll
            for (int tt = 0; tt < 16; ++tt) { dst[tt * 544] = (float)src[(size_t)(t0 + tt) * 1024]; vv[tt] = vp[(size_t)(t0 + tt) * 2048]; }
            __syncthreads();
#pragma unroll
            for (int tt = 0; tt < 16; ++tt) {
                const f32x4* qp = (const f32x4*)(qk + tt * 544 + iq * 68); const f32x4* kp = (const f32x4*)(qk + tt * 544 + 272 + iq * 68);
                const float v = (float)vv[tt]; float o = 0.f;
#pragma unroll
                for (int i4 = 0; i4 < 16; ++i4) { const f32x4 q4 = qp[i4], k4 = kp[i4];
#pragma unroll
                    for (int e = 0; e < 4; ++e) { S[i4 * 4 + e] = fmaf(gamma, S[i4 * 4 + e], k4[e] * v); o = fmaf(q4[e], S[i4 * 4 + e], o); } }
                o += __shfl_xor(o, 1); o += __shfl_xor(o, 2);
                if (iq == 0) vp[(size_t)(t0 + tt) * 2048] = (h16)o;
            }
        }
    }
}


namespace ret {
typedef __attribute__((address_space(3))) unsigned char lch;
typedef __attribute__((address_space(3))) h16x8 lh16x8;
typedef __attribute__((address_space(3))) h16x4 lh16x4;
typedef __attribute__((address_space(3))) u32x4 lu32x4;
typedef short v4i16 __attribute__((ext_vector_type(4)));
typedef __attribute__((address_space(3))) v4i16 lv4i16;
constexpr int SKB = 544, SVB = 288, SSB = 544;
constexpr int OFF_K = 0, OFF_V = 64 * SKB, OFF_S = OFF_V + 64 * SVB, LDS_RET = OFF_S + 128 * SSB;
__device__ __forceinline__ h16x4 trrd(const lch* p) { return __builtin_bit_cast(h16x4, __builtin_amdgcn_ds_read_tr16_b64_v4i16((lv4i16*)p)); }
__device__ __forceinline__ h16x8 cat8(h16x4 a, h16x4 b) { return __builtin_shufflevector(a, b, 0, 1, 2, 3, 4, 5, 6, 7); }
}
#define P8_GATE(m_, ro_) do { const char* gp_ = (const char*)(RG + ((size_t)b * L + (size_t)(m_) * 64) * 2048 + h * 512 + sl * 128) + (ro_); gt0 = *(const h16x8*)gp_; gt1 = *(const h16x8*)(gp_ + 16); } while (0)
#define P8_XSLD(m_, rw_) do { _Pragma("unroll") for (int s_ = 0; s_ < 4; ++s_) xsv[s_] = __hip_atomic_load((const unsigned long long*)((const char*)(XS + (size_t)(grp0 + (m_)) * 256) + (unsigned)(s_ * 512 + (rw_) * 8)), __ATOMIC_RELAXED, __HIP_MEMORY_SCOPE_AGENT); } while (0)
#define P8_XSOK() (((unsigned)xsv[0] != 0xffffffffu) && ((unsigned)xsv[1] != 0xffffffffu) && ((unsigned)xsv[2] != 0xffffffffu) && ((unsigned)xsv[3] != 0xffffffffu))
#define P8_WAIT(m_, rw_) do { unsigned sp_ = 0u; while (!__all(P8_XSOK())) { __builtin_amdgcn_s_sleep(1); P8_XSLD(m_, rw_); \
        if (++sp_ > (1u << 20)) { if (lane == 0) __hip_atomic_store((unsigned*)(ws + WS_BAR) + XB_TMO_W, 1u, __ATOMIC_RELAXED, __HIP_MEMORY_SCOPE_AGENT); break; } } } while (0)
#define P8_STATS(m_) do { P8_WAIT(m_, lO0); float S1_ = 0.f, S2_ = 0.f;   \
        _Pragma("unroll") for (int s_ = 0; s_ < 4; ++s_) { S1_ += __uint_as_float((unsigned)xsv[s_]); S2_ += __uint_as_float((unsigned)(xsv[s_] >> 32)); } \
        const float mu_ = S1_ * (1.0f / 512.0f); const float var_ = fmaxf(S2_ * (1.0f / 512.0f) - mu_ * mu_, 0.f); const float rs_ = rsqrtf(var_ + EPS); MR[lO0] = (f32x2){rs_, -mu_ * rs_}; } while (0)
#define P8_FINAL(m_, rw_, ro_, lo_) do { const int mm_ = (m_); const f32x2 mr_ = MR[rw_]; const float rs_ = mr_[0], nb_ = mr_[1]; \
        const lch* op_ = OT + (mm_ & 1) * OT_BYTES + (lo_); const h16x8 o0_ = *(const lh16x8*)op_, o1_ = *(const lh16x8*)(op_ + 16); h16x8 y0_, y1_; \
        _Pragma("unroll") for (int e = 0; e < 8; ++e) { y0_[e] = (h16)(fmaf((float)o0_[e], rs_, nb_) * (float)gt0[e]); y1_[e] = (h16)(fmaf((float)o1_[e], rs_, nb_) * (float)gt1[e]); } \
        char* dp_ = (char*)(vg + (size_t)mm_ * 64 * 2048) + (ro_); *(h16x8*)dp_ = y0_; *(h16x8*)(dp_ + 16) = y1_; } while (0)
#define XB_TMO_W 128
__device__ __forceinline__ void p8_retention(const Params& P, unsigned char* lds_, int blk, int nblk, int wv) {
    using namespace ret;
    const int tid = my_tid(wv), wid = __builtin_amdgcn_readfirstlane(tid >> 6), lane = tid & 63, c16 = lane & 15, g = lane >> 4, q4 = c16 >> 2, p4 = c16 & 3;
    const int it = wid & 3, dh = wid >> 2;
    unsigned char* ws = opaque_ptr(P.ws);
    lch* Kc = (lch*)lds_ + OFF_K; lch* Vc = (lch*)lds_ + OFF_V; lch* St = (lch*)lds_ + OFF_S;
    const h16* RQ = (const h16*)(ws + WS_R1); const h16* RK = (const h16*)(ws + WS_R2); h16* RV = (h16*)(ws + WS_R4);
    const bool fusedgn = (nblk == 256);
    const h16* RG = (const h16*)(ws + WS_RG);
    unsigned long long* XS = (unsigned long long*)(ws + WS_KIDXN);
    typedef __attribute__((address_space(3))) f32x2 lf32x2;
    lf32x2* PS = (lf32x2*)((lch*)lds_ + LDS_RET);
    for (int item = blk; item < 256; item += nblk) {
        const int b = item >> 4, h = (item >> 2) & 3, sl = item & 3;
        const int grp0 = (b * 4 + h) * 32;
        constexpr int OT_PITCH = 272, OT_BYTES = 64 * OT_PITCH;
        lch* OT = (lch*)lds_ + LDS_RET + 1024;
        lf32x2* MR = (lf32x2*)(OT + 2 * OT_BYTES);
        h16x8 gt0 = (h16x8){0, 0, 0, 0, 0, 0, 0, 0}, gt1 = gt0;
        const float lgam = log2f(1.0f - exp2f(-5.0f - (float)h));
        const float gamma64 = exp2f(64.0f * lgam);
        f32x4 state[16];
#pragma unroll
        for (int d = 0; d < 16; ++d) state[d] = (f32x4){0.f, 0.f, 0.f, 0.f};
        __syncthreads();
        { unsigned zz = 0u; asm volatile("" : "+v"(zz));
          for (int i = tid; i < 128 * SSB / 16; i += NTHREADS) ((lu32x4*)St)[i] = (u32x4){zz, zz, zz, zz}; }
        const h16* kg = RK + (size_t)b * L * 1024 + h * 256; const h16* vg = RV + (size_t)b * L * 2048 + h * 512 + sl * 128;
        h16x8 kreg[4], vreg[2];
        const unsigned qoff = (unsigned)((16 * it + c16) * 1024 + 8 * g) * 2u, ooff = (unsigned)((16 * it + c16) * 2048 + 64 * dh + 4 * g) * 2u;
        unsigned ko[4], vo[2];
#pragma unroll
        for (int i = 0; i < 4; ++i) { const int c = tid + NTHREADS * i; ko[i] = (unsigned)((c >> 5) * 1024 + (c & 31) * 8) * 2u; }
#pragma unroll
        for (int i = 0; i < 2; ++i) { const int c = tid + NTHREADS * i; vo[i] = (unsigned)((c >> 4) * 2048 + (c & 15) * 8) * 2u; }
#pragma unroll
        for (int i = 0; i < 4; ++i) kreg[i] = *(const h16x8*)((const char*)kg + ko[i]);
#pragma unroll
        for (int i = 0; i < 2; ++i) vreg[i] = *(const h16x8*)((const char*)vg + vo[i]);
#pragma unroll
        for (int i = 0; i < 4; ++i) { const int c = tid + NTHREADS * i; *(lh16x8*)(Kc + (c >> 5) * SKB + (c & 31) * 16) = kreg[i]; }
#pragma unroll
        for (int i = 0; i < 2; ++i) { const int c = tid + NTHREADS * i; *(lh16x8*)(Vc + (c >> 4) * SVB + (c & 15) * 16) = vreg[i]; }
        h16x8 Qn[8];
#pragma unroll
        for (int s = 0; s < 8; ++s) Qn[s] = *(const h16x8*)((const char*)(RQ + (size_t)b * L * 1024 + h * 256) + (qoff + (unsigned)(64 * s)));
        __syncthreads();
        for (int n = 0; n < L / 64; ++n) {
            const size_t row0 = (size_t)b * L + (size_t)n * 64;
            const int nn = (n + 1 < L / 64) ? n + 1 : n;
            unsigned kO[4] = {ko[0], ko[1], ko[2], ko[3]}, vO[2] = {vo[0], vo[1]}, qO = qoff, oO = ooff;
            asm volatile("" : "+v"(kO[0]), "+v"(kO[1]), "+v"(kO[2]), "+v"(kO[3]), "+v"(vO[0]), "+v"(vO[1]), "+v"(qO), "+v"(oO));
            int gO = g, cO = c16; asm volatile("" : "+v"(gO), "+v"(cO)); const int q4O = cO >> 2, p4O = cO & 3;
            float lg = lgam; asm volatile("" : "+v"(lg));
            const float xi = __builtin_amdgcn_exp2f((float)(16 * it + cO + 1) * lg);
            h16x8 Qf[8];
#pragma unroll
            for (int s = 0; s < 8; ++s) Qf[s] = Qn[s];
            unsigned long long xsv[4] = {0ull, 0ull, 0ull, 0ull};
            const int tF_ = my_tid(wv); const unsigned rowF = (unsigned)(tF_ >> 3), roF = rowF * 4096u + (unsigned)(tF_ & 7) * 32u, loF = rowF * (unsigned)OT_PITCH + (unsigned)(tF_ & 7) * 32u;
            if (fusedgn && n > 0) { P8_GATE(n - 1, roF); }
#pragma unroll
            for (int i = 0; i < 4; ++i) kreg[i] = *(const h16x8*)((const char*)(kg + (size_t)nn * 64 * 1024) + kO[i]);
#pragma unroll
            for (int i = 0; i < 2; ++i) vreg[i] = *(const h16x8*)((const char*)(vg + (size_t)nn * 64 * 2048) + vO[i]);
            h16x8 Pf[2];
#pragma unroll
            for (int ks = 0; ks < 2; ++ks)
#pragma unroll
                for (int e = 0; e < 8; ++e) Pf[ks][e] = (h16)0.f;
#pragma unroll
            for (int jt = 0; jt < 4; ++jt) {
                if (jt <= it) {
                    f32x4 S = (f32x4){0.f, 0.f, 0.f, 0.f}, Sb = S;
#pragma unroll
                    for (int s4 = 0; s4 < 8; s4 += 4) {
                        h16x8 A4[4];
#pragma unroll
                        for (int s = 0; s < 4; ++s) A4[s] = *(const lh16x8*)(Kc + (16 * jt + c16) * SKB + (32 * (s4 + s) + 8 * g) * 2);
                        __builtin_amdgcn_sched_barrier(0);
#pragma unroll
                        for (int s = 0; s < 4; s += 2) { S = __builtin_amdgcn_mfma_f32_16x16x32_f16(A4[s], Qf[s4 + s], S, 0, 0, 0); Sb = __builtin_amdgcn_mfma_f32_16x16x32_f16(A4[s + 1], Qf[s4 + s + 1], Sb, 0, 0, 0); }
                        __builtin_amdgcn_sched_barrier(0);
                    }
                    S = S + Sb;
#pragma unroll
                    for (int e = 0; e < 4; ++e) { const int d = (16 * it + cO) - (16 * jt + 4 * gO + e); const float f = (d >= 0) ? __builtin_amdgcn_exp2f((float)d * lg) : 0.f; Pf[jt >> 1][(jt & 1) * 4 + e] = (h16)(S[e] * f); }
                }
            }
            int lO0 = lane; asm volatile("" : "+v"(lO0));
            if (fusedgn && n > 0 && wid == 0) { P8_XSLD(n - 1, lO0); }
            f32x4 acc[4];
#pragma unroll
            for (int dt = 0; dt < 4; ++dt) acc[dt] = (f32x4){0.f, 0.f, 0.f, 0.f};
#pragma unroll
            for (int s2 = 0; s2 < 8; ++s2) {
                h16x8 A4[4];
#pragma unroll
                for (int dt = 0; dt < 4; ++dt) A4[dt] = *(const lh16x8*)(St + (16 * (4 * dh + dt) + c16) * SSB + (32 * s2 + 8 * g) * 2);
                __builtin_amdgcn_sched_barrier(0);
#pragma unroll
                for (int dt = 0; dt < 4; ++dt) acc[dt] = __builtin_amdgcn_mfma_f32_16x16x32_f16(A4[dt], Qf[s2], acc[dt], 0, 0, 0);
                __builtin_amdgcn_sched_barrier(0);
            }
#pragma unroll
            for (int dt = 0; dt < 4; ++dt) acc[dt] = acc[dt] * xi;
#pragma unroll
            for (int ks = 0; ks < 2; ++ks) {
                if (2 * ks <= it) {
                    h16x8 A4[4];
#pragma unroll
                    for (int dt = 0; dt < 4; ++dt) { const lch* vp = Vc + (32 * ks + 4 * gO + q4O) * SVB + (16 * (4 * dh + dt) + 4 * p4O) * 2; A4[dt] = cat8(trrd(vp), trrd(vp + 16 * SVB)); }
                    __builtin_amdgcn_sched_barrier(0);
#pragma unroll
                    for (int dt = 0; dt < 4; ++dt) acc[dt] = __builtin_amdgcn_mfma_f32_16x16x32_f16(A4[dt], Pf[ks], acc[dt], 0, 0, 0);
                    __builtin_amdgcn_sched_barrier(0);
                }
            }
            if (!fusedgn) {
#pragma unroll
                for (int dt = 0; dt < 4; ++dt) *(h16x4*)((char*)(vg + (size_t)n * 64 * 2048) + (oO + (unsigned)(32 * dt))) = pack4(acc[dt]);
            } else {
                float s1 = 0.f, s2 = 0.f;
#pragma unroll
                for (int dt = 0; dt < 4; ++dt)
#pragma unroll
                    for (int e = 0; e < 4; ++e) { s1 += acc[dt][e]; s2 = fmaf(acc[dt][e], acc[dt][e], s2); }
                s1 = fq_sum(s1); s2 = fq_sum(s2);
                const int tk = (int)(oO >> 12);
                if ((oO & 24u) == 0u) PS[dh * 64 + tk] = (f32x2){s1, s2};
                { lch* wp_ = OT + (n & 1) * OT_BYTES + (unsigned)tk * (unsigned)OT_PITCH + (oO & 4095u);
#pragma unroll
                  for (int dt = 0; dt < 4; ++dt) *(lh16x4*)(wp_ + 32 * dt) = pack4(acc[dt]); }
            }
#pragma unroll
            for (int s = 0; s < 8; ++s) Qn[s] = *(const h16x8*)((const char*)(RQ + ((size_t)b * L + (size_t)nn * 64) * 1024 + h * 256) + (qO + (unsigned)(64 * s)));
            h16x8 Bv[2];
#pragma unroll
            for (int ks = 0; ks < 2; ++ks) { const lch* vp = Vc + (32 * ks + 8 * gO + q4O) * SVB + (16 * wid + 4 * p4O) * 2; h16x8 zf;
#pragma unroll
                for (int e = 0; e < 8; ++e) zf[e] = (h16)__builtin_amdgcn_exp2f((float)(63 - (32 * ks + 8 * gO + e)) * lg);
                Bv[ks] = cat8(trrd(vp), trrd(vp + 4 * SVB)) * zf; }
#pragma unroll
            for (int d4 = 0; d4 < 16; d4 += 2) {
                h16x8 A4[4];
#pragma unroll
                for (int j = 0; j < 2; ++j)
#pragma unroll
                    for (int ks = 0; ks < 2; ++ks) { const lch* kp = Kc + (32 * ks + 8 * gO + q4O) * SKB + (16 * (d4 + j) + 4 * p4O) * 2; A4[j * 2 + ks] = cat8(trrd(kp), trrd(kp + 4 * SKB)); }
#pragma unroll
                for (int j = 0; j < 2; ++j) state[d4 + j] = state[d4 + j] * gamma64;
                __builtin_amdgcn_sched_barrier(0);
#pragma unroll
                for (int ks = 0; ks < 2; ++ks)
#pragma unroll
                    for (int j = 0; j < 2; ++j) state[d4 + j] = __builtin_amdgcn_mfma_f32_16x16x32_f16(A4[j * 2 + ks], Bv[ks], state[d4 + j], 0, 0, 0);
                __builtin_amdgcn_sched_barrier(0);
            }
            if (fusedgn && n > 0 && wid == 0) { P8_STATS(n - 1); }
            __syncthreads();
            if (fusedgn && n > 0) { P8_FINAL(n - 1, rowF, roF, loF); }
            if (fusedgn && wid == 0) {
                int lO = lane; asm volatile("" : "+v"(lO));
                const f32x2 pa = PS[lO], pb = PS[64 + lO];
                const unsigned long long pk = (unsigned long long)__float_as_uint(pa[0] + pb[0]) | ((unsigned long long)__float_as_uint(pa[1] + pb[1]) << 32);
                __hip_atomic_store((unsigned long long*)((char*)(XS + ((size_t)(grp0 + n) * 4 + sl) * 64) + (unsigned)(lO * 8)), pk, __ATOMIC_RELAXED, __HIP_MEMORY_SCOPE_AGENT);
            }
#pragma unroll
            for (int dkt = 0; dkt < 16; ++dkt) *(lh16x4*)(St + (16 * wid + c16) * SSB + (16 * dkt + 4 * g) * 2) = pack4(state[dkt]);
#pragma unroll
            for (int i = 0; i < 4; ++i) { const int c = tid + NTHREADS * i; *(lh16x8*)(Kc + (c >> 5) * SKB + (c & 31) * 16) = kreg[i]; }
#pragma unroll
            for (int i = 0; i < 2; ++i) { const int c = tid + NTHREADS * i; *(lh16x8*)(Vc + (c >> 4) * SVB + (c & 15) * 16) = vreg[i]; }
            __syncthreads();
        }
        if (fusedgn) {
            const int tF_ = my_tid(wv); const unsigned rowF = (unsigned)(tF_ >> 3), roF = rowF * 4096u + (unsigned)(tF_ & 7) * 32u, loF = rowF * (unsigned)OT_PITCH + (unsigned)(tF_ & 7) * 32u;
            unsigned long long xsv[4] = {0ull, 0ull, 0ull, 0ull}; int lO0 = lane; asm volatile("" : "+v"(lO0)); P8_GATE(L / 64 - 1, roF);
            if (wid == 0) { P8_XSLD(L / 64 - 1, lO0); P8_STATS(L / 64 - 1); }
            __syncthreads();
            P8_FINAL(L / 64 - 1, rowF, roF, loF);
        }
    }
#undef P8_FINAL
#undef P8_STATS
#undef P8_XSLD
#undef P8_GATE
#undef P8_WAIT
#undef P8_XSOK
}

__device__ __forceinline__ void p9_gnorm(const Params& P, int blk, int nblk, int wv) {
    const int tid = my_tid(wv), wid = tid >> 6, lane = tid & 63;
    unsigned char* ws = opaque_ptr(P.ws);
    h16* RO = (h16*)(ws + WS_R4); const h16* RG = (const h16*)(ws + WS_RG);
    const int gw = blk * NWAVES + wid, ngw = nblk * NWAVES;
    for (int t0 = gw; t0 < T; t0 += 2 * ngw) {
        h16x8 xv[2][4], gv[2][4];
#pragma unroll
        for (int k = 0; k < 2; ++k) { const int t = (t0 + k * ngw < T) ? t0 + k * ngw : t0;
#pragma unroll
            for (int h = 0; h < 4; ++h) { const size_t o = (size_t)t * 2048 + h * 512 + lane * 8; xv[k][h] = *(const h16x8*)(RO + o); gv[k][h] = *(const h16x8*)(RG + o); } }
#pragma unroll
        for (int k = 0; k < 2; ++k) { const int t = t0 + k * ngw;
#pragma unroll
            for (int h = 0; h < 4; ++h) {
                float v[8]; float s = 0.f;
#pragma unroll
                for (int e = 0; e < 8; ++e) { v[e] = (float)xv[k][h][e]; s += v[e]; }
                const float mu = wave_sum_dpp(s) * (1.0f / 512.0f); float q = 0.f;
#pragma unroll
                for (int e = 0; e < 8; ++e) { v[e] -= mu; q += v[e] * v[e]; }
                const float rstd = rsqrtf(wave_sum_dpp(q) * (1.0f / 512.0f) + EPS);
                h16x8 y;
#pragma unroll
                for (int e = 0; e < 8; ++e) y[e] = (h16)(v[e] * rstd * (float)gv[k][h][e]);
                if (t < T) *(h16x8*)(RO + (size_t)t * 2048 + h * 512 + lane * 8) = y;
            } }
    }
}

__device__ __forceinline__ void p12_final(const Params& P, int blk, int nblk, int wv) {
    const int tid = my_tid(wv), wid = tid >> 6, lane = tid & 63;
    unsigned char* ws = opaque_ptr(P.ws);
    const float* sq = (const float*)(ws + WS_SQH) + (size_t)3 * T * 16; const f32x4* g4 = (const f32x4*)P.in[18]; const h16* H4 = (const h16*)(ws + WS_R1);
    const int gw = blk * NWAVES + wid, ngw = nblk * NWAVES;
    for (int r0 = gw; r0 < T; r0 += 4 * ngw) {
        h16x8 hv[4][2]; f32x4 qv[4][4];
#pragma unroll
        for (int k = 0; k < 4; ++k) { const int r = r0 + k * ngw; if (r < T) {
#pragma unroll
            for (int j = 0; j < 2; ++j) hv[k][j] = *(const h16x8*)(H4 + (size_t)r * 1024 + (lane + 64 * j) * 8);
#pragma unroll
            for (int j = 0; j < 4; ++j) qv[k][j] = ((const f32x4*)(sq + (size_t)r * 16))[j]; } }
#pragma unroll
        for (int k = 0; k < 4; ++k) { const int r = r0 + k * ngw; if (r < T) {
            float s = 0.f;
#pragma unroll
            for (int j = 0; j < 4; ++j) s += (qv[k][j][0] + qv[k][j][1]) + (qv[k][j][2] + qv[k][j][3]);
            const float rstd = rsqrtf(s * (1.0f / 1024.0f) + EPS);
            f32x4* orow = (f32x4*)(P.out + (size_t)r * 1024);
#pragma unroll
            for (int j = 0; j < 2; ++j) { const int c4 = (lane + 64 * j) * 2; const f32x4 ga = g4[c4], gb = g4[c4 + 1]; f32x4 a, b2;
#pragma unroll
                for (int e = 0; e < 4; ++e) { a[e] = (float)hv[k][j][e] * rstd * ga[e]; b2[e] = (float)hv[k][j][4 + e] * rstd * gb[e]; }
                orow[c4] = a; orow[c4 + 1] = b2; } } }
    }
}

#define XB_TMO      128
#define XB_XCNT(j)  (256  + 64 * (j))
#define XB_XSUB(j)  (1280 + 64 * (j))
#define XB_XGEN(j)  (2304 + 64 * (j))
#define XB_TOP      3328
#define XB_TOPGEN   3392
#define XCD_BAR_WORDS 3456
#define XB_SPIN_CAP (1u << 18)
__device__ __forceinline__ unsigned xb_ld(unsigned* p)              { return __hip_atomic_load(p, __ATOMIC_RELAXED, __HIP_MEMORY_SCOPE_AGENT); }
__device__ __forceinline__ unsigned xb_add(unsigned* p, unsigned v) { return __hip_atomic_fetch_add(p, v, __ATOMIC_RELAXED, __HIP_MEMORY_SCOPE_AGENT); }
__device__ __forceinline__ unsigned xb_xcc_id() { return (unsigned)__builtin_amdgcn_s_getreg((3 << 11) | 20) & 0xFu; }
#define XB_SPIN(cond, bar) do { unsigned _sp = 0; while (cond) { __builtin_amdgcn_s_sleep(1); \
    if ((++_sp & 255u) == 0u) { if (xb_ld(&(bar)[XB_TMO])) break; if (_sp > XB_SPIN_CAP) { atomicAdd(&(bar)[XB_TMO], 1u); break; } } } } while (0)
typedef volatile __attribute__((address_space(3))) unsigned lvu32;
__device__ __forceinline__ void xcd_barrier_complete(unsigned* bar, unsigned x, unsigned G, unsigned& nloc, unsigned& nx) {
    unsigned sum, cnt, mine, sp = 0u;
    for (;;) {
        sum = 0u; cnt = 0u; mine = 0u;
#pragma unroll
        for (unsigned j = 0; j < 16; ++j) { const unsigned c = xb_ld(&bar[XB_XCNT(j)]); sum += c; cnt += (c > 0u) ? 1u : 0u; mine = (j == x) ? c : mine; }
        if (sum == G) break;
        __builtin_amdgcn_s_sleep(1);
        if ((++sp & 255u) == 0u) { if (xb_ld(&bar[XB_TMO])) break; if (sp > XB_SPIN_CAP) { atomicAdd(&bar[XB_TMO], 1u); break; } }
    }
    nloc = mine > 0u ? mine : 1u; nx = cnt > 0u ? cnt : 1u;
}
__device__ __forceinline__ void xcd_barrier(unsigned* bar_, unsigned x_, lvu32* st, unsigned G, int wv) {
    unsigned x = x_; asm volatile("" : "+s"(x));
    unsigned* bar = opaque_ptr(bar_);
    asm volatile("s_waitcnt vmcnt(0)" ::: "memory");
    __syncthreads();
    if (my_tid(wv) == 0) {
        __builtin_amdgcn_s_waitcnt(0);
        unsigned nloc = st[0], nx = st[1];
        if (nloc == 0u) { xcd_barrier_complete(bar, x, G, nloc, nx); st[0] = nloc; st[1] = nx; }
        const unsigned old = xb_add(&bar[XB_XSUB(x)], 1u);
        const unsigned gen = old / nloc;
        if (old + 1u == (gen + 1u) * nloc) {
            __builtin_amdgcn_fence(__ATOMIC_RELEASE, "agent");
            asm volatile("s_waitcnt vmcnt(0)" ::: "memory");
            const unsigned og = xb_add(&bar[XB_TOP], 1u);
            const unsigned tg = og / nx;
            if (og + 1u == (tg + 1u) * nx) xb_add(&bar[XB_TOPGEN], 1u);
            else XB_SPIN(xb_ld(&bar[XB_TOPGEN]) == tg, bar);
            __builtin_amdgcn_fence(__ATOMIC_ACQUIRE, "agent");
            xb_add(&bar[XB_XGEN(x)], 1u);
            asm volatile("s_waitcnt vmcnt(0)" ::: "memory");
        } else {
            XB_SPIN(xb_ld(&bar[XB_XGEN(x)]) == gen, bar);
            __builtin_amdgcn_fence(__ATOMIC_ACQUIRE, "agent");
            asm volatile("s_waitcnt vmcnt(0)" ::: "memory");
        }
    }
    __syncthreads();
}

__device__ __forceinline__ void run_gemm_job(const Params& P, unsigned char* lds, int ph, int j, int blk, int nblk, int wv) {
    unsigned char* ws = opaque_ptr(P.ws);
    float* SQKV = (float*)(ws + WS_SQKV); float* SQQ = (float*)(ws + WS_SQQ); float* SQH = (float*)(ws + WS_SQH);
    int kind = 0; Gemm g; g.M = T; g.A = nullptr; g.Bt = nullptr; g.lda = g.ldb = g.N = g.K = 0;
    h16 *h0 = nullptr, *h1 = nullptr; const h16* ch0 = nullptr; const h16* ch1 = nullptr; const float* cf0 = nullptr; float* f0 = nullptr; float* f1 = nullptr; int i0 = 0, i1 = 0, i2 = 0, i3 = 0, i4 = 0; float x0 = 0.f;
    if (ph == 1) { kind = 0; g.A = (const h16*)(ws + WS_R1); g.Bt = (const h16*)(ws + WS_WAIN); g.lda = 1024; g.ldb = 1024; g.N = 1792; g.K = 1024; }
    else if (ph == 2) {
        kind = 1;
        if (j == 0) { g.A = (const h16*)(ws + WS_CQX); g.Bt = (const h16*)(ws + WS_WQ); g.lda = 512; g.ldb = 384; g.N = 1536; g.K = 384;
                      cf0 = SQQ; i0 = 8; x0 = 1.0f / 384.0f; h0 = (h16*)(ws + WS_R1); h1 = (h16*)(ws + WS_QIDX); i1 = 1024; i2 = 512; i3 = 1; i4 = 0; }
        else if (j == 1) { g.A = (const h16*)(ws + WS_CKV); g.Bt = (const h16*)(ws + WS_WKV); g.lda = 256; g.ldb = 256; g.N = 2048; g.K = 256;
                      cf0 = SQKV; i0 = 4; x0 = 1.0f / 256.0f; h0 = (h16*)(ws + WS_R2); h1 = (h16*)(ws + WS_R3); i1 = 1024; i2 = 1024; i3 = 1; i4 = 1; }
        else { g.A = (const h16*)(ws + WS_PH0); g.Bt = (const h16*)(ws + WS_WPLE); g.lda = 256; g.ldb = 256; g.N = 1024; g.K = 256;
                      cf0 = nullptr; i0 = 0; x0 = 0.f; h0 = (h16*)(ws + WS_R5); h1 = nullptr; i1 = 1024; i2 = 1024; }
    }
    else if (ph == 5) { kind = 2; g.A = (const h16*)(ws + WS_AO); g.Bt = (const h16*)(ws + WS_WAOUT); g.lda = 1024; g.ldb = 1024; g.N = 1024; g.K = 1024;
                      cf0 = P.in[0]; ch0 = nullptr; h0 = (h16*)(ws + WS_R2); f1 = SQH; }
    else if (ph == 6) { kind = 3; g.A = (const h16*)(ws + WS_R2); g.Bt = (const h16*)(ws + WS_WPG); g.lda = 1024; g.ldb = 1024; g.N = 1024; g.K = 1024;
                      ch1 = (const h16*)(ws + WS_R2); ch0 = (const h16*)(ws + WS_R5); h0 = (h16*)(ws + WS_R3); cf0 = SQH; f1 = SQH + (size_t)T * 16; }
    else if (ph == 7) { kind = 4; g.A = (const h16*)(ws + WS_R3); g.Bt = (const h16*)(ws + WS_WRIN); g.lda = 1024; g.ldb = 1024; g.N = 6144; g.K = 1024; }
    else if (ph == 10) {
        if (j == 0) { kind = 2; g.A = (const h16*)(ws + WS_R4); g.Bt = (const h16*)(ws + WS_WROUT); g.lda = 2048; g.ldb = 2048; g.N = 1024; g.K = 2048;
                      cf0 = nullptr; ch0 = (const h16*)(ws + WS_R3); h0 = (h16*)(ws + WS_R2); f1 = SQH + (size_t)2 * T * 16; }
        else { kind = 1; g.A = (const h16*)(ws + WS_PH1); g.Bt = (const h16*)(ws + WS_WPLE) + (size_t)1024 * 256; g.lda = 256; g.ldb = 256; g.N = 1024; g.K = 256;
                      cf0 = nullptr; i0 = 0; x0 = 0.f; h0 = (h16*)(ws + WS_R1); h1 = nullptr; i1 = 1024; i2 = 1024; }
    }
    else { kind = 5; g.A = (const h16*)(ws + WS_R2); g.Bt = (const h16*)(ws + WS_WPG) + (size_t)1024 * 1024; g.lda = 1024; g.ldb = 1024; g.N = 1024; g.K = 1024;
                      ch1 = (const h16*)(ws + WS_R2); ch0 = (const h16*)(ws + WS_R1); h0 = (h16*)(ws + WS_R1); cf0 = SQH + (size_t)2 * T * 16; f1 = SQH + (size_t)3 * T * 16; }
    switch (kind) {
        case 0: { EpiInA E{(h16*)(ws + WS_CKV), (h16*)(ws + WS_CQX), (h16*)(ws + WS_R4), SQKV, SQQ, nullptr, 0, 0.f}; gemm_run(lds, g, E, blk, nblk, wv); break; }
        case 1: { EpiScale E{cf0, i0, x0, h0, h1, 4, i1, i2, i3, i4}; gemm_run(lds, g, E, blk, nblk, wv); break; }
        case 2: { EpiRes E{cf0, ch0, h0, f1, nullptr, 0, 0.f}; gemm_run(lds, g, E, blk, nblk, wv); break; }
        case 3: { EpiPle E{ch1, ch0, h0, cf0, f1, 16, 1.0f / 1024.0f}; gemm_run(lds, g, E, blk, nblk, wv); break; }
        case 5: { EpiPleFinal E{ch1, ch0, cf0, 16, 1.0f / 1024.0f, P.in[18], P.out, (unsigned*)(SQH + (size_t)3 * T * 16), (unsigned*)(ws + WS_BAR + 16384), (unsigned*)(ws + WS_BAR) + XB_TMO}; gemm_run(lds, g, E, blk, nblk, wv); break; }
        default: { EpiInR E{SQH + (size_t)T * 16, (const f32x2*)(ws + WS_SINCOS), (h16*)(ws + WS_R1), (h16*)(ws + WS_R2), (h16*)(ws + WS_R4), (h16*)(ws + WS_RG), 16, 1.0f / 1024.0f}; gemm_run(lds, g, E, blk, nblk, wv); break; }
    }
}

__global__ void __launch_bounds__(NTHREADS, 2) mk_fwd(Params P_) {
    extern __shared__ __attribute__((aligned(16))) unsigned char lds[];
    cg::grid_group grid = cg::this_grid();
    const int wv = __builtin_amdgcn_readfirstlane((int)(threadIdx.x >> 6));
    lvu32* bst = (lvu32*)(lds + LDS_BYTES - 16);
    unsigned* bar = (unsigned*)(P_.ws + WS_BAR);
    const unsigned xcc = xb_xcc_id();
    if (threadIdx.x == 0) { bst[0] = 0u; bst[1] = 0u; if (P_.ph_hi - P_.ph_lo > 1) (void)xb_add(&bar[XB_XCNT(xcc)], 1u); }
    __syncthreads();
    int dup_cnt = 0; (void)dup_cnt;
    const int blk_k = blockIdx.x, nblk_k = gridDim.x; const int ph_lo = P_.ph_lo, ph_hi = P_.ph_hi;
    for (int ph = ph_lo; ph < ph_hi; ++ph) {
        int blk = blk_k, nblk = nblk_k; asm volatile("" : "+s"(blk), "+s"(nblk));
        const Params& P = P_;
        if (ph == 0) p0_prologue(P, lds, blk, nblk, wv, 0);
        else if (ph == 3) p3_indexer(P, lds, blk, nblk, wv);
        else if (ph == 4) p4_attn(P, lds, blk, nblk, wv);
        else if (ph == 8) p8_retention(P, lds, blk, nblk, wv);
        else if (ph == 9) { if (nblk != 256) p9_gnorm(P, blk, nblk, wv); }
        else {
            if (ph == 2) p2_kidx(P, blk, nblk, wv);
            if (ph == 5) {
                unsigned ones = ~0u; asm volatile("" : "+v"(ones)); u32x4* xs_ = (u32x4*)(opaque_ptr(P.ws) + WS_KIDXN);
                for (int i = blk * NTHREADS + my_tid(wv); i < (4 << 20) / 16; i += nblk * NTHREADS) xs_[i] = (u32x4){ones, ones, ones, ones};
            }
            const int nj = (ph == 2) ? 3 : (ph == 10) ? 2 : 1;
            for (int j = 0; j < nj; ++j) run_gemm_job(P, lds, ph, j, blk, nblk, wv);
            if (ph == 1) p0_prologue(P, lds, blk, nblk, wv, 1);
        }
        if (ph + 1 < ph_hi && !(ph == 8 && nblk == 256)) { if (ph_hi < 0) grid.sync(); else xcd_barrier(bar, xcc, bst, (unsigned)nblk, wv); }
#if MK_DUP_MASK
        if (((MK_DUP_MASK >> ph) & 1) && dup_cnt < MK_DUP_N) { ++dup_cnt; --ph; } else dup_cnt = 0;
#endif
    }
}

#ifndef MK_FUSED
#define MK_FUSED 1
#endif
extern "C" void kernel_launch(void* const* d_in, const int* in_sizes, int n_in, void* d_out, int out_size, void* d_ws, size_t ws_size, hipStream_t stream) {
    static int grid = 0;
    if (grid == 0) {
        if (n_in != 19 || out_size != T * D || ws_size < WS_END) { fprintf(stderr, "kernel_launch: unexpected shapes (n_in %d, out %d, ws %zu)\n", n_in, out_size, ws_size); grid = -1; return; }
        int dev = 0, cus = 0, per_cu = 0;
        hipGetDevice(&dev);
        hipDeviceGetAttribute(&cus, hipDeviceAttributeMultiprocessorCount, dev);
        if (hipFuncSetAttribute((const void*)mk_fwd, hipFuncAttributeMaxDynamicSharedMemorySize, LDS_BYTES) != hipSuccess) { fprintf(stderr, "kernel_launch: hipFuncSetAttribute failed\n"); grid = -1; return; }
        hipOccupancyMaxActiveBlocksPerMultiprocessor(&per_cu, (const void*)mk_fwd, NTHREADS, LDS_BYTES);
        if (per_cu < 1) { fprintf(stderr, "kernel_launch: occupancy query says %d blocks per CU\n", per_cu); grid = -1; return; }
        grid = cus * 1;
    }
    if (grid < 0) return;
    (void)hipMemsetAsync((char*)d_ws + WS_BAR, 0, 16384 + 32768, stream);
    Params P{};
    for (int i = 0; i < 19; ++i) P.in[i] = (const float*)d_in[i];
    P.out = (float*)d_out; P.ws = (unsigned char*)d_ws;
#if MK_FUSED
    P.ph_lo = 0; P.ph_hi = NPH;
    void* args[] = {&P};
    hipError_t e = hipLaunchCooperativeKernel((const void*)mk_fwd, dim3(grid), dim3(NTHREADS), args, LDS_BYTES, stream);
    if (e != hipSuccess) fprintf(stderr, "cooperative launch failed: %s (grid %d)\n", hipGetErrorString(e), grid);
#else
    for (int ph = 0; ph < NPH; ++ph) {
        P.ph_lo = ph; P.ph_hi = ph + 1;
        hipLaunchKernelGGL(mk_fwd, dim3(grid), dim3(NTHREADS), LDS_BYTES, stream, P);
    }
#endif
}
```

```cpp
#include <hip/hip_runtime.h>
#include <hip/hip_cooperative_groups.h>
#include <cstdio>
#include <cstdint>
namespace cg = cooperative_groups;
#ifndef MK_DUP_MASK
#define MK_DUP_MASK 0
#endif
#ifndef MK_P3_REPA
#define MK_P3_REPA 0
#endif
#ifndef MK_P3_REPB
#define MK_P3_REPB 0
#endif
#ifndef MK_EPI_REP
#define MK_EPI_REP 0
#endif
#ifndef MK_DUP_N
#define MK_DUP_N 3
#endif

typedef _Float16 h16;
typedef _Float16 h16x2 __attribute__((ext_vector_type(2)));
typedef _Float16 h16x4 __attribute__((ext_vector_type(4)));
typedef _Float16 h16x8 __attribute__((ext_vector_type(8)));
typedef float f32x2 __attribute__((ext_vector_type(2)));
typedef float f32x4 __attribute__((ext_vector_type(4)));
typedef unsigned u32x4 __attribute__((ext_vector_type(4)));

constexpr int NB = 16, L = 2048, T = NB * L, D = 1024;
constexpr float EPS = 1e-6f;
constexpr int NPH = 12;
constexpr int NTHREADS = 512, NWAVES = 8;
constexpr int LDS_BYTES = 163840;

constexpr size_t MiB = (size_t)1 << 20;
constexpr size_t WS_WAIN = 0 * MiB;
constexpr size_t WS_WQ = 4 * MiB;
constexpr size_t WS_WKV = 6 * MiB;
constexpr size_t WS_WAOUT = 7 * MiB;
constexpr size_t WS_WPG = 9 * MiB;
constexpr size_t WS_WPLE = 13 * MiB;
constexpr size_t WS_WRIN = 14 * MiB;
constexpr size_t WS_WROUT = 26 * MiB;
constexpr size_t WS_SINCOS = 30 * MiB;
constexpr size_t WS_SQKV = 32 * MiB;
constexpr size_t WS_SQQ = 33 * MiB;
constexpr size_t WS_SQH = 34 * MiB;
constexpr size_t WS_KIDXN = 42 * MiB;
constexpr size_t WS_WIDX = 46 * MiB;
constexpr size_t WS_BAR = 47 * MiB;
constexpr size_t WS_PH1 = 48 * MiB;
constexpr size_t WS_R1 = 64 * MiB;
constexpr size_t WS_R2 = 128 * MiB;
constexpr size_t WS_R3 = 192 * MiB;
constexpr size_t WS_R4 = 256 * MiB;
constexpr size_t WS_R5 = 320 * MiB;
constexpr size_t WS_PH0 = 384 * MiB;
constexpr size_t WS_CQX = 400 * MiB;
constexpr size_t WS_CKV = 432 * MiB;
constexpr size_t WS_QIDX = 448 * MiB;
constexpr size_t WS_MASK = 480 * MiB;
constexpr size_t WS_AO = 400 * MiB;
constexpr size_t WS_RG = 384 * MiB;
constexpr size_t WS_END = 512 * MiB;

struct Params { const float* in[19]; float* out; unsigned char* ws; int ph_lo, ph_hi; };

__constant__ float kAngle[128] = {
    1.000000000e+00f, 9.300450087e-01f, 8.649836779e-01f, 8.044736385e-01f, 7.481966019e-01f, 6.958565116e-01f, 6.471778154e-01f, 6.019044518e-01f,
    5.597981811e-01f, 5.206375122e-01f, 4.842162728e-01f, 4.503428936e-01f, 4.188391268e-01f, 3.895392120e-01f, 3.622889817e-01f, 3.369450271e-01f,
    3.133740425e-01f, 2.914519310e-01f, 2.710633874e-01f, 2.521011233e-01f, 2.344653904e-01f, 2.180633694e-01f, 2.028087080e-01f, 1.886212230e-01f,
    1.754262149e-01f, 1.631542742e-01f, 1.517407894e-01f, 1.411257535e-01f, 1.312533021e-01f, 1.220714748e-01f, 1.135319397e-01f, 1.055898219e-01f,
    9.820328653e-02f, 9.133346379e-02f, 8.494423330e-02f, 7.900195569e-02f, 7.347535342e-02f, 6.833537668e-02f, 6.355497986e-02f, 5.910899118e-02f,
    5.497401953e-02f, 5.112830922e-02f, 4.755162448e-02f, 4.422515258e-02f, 4.113136977e-02f, 3.825402260e-02f, 3.557796404e-02f, 3.308910504e-02f,
    3.077435680e-02f, 2.862153389e-02f, 2.661931701e-02f, 2.475716174e-02f, 2.302526683e-02f, 2.141453326e-02f, 1.991648041e-02f, 1.852322184e-02f,
    1.722742990e-02f, 1.602228358e-02f, 1.490144618e-02f, 1.385901403e-02f, 1.288950257e-02f, 1.198781747e-02f, 1.114920899e-02f, 1.036926545e-02f,
    9.643883444e-03f, 8.969245479e-03f, 8.341802284e-03f, 7.758250926e-03f, 7.215522230e-03f, 6.710760761e-03f, 6.241309457e-03f, 5.804697983e-03f,
    5.398627371e-03f, 5.020966288e-03f, 4.669724498e-03f, 4.343053792e-03f, 4.039235413e-03f, 3.756670747e-03f, 3.493872471e-03f, 3.249458736e-03f,
    3.022142686e-03f, 2.810728736e-03f, 2.614103956e-03f, 2.431234345e-03f, 2.261157380e-03f, 2.102978062e-03f, 1.955864020e-03f, 1.819041790e-03f,
    1.691789716e-03f, 1.573440502e-03f, 1.463370281e-03f, 1.361000235e-03f, 1.265791478e-03f, 1.177242957e-03f, 1.094888896e-03f, 1.018295996e-03f,
    9.470609948e-04f, 8.808093844e-04f, 8.191923262e-04f, 7.618857198e-04f, 7.085879333e-04f, 6.590186385e-04f, 6.129170069e-04f, 5.700403708e-04f,
    5.301629426e-04f, 4.930753494e-04f, 4.585822753e-04f, 4.265021416e-04f, 3.966661752e-04f, 3.689173318e-04f, 3.431097430e-04f, 3.191074939e-04f,
    2.967843320e-04f, 2.760227653e-04f, 2.567135962e-04f, 2.387551940e-04f, 2.220530587e-04f, 2.065193403e-04f, 1.920722716e-04f, 1.786358480e-04f,
    1.661392889e-04f, 1.545170089e-04f, 1.437077590e-04f, 1.336546848e-04f, 1.243048755e-04f, 1.156091312e-04f, 1.075216787e-04f, 9.999999747e-05f,
};

__device__ __forceinline__ float wave_sum(float v) {
#pragma unroll
    for (int o = 1; o < 64; o <<= 1) v += __shfl_xor(v, o);
    return v;
}
__device__ __forceinline__ float wave_max(float v) {
#pragma unroll
    for (int o = 1; o < 64; o <<= 1) v = fmaxf(v, __shfl_xor(v, o));
    return v;
}
#define DPP_RED6S(v, F) do { v = F<0x111, 0xf>(v); v = F<0x112, 0xf>(v); v = F<0x114, 0xf>(v); v = F<0x118, 0xf>(v); v = F<0x142, 0xa>(v); v = F<0x143, 0xc>(v); } while (0)
template <int CTRL, int RMASK> __device__ __forceinline__ float fadd_dpp_(float a) { return a + __builtin_bit_cast(float, __builtin_amdgcn_update_dpp(0, __builtin_bit_cast(int, a), CTRL, RMASK, 0xf, false)); }
__device__ __forceinline__ float wave_sum_dpp(float v) { DPP_RED6S(v, fadd_dpp_); return __builtin_bit_cast(float, __builtin_amdgcn_readlane(__builtin_bit_cast(int, v), 63)); }
__device__ __forceinline__ float dot4(f32x4 a) { return (a[0] * a[0] + a[1] * a[1]) + (a[2] * a[2] + a[3] * a[3]); }
__device__ __forceinline__ float fq_sum(float s) {
    { auto rr = __builtin_amdgcn_permlane16_swap(__float_as_uint(s), __float_as_uint(s), false, false); s = __uint_as_float(rr[0]) + __uint_as_float(rr[1]); }
    { auto rr = __builtin_amdgcn_permlane32_swap(__float_as_uint(s), __float_as_uint(s), false, false); s = __uint_as_float(rr[0]) + __uint_as_float(rr[1]); }
    return s;
}
__device__ __forceinline__ h16x8 pack8(f32x4 a, f32x4 b) {
    h16x8 r; r[0] = (h16)a[0]; r[1] = (h16)a[1]; r[2] = (h16)a[2]; r[3] = (h16)a[3]; r[4] = (h16)b[0]; r[5] = (h16)b[1]; r[6] = (h16)b[2]; r[7] = (h16)b[3]; return r;
}
__device__ __forceinline__ h16x4 pack4(f32x4 a) { h16x4 r; r[0] = (h16)a[0]; r[1] = (h16)a[1]; r[2] = (h16)a[2]; r[3] = (h16)a[3]; return r; }
__device__ __forceinline__ float sigmoidf_(float x) { return __builtin_amdgcn_rcpf(1.0f + __builtin_amdgcn_exp2f(-1.4426950408889634f * x)); }
__device__ __forceinline__ float siluf_(float x) { return x * __builtin_amdgcn_rcpf(1.0f + __builtin_amdgcn_exp2f(-1.4426950408889634f * x)); }
#define LDS_FENCE() do { asm volatile("s_waitcnt lgkmcnt(0)" ::: "memory"); } while (0)
__device__ __forceinline__ int my_tid(int wv) { unsigned m = ~0u; asm volatile("" : "+s"(m)); int t = wv * 64 + (int)__builtin_amdgcn_mbcnt_hi(m, __builtin_amdgcn_mbcnt_lo(m, 0u)); asm volatile("" : "+v"(t)); return t; }
template <class Tp> __device__ __forceinline__ Tp* opaque_ptr(Tp* p) { size_t z = 0; asm volatile("" : "+s"(z)); return p + z; }

#define PG8_LAS __attribute__((address_space(3)))
__device__ __forceinline__ constexpr int pg8_stage_bytes() { return 131072; }
struct Unit { int pm, pn; };
struct Gemm { const h16* A; const h16* Bt; int lda, ldb, M, N, K; };
__device__ __forceinline__ int perm32(int rho) { const int n = rho >> 4, i = rho & 15; return 8 * (i >> 2) + 4 * n + (i & 3); }

template <class Epi>
__device__ __forceinline__ void gemm_simple(const Gemm g, const Epi& E, int blk, int nblk, int wv) {
    const int tid = my_tid(wv), wid = __builtin_amdgcn_readfirstlane(tid >> 6), lane = tid & 63, wr = wid >> 2, wc = wid & 3, fr = lane & 15, fq = lane >> 4;
    const int nN = g.N / 256, nU = (g.M / 256) * nN;
    for (int u = blk; u < nU; u += nblk) {
        Unit un; un.pm = u / nN; un.pn = u % nN;
        f32x4 acc[2][2][4][2];
#pragma unroll
        for (int a = 0; a < 2; ++a)
#pragma unroll
            for (int b = 0; b < 2; ++b)
#pragma unroll
                for (int m = 0; m < 4; ++m)
#pragma unroll
                    for (int n = 0; n < 2; ++n) acc[a][b][m][n] = (f32x4){0.f, 0.f, 0.f, 0.f};
        const h16* Ap = g.A + (size_t)(un.pm * 256 + wr * 64 + fr) * g.lda + fq * 8;
        const h16* Bp[2];
#pragma unroll
        for (int n = 0; n < 2; ++n) Bp[n] = g.Bt + (size_t)(un.pn * 256 + wc * 32 + (Epi::PERM ? perm32(16 * n + fr) : 16 * n + fr)) * g.ldb + fq * 8;
        for (int k0 = 0; k0 < g.K; k0 += 32) {
            h16x8 At[2][4], Bt[2][2];
#pragma unroll
            for (int ai = 0; ai < 2; ++ai)
#pragma unroll
                for (int m = 0; m < 4; ++m) At[ai][m] = *(const h16x8*)(Ap + (size_t)(ai * 128 + m * 16) * g.lda + k0);
#pragma unroll
            for (int bj = 0; bj < 2; ++bj)
#pragma unroll
                for (int n = 0; n < 2; ++n) Bt[bj][n] = *(const h16x8*)(Bp[n] + (size_t)(bj * 128) * g.ldb + k0);
#pragma unroll
            for (int ai = 0; ai < 2; ++ai)
#pragma unroll
                for (int bj = 0; bj < 2; ++bj)
#pragma unroll
                    for (int m = 0; m < 4; ++m)
#pragma unroll
                        for (int n = 0; n < 2; ++n) acc[ai][bj][m][n] = __builtin_amdgcn_mfma_f32_16x16x32_f16(Bt[bj][n], At[ai][m], acc[ai][bj][m][n], 0, 0, 0);
        }
        E(acc, un, wr, wc, fr, fq, nullptr);
    }
}

template <class E_> struct epi_fused { template <class X> static constexpr bool g(decltype(X::FUSED_FINAL)*) { return X::FUSED_FINAL; } template <class X> static constexpr bool g(...) { return false; } static constexpr bool v = g<E_>(nullptr); };
namespace pg8 {
constexpr int BM = 256, BK = 64, HALF = 128, HTB = HALF * BK * 2  , STAGE_BYTES = 8 * HTB, NXCD = 8, WGM = 8;
__host__ __device__ __forceinline__ int lds_byte(int r, int c) { const int st = (r >> 4) * 2 + (c >> 5), rr = r & 15, cc = c & 31, ob = rr * 64 + cc * 2; return st * 1024 + (ob ^ (((ob >> 9) & 1) << 5)); }
__host__ __device__ __forceinline__ void stage_rc(int b, int& R, int& C) { const int st = b / 1024, sb = b % 1024, swz = sb ^ (((sb >> 9) & 1) << 5); R = (st >> 1) * 16 + swz / 64; C = (st & 1) * 32 + (swz % 64) / 2; }
struct StaticOrder {
    int nM, nN, nwg, G, c;
    __host__ __device__ void init(int M, int N, int G_, int c_) { nM = M / BM; nN = N / BM; nwg = nM * nN; G = G_; c = c_; }
    __host__ __device__ bool next(int i, Unit& u) const {
        const long Lq = (long)i * G + c; if (Lq >= nwg) return false;
        int wgid = (int)Lq; { const int q = nwg / NXCD, r = nwg % NXCD, xcd = wgid % NXCD, off = wgid / NXCD; wgid = (xcd < r ? xcd * (q + 1) : r * (q + 1) + (xcd - r) * q) + off; }
        const int nig = WGM * nN, gid = wgid / nig, fm = gid * WGM, gsz = (nM - fm) < WGM ? (nM - fm) : WGM;
        u.pm = fm + ((wgid % nig) % gsz); u.pn = (wgid % nig) / gsz; return true;
    }
};
template <class Epi, bool ALIGN_EPI = true>
__device__ __forceinline__ void gemm_phase(PG8_LAS unsigned char* lds, const Gemm g, const StaticOrder& S, const Epi& E, int wv) {
    const int tid = my_tid(wv), wid = __builtin_amdgcn_readfirstlane(tid >> 6), lane = tid & 63, wr = wid >> 2, wc = wid & 3, fr = lane & 15, fq = lane >> 4;
    const int K = g.K, nt = K / BK;
    unsigned voffA[2], voffB[2];
#pragma unroll
    for (int i = 0; i < 2; ++i) { int R, C; stage_rc(tid * 16 + i * 8192, R, C); const int Rb = Epi::PERM ? ((R & ~31) + perm32(R & 31)) : R;
        voffA[i] = (unsigned)(R * g.lda + C) * 2u; voffB[i] = (unsigned)(Rb * g.ldb + C) * 2u; }
    const size_t kstep = (size_t)(BK * 2);
    const size_t hstepA = (size_t)HALF * g.lda * 2, hstepB = (size_t)HALF * g.ldb * 2;
    const size_t tstepA = 2 * hstepA, tstepB = 2 * hstepB;
    const unsigned ldsw = (unsigned)wid * 1024u;
    const int aoff = lds_byte(wr * 64 + fr, fq * 8), boff = lds_byte(wc * 32 + fr, fq * 8);
#define PG8_SA(b, h) (((b) * 2 + (h)) * HTB)
#define PG8_SB(b, h) ((4 + (b) * 2 + (h)) * HTB)
#define PG8_STAGE(bufoff, gbase, voff) do { _Pragma("unroll") for (int _i = 0; _i < 2; ++_i) \
        __builtin_amdgcn_global_load_lds((const unsigned*)((const char*)(gbase) + (voff)[_i]), (PG8_LAS unsigned*)(lds + (bufoff) + ldsw + _i * 8192), 16, 0, 0); } while (0)
#define PG8_LDA(dst, b, h) do { _Pragma("unroll") for (int m = 0; m < 4; ++m) _Pragma("unroll") for (int k = 0; k < 2; ++k) dst[m][k] = *(const PG8_LAS h16x8*)(lds + PG8_SA(b, h) + aoff + m * 2048 + k * 1024); } while (0)
#define PG8_LDB(dst, b, h) do { _Pragma("unroll") for (int n = 0; n < 2; ++n) _Pragma("unroll") for (int k = 0; k < 2; ++k) dst[n][k] = *(const PG8_LAS h16x8*)(lds + PG8_SB(b, h) + boff + n * 2048 + k * 1024); } while (0)
#define PG8_MMA(ai, bj, At, Bt) do { __builtin_amdgcn_s_setprio(1); _Pragma("unroll") for (int m = 0; m < 4; ++m) _Pragma("unroll") for (int n = 0; n < 2; ++n) _Pragma("unroll") for (int k = 0; k < 2; ++k) \
        acc[ai][bj][m][n] = __builtin_amdgcn_mfma_f32_16x16x32_f16(Bt[n][k], At[m][k], acc[ai][bj][m][n], 0, 0, 0); __builtin_amdgcn_s_setprio(0); } while (0)
#define PG8_WAIT_V(n) asm volatile("s_waitcnt vmcnt(" #n ")" ::: "memory")
#define PG8_WAIT_L(n) asm volatile("s_waitcnt lgkmcnt(" #n ")" ::: "memory")
#define PG8_BAR __builtin_amdgcn_s_barrier()
#define PG8_SCHED __builtin_amdgcn_sched_barrier(0)
    Unit cur, nxt; int ui = 0;
    if (!S.next(0, cur)) return;
    PG8_LAS float* rtab = (PG8_LAS float*)(lds + STAGE_BYTES);
#define PG8_FILL(U, PAR) do { const int tf_ = my_tid(wv); if (E.sqp != nullptr && tf_ < 256) { const size_t r_ = (size_t)(U).pm * 256 + tf_; float s_ = 0.f; \
        for (int j_ = 0; j_ < E.sqn; j_ += 4) { const f32x4 q_ = *(const f32x4*)(E.sqp + r_ * E.sqn + j_); s_ += (q_[0] + q_[1]) + (q_[2] + q_[3]); } \
        rtab[(PAR) * 256 + tf_] = rsqrtf(s_ * E.sqi + EPS); } } while (0)
    PG8_FILL(cur, 0);
    f32x4 acc[2][2][4][2];
#pragma unroll
    for (int a = 0; a < 2; ++a)
#pragma unroll
        for (int b = 0; b < 2; ++b)
#pragma unroll
            for (int m = 0; m < 4; ++m)
#pragma unroll
                for (int n = 0; n < 2; ++n) acc[a][b][m][n] = (f32x4){0.f, 0.f, 0.f, 0.f};
    h16x8 At[4][2], B0[2][2], B1[2][2];
    const char* cA = (const char*)g.A + (size_t)cur.pm * tstepA; const char* cB = (const char*)g.Bt + (size_t)cur.pn * tstepB;
    PG8_STAGE(PG8_SB(0, 0), cB, voffB); PG8_STAGE(PG8_SB(0, 1), cB + hstepB, voffB); PG8_STAGE(PG8_SA(0, 0), cA, voffA); PG8_STAGE(PG8_SA(0, 1), cA + hstepA, voffA);
    if (wr == 1) PG8_BAR;
    PG8_WAIT_V(2); PG8_BAR;
    PG8_STAGE(PG8_SB(1, 0), cB + kstep, voffB); PG8_STAGE(PG8_SA(1, 0), cA + kstep, voffA); PG8_STAGE(PG8_SB(1, 1), cB + hstepB + kstep, voffB);
    PG8_WAIT_V(6); PG8_BAR;
    for (;;) {
        const bool has_next = S.next(ui + 1, nxt);
        const char* nA = has_next ? (const char*)g.A + (size_t)nxt.pm * tstepA : cA; const char* nB = has_next ? (const char*)g.Bt + (size_t)nxt.pn * tstepB : cB;
        for (int t = 0; t < nt; t += 2) {
            const bool last = (t == nt - 2);
            const char* a1 = cA + (size_t)(t + 1) * kstep;
            const char* a2 = last ? nA : cA + (size_t)(t + 2) * kstep; const char* b2 = last ? nB : cB + (size_t)(t + 2) * kstep;
            const char* a3 = a2 + kstep; const char* b3 = b2 + kstep;
            PG8_LDB(B0, 0, 0); PG8_LDB(B1, 0, 1); PG8_SCHED; PG8_LDA(At, 0, 0); PG8_STAGE(PG8_SA(1, 1), a1 + hstepA, voffA);
            PG8_WAIT_V(8); PG8_WAIT_L(0); PG8_BAR; PG8_MMA(0, 0, At, B0); PG8_MMA(0, 1, At, B1); PG8_BAR; PG8_SCHED;
            PG8_LDA(At, 0, 1); PG8_STAGE(PG8_SB(0, 0), b2, voffB); PG8_STAGE(PG8_SB(0, 1), b2 + hstepB, voffB); PG8_STAGE(PG8_SA(0, 0), a2, voffA);
            PG8_WAIT_V(8); PG8_WAIT_L(0); PG8_BAR; PG8_MMA(1, 0, At, B0); PG8_MMA(1, 1, At, B1); PG8_BAR; PG8_SCHED;
            PG8_LDB(B0, 1, 0); PG8_LDB(B1, 1, 1); PG8_SCHED; PG8_LDA(At, 1, 0); PG8_STAGE(PG8_SA(0, 1), a2 + hstepA, voffA);
            PG8_WAIT_V(8); PG8_WAIT_L(0); PG8_BAR; PG8_MMA(0, 0, At, B0); PG8_MMA(0, 1, At, B1); PG8_BAR; PG8_SCHED;
            PG8_LDA(At, 1, 1); PG8_STAGE(PG8_SB(1, 0), b3, voffB); PG8_STAGE(PG8_SB(1, 1), b3 + hstepB, voffB); PG8_STAGE(PG8_SA(1, 0), a3, voffA);
            PG8_WAIT_V(8); PG8_WAIT_L(0); PG8_BAR; PG8_MMA(1, 0, At, B0); PG8_MMA(1, 1, At, B1); PG8_BAR; PG8_SCHED;
        }
        if constexpr (ALIGN_EPI) { if (wr == 0) PG8_BAR; }
        { const int te_ = my_tid(wv), le_ = te_ & 63;
          if constexpr (epi_fused<Epi>::v) E.final(acc, cur, wr, wc, le_ & 15, le_ >> 4, rtab + (ui & 1) * 256, lds, te_); else E(acc, cur, wr, wc, le_ & 15, le_ >> 4, rtab + (ui & 1) * 256); }
        if (has_next) PG8_FILL(nxt, (ui + 1) & 1);
        if (!has_next) break;
#pragma unroll
        for (int a = 0; a < 2; ++a)
#pragma unroll
            for (int b = 0; b < 2; ++b)
#pragma unroll
                for (int m = 0; m < 4; ++m)
#pragma unroll
                    for (int n = 0; n < 2; ++n) acc[a][b][m][n] = (f32x4){0.f, 0.f, 0.f, 0.f};
        cur = nxt; cA = nA; cB = nB; ++ui;
        if constexpr (ALIGN_EPI) { if (wr == 1) PG8_BAR; }
    }
    PG8_WAIT_V(0);
    if constexpr (!ALIGN_EPI) { if (wr == 0) PG8_BAR; }
    PG8_BAR;
#undef PG8_FILL
#undef PG8_SA
#undef PG8_SB
#undef PG8_STAGE
#undef PG8_LDA
#undef PG8_LDB
#undef PG8_MMA
#undef PG8_WAIT_V
#undef PG8_WAIT_L
#undef PG8_BAR
#undef PG8_SCHED
}
}
template <class Epi>
__device__ __forceinline__ void gemm_run(unsigned char* lds, const Gemm g, const Epi& E, int blk, int nblk, int wv) {
    pg8::StaticOrder S; S.init(g.M, g.N, nblk, blk);
    pg8::gemm_phase<Epi, true>((PG8_LAS unsigned char*)lds, g, S, E, wv);
}

struct EpiInA {
    static constexpr bool PERM = true;
    h16* ckv; h16* cqx; h16* sg; float* sqkv; float* sqq; const float* sqp; int sqn; float sqi;
    __device__ __forceinline__ void operator()(const f32x4 (&acc)[2][2][4][2], const Unit& u, int wr, int wc, int fr, int fq, const PG8_LAS float* rtab) const {
        asm volatile("" : "+v"(fr), "+v"(fq));
#pragma unroll
        for (int ai = 0; ai < 2; ++ai)
#pragma unroll
            for (int m = 0; m < 4; ++m) {
                const size_t r = (size_t)u.pm * 256 + ai * 128 + wr * 64 + m * 16 + fr;
                float ss = 0.f;
#pragma unroll
                for (int bj = 0; bj < 2; ++bj) {
                    const int c0 = bj * 128 + wc * 32 + 8 * fq;
                    f32x4 v0 = acc[ai][bj][m][0], v1 = acc[ai][bj][m][1];
                    if (u.pn == 0) { *(h16x8*)(ckv + r * 256 + c0) = pack8(v0, v1); ss += dot4(v0) + dot4(v1); }
                    else if (u.pn <= 2) { const int cq = (u.pn - 1) * 256 + c0; *(h16x8*)(cqx + r * 512 + cq) = pack8(v0, v1); if (cq < 384) ss += dot4(v0) + dot4(v1); }
                    else {
#pragma unroll
                        for (int e = 0; e < 4; ++e) { v0[e] = siluf_(v0[e]); v1[e] = siluf_(v1[e]); }
                        *(h16x8*)(sg + r * 1024 + (u.pn - 3) * 256 + c0) = pack8(v0, v1);
                    }
                }
                if (u.pn <= 2) {
                    ss = fq_sum(ss);
                    if (fq == 0) { if (u.pn == 0) sqkv[r * 4 + wc] = ss; else sqq[r * 8 + (u.pn - 1) * 4 + wc] = ss; }
                }
            }
    }
};
__device__ __forceinline__ unsigned cvtpk_bf16(float lo, float hi) { unsigned r; asm volatile("v_cvt_pk_bf16_f32 %0, %1, %2" : "=v"(r) : "v"(lo), "v"(hi)); return r; }
struct EpiScale {
    static constexpr bool PERM = true;
    const float* sqp; int sqn; float sqi; h16* d0; h16* d1; int split, ld0, ld1, bf0, bf1;
    __device__ __forceinline__ void operator()(const f32x4 (&acc)[2][2][4][2], const Unit& u, int wr, int wc, int fr, int fq, const PG8_LAS float* rtab) const {
        asm volatile("" : "+v"(fr), "+v"(fq));
#pragma unroll
        for (int ai = 0; ai < 2; ++ai)
#pragma unroll
            for (int m = 0; m < 4; ++m) {
                const size_t r = (size_t)u.pm * 256 + ai * 128 + wr * 64 + m * 16 + fr;
                float rs = 1.f;
                if (sqp) rs = rtab[ai * 128 + wr * 64 + m * 16 + fr];
#pragma unroll
                for (int bj = 0; bj < 2; ++bj) {
                    const int c0 = bj * 128 + wc * 32 + 8 * fq;
                    const f32x4 v0 = acc[ai][bj][m][0] * rs, v1 = acc[ai][bj][m][1] * rs;
                    const bool first = u.pn < split;
                    h16* dst = first ? d0 + r * ld0 + u.pn * 256 + c0 : d1 + r * ld1 + (u.pn - split) * 256 + c0;
                    if (first ? bf0 : bf1) { u32x4 w; w[0] = cvtpk_bf16(v0[0], v0[1]); w[1] = cvtpk_bf16(v0[2], v0[3]); w[2] = cvtpk_bf16(v1[0], v1[1]); w[3] = cvtpk_bf16(v1[2], v1[3]); *(u32x4*)dst = w; }
                    else *(h16x8*)dst = pack8(v0, v1);
                }
            }
    }
};
struct EpiRes {
    static constexpr bool PERM = true;
    const float* basef; const h16* baseh; h16* HH; float* sq; const float* sqp; int sqn; float sqi;
    __device__ __forceinline__ void operator()(const f32x4 (&acc)[2][2][4][2], const Unit& u, int wr, int wc, int fr, int fq, const PG8_LAS float* rtab) const {
        asm volatile("" : "+v"(fr), "+v"(fq));
#pragma unroll
        for (int ai = 0; ai < 2; ++ai)
#pragma unroll
            for (int m = 0; m < 4; ++m) {
                const size_t r = (size_t)u.pm * 256 + ai * 128 + wr * 64 + m * 16 + fr;
                float ss = 0.f;
#pragma unroll
                for (int bj = 0; bj < 2; ++bj) {
                    const size_t o = r * 1024 + u.pn * 256 + bj * 128 + wc * 32 + 8 * fq;
                    f32x4 h0, h1;
                    if (basef) { h0 = *(const f32x4*)(basef + o); h1 = *(const f32x4*)(basef + o + 4); }
                    else { const h16x8 b = *(const h16x8*)(baseh + o); h0 = (f32x4){(float)b[0], (float)b[1], (float)b[2], (float)b[3]}; h1 = (f32x4){(float)b[4], (float)b[5], (float)b[6], (float)b[7]}; }
                    h0 = h0 + acc[ai][bj][m][0]; h1 = h1 + acc[ai][bj][m][1];
                    *(h16x8*)(HH + o) = pack8(h0, h1); ss += dot4(h0) + dot4(h1);
                }
                ss = fq_sum(ss);
                if (fq == 0) sq[r * 16 + u.pn * 4 + wc] = ss;
            }
    }
};
struct EpiPle {
    static constexpr bool PERM = true;
    const h16* Hin; const h16* U; h16* Hout; const float* sqp; float* sqout; int sqn; float sqi;
    __device__ __forceinline__ void operator()(const f32x4 (&acc)[2][2][4][2], const Unit& u, int wr, int wc, int fr, int fq, const PG8_LAS float* rtab) const {
        asm volatile("" : "+v"(fr), "+v"(fq));
#pragma unroll
        for (int ai = 0; ai < 2; ++ai)
#pragma unroll
            for (int m = 0; m < 4; ++m) {
                const size_t r = (size_t)u.pm * 256 + ai * 128 + wr * 64 + m * 16 + fr;
                const float rs = rtab[ai * 128 + wr * 64 + m * 16 + fr];
                float ss = 0.f;
#pragma unroll
                for (int bj = 0; bj < 2; ++bj) {
                    const size_t o = r * 1024 + u.pn * 256 + bj * 128 + wc * 32 + 8 * fq;
                    const h16x8 uu = *(const h16x8*)(U + o); const h16x8 hh = *(const h16x8*)(Hin + o);
                    const f32x4 a0 = acc[ai][bj][m][0] * rs, a1 = acc[ai][bj][m][1] * rs; f32x4 h0, h1;
#pragma unroll
                    for (int e = 0; e < 4; ++e) { h0[e] = (float)hh[e] + (float)uu[e] * sigmoidf_(a0[e]); h1[e] = (float)hh[4 + e] + (float)uu[4 + e] * sigmoidf_(a1[e]); }
                    *(h16x8*)(Hout + o) = pack8(h0, h1); ss += dot4(h0) + dot4(h1);
                }
                ss = fq_sum(ss);
                if (fq == 0) sqout[r * 16 + u.pn * 4 + wc] = ss;
            }
    }
};
struct EpiPleFinal {
    static constexpr bool PERM = true, FUSED_FINAL = true;
    const h16* Hin; const h16* U; const float* sqp; int sqn; float sqi; const float* gfin; float* out; unsigned* xslot; unsigned* pcnt; unsigned* tmo;
    __device__ __forceinline__ void final(f32x4 (&acc)[2][2][4][2], const Unit& u, int wr, int wc, int fr, int fq, const PG8_LAS float* rtab, PG8_LAS unsigned char* lds, int tid) const {
        PG8_LAS float* Pt = (PG8_LAS float*)(lds + pg8_stage_bytes() + 2048);
        PG8_LAS float* St = Pt + 1024;
        const int wid = tid >> 6, lane = tid & 63;
        asm volatile("" : "+v"(fr), "+v"(fq));
#pragma unroll
        for (int ai = 0; ai < 2; ++ai)
#pragma unroll
            for (int m = 0; m < 4; ++m) {
                const int rl = ai * 128 + wr * 64 + m * 16 + fr; const size_t r = (size_t)u.pm * 256 + rl;
                const float rs = rtab[rl]; float ss = 0.f;
#pragma unroll
                for (int bj = 0; bj < 2; ++bj) {
                    const size_t o = r * 1024 + u.pn * 256 + bj * 128 + wc * 32 + 8 * fq;
                    const h16x8 uu = *(const h16x8*)(U + o); const h16x8 hh = *(const h16x8*)(Hin + o);
                    const f32x4 a0 = acc[ai][bj][m][0] * rs, a1 = acc[ai][bj][m][1] * rs; f32x4 h0, h1;
#pragma unroll
                    for (int e = 0; e < 4; ++e) { h0[e] = (float)hh[e] + (float)uu[e] * sigmoidf_(a0[e]); h1[e] = (float)hh[4 + e] + (float)uu[4 + e] * sigmoidf_(a1[e]); }
                    acc[ai][bj][m][0] = h0; acc[ai][bj][m][1] = h1; ss += dot4(h0) + dot4(h1);
                }
                ss = fq_sum(ss);
                if (fq == 0) Pt[rl * 4 + wc] = ss;
                asm volatile("" : "+v"(acc[ai][0][m][0]), "+v"(acc[ai][0][m][1]), "+v"(acc[ai][1][m][0]), "+v"(acc[ai][1][m][1]) :: "memory");
            }
        asm volatile("s_waitcnt lgkmcnt(0)" ::: "memory"); __builtin_amdgcn_s_barrier(); asm volatile("" ::: "memory");
        if (tid < 256) {
            const f32x4 p = *(const PG8_LAS f32x4*)(Pt + tid * 4);
            __hip_atomic_store(xslot + ((size_t)u.pm * 256 + tid) * 4 + u.pn, __float_as_uint((p[0] + p[1]) + (p[2] + p[3])), __ATOMIC_RELAXED, __HIP_MEMORY_SCOPE_AGENT);
            asm volatile("s_waitcnt vmcnt(0)" ::: "memory");
            if (lane == 0) __hip_atomic_fetch_add(pcnt + 64 * u.pm, 1u, __ATOMIC_RELAXED, __HIP_MEMORY_SCOPE_AGENT);
        }
        if (wid == 0) {
            unsigned sp = 0u;
            while (__hip_atomic_load(pcnt + 64 * u.pm, __ATOMIC_RELAXED, __HIP_MEMORY_SCOPE_AGENT) < 16u) {
                __builtin_amdgcn_s_sleep(2);
                if (++sp > (1u << 22)) { if (lane == 0) __hip_atomic_store(tmo, 1u, __ATOMIC_RELAXED, __HIP_MEMORY_SCOPE_AGENT); break; }
            }
            __builtin_amdgcn_fence(__ATOMIC_ACQUIRE, "agent");
        }
        asm volatile("s_waitcnt vmcnt(0) lgkmcnt(0)" ::: "memory"); __builtin_amdgcn_s_barrier(); asm volatile("" ::: "memory");
        if (tid < 256) {
            const unsigned* sl = xslot + ((size_t)u.pm * 256 + tid) * 4; float s = 0.f;
#pragma unroll
            for (int t = 0; t < 4; ++t) s += __uint_as_float(__hip_atomic_load(sl + t, __ATOMIC_RELAXED, __HIP_MEMORY_SCOPE_AGENT));
            St[tid] = rsqrtf(s * (1.0f / 1024.0f) + EPS);
        }
        asm volatile("s_waitcnt vmcnt(0) lgkmcnt(0)" ::: "memory"); __builtin_amdgcn_s_barrier(); asm volatile("" ::: "memory");
#pragma unroll
        for (int ai = 0; ai < 2; ++ai)
#pragma unroll
            for (int m = 0; m < 4; ++m) {
                const int rl = ai * 128 + wr * 64 + m * 16 + fr; const size_t r = (size_t)u.pm * 256 + rl;
                const float rr = St[rl];
#pragma unroll
                for (int bj = 0; bj < 2; ++bj) {
                    const int c = u.pn * 256 + bj * 128 + wc * 32 + 8 * fq;
                    const f32x4 g0 = *(const f32x4*)(gfin + c), g1 = *(const f32x4*)(gfin + c + 4);
                    *(f32x4*)(out + r * 1024 + c) = acc[ai][bj][m][0] * rr * g0; *(f32x4*)(out + r * 1024 + c + 4) = acc[ai][bj][m][1] * rr * g1;
                }
            }
    }
};
struct EpiInR {
    static constexpr bool PERM = true;
    const float* sqp; const f32x2* sincos; h16* rq; h16* rk; h16* rv; h16* rg; int sqn; float sqi;
    __device__ __forceinline__ void operator()(const f32x4 (&acc)[2][2][4][2], const Unit& u, int wr, int wc, int fr, int fq, const PG8_LAS float* rtab) const {
        asm volatile("" : "+v"(fr), "+v"(fq));
#pragma unroll
        for (int ai = 0; ai < 2; ++ai)
#pragma unroll
            for (int m = 0; m < 4; ++m) {
                const size_t r = (size_t)u.pm * 256 + ai * 128 + wr * 64 + m * 16 + fr;
                const float rs = rtab[ai * 128 + wr * 64 + m * 16 + fr];
                const int pos = (int)(r & (L - 1));
#pragma unroll
                for (int bj = 0; bj < 2; ++bj) {
                    const int c0 = bj * 128 + wc * 32 + 8 * fq;
                    f32x4 v0 = acc[ai][bj][m][0] * rs, v1 = acc[ai][bj][m][1] * rs;
                    if (u.pn < 8) {
                        const f32x2* sc = sincos + (size_t)pos * 128 + (c0 >> 1);
                        const f32x2 s0 = sc[0], s1 = sc[1], s2 = sc[2], s3 = sc[3];
                        f32x4 w0, w1;
                        w0[0] = v0[0] * s0[1] - v0[1] * s0[0]; w0[1] = v0[1] * s0[1] + v0[0] * s0[0];
                        w0[2] = v0[2] * s1[1] - v0[3] * s1[0]; w0[3] = v0[3] * s1[1] + v0[2] * s1[0];
                        w1[0] = v1[0] * s2[1] - v1[1] * s2[0]; w1[1] = v1[1] * s2[1] + v1[0] * s2[0];
                        w1[2] = v1[2] * s3[1] - v1[3] * s3[0]; w1[3] = v1[3] * s3[1] + v1[2] * s3[0];
                        h16* dst = (u.pn < 4) ? rq + r * 1024 + u.pn * 256 + c0 : rk + r * 1024 + (u.pn - 4) * 256 + c0;
                        *(h16x8*)dst = pack8(w0, w1);
                    } else if (u.pn < 16) {
                        *(h16x8*)(rv + r * 2048 + (u.pn - 8) * 256 + c0) = pack8(v0, v1);
                    } else {
#pragma unroll
                        for (int e = 0; e < 4; ++e) { v0[e] = siluf_(v0[e]); v1[e] = siluf_(v1[e]); }
                        *(h16x8*)(rg + r * 2048 + (u.pn - 16) * 256 + c0) = pack8(v0, v1);
                    }
                }
            }
    }
};

template <int MODE>
__device__ __forceinline__ void tr_item(const float* __restrict__ W, int K, int N, h16* Wt, int ld, int row_off, const float* ks, float scale, float* scr, int item, int lane) {
    const int nbn = (N + 31) >> 5, kb = item / nbn, nb = item % nbn, k0 = kb * 64, n0 = nb * 32;
    const int n4 = n0 + (lane & 7) * 4;
    f32x4 wv[8];
#pragma unroll
    for (int i = 0; i < 8; ++i) { const int kk = 8 * i + (lane >> 3); wv[i] = (n4 < N) ? __builtin_nontemporal_load((const f32x4*)(W + (size_t)(k0 + kk) * N + n4)) : (f32x4){0.f, 0.f, 0.f, 0.f}; }
#pragma unroll
    for (int i = 0; i < 8; ++i) { const int kk = 8 * i + (lane >> 3); const float kf = ks ? ks[k0 + kk] : 1.f;
#pragma unroll
        for (int e = 0; e < 4; ++e) scr[kk * 33 + (lane & 7) * 4 + e] = wv[i][e] * kf; }
    LDS_FENCE();
    const int c = lane & 7;
#pragma unroll
    for (int j = 0; j < 4; ++j) {
        const int nl = (lane >> 3) + 8 * j, n = n0 + nl;
        if (n < N) {
            int row = n; float sc = scale;
            if (MODE == 1) row = (n < 384) ? 256 + n : (n < 640) ? n - 384 : (n < 712) ? n : n + 56;
            if (MODE == 2 && n >= 1024 && n < 2048) sc *= 0.0625f;
            const float* s = scr + (8 * c) * 33 + nl;
            h16x8 o;
#pragma unroll
            for (int e = 0; e < 8; ++e) o[e] = (h16)(s[e * 33] * sc);
            *(h16x8*)(Wt + (size_t)(row_off + row) * ld + k0 + 8 * c) = o;
        }
    }
    LDS_FENCE();
}

__device__ __forceinline__ void p0_prologue(const Params& P, unsigned char* lds, int blk, int nblk, int wv, int mode) {
    const int tid = my_tid(wv), wid = __builtin_amdgcn_readfirstlane(tid >> 6), lane = tid & 63;
    float* scr = (float*)lds + wid * (64 * 33);
    unsigned char* ws = opaque_ptr(P.ws);
    h16* WAIN = (h16*)(ws + WS_WAIN); h16* WQ = (h16*)(ws + WS_WQ); h16* WKV = (h16*)(ws + WS_WKV); h16* WAOUT = (h16*)(ws + WS_WAOUT);
    h16* WPG = (h16*)(ws + WS_WPG); h16* WPLE = (h16*)(ws + WS_WPLE); h16* WRIN = (h16*)(ws + WS_WRIN); h16* WROUT = (h16*)(ws + WS_WROUT);
    const float QSCALE = 0.08838834764831845f * 1.4426950408889634f;
    constexpr int I1 = 16 * 55, I2 = 6 * 32, I3 = 6 * 16, I4 = 8 * 16, I5 = 8 * 16, I6 = 16 * 32, I7 = 2 * 16 * 32, I8 = 2 * 4 * 32, I9 = 16 * 192, I10 = 32 * 32;
    constexpr int NIT = I1 + I2 + I3 + I4 + I5 + I6 + I7 + I8 + I9 + I10;
    const bool wgt = (nblk == 256);
    const int nslot = wgt ? 1152 : nblk, s_lo = (mode == 0) ? blk : wgt ? (blk < 128 ? 2 * blk : 256 + 7 * (blk - 128)) : blk, s_n = (mode == 0) ? 1 : wgt ? (blk < 128 ? 2 : 7) : 1, s_tot = (mode == 0) ? nblk : nslot;
    for (int sl_ = s_lo; sl_ < s_lo + s_n; ++sl_) {
    const int gw = sl_ * NWAVES + wid, ngw = s_tot * NWAVES;
    for (int it = (mode == 0 ? 0 : I1) + gw; it < (mode == 0 ? I1 : NIT); it += ngw) {
        int r = it;
        if (r < I1) { tr_item<1>(P.in[3], 1024, 1736, WAIN, 1024, 0, nullptr, 1.f, scr, r, lane); continue; } r -= I1;
        if (r < I2) { tr_item<0>(P.in[6], 384, 1024, WQ, 384, 0, P.in[4], QSCALE, scr, r, lane); continue; } r -= I2;
        if (r < I3) { tr_item<0>(P.in[7], 384, 512, WQ, 384, 1024, P.in[4], 1.f, scr, r, lane); continue; } r -= I3;
        if (r < I4) { const int h = r / 16; tr_item<0>(P.in[10] + (size_t)h * 256 * 128, 256, 128, WKV, 256, h * 128, P.in[5], 1.f, scr, r % 16, lane); continue; } r -= I4;
        if (r < I5) { const int h = r / 16; tr_item<0>(P.in[11] + (size_t)h * 256 * 128, 256, 128, WKV, 256, 1024 + h * 128, P.in[5], 1.f, scr, r % 16, lane); continue; } r -= I5;
        if (r < I6) { tr_item<0>(P.in[12], 1024, 1024, WAOUT, 1024, 0, nullptr, 1.f, scr, r, lane); continue; } r -= I6;
        if (r < I7) { const int i = r / 512; tr_item<0>(P.in[15] + (size_t)i * 1024 * 1024, 1024, 1024, WPG + (size_t)i * 1024 * 1024, 1024, 0, P.in[16] + i * 1024, 1.f, scr, r % 512, lane); continue; } r -= I7;
        if (r < I8) { const int i = r / 128; tr_item<0>(P.in[17] + (size_t)i * 256 * 1024, 256, 1024, WPLE + (size_t)i * 1024 * 256, 256, 0, nullptr, 1.f, scr, r % 128, lane); continue; } r -= I8;
        if (r < I9) { tr_item<2>(P.in[13], 1024, 6144, WRIN, 1024, 0, P.in[2] + 1024, 1.f, scr, r, lane); continue; } r -= I9;
        tr_item<0>(P.in[14], 2048, 1024, WROUT, 2048, 0, nullptr, 1.f, scr, r, lane);
    }
    }
    if (mode == 0) {
    const int gw = blk * NWAVES + wid, ngw = nblk * NWAVES;
    const int gt = blk * NTHREADS + tid, ngt = nblk * NTHREADS;
    { unsigned zz = 0u; asm volatile("" : "+v"(zz));
      for (int i = gt; i < 56 * 1024 / 8; i += ngt) ((u32x4*)(WAIN + 712 * 1024))[i] = (u32x4){zz, zz, zz, zz}; }
    {
        const float* x = P.in[0]; const f32x4* g4 = (const f32x4*)P.in[2]; h16* XN0 = (h16*)(ws + WS_R1);
        f32x4 gv[4];
#pragma unroll
        for (int j = 0; j < 4; ++j) gv[j] = g4[(j >> 1) * 128 + lane * 2 + (j & 1)];
        for (int r0 = gw; r0 < T; r0 += 4 * ngw) {
            f32x4 v[4][4];
#pragma unroll
            for (int k = 0; k < 4; ++k) { const int r = (r0 + k * ngw < T) ? r0 + k * ngw : r0; const f32x4* xr = (const f32x4*)(x + (size_t)r * 1024);
#pragma unroll
                for (int j = 0; j < 4; ++j) v[k][j] = __builtin_nontemporal_load(xr + ((j >> 1) * 128 + lane * 2 + (j & 1))); }
#pragma unroll
            for (int k = 0; k < 4; ++k) { const int r = r0 + k * ngw; float s = 0.f;
#pragma unroll
                for (int j = 0; j < 4; ++j) s += dot4(v[k][j]);
                const float rstd = rsqrtf(wave_sum_dpp(s) * (1.0f / 1024.0f) + EPS);
                if (r < T) {
#pragma unroll
                    for (int hh = 0; hh < 2; ++hh) *(h16x8*)(XN0 + (size_t)r * 1024 + hh * 512 + lane * 8) = pack8(v[k][2 * hh] * rstd * gv[2 * hh], v[k][2 * hh + 1] * rstd * gv[2 * hh + 1]); } }
        }
    }
    }
    if (mode == 1)
    for (int sl_ = s_lo; sl_ < s_lo + s_n; ++sl_) {
    const int gt = sl_ * NTHREADS + tid, ngt = s_tot * NTHREADS;
    {
        const f32x4* p4 = (const f32x4*)P.in[1]; h16* PH0 = (h16*)(ws + WS_PH0); h16* PH1 = (h16*)(ws + WS_PH1);
        const int nv = T * 256 / 8;
        for (int i0_ = gt; i0_ < 2 * nv; i0_ += 4 * ngt) {
            f32x4 a[4], b2[4];
#pragma unroll
            for (int k = 0; k < 4; ++k) { const int i = (i0_ + k * ngt < 2 * nv) ? i0_ + k * ngt : i0_; a[k] = p4[2 * (size_t)i]; b2[k] = p4[2 * (size_t)i + 1]; }
#pragma unroll
            for (int k = 0; k < 4; ++k) { const int i = i0_ + k * ngt; if (i < 2 * nv) { h16* dst = (i < nv) ? PH0 + (size_t)i * 8 : PH1 + (size_t)(i - nv) * 8; *(h16x8*)dst = pack8(a[k], b2[k]); } }
        }
    }
    {
        f32x2* SC = (f32x2*)(ws + WS_SINCOS);
        for (int i = gt; i < L * 128; i += ngt) {
            const int pos = i >> 7, fi = i & 127;
            const float th = (float)pos * kAngle[fi];
            double rev = (double)th * 0.15915494309189535; rev -= __builtin_rint(rev);
            const float r = (float)(rev * 6.283185307179586), r2 = r * r;
            float sn = 1.9572941e-20f;
            sn = sn * r2 - 8.2206352e-18f;
            sn = sn * r2 + 2.8114573e-15f;
            sn = sn * r2 - 7.6471637e-13f;
            sn = sn * r2 + 1.6059044e-10f;
            sn = sn * r2 - 2.5052108e-8f;
            sn = sn * r2 + 2.7557319e-6f;
            sn = sn * r2 - 1.9841270e-4f;
            sn = sn * r2 + 8.3333333e-3f;
            sn = sn * r2 - 1.6666667e-1f;
            sn = sn * r2 + 1.0f;
            sn = sn * r;
            float cs = 4.1103176e-19f;
            cs = cs * r2 - 1.5619207e-16f;
            cs = cs * r2 + 4.7794773e-14f;
            cs = cs * r2 - 1.1470746e-11f;
            cs = cs * r2 + 2.0876757e-9f;
            cs = cs * r2 - 2.7557319e-7f;
            cs = cs * r2 + 2.4801587e-5f;
            cs = cs * r2 - 1.3888889e-3f;
            cs = cs * r2 + 4.1666667e-2f;
            cs = cs * r2 - 0.5f;
            cs = cs * r2 + 1.0f;
            SC[i] = (f32x2){sn, cs};
        }
    }
    }
}

__device__ __forceinline__ void p2_kidx(const Params& P, int blk, int nblk, int wv) {
    const h16* CQX = (const h16*)(P.ws + WS_CQX); h16* KIDXN = (h16*)(P.ws + WS_KIDXN); float* WIDX = (float*)(P.ws + WS_WIDX);
    const float* g = P.in[8]; const float* bb = P.in[9];
    for (int r = blk * NTHREADS + my_tid(wv); r < T; r += nblk * NTHREADS) {
        float v[64]; float s = 0.f;
#pragma unroll
        for (int c = 0; c < 8; ++c) { const h16x8 k = *(const h16x8*)(CQX + (size_t)r * 512 + 384 + c * 8);
#pragma unroll
            for (int e = 0; e < 8; ++e) { v[c * 8 + e] = (float)k[e]; s += v[c * 8 + e]; } }
        const float mu = s * (1.0f / 64.0f); float q = 0.f;
#pragma unroll
        for (int i = 0; i < 64; ++i) { v[i] -= mu; q += v[i] * v[i]; }
        const float rstd = rsqrtf(q * (1.0f / 64.0f) + EPS);
#pragma unroll
        for (int c = 0; c < 8; ++c) { h16x8 o;
#pragma unroll
            for (int e = 0; e < 8; ++e) o[e] = (h16)(v[c * 8 + e] * rstd * g[c * 8 + e] + bb[c * 8 + e]);
            *(h16x8*)(KIDXN + (size_t)r * 64 + c * 8) = o; }
        const h16x8 w = *(const h16x8*)(CQX + (size_t)r * 512 + 448);
        const float wsc = 0.04419417382415922f;
        f32x4 w0, w1;
#pragma unroll
        for (int e = 0; e < 4; ++e) { w0[e] = (float)w[e] * wsc; w1[e] = (float)w[4 + e] * wsc; }
        *(f32x4*)(WIDX + (size_t)r * 8) = w0; *(f32x4*)(WIDX + (size_t)r * 8 + 4) = w1;
    }
}

__device__ __forceinline__ unsigned fmap_u(float s) { s += 0.0f; const unsigned b = __float_as_uint(s); return (b & 0x80000000u) ? ~b : (b | 0x80000000u); }
__device__ __forceinline__ unsigned topk_select(const unsigned (&u)[32], int lane) {
    unsigned Tv = 0u;
    for (int bit = 31; bit >= 0; --bit) {
        const unsigned cand = Tv | (1u << bit); int cnt = 0;
#pragma unroll
        for (int i = 0; i < 32; ++i) cnt += __popcll(__ballot(u[i] >= cand));
        if (cnt >= 256) Tv = cand;
    }
    int gt = 0;
#pragma unroll
    for (int i = 0; i < 32; ++i) gt += __popcll(__ballot(u[i] > Tv));
    int need = 256 - gt;
    unsigned sel = 0u;
#pragma unroll
    for (int i = 0; i < 32; ++i) {
        const bool eq = (u[i] == Tv);
        const unsigned long long em = __ballot(eq);
        const int rank = (int)__builtin_amdgcn_mbcnt_hi((unsigned)(em >> 32), __builtin_amdgcn_mbcnt_lo((unsigned)em, 0u));
        const bool take = (u[i] > Tv) || (eq && rank < need);
        sel |= (take ? 1u : 0u) << i;
        need -= __popcll(em);
    }
    return sel;
}


__device__ __forceinline__ unsigned topk_select_radix(const unsigned (&u)[32], int lane, volatile __attribute__((address_space(3))) unsigned* hist) {
    typedef __attribute__((address_space(3))) unsigned lu32;
    unsigned prefix = 0u; int kk = 256;
#pragma unroll 1
    for (int pass = 0; pass < 4; ++pass) {
        const int shift = 24 - 8 * pass;
        { unsigned zz = 0u; asm volatile("" : "+v"(zz)); ((__attribute__((address_space(3))) u32x4*)hist)[lane] = (u32x4){zz, zz, zz, zz}; }
        LDS_FENCE();
#pragma unroll
        for (int i = 0; i < 32; ++i) {
            const bool in = (u[i] != 0u) && (pass == 0 || (u[i] >> (shift + 8)) == prefix);
            if (in) __hip_atomic_fetch_add((lu32*)hist + ((u[i] >> shift) & 255u), 1u, __ATOMIC_RELAXED, __HIP_MEMORY_SCOPE_WORKGROUP);
        }
        LDS_FENCE();
        const u32x4 c = ((__attribute__((address_space(3))) u32x4*)hist)[lane];
        const int tot = (int)(c[0] + c[1] + c[2] + c[3]);
        int S = tot;
#pragma unroll
        for (int o = 1; o < 64; o <<= 1) { const int v = __shfl_down(S, o); if (lane + o < 64) S += v; }
        const unsigned long long bm = __ballot(S >= kk);
        const int Ls = 63 - __builtin_clzll(bm);
        int cum = S - tot, bin = 0, above = 0; bool found = false;
#pragma unroll
        for (int j = 3; j >= 0; --j) { const int cj = (int)c[j]; if (!found && cum + cj >= kk) { bin = 4 * lane + j; above = cum; found = true; } cum += cj; }
        bin = __builtin_amdgcn_readlane(bin, Ls); above = __builtin_amdgcn_readlane(above, Ls);
        kk -= above; prefix = (prefix << 8) | (unsigned)bin;
        LDS_FENCE();
    }
    const unsigned Tv = prefix; int need = kk;
    unsigned sel = 0u;
#pragma unroll
    for (int i = 0; i < 32; ++i) {
        const bool eq = (u[i] == Tv);
        const unsigned long long em = __ballot(eq);
        const int rank = (int)__builtin_amdgcn_mbcnt_hi((unsigned)(em >> 32), __builtin_amdgcn_mbcnt_lo((unsigned)em, 0u));
        const bool take = (u[i] > Tv) || (eq && rank < need);
        sel |= (take ? 1u : 0u) << i;
        need -= __popcll(em);
    }
    return sel;
}


#define DPP_STEP_I(v, op, ident, ctrl, rmask) v = op(v, __builtin_amdgcn_update_dpp((int)(ident), v, ctrl, rmask, 0xf, false))
__device__ __forceinline__ int imax_(int a, int b) { return a > b ? a : b; }
__device__ __forceinline__ int iadd_(int a, int b) { return a + b; }
__device__ __forceinline__ int wave_scan_add(int v) {
    DPP_STEP_I(v, iadd_, 0, 0x111, 0xf); DPP_STEP_I(v, iadd_, 0, 0x112, 0xf); DPP_STEP_I(v, iadd_, 0, 0x114, 0xf); DPP_STEP_I(v, iadd_, 0, 0x118, 0xf);
    DPP_STEP_I(v, iadd_, 0, 0x142, 0xa); DPP_STEP_I(v, iadd_, 0, 0x143, 0xc); return v;
}
template <int CTRL, int RMASK> __device__ __forceinline__ float fmax_dpp_(float a) { return fmaxf(a, __builtin_bit_cast(float, __builtin_amdgcn_update_dpp((int)0xff800000u, __builtin_bit_cast(int, a), CTRL, RMASK, 0xf, false))); }
template <int CTRL, int RMASK> __device__ __forceinline__ float fmin_dpp_(float a) { return fminf(a, __builtin_bit_cast(float, __builtin_amdgcn_update_dpp((int)0x7f800000u, __builtin_bit_cast(int, a), CTRL, RMASK, 0xf, false))); }
#define DPP_RED6(v, F) do { v = F<0x111, 0xf>(v); v = F<0x112, 0xf>(v); v = F<0x114, 0xf>(v); v = F<0x118, 0xf>(v); v = F<0x142, 0xa>(v); v = F<0x143, 0xc>(v); } while (0)
__device__ __forceinline__ float wave_max_dpp(float v) { DPP_RED6(v, fmax_dpp_); return __builtin_bit_cast(float, __builtin_amdgcn_readlane(__builtin_bit_cast(int, v), 63)); }
__device__ __forceinline__ float wave_min_dpp(float v) { DPP_RED6(v, fmin_dpp_); return __builtin_bit_cast(float, __builtin_amdgcn_readlane(__builtin_bit_cast(int, v), 63)); }
__device__ __forceinline__ unsigned topk_select_lin(const float (&s)[32], unsigned valid, int lane, volatile __attribute__((address_space(3))) unsigned* ws_) {
    typedef __attribute__((address_space(3))) unsigned lu32;
    typedef __attribute__((address_space(3))) float lf32;
    typedef __attribute__((address_space(3))) f32x4 lf32x4;
    lu32* hist = (lu32*)ws_; lf32* cand = (lf32*)ws_ + 256;
    unsigned act = valid; int kk = 256; float Tv = 0.f; int need = 0; bool solved = false; int cnt = 0;
#pragma unroll 1
    for (int iter = 0; iter < 8; ++iter) {
        float mn = __builtin_inff(), mx = -__builtin_inff();
        if (iter == 0) {
#pragma unroll
            for (int i = 0; i < 32; ++i) { mn = fminf(mn, s[i]); mx = fmaxf(mx, s[i]); }
        } else {
#pragma unroll
            for (int i = 0; i < 32; ++i) { const bool a = (act >> i) & 1u; mn = fminf(mn, a ? s[i] : __builtin_inff()); mx = fmaxf(mx, a ? s[i] : -__builtin_inff()); }
        }
        mn = wave_min_dpp(mn); mx = wave_max_dpp(mx);
        if (mn == mx) { Tv = mx; need = kk; solved = true; break; }
        const float scale = 254.9f / (mx - mn), bias = -mn * scale;
        { unsigned zz = 0u; asm volatile("" : "+v"(zz)); ((__attribute__((address_space(3))) u32x4*)hist)[lane] = (u32x4){zz, zz, zz, zz}; }
        LDS_FENCE();
#pragma unroll
        for (int i = 0; i < 32; ++i) { int b = (int)fmaf(s[i], scale, bias); b = b < 0 ? 0 : b;
            __hip_atomic_fetch_add(hist + (((act >> i) & 1u) ? b : 321 + (lane & 15)), 1u, __ATOMIC_RELAXED, __HIP_MEMORY_SCOPE_WORKGROUP); }
        LDS_FENCE();
        const u32x4 c = ((__attribute__((address_space(3))) u32x4*)hist)[lane];
        const int tot = (int)(c[0] + c[1] + c[2] + c[3]);
        const int pre = wave_scan_add(tot);
        const int total = __builtin_amdgcn_readlane(pre, 63);
        const int S = total - pre + tot;
        const unsigned long long bm = __ballot(S >= kk);
        const int Ls = 63 - __builtin_clzll(bm | 1ull);
        int cum = S - tot, bin = 0, above = 0, cb = 0; bool found = false;
#pragma unroll
        for (int j = 3; j >= 0; --j) { const int cj = (int)c[j]; if (!found && cum + cj >= kk) { bin = 4 * lane + j; above = cum; cb = cj; found = true; } cum += cj; }
        bin = __builtin_amdgcn_readlane(bin, Ls); above = __builtin_amdgcn_readlane(above, Ls); cnt = __builtin_amdgcn_readlane(cb, Ls);
        kk -= above;
        { float sc2 = scale; asm volatile("" : "+v"(sc2));
#pragma unroll
          for (int i = 0; i < 32; ++i) { int b = (int)fmaf(s[i], sc2, bias); b = b < 0 ? 0 : b; act &= ~((b != bin ? 1u : 0u) << i); } }
        LDS_FENCE();
        if (cnt <= 64) break;
    }
    if (!solved) {
        cand[lane] = __builtin_nanf("");
        const int myc = __popc(act);
        int off = wave_scan_add(myc) - myc;
        LDS_FENCE();
#pragma unroll
        for (int i = 0; i < 32; ++i) { const bool a = (act >> i) & 1u; const int slot = (a && off < 64) ? off : 65 + (lane & 15); cand[slot] = s[i]; off += a ? 1 : 0; }
        LDS_FENCE();
        const int m = cnt < 64 ? cnt : 64;
        const float v = (lane < m) ? cand[lane] : -__builtin_inff();
        int gt = 0, eq = 0;
#pragma unroll
        for (int j4 = 0; j4 < 16; ++j4) { const f32x4 cj = ((lf32x4*)cand)[j4];
#pragma unroll
            for (int e = 0; e < 4; ++e) { gt += (cj[e] > v) ? 1 : 0; eq += (cj[e] == v) ? 1 : 0; } }
        const bool ok = (lane < m) && gt < kk && kk <= gt + eq;
        const unsigned long long okm = __ballot(ok);
        const int fl = okm ? __builtin_ctzll(okm) : 0;
        Tv = __builtin_bit_cast(float, __builtin_amdgcn_readlane(__builtin_bit_cast(int, v), fl)); need = kk - __builtin_amdgcn_readlane(gt, fl);
        LDS_FENCE();
    }
    unsigned sel = 0u, eqb = 0u;
#pragma unroll
    for (int i = 0; i < 32; ++i) { sel |= ((s[i] > Tv) ? 1u : 0u) << i; eqb |= ((s[i] == Tv) ? 1u : 0u) << i; }
    const int eqtot = __builtin_amdgcn_readlane(wave_scan_add(__popc(eqb)), 63);
    if (eqtot <= need) sel |= eqb;
    else {
#pragma unroll
        for (int i = 0; i < 32; ++i) {
            const bool eq = (eqb >> i) & 1u;
            const unsigned long long em = __ballot(eq);
            const int rank = (int)__builtin_amdgcn_mbcnt_hi((unsigned)(em >> 32), __builtin_amdgcn_mbcnt_lo((unsigned)em, 0u));
            sel |= ((eq && rank < need) ? 1u : 0u) << i;
            need -= __popcll(em);
        }
    }
    return sel;
}


__device__ __forceinline__ unsigned topk_select_fast(const float (&s)[32], unsigned valid, int nk, int lane, const __attribute__((address_space(3))) float* row, volatile __attribute__((address_space(3))) unsigned* ws_) {
    typedef __attribute__((address_space(3))) unsigned lu32; typedef __attribute__((address_space(3))) float lf32; typedef __attribute__((address_space(3))) f32x4 lf32x4;
    lu32* hist = (lu32*)ws_; lf32* cand = (lf32*)ws_ + 256;
    float mn = __builtin_inff(), mx = -__builtin_inff();
#pragma unroll
    for (int i = 0; i < 32; ++i) { mn = fminf(mn, s[i]); mx = fmaxf(mx, s[i]); }
    mn = wave_min_dpp(mn); mx = wave_max_dpp(mx);
    const bool flat = (mn == mx);
    const float scale = flat ? 0.f : 254.9f / (mx - mn), bias = flat ? 0.f : -mn * scale;
    { unsigned zz = 0u; asm volatile("" : "+v"(zz)); ((__attribute__((address_space(3))) u32x4*)hist)[lane] = (u32x4){zz, zz, zz, zz}; }
    LDS_FENCE();
    const int full = nk >> 6, rem = nk & 63;
#pragma unroll
    for (int i = 0; i < 32; ++i) if (i <= full) { const int b = (int)fmaf(s[i], scale, bias);     __hip_atomic_fetch_add(hist + b, 1u, __ATOMIC_RELAXED, __HIP_MEMORY_SCOPE_WORKGROUP); }
    LDS_FENCE();
    u32x4 c = ((__attribute__((address_space(3))) u32x4*)hist)[lane];
    if (lane == 0 && full < 32) c[0] -= (unsigned)(64 - rem);
    const int tot = (int)(c[0] + c[1] + c[2] + c[3]);
    const int pre = wave_scan_add(tot), total = __builtin_amdgcn_readlane(pre, 63);
    const int S = total - pre + tot;
    const unsigned long long bm = __ballot(S >= 256);
    const int Ls = 63 - __builtin_clzll(bm | 1ull);
    int cum = S - tot, bin = 0, above = 0, cb = 0; bool found = false;
#pragma unroll
    for (int j = 3; j >= 0; --j) { const int cj = (int)c[j]; if (!found && cum + cj >= 256) { bin = 4 * lane + j; above = cum; cb = cj; found = true; } cum += cj; }
    bin = __builtin_amdgcn_readlane(bin, Ls); above = __builtin_amdgcn_readlane(above, Ls); const int cnt = __builtin_amdgcn_readlane(cb, Ls);
    if (flat || cnt > 64) return topk_select_lin(s, valid, lane, ws_);
    const int kk = 256 - above;
    unsigned gtb = 0u, eqb = 0u;
    { float sc2 = scale; asm volatile("" : "+v"(sc2));
#pragma unroll
      for (int i = 0; i < 32; ++i) if (i <= full) { const int b = (int)fmaf(s[i], sc2, bias); gtb |= (b > bin ? 1u : 0u) << i; eqb |= (b == bin ? 1u : 0u) << i; } }
    eqb &= valid;
    cand[lane] = __builtin_nanf("");
    int off = wave_scan_add(__popc(eqb)) - __popc(eqb);
    LDS_FENCE();
    { unsigned m = eqb;
      while (__any(m != 0u)) { if (m != 0u) { const int i = __builtin_ctz(m); cand[off < 64 ? off : 65 + (lane & 15)] = row[i * 64 + lane]; ++off; m &= m - 1u; } } }
    LDS_FENCE();
    const float v = (lane < cnt) ? cand[lane] : -__builtin_inff();
    int gt = 0, eq = 0;
#pragma unroll
    for (int j4 = 0; j4 < 16; ++j4) if (j4 * 4 < cnt) { const f32x4 cj = ((lf32x4*)cand)[j4];
#pragma unroll
        for (int e = 0; e < 4; ++e) { gt += (cj[e] > v) ? 1 : 0; eq += (cj[e] == v) ? 1 : 0; } }
    const unsigned long long okm = __ballot((lane < cnt) && gt < kk && kk <= gt + eq);
    const int fl = okm ? __builtin_ctzll(okm) : 0;
    const float Tv = __builtin_bit_cast(float, __builtin_amdgcn_readlane(__builtin_bit_cast(int, v), fl)); int need = kk - __builtin_amdgcn_readlane(gt, fl);
    const int eqtot = __builtin_amdgcn_readlane(eq, fl);
    LDS_FENCE();
    unsigned sel = gtb;
    if (eqtot <= need) {
        unsigned m = eqb;
        while (__any(m != 0u)) { if (m != 0u) { const int i = __builtin_ctz(m); if (row[i * 64 + lane] >= Tv) sel |= 1u << i; m &= m - 1u; } }
    } else {
#pragma unroll
        for (int i = 0; i < 32; ++i) {
            const bool inb = (eqb >> i) & 1u; const bool e_ = inb && (s[i] == Tv);
            const unsigned long long em = __ballot(e_);
            const int rank = (int)__builtin_amdgcn_mbcnt_hi((unsigned)(em >> 32), __builtin_amdgcn_mbcnt_lo((unsigned)em, 0u));
            sel |= (((inb && s[i] > Tv) || (e_ && rank < need)) ? 1u : 0u) << i;
            need -= __popcll(em);
        }
    }
    return sel;
}

__device__ __forceinline__ void p3_indexer_naive(const Params& P, unsigned char* lds, int blk, int nblk, int wv) {
    const int tid = my_tid(wv), wid = __builtin_amdgcn_readfirstlane(tid >> 6), lane = tid & 63;
    float* sc = (float*)lds + wid * 2048; float* qf = (float*)(lds + 65536) + wid * 512; float* wf = (float*)(lds + 65536 + 16384) + wid * 8;
    const h16* QIDX = (const h16*)(P.ws + WS_QIDX); const h16* KIDXN = (const h16*)(P.ws + WS_KIDXN); const float* WIDX = (const float*)(P.ws + WS_WIDX);
    unsigned long long* MASK = (unsigned long long*)(P.ws + WS_MASK);
    const int gw = blk * NWAVES + wid, ngw = nblk * NWAVES;
    for (int it = gw; it < T; it += ngw) {
        const int b = it >> 11, pos = ((it & 2047) + b * 389) & 2047, t = b * L + pos, nk = pos + 1;
        { const h16x8 qv = *(const h16x8*)(QIDX + (size_t)t * 512 + lane * 8);
#pragma unroll
          for (int e = 0; e < 8; ++e) qf[lane * 8 + e] = (float)qv[e];
          if (lane < 8) wf[lane] = WIDX[(size_t)t * 8 + lane]; }
        LDS_FENCE();
        for (int i = 0; i * 64 < nk; ++i) {
            const int key = i * 64 + lane; float score = 0.f;
            if (key < nk) {
                const h16x8* kp = (const h16x8*)(KIDXN + (size_t)(b * L + key) * 64);
                float kf[64];
#pragma unroll
                for (int c = 0; c < 8; ++c) { const h16x8 kv = kp[c];
#pragma unroll
                    for (int e = 0; e < 8; ++e) kf[c * 8 + e] = (float)kv[e]; }
                for (int h = 0; h < 8; ++h) {
                    float a = 0.f;
#pragma unroll
                    for (int d = 0; d < 64; ++d) a = fmaf(qf[h * 64 + d], kf[d], a);
                    score += fmaxf(a, 0.f) * wf[h];
                }
            }
            sc[key] = score;
        }
        LDS_FENCE();
        unsigned selbits = 0u;
        if (nk <= 256) {
#pragma unroll
            for (int i = 0; i < 32; ++i) selbits |= ((i * 64 + lane) < nk ? 1u : 0u) << i;
        } else {
            unsigned u[32];
#pragma unroll
            for (int i = 0; i < 32; ++i) { const int key = i * 64 + lane; const float s = sc[key]; u[i] = (key < nk) ? fmap_u(s) : 0u; }
            selbits = topk_select(u, lane);
        }
#pragma unroll
        for (int i = 0; i < 32; ++i) { const unsigned long long bal = __ballot((selbits >> i) & 1u); if (lane == 0) MASK[(size_t)t * 32 + i] = bal; }
        LDS_FENCE();
    }
}


typedef float f32x16 __attribute__((ext_vector_type(16)));
__device__ __forceinline__ h16x8 relu_pk8(const f32x16& s, int base) {
    h16x8 r;
#pragma unroll
    for (int e = 0; e < 4; ++e) { h16x2 p = __builtin_bit_cast(h16x2, __builtin_amdgcn_cvt_pkrtz(s[base + 2 * e], s[base + 2 * e + 1])); p = __builtin_elementwise_max(p, (h16x2){(h16)0.f, (h16)0.f});
        r[2 * e] = p[0]; r[2 * e + 1] = p[1]; }
    return r;
}
#define P3_QG(u_) ((((u_) >> 4) & 16) ? (((u_) >> 4) ^ 15) : ((u_) >> 4))
__device__ __forceinline__ void p3_indexer(const Params& P, unsigned char* lds_, int blk, int nblk, int wv) {
    typedef __attribute__((address_space(3))) float lfloat;
    const int tid = my_tid(wv), wid = __builtin_amdgcn_readfirstlane(tid >> 6), lane = tid & 63;
    unsigned char* ws = opaque_ptr(P.ws);
    lfloat* sc = (lfloat*)lds_;
    const h16* QIDX = (const h16*)(ws + WS_QIDX); const h16* KIDXN = (const h16*)(ws + WS_KIDXN); const float* WIDX = (const float*)(ws + WS_WIDX);
    unsigned long long* MASK = (unsigned long long*)(ws + WS_MASK);
    h16x8 Afn[4][4]; f32x4 wn = (f32x4){0.f, 0.f, 0.f, 0.f};
    { const int r = lane & 31, h = lane >> 5; const int u0 = (blk < NB * (L / 16)) ? blk : 0; const int tt0 = (u0 & 15) * L + P3_QG(u0) * 16;
#pragma unroll
      for (int g = 0; g < 4; ++g)
#pragma unroll
          for (int s = 0; s < 4; ++s) Afn[g][s] = *(const h16x8*)(QIDX + (size_t)(tt0 + 4 * g + (r >> 3)) * 512 + (r & 7) * 64 + 16 * s + 8 * h);
      if (r < 16) wn = *(const f32x4*)(WIDX + (size_t)(tt0 + r) * 8 + 4 * h); }
    for (int unit = blk; unit < NB * (L / 16); unit += nblk) {
        const int b = unit & 15, qg = P3_QG(unit), p0 = qg * 16, t0 = b * L + p0, NT = (p0 + 15) / 32 + 1;
        int lane_o = lane; asm volatile("" : "+v"(lane_o));
        const int r = lane_o & 31, h = lane_o >> 5;
        h16x8 Af[4][4];
#pragma unroll
        for (int g = 0; g < 4; ++g)
#pragma unroll
            for (int s = 0; s < 4; ++s) Af[g][s] = Afn[g][s];
        h16x8 fragA;
        { const f32x4 w = wn;
          const h16 z = (h16)0.f;
          if (r & 1) { fragA[0] = z; fragA[1] = z; fragA[2] = z; fragA[3] = z; fragA[4] = (h16)w[0]; fragA[5] = (h16)w[1]; fragA[6] = (h16)w[2]; fragA[7] = (h16)w[3]; }
          else { fragA[0] = (h16)w[0]; fragA[1] = (h16)w[1]; fragA[2] = (h16)w[2]; fragA[3] = (h16)w[3]; fragA[4] = z; fragA[5] = z; fragA[6] = z; fragA[7] = z; } }
        const int code = (r < 16) ? (r >> 1) : -1;
        const h16* kbase = KIDXN + (size_t)b * L * 64 + (size_t)r * 64 + 8 * h;
        h16x8 Bf[4];
        if (wid < NT) {
#pragma unroll
            for (int s = 0; s < 4; ++s) Bf[s] = *(const h16x8*)(kbase + (size_t)wid * 32 * 64 + 16 * s);
        }
        for (int rep_ = 0; rep_ <= MK_P3_REPA; ++rep_) {
        if (rep_ > 0 && wid < NT) {
#pragma unroll
            for (int s = 0; s < 4; ++s) Bf[s] = *(const h16x8*)(kbase + (size_t)wid * 32 * 64 + 16 * s);
        }
        for (int kt = wid; kt < NT; kt += NWAVES) {
            h16x8 Bn[4];
            const int ktn = (kt + NWAVES < NT) ? kt + NWAVES : kt;
#pragma unroll
            for (int s = 0; s < 4; ++s) Bn[s] = *(const h16x8*)(kbase + (size_t)ktn * 32 * 64 + 16 * s);
            f32x16 C = {};
#pragma unroll
            for (int g = 0; g < 4; ++g) {
                f32x16 S = {};
#pragma unroll
                for (int s = 0; s < 4; ++s) S = __builtin_amdgcn_mfma_f32_32x32x16_f16(Af[g][s], Bf[s], S, 0, 0, 0);
                const h16x8 X0 = relu_pk8(S, 0), X1 = relu_pk8(S, 8);
                const h16x8 zero8 = (h16x8){0, 0, 0, 0, 0, 0, 0, 0};
                const h16x8 W0 = (code == 2 * g) ? fragA : zero8, W1 = (code == 2 * g + 1) ? fragA : zero8;
                C = __builtin_amdgcn_mfma_f32_32x32x16_f16(W0, X0, C, 0, 0, 0);
                C = __builtin_amdgcn_mfma_f32_32x32x16_f16(W1, X1, C, 0, 0, 0);
            }
            const int key = kt * 32 + r;
#pragma unroll
            for (int e = 0; e < 4; ++e) { sc[(e + 4 * h) * 2048 + key] = C[e]; sc[(8 + e + 4 * h) * 2048 + key] = C[4 + e]; }
#pragma unroll
            for (int s = 0; s < 4; ++s) Bf[s] = Bn[s];
        }
        }
        __syncthreads();
        { const int un = (unit + nblk < NB * (L / 16)) ? unit + nblk : unit; const int ttn = (un & 15) * L + P3_QG(un) * 16;
#pragma unroll
          for (int g = 0; g < 4; ++g)
#pragma unroll
              for (int s = 0; s < 4; ++s) Afn[g][s] = *(const h16x8*)(QIDX + (size_t)(ttn + 4 * g + (r >> 3)) * 512 + (r & 7) * 64 + 16 * s + 8 * h);
          if (r < 16) wn = *(const f32x4*)(WIDX + (size_t)(ttn + r) * 8 + 4 * h); }
#pragma unroll 1
        for (int qq_ = 0; qq_ < 2 * (1 + MK_P3_REPB); ++qq_) {
            const int qq = qq_ & 1;
            const int qi = 2 * wid + qq, pos = p0 + qi, nk = pos + 1, t = t0 + qi;
            unsigned selbits = 0u;
            if (nk <= 256) {
#pragma unroll
                for (int i = 0; i < 32; ++i) selbits |= ((i * 64 + lane) < nk ? 1u : 0u) << i;
            } else {
                float sv[32];
                const int full = nk >> 6;
                const unsigned valid = (full >= 32 ? 0xffffffffu : ((1u << full) - 1u)) | ((full < 32 && lane < (nk & 63)) ? (1u << full) : 0u);
#pragma unroll
                for (int i = 0; i < 32; ++i) { const float x = sc[qi * 2048 + i * 64 + lane]; sv[i] = ((valid >> i) & 1u) ? x : __builtin_nanf(""); }
                selbits = topk_select_fast(sv, valid, nk, lane, (const __attribute__((address_space(3))) float*)(sc + qi * 2048), (volatile __attribute__((address_space(3))) unsigned*)(sc + 16 * 2048 + wid * 448));
            }
            {
                __attribute__((address_space(3))) unsigned long long* stg = (__attribute__((address_space(3))) unsigned long long*)(sc + 16 * 2048 + wid * 448 + (qq ? 0 : 338));
                LDS_FENCE();
                if (lane < 32) { unsigned zz = 0u; asm volatile("" : "+v"(zz)); typedef unsigned u32x2_ __attribute__((ext_vector_type(2))); ((__attribute__((address_space(3))) u32x2_*)stg)[lane] = (u32x2_){zz, zz}; }
                const int fullq = nk >> 6;
#pragma unroll
                for (int i = 0; i < 32; ++i) if (i <= fullq) { const unsigned long long bal = __ballot((selbits >> i) & 1u); if (lane == 0) stg[i] = bal; }
            }
            (void)t;
        }
        __syncthreads();
        { const int q = tid & 15, tl = tid >> 4;
          MASK[((size_t)b * 32 + tl) * L + p0 + q] = ((__attribute__((address_space(3))) unsigned long long*)(sc + 16 * 2048 + (q >> 1) * 448 + ((q & 1) ? 0 : 338)))[tl]; }
    }
}

__device__ __forceinline__ void p4_attn_naive(const Params& P, unsigned char* lds, int blk, int nblk, int wv) {
    const int tid = my_tid(wv), wid = __builtin_amdgcn_readfirstlane(tid >> 6), lane = tid & 63;
    int* keys = (int*)lds; float* qf = (float*)(lds + 1024); float* pf = (float*)(lds + 1024 + 4096) + wid * 256; int* nselp = (int*)(lds + 1024 + 4096 + 8192);
    h16* QA = (h16*)(P.ws + WS_R1); const h16* Kb = (const h16*)(P.ws + WS_R2); const h16* Vb = (const h16*)(P.ws + WS_R3); const h16* SG = (const h16*)(P.ws + WS_R4);
    const unsigned long long* MASK = (const unsigned long long*)(P.ws + WS_MASK);
    for (int t = blk; t < T; t += nblk) {
        const int b = t >> 11;
        __syncthreads();
        if (tid < 128) { const h16x8 qv = *(const h16x8*)(QA + (size_t)t * 1024 + tid * 8);
#pragma unroll
            for (int e = 0; e < 8; ++e) qf[tid * 8 + e] = (float)qv[e]; }
        if (wid == 0) {
            unsigned long long m = (lane < 32) ? MASK[(size_t)t * 32 + lane] : 0ull;
            const int cnt = __popcll(m); int inc = cnt;
#pragma unroll
            for (int o = 1; o < 64; o <<= 1) { const int v = __shfl_up(inc, o); if (lane >= o) inc += v; }
            int off = inc - cnt;
            while (m) { const int k = __builtin_ctzll(m); keys[off++] = lane * 64 + k; m &= m - 1; }
            if (lane == 63) nselp[0] = inc;
        }
        __syncthreads();
        const int nsel = nselp[0], h = wid;
        float s[4];
#pragma unroll
        for (int c = 0; c < 4; ++c) {
            const int idx = lane + 64 * c; s[c] = -INFINITY;
            if (idx < nsel) {
                const h16x8* kp = (const h16x8*)(Kb + (size_t)(b * L + keys[idx]) * 1024 + h * 128); float a = 0.f;
#pragma unroll
                for (int cc = 0; cc < 16; ++cc) { const h16x8 kv = kp[cc];
#pragma unroll
                    for (int e = 0; e < 8; ++e) a = fmaf(qf[h * 128 + cc * 8 + e], (float)kv[e], a); }
                s[c] = a;
            }
        }
        const float mx = wave_max(fmaxf(fmaxf(s[0], s[1]), fmaxf(s[2], s[3])));
        float ls = 0.f;
#pragma unroll
        for (int c = 0; c < 4; ++c) { const int idx = lane + 64 * c; const float p = (idx < nsel) ? exp2f(s[c] - mx) : 0.f; pf[idx] = p; ls += p; }
        ls = wave_sum(ls);
        LDS_FENCE();
        float o0 = 0.f, o1 = 0.f;
        for (int k = 0; k < nsel; ++k) {
            const h16x2 v = *(const h16x2*)(Vb + (size_t)(b * L + keys[k]) * 1024 + h * 128 + 2 * lane); const float pk = pf[k];
            o0 = fmaf(pk, (float)v[0], o0); o1 = fmaf(pk, (float)v[1], o1);
        }
        const float inv = 1.0f / ls;
        const h16x2 g = *(const h16x2*)(SG + (size_t)t * 1024 + h * 128 + 2 * lane);
        h16x2 o; o[0] = (h16)(o0 * inv * (float)g[0]); o[1] = (h16)(o1 * inv * (float)g[1]);
        *(h16x2*)(QA + (size_t)t * 1024 + h * 128 + 2 * lane) = o;
    }
}


namespace att {
typedef unsigned short bf16;
typedef short bf16x8 __attribute__((ext_vector_type(8)));
typedef short s16x4 __attribute__((ext_vector_type(4)));
typedef float f32x16 __attribute__((ext_vector_type(16)));
typedef __attribute__((address_space(3))) char lchar;
typedef __attribute__((address_space(3))) float lfloat;
typedef __attribute__((address_space(3))) bf16x8 lbf16x8;
constexpr int D = 128, PITCH = 1024, NW = 8, QBLK = 32, KVBLK = 64, QB = NW * QBLK;
constexpr int SHM_V = KVBLK * D * 2, SHM_K = KVBLK * D * 2;
constexpr int LDS_ATT = 2 * SHM_V + 2 * SHM_K + NW * 64 * 4;
constexpr float THR = 8.f;
#define KSWZ(row, colB) ((row) * 256 + ((colB) ^ (((row) & 7) << 4)))
#define SBAR() __builtin_amdgcn_sched_barrier(0)
__device__ __forceinline__ int v_st(int k, int c) { const int kk = (k & ~0xC) | ((k & 4) << 1) | ((k & 8) >> 1); return ((kk >> 3) * 4 + (c >> 5)) * 512 + ((kk & 7) * 32 + (c & 31)) * 2; }
__device__ __forceinline__ int v_rd_base(int lane) { return ((lane & 3) << 3) | (((lane >> 2) & 3) << 6) | (((lane >> 4) & 1) << 5) | (((lane >> 5) & 1) << 8); }
constexpr int v_rd_off(int d0, int ks, int half) { return d0 * 512 + ks * 4096 + half * 2048; }
__device__ __forceinline__ int crow(int r, int hi) { return (r & 3) + 8 * (r >> 2) + 4 * hi; }
__device__ __forceinline__ bf16x8 load8(const bf16* p) { return *reinterpret_cast<const bf16x8*>(p); }
__device__ __forceinline__ void mask_init(f32x16& p0, f32x16& p1, unsigned long long mk, int hi) {
    const unsigned lo = (unsigned)mk >> (4 * hi), hh = (unsigned)(mk >> 32) >> (4 * hi);
#pragma unroll
    for (int r = 0; r < 16; ++r) {
        const int c = (r & 3) + 8 * (r >> 2);
        const int t0 = __builtin_amdgcn_sbfe(lo, c, 1), t1 = __builtin_amdgcn_sbfe(hh, c, 1);
        p0[r] = __uint_as_float(~(unsigned)t0 & 0xff800000u); p1[r] = __uint_as_float(~(unsigned)t1 & 0xff800000u);
    }
}
__device__ __forceinline__ void partialSM(f32x16& p0, f32x16& p1, float& m_reg, float& mn, float& alpha) {
    float pmax = p0[0]; for (int r = 1; r < 16; ++r) pmax = fmaxf(pmax, p0[r]); for (int r = 0; r < 16; ++r) pmax = fmaxf(pmax, p1[r]);
    { auto rr = __builtin_amdgcn_permlane32_swap(__float_as_uint(pmax), __float_as_uint(pmax), false, false);
      pmax = fmaxf(__uint_as_float(rr[0]), __uint_as_float(rr[1])); }
    if (__builtin_expect(__all((pmax - m_reg) <= THR), 1)) { mn = m_reg; alpha = 1.f; }
    else { mn = fmaxf(m_reg, pmax); alpha = __builtin_amdgcn_exp2f(m_reg - mn); m_reg = mn; }
    for (int r = 0; r < 16; ++r) p0[r] = p0[r] - mn; for (int r = 0; r < 16; ++r) p1[r] = p1[r] - mn;
    for (int r = 0; r < 16; ++r) p0[r] = __builtin_amdgcn_exp2f(p0[r]);
}
__device__ __forceinline__ void finishSM(f32x16& p0, f32x16& p1, float alpha, float& l_reg, bf16x8& pa0, bf16x8& pa1, bf16x8& pa2, bf16x8& pa3) {
    for (int r = 0; r < 16; ++r) p1[r] = __builtin_amdgcn_exp2f(p1[r]);
    float ps = 0; for (int r = 0; r < 16; ++r) ps += p0[r]; for (int r = 0; r < 16; ++r) ps += p1[r];
    { auto rr = __builtin_amdgcn_permlane32_swap(__float_as_uint(ps), __float_as_uint(ps), false, false);
      ps = __uint_as_float(rr[0]) + __uint_as_float(rr[1]); }
    l_reg = l_reg * alpha + ps;
#define PK4(P, B_, OUT) do { unsigned a0 = cvtpk_bf16(P[B_+0], P[B_+1]), a1 = cvtpk_bf16(P[B_+2], P[B_+3]);                          \
        unsigned b0 = cvtpk_bf16(P[B_+4], P[B_+5]), b1 = cvtpk_bf16(P[B_+6], P[B_+7]);                                             \
        auto r0 = __builtin_amdgcn_permlane32_swap(a0, b0, false, false); auto r1 = __builtin_amdgcn_permlane32_swap(a1, b1, false, false); \
        u32x4 w = {r0[0], r1[0], r0[1], r1[1]}; OUT = *reinterpret_cast<bf16x8*>(&w); } while (0)
    PK4(p0, 0, pa0); PK4(p0, 8, pa1); PK4(p1, 0, pa2); PK4(p1, 8, pa3);
#undef PK4
}
template <int KB>
__device__ __forceinline__ void qkt(f32x16& p0, f32x16& p1, const lchar* K_lds, int r32, int hi, const bf16x8* qr) {
    const lchar* kb[4];
#pragma unroll
    for (int dd = 0; dd < 4; ++dd) kb[dd] = K_lds + KB * SHM_K + KSWZ(r32, (dd * 16 + hi * 8) * 2);
#pragma unroll
    for (int d0 = 0; d0 < 8; ++d0) { const lchar* a = kb[d0 & 3] + (d0 >> 2) * 128;
        bf16x8 b0 = *(const lbf16x8*)(a);
        bf16x8 b1 = *(const lbf16x8*)(a + 32 * 256);
        p0 = __builtin_amdgcn_mfma_f32_32x32x16_bf16(b0, qr[d0], p0, 0, 0, 0);
        p1 = __builtin_amdgcn_mfma_f32_32x32x16_bf16(b1, qr[d0], p1, 0, 0, 0); }
}
template <int VB>
__device__ __forceinline__ void pv_tile(f32x16* o, int vb0, bf16x8 pa0, bf16x8 pa1, bf16x8 pa2, bf16x8 pa3) {
#define TRRD(dst, off) asm volatile("ds_read_b64_tr_b16 %0, %1 offset:%2" : "=&v"(dst) : "v"(vb0), "i"(off) : "memory")
#define PV_D0(d0) do { s16x4 l0, l1, l2, l3, h0, h1, h2, h3; constexpr int b_ = VB * SHM_V + v_rd_off(d0, 0, 0); \
        TRRD(l0, b_); TRRD(h0, b_ + 2048); TRRD(l1, b_ + 4096); TRRD(h1, b_ + 6144); TRRD(l2, b_ + 8192); TRRD(h2, b_ + 10240); TRRD(l3, b_ + 12288); TRRD(h3, b_ + 14336); \
        asm volatile("s_waitcnt lgkmcnt(0)" ::: "memory"); SBAR();   \
        o[d0] = __builtin_amdgcn_mfma_f32_32x32x16_bf16(pa0, (bf16x8){l0[0], l0[1], l0[2], l0[3], h0[0], h0[1], h0[2], h0[3]}, o[d0], 0, 0, 0);   \
        o[d0] = __builtin_amdgcn_mfma_f32_32x32x16_bf16(pa1, (bf16x8){l1[0], l1[1], l1[2], l1[3], h1[0], h1[1], h1[2], h1[3]}, o[d0], 0, 0, 0);   \
        o[d0] = __builtin_amdgcn_mfma_f32_32x32x16_bf16(pa2, (bf16x8){l2[0], l2[1], l2[2], l2[3], h2[0], h2[1], h2[2], h2[3]}, o[d0], 0, 0, 0);   \
        o[d0] = __builtin_amdgcn_mfma_f32_32x32x16_bf16(pa3, (bf16x8){l3[0], l3[1], l3[2], l3[3], h3[0], h3[1], h3[2], h3[3]}, o[d0], 0, 0, 0); } while (0)
    PV_D0(0); PV_D0(1); PV_D0(2); PV_D0(3);
#undef PV_D0
#undef TRRD
}
struct BlockRef { const bf16* Q; const bf16* K; const bf16* V; h16* O; const unsigned long long* M; const h16* G; int P0; };
struct Seam { bf16x8 qr[8]; bf16x8 st_v0, st_v1, st_k0, st_k1; };
#define VMW() asm volatile("s_waitcnt vmcnt(0)" ::: "memory")
#define VMWN(n) asm volatile("s_waitcnt vmcnt(%0)" :: "i"(n) : "memory")
#define SLOAD_H(Kp, Vp, k0) do { const unsigned o0_ = ro0 + (unsigned)(k0) * PITCH, o1_ = o0_ + 32u * PITCH;     \
                         S.st_v0 = load8((Vp) + o0_); S.st_v1 = load8((Vp) + o1_); S.st_k0 = load8((Kp) + o0_); S.st_k1 = load8((Kp) + o1_); } while (0)
#define SWRITE_HK(bf) do { *(lbf16x8*)(K_lds + (bf) * SHM_K + kws) = S.st_k0; *(lbf16x8*)(K_lds + (bf) * SHM_K + kws + 32 * 256) = S.st_k1; } while (0)
#define SWRITE_HV(bf) do { *(lbf16x8*)(V_lds + (bf) * SHM_V + vst0) = S.st_v0; *(lbf16x8*)(V_lds + (bf) * SHM_V + vst1) = S.st_v1; } while (0)
#define SWRITE_H(bf) do { SWRITE_HV(bf); SWRITE_HK(bf); } while (0)
__device__ __forceinline__ void prime(const BlockRef& cur, lchar* lds, Seam& S, int wv) {
    const int tid = my_tid(wv);
    const int wid = __builtin_amdgcn_readfirstlane(tid >> 6), lane = tid & 63, r32 = lane & 31, hi = lane >> 5;
    const int sr = tid >> 4, sc = (tid & 15) * 8, kws = KSWZ(sr, sc * 2); lchar* K_lds = lds + 2 * SHM_V;
    const unsigned ro0 = (unsigned)(sr * PITCH + sc), qo = (unsigned)((wid * QBLK + r32) * PITCH + hi * 8);
    for (int d0 = 0; d0 < 8; ++d0) S.qr[d0] = load8(cur.Q + (qo + (unsigned)(d0 * 16)));
    SLOAD_H(cur.K, cur.V, 0); VMW(); SWRITE_HK(0);
    __syncthreads();
}
__device__ __forceinline__ void block(const BlockRef& cur, const BlockRef& nxt, lchar* lds, Seam& S, int wv) {
    const int tid = my_tid(wv);
    const int wid = __builtin_amdgcn_readfirstlane(tid >> 6), lane = tid & 63, r32 = lane & 31, hi = lane >> 5;
    const int NT = (cur.P0 + QB - 1) / KVBLK + 1;
    lchar* V_lds = lds; lchar* K_lds = lds + 2 * SHM_V;
    lfloat* ws = (lfloat*)(lds + 2 * SHM_V + 2 * SHM_K) + wid * 64; lfloat* li_l = ws, * al_l = ws + 32;
    float m_reg = -1e30f, l_reg = 0; f32x16 o[4] = {};
    const int sr = tid >> 4, sc = (tid & 15) * 8, vst0 = v_st(sr, sc), vst1 = v_st(32 + sr, sc), kws = KSWZ(sr, sc * 2);
    const int vb0 = (int)(unsigned)(uintptr_t)V_lds + v_rd_base(lane);
    const unsigned ro0 = (unsigned)(sr * PITCH + sc), qo = (unsigned)((wid * QBLK + r32) * PITCH + hi * 8);
    const bf16* Kh = cur.K; const bf16* Vh = cur.V;
    const unsigned mro = (unsigned)(wid * QBLK + r32) * 8u;
#define LDMASK(tile) (*(const unsigned long long*)((const char*)cur.M + (mro + (unsigned)(tile) * (unsigned)(L * 8))))
    unsigned long long mk;
#define RESC(a) do { if (__any((a) < 1.f)) { if (hi == 0) al_l[r32] = (a); asm volatile("s_waitcnt lgkmcnt(0)" ::: "memory");              \
                     for (int d_ = 0; d_ < 4; ++d_) for (int r = 0; r < 16; ++r) o[d_][r] *= al_l[crow(r, hi)]; } } while (0)
#define KBASE(t) ((t) * KVBLK)
    constexpr int NQL = 8;
#define SEAM_K0() do { VMWN(NQL); SWRITE_HK(0); SBAR(); } while (0)
    f32x16 pA0, pA1, pB0, pB1; float mnA, mnB, alA, alB; bf16x8 pa0, pa1, pa2, pa3;
    SWRITE_HV(0); SBAR();
    mk = LDMASK(0);
    if (NT > 1) { SLOAD_H(Kh, Vh, KBASE(1)); }
    mask_init(pA0, pA1, mk, hi); if (NT > 1) mk = LDMASK(1);
    SBAR(); qkt<0>(pA0, pA1, K_lds, r32, hi, S.qr);
    partialSM(pA0, pA1, m_reg, mnA, alA);
    if (NT > 1) { VMW(); SWRITE_H(1); }
    __syncthreads();
#define HALF_STEP(PX0, PX1, mnX, alX, PY0, PY1, alY, t, KB, VB, SB) do {                                                      \
        mask_init(PX0, PX1, mk, hi);                                       \
        SBAR(); qkt<KB>(PX0, PX1, K_lds, r32, hi, S.qr);                                                                      \
        if ((t) + 1 < NT) mk = LDMASK((t) + 1);                                                              \
        finishSM(PY0, PY1, alY, l_reg, pa0, pa1, pa2, pa3); SBAR();                                                           \
        if ((t) + 1 < NT) { SLOAD_H(Kh, Vh, KBASE((t) + 1)); SBAR(); }                                                        \
        pv_tile<VB>(o, vb0, pa0, pa1, pa2, pa3); partialSM(PX0, PX1, m_reg, mnX, alX);                                        \
        __syncthreads();                                                                                                      \
        if ((t) + 1 < NT) { VMW(); SWRITE_H(SB); }                                                                            \
        RESC(alX); __syncthreads(); } while (0)
    for (int t = 1; t + 1 < NT; t += 2) {
        HALF_STEP(pB0, pB1, mnB, alB, pA0, pA1, alA, t, 1, 0, 0);
        HALF_STEP(pA0, pA1, mnA, alA, pB0, pB1, alB, t + 1, 0, 1, 1);
    }
    const bool even = (NT & 1) == 0;
    if (even) { mask_init(pB0, pB1, mk, hi); SBAR(); qkt<1>(pB0, pB1, K_lds, r32, hi, S.qr); SBAR(); }
    SLOAD_H(nxt.K, nxt.V, 0); SBAR();
#pragma unroll
    for (int d0 = 0; d0 < 8; ++d0) S.qr[d0] = load8(nxt.Q + (qo + (unsigned)(d0 * 16)));
    SBAR();
    finishSM(pA0, pA1, alA, l_reg, pa0, pa1, pa2, pa3); SBAR();
    pv_tile<0>(o, vb0, pa0, pa1, pa2, pa3);
    if (even) { partialSM(pB0, pB1, m_reg, mnB, alB); __syncthreads(); RESC(alB);
        finishSM(pB0, pB1, alB, l_reg, pa0, pa1, pa2, pa3); SBAR(); pv_tile<1>(o, vb0, pa0, pa1, pa2, pa3); }
    SBAR(); SEAM_K0();
    if (hi == 0) li_l[r32] = l_reg; asm volatile("s_waitcnt lgkmcnt(0)" ::: "memory");
    float rli[16];
#pragma unroll
    for (int r = 0; r < 16; ++r) rli[r] = __builtin_amdgcn_rcpf(li_l[crow(r, hi)]);
    __syncthreads();
    {
        typedef __attribute__((address_space(3))) h16 lh16; typedef __attribute__((address_space(3))) h16x8 lh16x8_;
        lchar* ob = V_lds + wid * 4096;
#pragma unroll
        for (int half = 0; half < 2; ++half) {
#pragma unroll
            for (int r = 0; r < 16; ++r) { const int orow = crow(r, hi);
#pragma unroll
                for (int dd = 0; dd < 2; ++dd) *(lh16*)(ob + orow * 128 + (dd * 32 + r32) * 2) = (h16)(o[half * 2 + dd][r] * rli[r]); }
            asm volatile("s_waitcnt lgkmcnt(0)" ::: "memory");
#pragma unroll
            for (int i = 0; i < 4; ++i) { const int c = lane + 64 * i, row = c >> 3, c8 = c & 7;
                const h16x8 ov = *(const lh16x8_*)(ob + row * 128 + c8 * 16);
                const unsigned oo = (unsigned)((wid * QBLK + row) * PITCH + half * 64 + c8 * 8);
                const h16x8 gv = *(const h16x8*)(cur.G + oo);
                *(h16x8*)(cur.O + oo) = ov * gv; }
            asm volatile("s_waitcnt lgkmcnt(0)" ::: "memory");
        }
    }
    __syncthreads();
#undef LDMASK
#undef RESC
#undef KBASE
#undef SEAM_K0
#undef HALF_STEP
}
#undef VMW
#undef VMWN
#undef SLOAD_H
#undef SWRITE_HK
#undef SWRITE_HV
#undef SWRITE_H
#undef KSWZ
#undef SBAR
}

__device__ __forceinline__ att::BlockRef att_ref(const Params& P, unsigned char* ws, int item, int pass) {
    const int xcd = item & 7, kq = item >> 3, bh = (kq >> 2) * 8 + xcd, x = kq & 3, qb = pass ? 7 - x : x, b = bh >> 3, h = bh & 7;
    const size_t row0 = (size_t)b * L + (size_t)qb * 256;
    att::BlockRef r;
    r.Q = (const att::bf16*)(ws + WS_R1) + row0 * 1024 + h * 128; r.O = (h16*)(ws + WS_AO) + row0 * 1024 + h * 128;
    r.K = (const att::bf16*)(ws + WS_R2) + (size_t)b * L * 1024 + h * 128; r.V = (const att::bf16*)(ws + WS_R3) + (size_t)b * L * 1024 + h * 128;
    r.M = (const unsigned long long*)(ws + WS_MASK) + (size_t)b * 32 * L + (size_t)qb * 256;
    r.G = (const h16*)(ws + WS_R4) + row0 * 1024 + h * 128; r.P0 = qb * 256;
    return r;
}
__device__ __forceinline__ void p4_attn(const Params& P, unsigned char* lds, int blk, int nblk, int wv) {
    unsigned char* ws = opaque_ptr(P.ws);
    const int total = NB * 8 * 4;
    int it = blk; if (it >= total) return;
    int pass = 0;
    att::BlockRef cur = att_ref(P, ws, it, 0);
    att::Seam S;
    att::prime(cur, (att::lchar*)lds, S, wv);
    for (;;) {
        const bool more_pass = pass == 0, more_item = it + nblk < total, last = !more_pass && !more_item;
        int itn = it, passn = pass + 1;
        if (!more_pass) { passn = 0; itn = more_item ? it + nblk : it; }
        const att::BlockRef nxt = last ? cur : att_ref(P, ws, itn, passn);
        att::block(cur, nxt, (att::lchar*)lds, S, wv);
        if (last) break;
        cur = nxt; it = itn; pass = passn;
    }
}

__device__ __forceinline__ void p8_ret_naive(const Params& P, unsigned char* lds, int blk, int nblk, int wv) {
    const int tid = my_tid(wv);
    float* qk = (float*)lds;
    const h16* RQ = (const h16*)(P.ws + WS_R1); const h16* RK = (const h16*)(P.ws + WS_R2); h16* RV = (h16*)(P.ws + WS_R4);
    const int j = tid >> 2, iq = tid & 3;
    for (int it = blk; it < 256; it += nblk) {
        const int b = it >> 4, h = (it >> 2) & 3, sl = it & 3;
        const float gamma = 1.0f - exp2f(-5.0f - (float)h);
        float S[64];
#pragma unroll
        for (int i = 0; i < 64; ++i) S[i] = 0.f;
        const int col = tid & 255;
        const h16* src = (tid < 256 ? RQ : RK) + (size_t)b * L * 1024 + h * 256 + col;
        float* dst = qk + (tid >> 8) * 272 + (col >> 6) * 68 + (col & 63);
        h16* vp = RV + (size_t)b * L * 2048 + h * 512 + sl * 128 + j;
        for (int t0 = 0; t0 < L; t0 += 16) {
            __syncthreads();
            h16 vv[16];
#pragma unroll
            for (int tt = 0; tt < 16; ++tt) { dst[tt * 544] = (float)src[(size_t)(t0 + tt) * 1024]; vv[tt] = vp[(size_t)(t0 + tt) * 2048]; }
            __syncthreads();
#pragma unroll
            for (int tt = 0; tt < 16; ++tt) {
                const f32x4* qp = (const f32x4*)(qk + tt * 544 + iq * 68); const f32x4* kp = (const f32x4*)(qk + tt * 544 + 272 + iq * 68);
                const float v = (float)vv[tt]; float o = 0.f;
#pragma unroll
                for (int i4 = 0; i4 < 16; ++i4) { const f32x4 q4 = qp[i4], k4 = kp[i4];
#pragma unroll
                    for (int e = 0; e < 4; ++e) { S[i4 * 4 + e] = fmaf(gamma, S[i4 * 4 + e], k4[e] * v); o = fmaf(q4[e], S[i4 * 4 + e], o); } }
                o += __shfl_xor(o, 1); o += __shfl_xor(o, 2);
                if (iq == 0) vp[(size_t)(t0 + tt) * 2048] = (h16)o;
            }
        }
    }
}


namespace ret {
typedef __attribute__((address_space(3))) unsigned char lch;
typedef __attribute__((address_space(3))) h16x8 lh16x8;
typedef __attribute__((address_space(3))) h16x4 lh16x4;
typedef __attribute__((address_space(3))) u32x4 lu32x4;
typedef short v4i16 __attribute__((ext_vector_type(4)));
typedef __attribute__((address_space(3))) v4i16 lv4i16;
constexpr int SKB = 544, SVB = 288, SSB = 544;
constexpr int OFF_K = 0, OFF_V = 64 * SKB, OFF_S = OFF_V + 64 * SVB, LDS_RET = OFF_S + 128 * SSB;
__device__ __forceinline__ h16x4 trrd(const lch* p) { return __builtin_bit_cast(h16x4, __builtin_amdgcn_ds_read_tr16_b64_v4i16((lv4i16*)p)); }
__device__ __forceinline__ h16x8 cat8(h16x4 a, h16x4 b) { return __builtin_shufflevector(a, b, 0, 1, 2, 3, 4, 5, 6, 7); }
}
#define P8_GATE(m_, ro_) do { const char* gp_ = (const char*)(RG + ((size_t)b * L + (size_t)(m_) * 64) * 2048 + h * 512 + sl * 128) + (ro_); gt0 = *(const h16x8*)gp_; gt1 = *(const h16x8*)(gp_ + 16); } while (0)
#define P8_XSLD(m_, rw_) do { _Pragma("unroll") for (int s_ = 0; s_ < 4; ++s_) xsv[s_] = __hip_atomic_load((const unsigned long long*)((const char*)(XS + (size_t)(grp0 + (m_)) * 256) + (unsigned)(s_ * 512 + (rw_) * 8)), __ATOMIC_RELAXED, __HIP_MEMORY_SCOPE_AGENT); } while (0)
#define P8_XSOK() (((unsigned)xsv[0] != 0xffffffffu) && ((unsigned)xsv[1] != 0xffffffffu) && ((unsigned)xsv[2] != 0xffffffffu) && ((unsigned)xsv[3] != 0xffffffffu))
#define P8_WAIT(m_, rw_) do { unsigned sp_ = 0u; while (!__all(P8_XSOK())) { __builtin_amdgcn_s_sleep(1); P8_XSLD(m_, rw_); \
        if (++sp_ > (1u << 20)) { if (lane == 0) __hip_atomic_store((unsigned*)(ws + WS_BAR) + XB_TMO_W, 1u, __ATOMIC_RELAXED, __HIP_MEMORY_SCOPE_AGENT); break; } } } while (0)
#define P8_STATS(m_) do { P8_WAIT(m_, lO0); float S1_ = 0.f, S2_ = 0.f;   \
        _Pragma("unroll") for (int s_ = 0; s_ < 4; ++s_) { S1_ += __uint_as_float((unsigned)xsv[s_]); S2_ += __uint_as_float((unsigned)(xsv[s_] >> 32)); } \
        const float mu_ = S1_ * (1.0f / 512.0f); const float var_ = fmaxf(S2_ * (1.0f / 512.0f) - mu_ * mu_, 0.f); const float rs_ = rsqrtf(var_ + EPS); MR[lO0] = (f32x2){rs_, -mu_ * rs_}; } while (0)
#define P8_FINAL(m_, rw_, ro_, lo_) do { const int mm_ = (m_); const f32x2 mr_ = MR[rw_]; const float rs_ = mr_[0], nb_ = mr_[1]; \
        const lch* op_ = OT + (mm_ & 1) * OT_BYTES + (lo_); const h16x8 o0_ = *(const lh16x8*)op_, o1_ = *(const lh16x8*)(op_ + 16); h16x8 y0_, y1_; \
        _Pragma("unroll") for (int e = 0; e < 8; ++e) { y0_[e] = (h16)(fmaf((float)o0_[e], rs_, nb_) * (float)gt0[e]); y1_[e] = (h16)(fmaf((float)o1_[e], rs_, nb_) * (float)gt1[e]); } \
        char* dp_ = (char*)(vg + (size_t)mm_ * 64 * 2048) + (ro_); *(h16x8*)dp_ = y0_; *(h16x8*)(dp_ + 16) = y1_; } while (0)
#define XB_TMO_W 128
__device__ __forceinline__ void p8_retention(const Params& P, unsigned char* lds_, int blk, int nblk, int wv) {
    using namespace ret;
    const int tid = my_tid(wv), wid = __builtin_amdgcn_readfirstlane(tid >> 6), lane = tid & 63, c16 = lane & 15, g = lane >> 4, q4 = c16 >> 2, p4 = c16 & 3;
    const int dh = wid >> 2, it = dh ? 3 - (wid & 3) : (wid & 3);
    unsigned char* ws = opaque_ptr(P.ws);
    lch* Kc = (lch*)lds_ + OFF_K; lch* Vc = (lch*)lds_ + OFF_V; lch* St = (lch*)lds_ + OFF_S;
    const h16* RQ = (const h16*)(ws + WS_R1); const h16* RK = (const h16*)(ws + WS_R2); h16* RV = (h16*)(ws + WS_R4);
    const bool fusedgn = (nblk == 256);
    const h16* RG = (const h16*)(ws + WS_RG);
    unsigned long long* XS = (unsigned long long*)(ws + WS_KIDXN);
    typedef __attribute__((address_space(3))) f32x2 lf32x2;
    lf32x2* PS = (lf32x2*)((lch*)lds_ + LDS_RET);
    for (int item = blk; item < 256; item += nblk) {
        const int b = item >> 4, h = (item >> 2) & 3, sl = item & 3;
        const int grp0 = (b * 4 + h) * 32;
        constexpr int OT_PITCH = 272, OT_BYTES = 64 * OT_PITCH;
        lch* OT = (lch*)lds_ + LDS_RET + 1024;
        lf32x2* MR = (lf32x2*)(OT + 2 * OT_BYTES);
        typedef __attribute__((address_space(3))) float lfl_; typedef __attribute__((address_space(3))) h16 lh16_;
        lfl_* FT = (lfl_*)(OT + 2 * OT_BYTES + 512);
        lh16_* ZT = (lh16_*)(OT + 2 * OT_BYTES + 512 + 256);
        h16x8 gt0 = (h16x8){0, 0, 0, 0, 0, 0, 0, 0}, gt1 = gt0;
        const float lgam = log2f(1.0f - exp2f(-5.0f - (float)h));
        const float gamma64 = exp2f(64.0f * lgam);
        f32x4 state[16];
#pragma unroll
        for (int d = 0; d < 16; ++d) state[d] = (f32x4){0.f, 0.f, 0.f, 0.f};
        __syncthreads();
        { unsigned zz = 0u; asm volatile("" : "+v"(zz));
          for (int i = my_tid(wv); i < 128 * SSB / 16; i += NTHREADS) ((lu32x4*)St)[i] = (u32x4){zz, zz, zz, zz}; }
        const h16* kg = RK + (size_t)b * L * 1024 + h * 256; const h16* vg = RV + (size_t)b * L * 2048 + h * 512 + sl * 128;
        h16x8 kreg[4], vreg[2];
        const unsigned qoff = (unsigned)((16 * it + c16) * 1024 + 8 * g) * 2u, ooff = (unsigned)((16 * it + c16) * 2048 + 64 * dh + 4 * g) * 2u;
        unsigned ko[4], vo[2];
#pragma unroll
        for (int i = 0; i < 4; ++i) { const int c = tid + NTHREADS * i; ko[i] = (unsigned)((c >> 5) * 1024 + (c & 31) * 8) * 2u; }
#pragma unroll
        for (int i = 0; i < 2; ++i) { const int c = tid + NTHREADS * i; vo[i] = (unsigned)((c >> 4) * 2048 + (c & 15) * 8) * 2u; }
#pragma unroll
        for (int i = 0; i < 4; ++i) kreg[i] = *(const h16x8*)((const char*)kg + ko[i]);
#pragma unroll
        for (int i = 0; i < 2; ++i) vreg[i] = *(const h16x8*)((const char*)vg + vo[i]);
#pragma unroll
        for (int i = 0; i < 4; ++i) { const int c = tid + NTHREADS * i; *(lh16x8*)(Kc + (c >> 5) * SKB + (c & 31) * 16) = kreg[i]; }
#pragma unroll
        for (int i = 0; i < 2; ++i) { const int c = tid + NTHREADS * i; *(lh16x8*)(Vc + (c >> 4) * SVB + (c & 15) * 16) = vreg[i]; }
        h16x8 Qn[8];
#pragma unroll
        for (int s = 0; s < 8; ++s) Qn[s] = *(const h16x8*)((const char*)(RQ + (size_t)b * L * 1024 + h * 256) + (qoff + (unsigned)(64 * s)));
        { const int tt_ = my_tid(wv); if (tt_ < 64) { FT[tt_] = __builtin_amdgcn_exp2f((float)tt_ * lgam); ZT[tt_] = (h16)__builtin_amdgcn_exp2f((float)(63 - tt_) * lgam); } }
        __syncthreads();
        for (int n = 0; n < L / 64; ++n) {
            const size_t row0 = (size_t)b * L + (size_t)n * 64;
            const int nn = (n + 1 < L / 64) ? n + 1 : n;
            unsigned kO[4] = {ko[0], ko[1], ko[2], ko[3]}, vO[2] = {vo[0], vo[1]}, qO = qoff, oO = ooff;
            asm volatile("" : "+v"(kO[0]), "+v"(kO[1]), "+v"(kO[2]), "+v"(kO[3]), "+v"(vO[0]), "+v"(vO[1]), "+v"(qO), "+v"(oO));
            int gO = g, cO = c16; asm volatile("" : "+v"(gO), "+v"(cO)); const int q4O = cO >> 2, p4O = cO & 3;
            float lg = lgam; asm volatile("" : "+v"(lg));
            const float xi = __builtin_amdgcn_exp2f((float)(16 * it + cO + 1) * lg);
            h16x8 (&Qf)[8] = Qn;
            unsigned long long xsv[4] = {0ull, 0ull, 0ull, 0ull};
#pragma unroll
            for (int i = 0; i < 4; ++i) kreg[i] = *(const h16x8*)((const char*)(kg + (size_t)nn * 64 * 1024) + kO[i]);
#pragma unroll
            for (int i = 0; i < 2; ++i) vreg[i] = *(const h16x8*)((const char*)(vg + (size_t)nn * 64 * 2048) + vO[i]);
            h16x8 Pf[2];
#pragma unroll
            for (int ks = 0; ks < 2; ++ks)
#pragma unroll
                for (int e = 0; e < 8; ++e) Pf[ks][e] = (h16)0.f;
#pragma unroll
            for (int jt = 0; jt < 4; ++jt) {
                if (jt <= it) {
                    f32x4 S = (f32x4){0.f, 0.f, 0.f, 0.f}, Sb = S;
#pragma unroll
                    for (int s4 = 0; s4 < 8; s4 += 4) {
                        h16x8 A4[4];
#pragma unroll
                        for (int s = 0; s < 4; ++s) A4[s] = *(const lh16x8*)(Kc + (16 * jt + c16) * SKB + (32 * (s4 + s) + 8 * g) * 2);
                        __builtin_amdgcn_sched_barrier(0);
#pragma unroll
                        for (int s = 0; s < 4; s += 2) { S = __builtin_amdgcn_mfma_f32_16x16x32_f16(A4[s], Qf[s4 + s], S, 0, 0, 0); Sb = __builtin_amdgcn_mfma_f32_16x16x32_f16(A4[s + 1], Qf[s4 + s + 1], Sb, 0, 0, 0); }
                        __builtin_amdgcn_sched_barrier(0);
                    }
                    S = S + Sb;
#pragma unroll
                    for (int e = 0; e < 4; ++e) { const int d = (16 * it + cO) - (16 * jt + 4 * gO + e); const float f = (d >= 0) ? FT[d > 0 ? d : 0] : 0.f; Pf[jt >> 1][(jt & 1) * 4 + e] = (h16)(S[e] * f); }
                }
            }
            int lO0 = lane; asm volatile("" : "+v"(lO0));
            f32x4 acc[4];
#pragma unroll
            for (int dt = 0; dt < 4; ++dt) acc[dt] = (f32x4){0.f, 0.f, 0.f, 0.f};
            {
#define P8_LDA(dst, s_) do { _Pragma("unroll") for (int dt = 0; dt < 4; ++dt) dst[dt] = *(const lh16x8*)(St + (16 * (4 * dh + dt) + c16) * SSB + (32 * (s_) + 8 * g) * 2); } while (0)
#define P8_MMA(src, s_) do { _Pragma("unroll") for (int dt = 0; dt < 4; ++dt) acc[dt] = __builtin_amdgcn_mfma_f32_16x16x32_f16(src[dt], Qf[s_], acc[dt], 0, 0, 0); } while (0)
                h16x8 Aa[4], Ab[4];
                P8_LDA(Aa, 0); __builtin_amdgcn_sched_barrier(0);
#pragma unroll
                for (int s2 = 0; s2 < 8; s2 += 2) {
                    P8_LDA(Ab, s2 + 1); __builtin_amdgcn_sched_barrier(0); P8_MMA(Aa, s2); __builtin_amdgcn_sched_barrier(0);
                    if (s2 + 2 < 8) { P8_LDA(Aa, s2 + 2); } __builtin_amdgcn_sched_barrier(0); P8_MMA(Ab, s2 + 1); __builtin_amdgcn_sched_barrier(0);
                }
#undef P8_LDA
#undef P8_MMA
            }
#pragma unroll
            for (int dt = 0; dt < 4; ++dt) acc[dt] = acc[dt] * xi;
#pragma unroll
            for (int ks = 0; ks < 2; ++ks) {
                if (2 * ks <= it) {
                    h16x8 A4[4];
#pragma unroll
                    for (int dt = 0; dt < 4; ++dt) { const lch* vp = Vc + (32 * ks + 4 * gO + q4O) * SVB + (16 * (4 * dh + dt) + 4 * p4O) * 2; A4[dt] = cat8(trrd(vp), trrd(vp + 16 * SVB)); }
                    __builtin_amdgcn_sched_barrier(0);
#pragma unroll
                    for (int dt = 0; dt < 4; ++dt) acc[dt] = __builtin_amdgcn_mfma_f32_16x16x32_f16(A4[dt], Pf[ks], acc[dt], 0, 0, 0);
                    __builtin_amdgcn_sched_barrier(0);
                }
            }
            const int tF_ = my_tid(wv); const unsigned rowF = (unsigned)(tF_ >> 3), roF = rowF * 4096u + (unsigned)(tF_ & 7) * 32u, loF = rowF * (unsigned)OT_PITCH + (unsigned)(tF_ & 7) * 32u;
            if (fusedgn && n > 0) { P8_GATE(n - 1, roF); if (wid == 0) { P8_XSLD(n - 1, lO0); } }
            if (!fusedgn) {
#pragma unroll
                for (int dt = 0; dt < 4; ++dt) *(h16x4*)((char*)(vg + (size_t)n * 64 * 2048) + (oO + (unsigned)(32 * dt))) = pack4(acc[dt]);
            } else {
                float s1 = 0.f, s2 = 0.f;
#pragma unroll
                for (int dt = 0; dt < 4; ++dt)
#pragma unroll
                    for (int e = 0; e < 4; ++e) { s1 += acc[dt][e]; s2 = fmaf(acc[dt][e], acc[dt][e], s2); }
                s1 = fq_sum(s1); s2 = fq_sum(s2);
                const int tk = (int)(oO >> 12);
                if ((oO & 24u) == 0u) PS[dh * 64 + tk] = (f32x2){s1, s2};
                { lch* wp_ = OT + (n & 1) * OT_BYTES + (unsigned)tk * (unsigned)OT_PITCH + (oO & 4095u);
#pragma unroll
                  for (int dt = 0; dt < 4; ++dt) *(lh16x4*)(wp_ + 32 * dt) = pack4(acc[dt]); }
            }
#pragma unroll
            for (int s = 0; s < 8; ++s) Qn[s] = *(const h16x8*)((const char*)(RQ + ((size_t)b * L + (size_t)nn * 64) * 1024 + h * 256) + (qO + (unsigned)(64 * s)));
            h16x8 Bv[2];
#pragma unroll
            for (int ks = 0; ks < 2; ++ks) { const lch* vp = Vc + (32 * ks + 8 * gO + q4O) * SVB + (16 * wid + 4 * p4O) * 2;
                const h16x8 zf = *(const lh16x8*)((const lch*)ZT + (32 * ks + 8 * gO) * 2);
                Bv[ks] = cat8(trrd(vp), trrd(vp + 4 * SVB)) * zf; }
#pragma unroll
            for (int d4 = 0; d4 < 16; d4 += 2) {
                h16x8 A4[4];
#pragma unroll
                for (int j = 0; j < 2; ++j)
#pragma unroll
                    for (int ks = 0; ks < 2; ++ks) { const lch* kp = Kc + (32 * ks + 8 * gO + q4O) * SKB + (16 * (d4 + j) + 4 * p4O) * 2; A4[j * 2 + ks] = cat8(trrd(kp), trrd(kp + 4 * SKB)); }
#pragma unroll
                for (int j = 0; j < 2; ++j) state[d4 + j] = state[d4 + j] * gamma64;
                __builtin_amdgcn_sched_barrier(0);
#pragma unroll
                for (int ks = 0; ks < 2; ++ks)
#pragma unroll
                    for (int j = 0; j < 2; ++j) state[d4 + j] = __builtin_amdgcn_mfma_f32_16x16x32_f16(A4[j * 2 + ks], Bv[ks], state[d4 + j], 0, 0, 0);
                __builtin_amdgcn_sched_barrier(0);
            }
            if (fusedgn && n > 0 && wid == 0) { P8_STATS(n - 1); }
            __syncthreads();
            if (fusedgn && n > 0) { P8_FINAL(n - 1, rowF, roF, loF); }
            if (fusedgn && wid == 0) {
                int lO = lane; asm volatile("" : "+v"(lO));
                const f32x2 pa = PS[lO], pb = PS[64 + lO];
                const unsigned long long pk = (unsigned long long)__float_as_uint(pa[0] + pb[0]) | ((unsigned long long)__float_as_uint(pa[1] + pb[1]) << 32);
                __hip_atomic_store((unsigned long long*)((char*)(XS + ((size_t)(grp0 + n) * 4 + sl) * 64) + (unsigned)(lO * 8)), pk, __ATOMIC_RELAXED, __HIP_MEMORY_SCOPE_AGENT);
            }
#pragma unroll
            for (int dkt = 0; dkt < 16; ++dkt) *(lh16x4*)(St + (16 * wid + c16) * SSB + (16 * dkt + 4 * g) * 2) = pack4(state[dkt]);
#pragma unroll
            for (int i = 0; i < 4; ++i) { const int c = tid + NTHREADS * i; *(lh16x8*)(Kc + (c >> 5) * SKB + (c & 31) * 16) = kreg[i]; }
#pragma unroll
            for (int i = 0; i < 2; ++i) { const int c = tid + NTHREADS * i; *(lh16x8*)(Vc + (c >> 4) * SVB + (c & 15) * 16) = vreg[i]; }
            __syncthreads();
        }
        if (fusedgn) {
            const int tF_ = my_tid(wv); const unsigned rowF = (unsigned)(tF_ >> 3), roF = rowF * 4096u + (unsigned)(tF_ & 7) * 32u, loF = rowF * (unsigned)OT_PITCH + (unsigned)(tF_ & 7) * 32u;
            unsigned long long xsv[4] = {0ull, 0ull, 0ull, 0ull}; int lO0 = lane; asm volatile("" : "+v"(lO0)); P8_GATE(L / 64 - 1, roF);
            if (wid == 0) { P8_XSLD(L / 64 - 1, lO0); P8_STATS(L / 64 - 1); }
            __syncthreads();
            P8_FINAL(L / 64 - 1, rowF, roF, loF);
        }
    }
#undef P8_FINAL
#undef P8_STATS
#undef P8_XSLD
#undef P8_GATE
#undef P8_WAIT
#undef P8_XSOK
}

__device__ __forceinline__ void p9_gnorm(const Params& P, int blk, int nblk, int wv) {
    const int tid = my_tid(wv), wid = tid >> 6, lane = tid & 63;
    unsigned char* ws = opaque_ptr(P.ws);
    h16* RO = (h16*)(ws + WS_R4); const h16* RG = (const h16*)(ws + WS_RG);
    const int gw = blk * NWAVES + wid, ngw = nblk * NWAVES;
    for (int t0 = gw; t0 < T; t0 += 2 * ngw) {
        h16x8 xv[2][4], gv[2][4];
#pragma unroll
        for (int k = 0; k < 2; ++k) { const int t = (t0 + k * ngw < T) ? t0 + k * ngw : t0;
#pragma unroll
            for (int h = 0; h < 4; ++h) { const size_t o = (size_t)t * 2048 + h * 512 + lane * 8; xv[k][h] = *(const h16x8*)(RO + o); gv[k][h] = *(const h16x8*)(RG + o); } }
#pragma unroll
        for (int k = 0; k < 2; ++k) { const int t = t0 + k * ngw;
#pragma unroll
            for (int h = 0; h < 4; ++h) {
                float v[8]; float s = 0.f;
#pragma unroll
                for (int e = 0; e < 8; ++e) { v[e] = (float)xv[k][h][e]; s += v[e]; }
                const float mu = wave_sum_dpp(s) * (1.0f / 512.0f); float q = 0.f;
#pragma unroll
                for (int e = 0; e < 8; ++e) { v[e] -= mu; q += v[e] * v[e]; }
                const float rstd = rsqrtf(wave_sum_dpp(q) * (1.0f / 512.0f) + EPS);
                h16x8 y;
#pragma unroll
                for (int e = 0; e < 8; ++e) y[e] = (h16)(v[e] * rstd * (float)gv[k][h][e]);
                if (t < T) *(h16x8*)(RO + (size_t)t * 2048 + h * 512 + lane * 8) = y;
            } }
    }
}

__device__ __forceinline__ void p12_final(const Params& P, int blk, int nblk, int wv) {
    const int tid = my_tid(wv), wid = tid >> 6, lane = tid & 63;
    unsigned char* ws = opaque_ptr(P.ws);
    const float* sq = (const float*)(ws + WS_SQH) + (size_t)3 * T * 16; const f32x4* g4 = (const f32x4*)P.in[18]; const h16* H4 = (const h16*)(ws + WS_R1);
    const int gw = blk * NWAVES + wid, ngw = nblk * NWAVES;
    for (int r0 = gw; r0 < T; r0 += 4 * ngw) {
        h16x8 hv[4][2]; f32x4 qv[4][4];
#pragma unroll
        for (int k = 0; k < 4; ++k) { const int r = r0 + k * ngw; if (r < T) {
#pragma unroll
            for (int j = 0; j < 2; ++j) hv[k][j] = *(const h16x8*)(H4 + (size_t)r * 1024 + (lane + 64 * j) * 8);
#pragma unroll
            for (int j = 0; j < 4; ++j) qv[k][j] = ((const f32x4*)(sq + (size_t)r * 16))[j]; } }
#pragma unroll
        for (int k = 0; k < 4; ++k) { const int r = r0 + k * ngw; if (r < T) {
            float s = 0.f;
#pragma unroll
            for (int j = 0; j < 4; ++j) s += (qv[k][j][0] + qv[k][j][1]) + (qv[k][j][2] + qv[k][j][3]);
            const float rstd = rsqrtf(s * (1.0f / 1024.0f) + EPS);
            f32x4* orow = (f32x4*)(P.out + (size_t)r * 1024);
#pragma unroll
            for (int j = 0; j < 2; ++j) { const int c4 = (lane + 64 * j) * 2; const f32x4 ga = g4[c4], gb = g4[c4 + 1]; f32x4 a, b2;
#pragma unroll
                for (int e = 0; e < 4; ++e) { a[e] = (float)hv[k][j][e] * rstd * ga[e]; b2[e] = (float)hv[k][j][4 + e] * rstd * gb[e]; }
                orow[c4] = a; orow[c4 + 1] = b2; } } }
    }
}

#define XB_TMO      128
#define XB_XCNT(j)  (256  + 64 * (j))
#define XB_XSUB(j)  (1280 + 64 * (j))
#define XB_XGEN(j)  (2304 + 64 * (j))
#define XB_TOP      3328
#define XB_TOPGEN   3392
#define XCD_BAR_WORDS 3456
#define XB_SPIN_CAP (1u << 18)
__device__ __forceinline__ unsigned xb_ld(unsigned* p)              { return __hip_atomic_load(p, __ATOMIC_RELAXED, __HIP_MEMORY_SCOPE_AGENT); }
__device__ __forceinline__ unsigned xb_add(unsigned* p, unsigned v) { return __hip_atomic_fetch_add(p, v, __ATOMIC_RELAXED, __HIP_MEMORY_SCOPE_AGENT); }
__device__ __forceinline__ unsigned xb_xcc_id() { return (unsigned)__builtin_amdgcn_s_getreg((3 << 11) | 20) & 0xFu; }
#define XB_SPIN(cond, bar) do { unsigned _sp = 0; while (cond) { __builtin_amdgcn_s_sleep(1); \
    if ((++_sp & 255u) == 0u) { if (xb_ld(&(bar)[XB_TMO])) break; if (_sp > XB_SPIN_CAP) { atomicAdd(&(bar)[XB_TMO], 1u); break; } } } } while (0)
typedef volatile __attribute__((address_space(3))) unsigned lvu32;
__device__ __forceinline__ void xcd_barrier_complete(unsigned* bar, unsigned x, unsigned G, unsigned& nloc, unsigned& nx) {
    unsigned sum, cnt, mine, sp = 0u;
    for (;;) {
        sum = 0u; cnt = 0u; mine = 0u;
#pragma unroll
        for (unsigned j = 0; j < 16; ++j) { const unsigned c = xb_ld(&bar[XB_XCNT(j)]); sum += c; cnt += (c > 0u) ? 1u : 0u; mine = (j == x) ? c : mine; }
        if (sum == G) break;
        __builtin_amdgcn_s_sleep(1);
        if ((++sp & 255u) == 0u) { if (xb_ld(&bar[XB_TMO])) break; if (sp > XB_SPIN_CAP) { atomicAdd(&bar[XB_TMO], 1u); break; } }
    }
    nloc = mine > 0u ? mine : 1u; nx = cnt > 0u ? cnt : 1u;
}
__device__ __forceinline__ void xcd_barrier(unsigned* bar_, unsigned x_, lvu32* st, unsigned G, int wv) {
    unsigned x = x_; asm volatile("" : "+s"(x));
    unsigned* bar = opaque_ptr(bar_);
    asm volatile("s_waitcnt vmcnt(0)" ::: "memory");
    __syncthreads();
    if (my_tid(wv) == 0) {
        __builtin_amdgcn_s_waitcnt(0);
        unsigned nloc = st[0], nx = st[1];
        if (nloc == 0u) { xcd_barrier_complete(bar, x, G, nloc, nx); st[0] = nloc; st[1] = nx; }
        const unsigned old = xb_add(&bar[XB_XSUB(x)], 1u);
        const unsigned gen = old / nloc;
        if (old + 1u == (gen + 1u) * nloc) {
            __builtin_amdgcn_fence(__ATOMIC_RELEASE, "agent");
            asm volatile("s_waitcnt vmcnt(0)" ::: "memory");
            const unsigned og = xb_add(&bar[XB_TOP], 1u);
            const unsigned tg = og / nx;
            if (og + 1u == (tg + 1u) * nx) xb_add(&bar[XB_TOPGEN], 1u);
            else XB_SPIN(xb_ld(&bar[XB_TOPGEN]) == tg, bar);
            __builtin_amdgcn_fence(__ATOMIC_ACQUIRE, "agent");
            xb_add(&bar[XB_XGEN(x)], 1u);
            asm volatile("s_waitcnt vmcnt(0)" ::: "memory");
        } else {
            XB_SPIN(xb_ld(&bar[XB_XGEN(x)]) == gen, bar);
            __builtin_amdgcn_fence(__ATOMIC_ACQUIRE, "agent");
            asm volatile("s_waitcnt vmcnt(0)" ::: "memory");
        }
    }
    __syncthreads();
}

__device__ __forceinline__ void run_gemm_job(const Params& P, unsigned char* lds, int ph, int j, int blk, int nblk, int wv) {
    unsigned char* ws = opaque_ptr(P.ws);
    float* SQKV = (float*)(ws + WS_SQKV); float* SQQ = (float*)(ws + WS_SQQ); float* SQH = (float*)(ws + WS_SQH);
    int kind = 0; Gemm g; g.M = T; g.A = nullptr; g.Bt = nullptr; g.lda = g.ldb = g.N = g.K = 0;
    h16 *h0 = nullptr, *h1 = nullptr; const h16* ch0 = nullptr; const h16* ch1 = nullptr; const float* cf0 = nullptr; float* f0 = nullptr; float* f1 = nullptr; int i0 = 0, i1 = 0, i2 = 0, i3 = 0, i4 = 0; float x0 = 0.f;
    if (ph == 1) { kind = 0; g.A = (const h16*)(ws + WS_R1); g.Bt = (const h16*)(ws + WS_WAIN); g.lda = 1024; g.ldb = 1024; g.N = 1792; g.K = 1024; }
    else if (ph == 2) {
        kind = 1;
        if (j == 0) { g.A = (const h16*)(ws + WS_CQX); g.Bt = (const h16*)(ws + WS_WQ); g.lda = 512; g.ldb = 384; g.N = 1536; g.K = 384;
                      cf0 = SQQ; i0 = 8; x0 = 1.0f / 384.0f; h0 = (h16*)(ws + WS_R1); h1 = (h16*)(ws + WS_QIDX); i1 = 1024; i2 = 512; i3 = 1; i4 = 0; }
        else if (j == 1) { g.A = (const h16*)(ws + WS_CKV); g.Bt = (const h16*)(ws + WS_WKV); g.lda = 256; g.ldb = 256; g.N = 2048; g.K = 256;
                      cf0 = SQKV; i0 = 4; x0 = 1.0f / 256.0f; h0 = (h16*)(ws + WS_R2); h1 = (h16*)(ws + WS_R3); i1 = 1024; i2 = 1024; i3 = 1; i4 = 1; }
        else { g.A = (const h16*)(ws + WS_PH0); g.Bt = (const h16*)(ws + WS_WPLE); g.lda = 256; g.ldb = 256; g.N = 1024; g.K = 256;
                      cf0 = nullptr; i0 = 0; x0 = 0.f; h0 = (h16*)(ws + WS_R5); h1 = nullptr; i1 = 1024; i2 = 1024; }
    }
    else if (ph == 5) { kind = 2; g.A = (const h16*)(ws + WS_AO); g.Bt = (const h16*)(ws + WS_WAOUT); g.lda = 1024; g.ldb = 1024; g.N = 1024; g.K = 1024;
                      cf0 = P.in[0]; ch0 = nullptr; h0 = (h16*)(ws + WS_R2); f1 = SQH; }
    else if (ph == 6) { kind = 3; g.A = (const h16*)(ws + WS_R2); g.Bt = (const h16*)(ws + WS_WPG); g.lda = 1024; g.ldb = 1024; g.N = 1024; g.K = 1024;
                      ch1 = (const h16*)(ws + WS_R2); ch0 = (const h16*)(ws + WS_R5); h0 = (h16*)(ws + WS_R3); cf0 = SQH; f1 = SQH + (size_t)T * 16; }
    else if (ph == 7) { kind = 4; g.A = (const h16*)(ws + WS_R3); g.Bt = (const h16*)(ws + WS_WRIN); g.lda = 1024; g.ldb = 1024; g.N = 6144; g.K = 1024; }
    else if (ph == 10) {
        if (j == 0) { kind = 2; g.A = (const h16*)(ws + WS_R4); g.Bt = (const h16*)(ws + WS_WROUT); g.lda = 2048; g.ldb = 2048; g.N = 1024; g.K = 2048;
                      cf0 = nullptr; ch0 = (const h16*)(ws + WS_R3); h0 = (h16*)(ws + WS_R2); f1 = SQH + (size_t)2 * T * 16; }
        else { kind = 1; g.A = (const h16*)(ws + WS_PH1); g.Bt = (const h16*)(ws + WS_WPLE) + (size_t)1024 * 256; g.lda = 256; g.ldb = 256; g.N = 1024; g.K = 256;
                      cf0 = nullptr; i0 = 0; x0 = 0.f; h0 = (h16*)(ws + WS_R1); h1 = nullptr; i1 = 1024; i2 = 1024; }
    }
    else { kind = 5; g.A = (const h16*)(ws + WS_R2); g.Bt = (const h16*)(ws + WS_WPG) + (size_t)1024 * 1024; g.lda = 1024; g.ldb = 1024; g.N = 1024; g.K = 1024;
                      ch1 = (const h16*)(ws + WS_R2); ch0 = (const h16*)(ws + WS_R1); h0 = (h16*)(ws + WS_R1); cf0 = SQH + (size_t)2 * T * 16; f1 = SQH + (size_t)3 * T * 16; }
    switch (kind) {
        case 0: { EpiInA E{(h16*)(ws + WS_CKV), (h16*)(ws + WS_CQX), (h16*)(ws + WS_R4), SQKV, SQQ, nullptr, 0, 0.f}; gemm_run(lds, g, E, blk, nblk, wv); break; }
        case 1: { EpiScale E{cf0, i0, x0, h0, h1, 4, i1, i2, i3, i4}; gemm_run(lds, g, E, blk, nblk, wv); break; }
        case 2: { EpiRes E{cf0, ch0, h0, f1, nullptr, 0, 0.f}; gemm_run(lds, g, E, blk, nblk, wv); break; }
        case 3: { EpiPle E{ch1, ch0, h0, cf0, f1, 16, 1.0f / 1024.0f}; gemm_run(lds, g, E, blk, nblk, wv); break; }
        case 5: { EpiPleFinal E{ch1, ch0, cf0, 16, 1.0f / 1024.0f, P.in[18], P.out, (unsigned*)(SQH + (size_t)3 * T * 16), (unsigned*)(ws + WS_BAR + 16384), (unsigned*)(ws + WS_BAR) + XB_TMO}; gemm_run(lds, g, E, blk, nblk, wv); break; }
        default: { EpiInR E{SQH + (size_t)T * 16, (const f32x2*)(ws + WS_SINCOS), (h16*)(ws + WS_R1), (h16*)(ws + WS_R2), (h16*)(ws + WS_R4), (h16*)(ws + WS_RG), 16, 1.0f / 1024.0f}; gemm_run(lds, g, E, blk, nblk, wv); break; }
    }
}

__global__ void __launch_bounds__(NTHREADS, 2) mk_fwd(Params P_) {
    extern __shared__ __attribute__((aligned(16))) unsigned char lds[];
    cg::grid_group grid = cg::this_grid();
    const int wv = __builtin_amdgcn_readfirstlane((int)(threadIdx.x >> 6));
    lvu32* bst = (lvu32*)(lds + LDS_BYTES - 16);
    unsigned* bar = (unsigned*)(P_.ws + WS_BAR);
    const unsigned xcc = xb_xcc_id();
    if (threadIdx.x == 0) { bst[0] = 0u; bst[1] = 0u; if (P_.ph_hi - P_.ph_lo > 1) (void)xb_add(&bar[XB_XCNT(xcc)], 1u); }
    __syncthreads();
    int dup_cnt = 0; (void)dup_cnt;
    const int blk_k = blockIdx.x, nblk_k = gridDim.x; const int ph_lo = P_.ph_lo, ph_hi = P_.ph_hi;
    for (int ph = ph_lo; ph < ph_hi; ++ph) {
        int blk = blk_k, nblk = nblk_k; asm volatile("" : "+s"(blk), "+s"(nblk));
        const Params& P = P_;
        if (ph == 0) p0_prologue(P, lds, blk, nblk, wv, 0);
        else if (ph == 3) p3_indexer(P, lds, blk, nblk, wv);
        else if (ph == 4) p4_attn(P, lds, blk, nblk, wv);
        else if (ph == 8) p8_retention(P, lds, blk, nblk, wv);
        else if (ph == 9) { if (nblk != 256) p9_gnorm(P, blk, nblk, wv); }
        else {
            if (ph == 2) p2_kidx(P, blk, nblk, wv);
            if (ph == 5) {
                unsigned ones = ~0u; asm volatile("" : "+v"(ones)); u32x4* xs_ = (u32x4*)(opaque_ptr(P.ws) + WS_KIDXN);
                for (int i = blk * NTHREADS + my_tid(wv); i < (4 << 20) / 16; i += nblk * NTHREADS) xs_[i] = (u32x4){ones, ones, ones, ones};
            }
            const int nj = (ph == 2) ? 3 : (ph == 10) ? 2 : 1;
            for (int j = 0; j < nj; ++j) run_gemm_job(P, lds, ph, j, blk, nblk, wv);
            if (ph == 1) p0_prologue(P, lds, blk, nblk, wv, 1);
        }
        if (ph + 1 < ph_hi && !(ph == 8 && nblk == 256)) { if (ph_hi < 0) grid.sync(); else xcd_barrier(bar, xcc, bst, (unsigned)nblk, wv); }
#if MK_DUP_MASK
        if (((MK_DUP_MASK >> ph) & 1) && dup_cnt < MK_DUP_N) { ++dup_cnt; --ph; } else dup_cnt = 0;
#endif
    }
}

#ifndef MK_FUSED
#define MK_FUSED 1
#endif
extern "C" void kernel_launch(void* const* d_in, const int* in_sizes, int n_in, void* d_out, int out_size, void* d_ws, size_t ws_size, hipStream_t stream) {
    static int grid = 0;
    if (grid == 0) {
        if (n_in != 19 || out_size != T * D || ws_size < WS_END) { fprintf(stderr, "kernel_launch: unexpected shapes (n_in %d, out %d, ws %zu)\n", n_in, out_size, ws_size); grid = -1; return; }
        int dev = 0, cus = 0, per_cu = 0;
        hipGetDevice(&dev);
        hipDeviceGetAttribute(&cus, hipDeviceAttributeMultiprocessorCount, dev);
        if (hipFuncSetAttribute((const void*)mk_fwd, hipFuncAttributeMaxDynamicSharedMemorySize, LDS_BYTES) != hipSuccess) { fprintf(stderr, "kernel_launch: hipFuncSetAttribute failed\n"); grid = -1; return; }
        hipOccupancyMaxActiveBlocksPerMultiprocessor(&per_cu, (const void*)mk_fwd, NTHREADS, LDS_BYTES);
        if (per_cu < 1) { fprintf(stderr, "kernel_launch: occupancy query says %d blocks per CU\n", per_cu); grid = -1; return; }
        grid = cus * 1;
    }
    if (grid < 0) return;
    (void)hipMemsetAsync((char*)d_ws + WS_BAR, 0, 16384 + 32768, stream);
    Params P{};
    for (int i = 0; i < 19; ++i) P.in[i] = (const float*)d_in[i];
    P.out = (float*)d_out; P.ws = (unsigned char*)d_ws;
#if MK_FUSED
    P.ph_lo = 0; P.ph_hi = NPH;
    void* args[] = {&P};
    hipError_t e = hipLaunchCooperativeKernel((const void*)mk_fwd, dim3(grid), dim3(NTHREADS), args, LDS_BYTES, stream);
    if (e != hipSuccess) fprintf(stderr, "cooperative launch failed: %s (grid %d)\n", hipGetErrorString(e), grid);
#else
    for (int ph = 0; ph < NPH; ++ph) {
        P.ph_lo = ph; P.ph_hi = ph + 1;
        hipLaunchKernelGGL(mk_fwd, dim3(grid), dim3(NTHREADS), LDS_BYTES, stream, P);
    }
#endif
}
```
